# Optimizing an MI355X kernel written in HIP

```python
import math
import jax
import jax.numpy as jnp
from jax import lax

D_MODEL = 1024
BATCH = 32
SEQ = 2048
DEPTH = 4

N_MIXERS = 4
HEAD_DIM = 64
BLOCK = 128
RMS_EPS = 1e-6
NUM_BUCKETS = 32
MAX_DISTANCE = 2048
N_BIAS_HEADS = 16
DIL_GROUPS = ((128, 1), (512, 4), (2048, 16))
N_DIL = 3
A_HEADS = 8
MLA_HEADS = 16
MLA_NOPE = 64
MLA_ROPE = 32
MLA_QK = 96
MLA_V = 64
MLA_Q_RANK = 384
MLA_KV_RANK = 256
ROPE_THETA = 10000.0
DIFF_HEADS = 8
SWA_Q_HEADS = 16
SWA_KV_HEADS = 2
SWA_WINDOW = 128
D_FF = 2816
CONV_WIDTH = 3
N_A = (DEPTH + 3) // 4
N_B = (DEPTH + 2) // 4
N_C = (DEPTH + 1) // 4
N_D = DEPTH // 4

kernel_name = "hybrid_interleaved_dilated_mla_diff_swa_convffn"


def rms_norm(x, g):
    xf = x.astype(jnp.float32)
    y = xf * lax.rsqrt(jnp.mean(xf * xf, axis=-1, keepdims=True) + RMS_EPS)
    return (y * g.astype(jnp.float32)).astype(x.dtype)


def t5_bucket(dist):
    max_exact = NUM_BUCKETS // 2
    d_f = jnp.maximum(dist, 1).astype(jnp.float32)
    large = max_exact + (jnp.log(d_f / max_exact) / math.log(MAX_DISTANCE / max_exact)
                         * (NUM_BUCKETS - max_exact)).astype(jnp.int32)
    return jnp.where(dist < max_exact, dist, jnp.minimum(large, NUM_BUCKETS - 1))


def band_bias(table_cols, dilation):
    offset = jnp.arange(BLOCK)[:, None] + BLOCK - jnp.arange(2 * BLOCK)[None, :]
    bucket = t5_bucket(jnp.maximum(offset, 0) * dilation)
    return table_cols.T[:, bucket].astype(jnp.float32)


def banded_attention(q, k, v, bias, window, sinks=None):
    n, L, hq, dh = q.shape
    hk = k.shape[2]
    g = hq // hk
    nb = -(-L // BLOCK)
    pad = nb * BLOCK - L
    padl = lambda a: jnp.pad(a, ((0, 0), (0, pad), (0, 0), (0, 0)))
    q, k, v = padl(q), padl(k), padl(v)
    qb = q.reshape(n, nb, BLOCK, hk, g, dh)

    def pairs(a):
        cur = a.reshape(n, nb, BLOCK, hk, dh)
        prev = jnp.pad(cur, ((0, 0), (1, 0), (0, 0), (0, 0), (0, 0)))[:, :-1]
        return jnp.concatenate([prev, cur], axis=2)

    kb, vb = pairs(k), pairs(v)
    kj = jnp.arange(2 * BLOCK)
    offset = jnp.arange(BLOCK)[:, None] + BLOCK - kj[None, :]
    key_pos = jnp.arange(nb)[:, None, None] * BLOCK + kj[None, None, :] - BLOCK
    mask = (offset >= 0) & (offset <= window) & (key_pos >= 0)
    logits = jnp.einsum('nbqhgd,nbkhd->nbhgqk', qb, kb, preferred_element_type=jnp.float32) * (dh ** -0.5)
    logits = logits + bias.reshape(hk, g, BLOCK, 2 * BLOCK)
    logits = jnp.where(mask[None, :, None, None], logits, -jnp.inf)
    m = jnp.max(logits, axis=-1)
    if sinks is not None:
        sk = sinks.astype(jnp.float32).reshape(hk, g, 1)
        m = jnp.maximum(m, sk)
    p = jnp.exp(logits - m[..., None])
    s = jnp.sum(p, axis=-1)
    if sinks is not None:
        s = s + jnp.exp(sk - m)
    o = jnp.einsum('nbhgqk,nbkhd->nbqhgd', p, vb.astype(jnp.float32))
    o = o / s.transpose(0, 1, 4, 2, 3)[..., None]
    o = o.reshape(n, nb * BLOCK, hq, dh)[:, :L]
    lse = (m + jnp.log(s)).transpose(0, 1, 4, 2, 3).reshape(n, nb * BLOCK, hq)[:, :L]
    return o, lse


def dilated_attention(h, w_in, q_norm, k_norm, w_out, table):
    b, s, _ = h.shape
    qkv = (h @ w_in).reshape(b, s, N_DIL, 3, A_HEADS, HEAD_DIM)
    outs, lses = [], []
    for gi, (window, dil) in enumerate(DIL_GROUPS):
        q = rms_norm(qkv[:, :, gi, 0], q_norm[gi])
        k = rms_norm(qkv[:, :, gi, 1], k_norm[gi])
        v = qkv[:, :, gi, 2]
        to_res = lambda a: a.reshape(b, s // dil, dil, A_HEADS, HEAD_DIM).transpose(0, 2, 1, 3, 4).reshape(
            b * dil, s // dil, A_HEADS, HEAD_DIM)
        o, lse = banded_attention(to_res(q), to_res(k), to_res(v), band_bias(table[:, :A_HEADS], dil), window // dil)
        outs.append(o.reshape(b, dil, s // dil, A_HEADS, HEAD_DIM).transpose(0, 2, 1, 3, 4).reshape(
            b, s, A_HEADS, HEAD_DIM))
        lses.append(lse.reshape(b, dil, s // dil, A_HEADS).transpose(0, 2, 1, 3).reshape(b, s, A_HEADS))
    alpha = jax.nn.softmax(jnp.stack(lses, axis=0), axis=0)
    o = jnp.sum(alpha[..., None] * jnp.stack(outs, axis=0), axis=0)
    return o.reshape(b, s, A_HEADS * HEAD_DIM).astype(h.dtype) @ w_out


def apply_rope(x, s):
    inv_freq = ROPE_THETA ** (-jnp.arange(0, MLA_ROPE, 2, dtype=jnp.float32) / MLA_ROPE)
    ang = jnp.arange(s, dtype=jnp.float32)[:, None] * inv_freq[None, :]
    cos, sin = jnp.cos(ang)[:, None, :], jnp.sin(ang)[:, None, :]
    xf = x.astype(jnp.float32)
    x1, x2 = xf[..., :MLA_ROPE // 2], xf[..., MLA_ROPE // 2:]
    return jnp.concatenate([x1 * cos - x2 * sin, x2 * cos + x1 * sin], axis=-1).astype(x.dtype)


def mla_attention(h, w_in, q_a_norm, kv_a_norm, w_q_up, w_kv_up, q_norm, k_norm, w_out):
    b, s, _ = h.shape
    lat = h @ w_in
    c_q = lat[..., :MLA_Q_RANK]
    c_kv = lat[..., MLA_Q_RANK:MLA_Q_RANK + MLA_KV_RANK]
    k_pe = lat[..., MLA_Q_RANK + MLA_KV_RANK:]
    q = (rms_norm(c_q, q_a_norm) @ w_q_up).reshape(b, s, MLA_HEADS, MLA_QK)
    kv = (rms_norm(c_kv, kv_a_norm) @ w_kv_up).reshape(b, s, MLA_HEADS, MLA_NOPE + MLA_V)
    v = kv[..., MLA_NOPE:]
    k = jnp.concatenate([kv[..., :MLA_NOPE], jnp.broadcast_to(k_pe[:, :, None, :], (b, s, MLA_HEADS, MLA_ROPE))], axis=-1)
    q = rms_norm(q, q_norm)
    k = rms_norm(k, k_norm)
    q = jnp.concatenate([q[..., :MLA_NOPE], apply_rope(q[..., MLA_NOPE:], s)], axis=-1)
    k = jnp.concatenate([k[..., :MLA_NOPE], apply_rope(k[..., MLA_NOPE:], s)], axis=-1)
    nb = s // BLOCK
    qb = q.reshape(b, nb, BLOCK, MLA_HEADS, MLA_QK).transpose(1, 0, 2, 3, 4)
    kpos = jnp.arange(s)
    vf = v.astype(jnp.float32)

    def block(args):
        q_blk, i = args
        qpos = i * BLOCK + jnp.arange(BLOCK)
        logits = jnp.einsum('bqhd,bkhd->bhqk', q_blk, k, preferred_element_type=jnp.float32) * (MLA_QK ** -0.5)
        logits = jnp.where(kpos[None, :] <= qpos[:, None], logits, -jnp.inf)
        p = jax.nn.softmax(logits, axis=-1)
        return jnp.einsum('bhqk,bkhd->bqhd', p, vf)

    o = lax.map(block, (qb, jnp.arange(nb)))
    o = o.transpose(1, 0, 2, 3, 4).reshape(b, s, MLA_HEADS * MLA_V)
    return o.astype(h.dtype) @ w_out


def diff_attention(h, w_in, q_norm, k_norm, lq1, lk1, lq2, lk2, subln, w_out, table, layer_idx):
    b, s, _ = h.shape
    qk_w = DIFF_HEADS * 2 * HEAD_DIM
    proj = h @ w_in
    q = rms_norm(proj[..., :qk_w].reshape(b, s, DIFF_HEADS, 2, HEAD_DIM), q_norm)
    k = rms_norm(proj[..., qk_w:2 * qk_w].reshape(b, s, DIFF_HEADS, 2, HEAD_DIM), k_norm)
    vf = proj[..., 2 * qk_w:].reshape(b, s, DIFF_HEADS, 2 * HEAD_DIM).astype(jnp.float32)
    lam_init = 0.8 - 0.6 * math.exp(-0.3 * layer_idx)
    f32 = lambda a: a.astype(jnp.float32)
    lam = jnp.exp(jnp.sum(f32(lq1) * f32(lk1))) - jnp.exp(jnp.sum(f32(lq2) * f32(lk2))) + lam_init
    tab = table[:, :2 * DIFF_HEADS].T.reshape(2, DIFF_HEADS, NUM_BUCKETS).transpose(1, 0, 2).astype(jnp.float32)
    nb = s // BLOCK
    qb = q.reshape(b, nb, BLOCK, DIFF_HEADS, 2, HEAD_DIM).transpose(1, 0, 2, 3, 4, 5)
    kpos = jnp.arange(s)

    def block(args):
        q_blk, i = args
        qpos = i * BLOCK + jnp.arange(BLOCK)
        dist = qpos[:, None] - kpos[None, :]
        bias = tab[:, :, t5_bucket(jnp.maximum(dist, 0))]
        logits = jnp.einsum('bqhmd,bkhmd->bhmqk', q_blk, k, preferred_element_type=jnp.float32) * (HEAD_DIM ** -0.5)
        logits = jnp.where(dist >= 0, logits + bias, -jnp.inf)
        p = jax.nn.softmax(logits, axis=-1)
        a = p[:, :, 0] - lam * p[:, :, 1]
        return jnp.einsum('bhqk,bkhe->bqhe', a, vf)

    o = lax.map(block, (qb, jnp.arange(nb)))
    o = o.transpose(1, 0, 2, 3, 4).reshape(b, s, DIFF_HEADS, 2 * HEAD_DIM)
    o = rms_norm(o, subln) * (1.0 - lam_init)
    return o.reshape(b, s, DIFF_HEADS * 2 * HEAD_DIM).astype(h.dtype) @ w_out


def swa_sink_attention(h, w_in, q_norm, k_norm, sinks, w_out, table):
    b, s, _ = h.shape
    qw, kw = SWA_Q_HEADS * HEAD_DIM, SWA_KV_HEADS * HEAD_DIM
    proj = h @ w_in
    q = rms_norm(proj[..., :qw].reshape(b, s, SWA_Q_HEADS, HEAD_DIM), q_norm)
    k = rms_norm(proj[..., qw:qw + kw].reshape(b, s, SWA_KV_HEADS, HEAD_DIM), k_norm)
    v = proj[..., qw + kw:].reshape(b, s, SWA_KV_HEADS, HEAD_DIM)
    o, _ = banded_attention(q, k, v, band_bias(table[:, :SWA_Q_HEADS], 1), SWA_WINDOW - 1, sinks)
    return o.reshape(b, s, qw).astype(h.dtype) @ w_out


def conv_ffn(h, w_up, conv_w, conv_b, w_down):
    s = h.shape[1]
    gu = h @ w_up
    gate, up = gu[..., :D_FF], gu[..., D_FF:]
    gp = jnp.pad(gate, ((0, 0), (CONV_WIDTH - 1, 0), (0, 0)))
    conv = conv_b + conv_w[CONV_WIDTH - 1] * gate
    for j in range(CONV_WIDTH - 1):
        conv = conv + conv_w[j] * gp[:, j:j + s]
    return (jax.nn.silu(conv) * up) @ w_down


def setup_inputs(seed: int = 0) -> dict:
    key = jax.random.key(seed)
    ks = iter(jax.random.split(key, 40))
    nrm = lambda shape, scale: jax.random.normal(next(ks), shape, jnp.float32) * scale
    w = lambda shape: nrm(shape, shape[-2] ** -0.5)
    gain = lambda shape: 1.0 + nrm(shape, 0.02)
    return {
        "x": nrm((BATCH, SEQ, D_MODEL), 1.0),
        "rel_bias_table": nrm((NUM_BUCKETS, N_BIAS_HEADS), 0.2),
        "norm_mix": gain((DEPTH, D_MODEL)),
        "norm_ffn": gain((DEPTH, D_MODEL)),
        "a_w_in": w((N_A, D_MODEL, N_DIL * 3 * A_HEADS * HEAD_DIM)),
        "a_q_norm": gain((N_A, N_DIL, HEAD_DIM)),
        "a_k_norm": gain((N_A, N_DIL, HEAD_DIM)),
        "a_w_out": w((N_A, A_HEADS * HEAD_DIM, D_MODEL)),
        "b_w_in": w((N_B, D_MODEL, MLA_Q_RANK + MLA_KV_RANK + MLA_ROPE)),
        "b_q_a_norm": gain((N_B, MLA_Q_RANK)),
        "b_kv_a_norm": gain((N_B, MLA_KV_RANK)),
        "b_w_q_up": w((N_B, MLA_Q_RANK, MLA_HEADS * MLA_QK)),
        "b_w_kv_up": w((N_B, MLA_KV_RANK, MLA_HEADS * (MLA_NOPE + MLA_V))),
        "b_q_norm": gain((N_B, MLA_QK)),
        "b_k_norm": gain((N_B, MLA_QK)),
        "b_w_out": w((N_B, MLA_HEADS * MLA_V, D_MODEL)),
        "c_w_in": w((N_C, D_MODEL, DIFF_HEADS * 2 * HEAD_DIM * 3)),
        "c_q_norm": gain((N_C, HEAD_DIM)),
        "c_k_norm": gain((N_C, HEAD_DIM)),
        "c_lambda_q1": nrm((N_C, HEAD_DIM), 0.1),
        "c_lambda_k1": nrm((N_C, HEAD_DIM), 0.1),
        "c_lambda_q2": nrm((N_C, HEAD_DIM), 0.1),
        "c_lambda_k2": nrm((N_C, HEAD_DIM), 0.1),
        "c_subln": gain((N_C, 2 * HEAD_DIM)),
        "c_w_out": w((N_C, DIFF_HEADS * 2 * HEAD_DIM, D_MODEL)),
        "d_w_in": w((N_D, D_MODEL, (SWA_Q_HEADS + 2 * SWA_KV_HEADS) * HEAD_DIM)),
        "d_q_norm": gain((N_D, HEAD_DIM)),
        "d_k_norm": gain((N_D, HEAD_DIM)),
        "d_sinks": nrm((N_D, SWA_Q_HEADS), 0.5),
        "d_w_out": w((N_D, SWA_Q_HEADS * HEAD_DIM, D_MODEL)),
        "f_w_up": w((DEPTH, D_MODEL, 2 * D_FF)),
        "f_conv_w": nrm((DEPTH, CONV_WIDTH, D_FF), CONV_WIDTH ** -0.5),
        "f_conv_b": nrm((DEPTH, D_FF), 0.01),
        "f_w_down": w((DEPTH, D_FF, D_MODEL)),
    }


def reference(x, rel_bias_table, norm_mix, norm_ffn,
              a_w_in, a_q_norm, a_k_norm, a_w_out,
              b_w_in, b_q_a_norm, b_kv_a_norm, b_w_q_up, b_w_kv_up, b_q_norm, b_k_norm, b_w_out,
              c_w_in, c_q_norm, c_k_norm, c_lambda_q1, c_lambda_k1, c_lambda_q2, c_lambda_k2, c_subln, c_w_out,
              d_w_in, d_q_norm, d_k_norm, d_sinks, d_w_out,
              f_w_up, f_conv_w, f_conv_b, f_w_down):
    for i in range(DEPTH):
        m, j = i % N_MIXERS, i // N_MIXERS
        h = rms_norm(x, norm_mix[i])
        if m == 0:
            y = dilated_attention(h, a_w_in[j], a_q_norm[j], a_k_norm[j], a_w_out[j], rel_bias_table)
        elif m == 1:
            y = mla_attention(h, b_w_in[j], b_q_a_norm[j], b_kv_a_norm[j], b_w_q_up[j], b_w_kv_up[j],
                              b_q_norm[j], b_k_norm[j], b_w_out[j])
        elif m == 2:
            y = diff_attention(h, c_w_in[j], c_q_norm[j], c_k_norm[j], c_lambda_q1[j], c_lambda_k1[j],
                               c_lambda_q2[j], c_lambda_k2[j], c_subln[j], c_w_out[j], rel_bias_table, i)
        else:
            y = swa_sink_attention(h, d_w_in[j], d_q_norm[j], d_k_norm[j], d_sinks[j], d_w_out[j], rel_bias_table)
        x = x + y
        x = x + conv_ffn(rms_norm(x, norm_ffn[i]), f_w_up[i], f_conv_w[i], f_conv_b[i], f_w_down[i])
    return x
```

```cpp
#include <hip/hip_runtime.h>
#include <hip/hip_cooperative_groups.h>
#include <cstdio>
#include <cstdint>
namespace cg = cooperative_groups;
namespace pg8 {
#define PG8_LAS __attribute__((address_space(3)))
typedef unsigned short bf16_t;
typedef short bf16x8 __attribute__((ext_vector_type(8)));
typedef float f32x4 __attribute__((ext_vector_type(4)));
typedef unsigned u32x4 __attribute__((ext_vector_type(4)));
constexpr int BM = 256, BK = 64, HALF = 128, HTB = HALF * BK * 2  , STAGE_BYTES = 8 * HTB, NXCD = 8, WGM = 8;

__host__ __device__ __forceinline__ int lds_byte(int r, int c) { const int st = (r >> 4) * 2 + (c >> 5), rr = r & 15, cc = c & 31, ob = rr * 64 + cc * 2; return st * 1024 + (ob ^ (((ob >> 9) & 1) << 5)); }
__host__ __device__ __forceinline__ void stage_rc(int b, int& R, int& C) { const int st = b / 1024, sb = b % 1024, swz = sb ^ (((sb >> 9) & 1) << 5); R = (st >> 1) * 16 + swz / 64; C = (st & 1) * 32 + (swz % 64) / 2; }
__host__ __device__ __forceinline__ int perm32(int rho) { const int n = rho >> 4, i = rho & 15; return 8 * (i >> 2) + 4 * n + (i & 3); }

struct Unit { int pm, pn; };
struct Gemm { const bf16_t* A; const bf16_t* Bt; int M, N, K; };

struct StaticOrder {
    int nM, nN, nwg, G, c;
    __host__ __device__ void init(int M, int N, int G_, int c_) { nM = M / BM; nN = N / BM; nwg = nM * nN; G = G_; c = c_; }
    __host__ __device__ bool next(int i, Unit& u) const {
        const long L = (long)i * G + c; if (L >= nwg) return false;
        int wgid = (int)L; { const int q = nwg / NXCD, r = nwg % NXCD, xcd = wgid % NXCD, off = wgid / NXCD; wgid = (xcd < r ? xcd * (q + 1) : r * (q + 1) + (xcd - r) * q) + off; }
        const int nig = WGM * nN, gid = wgid / nig, fm = gid * WGM, gsz = (nM - fm) < WGM ? (nM - fm) : WGM;
        u.pm = fm + ((wgid % nig) % gsz); u.pn = (wgid % nig) / gsz; return true;
    }
    __device__ __forceinline__ void a_ready(const Unit&) const {}
    __device__ __forceinline__ void done(const Unit&) const {}
};

__device__ __forceinline__ unsigned cvt_pk_bf16(float lo, float hi) { unsigned r; asm volatile("v_cvt_pk_bf16_f32 %0, %1, %2" : "=v"(r) : "v"(lo), "v"(hi)); return r; }
template <class Epi, class Sched, bool ALIGN_EPI = false, bool SP2 = false>
__device__ __forceinline__ void gemm_phase(PG8_LAS unsigned char* lds, const Gemm g, const Sched& S, const Epi& E) {
    int tid = threadIdx.x; asm volatile("" : "+v"(tid)); const int wid = __builtin_amdgcn_readfirstlane(tid >> 6), lane = tid & 63, wr = wid >> 2, wc = wid & 3, fr = lane & 15, fq = lane >> 4;
    const int K = g.K, nt = K / BK;
    unsigned voffA[2], voffB[2];
#pragma unroll
    for (int i = 0; i < 2; ++i) { int R, C; stage_rc(tid * 16 + i * 8192, R, C); const int Rb = Epi::PERM ? ((R & ~31) + perm32(R & 31)) : R;
        voffA[i] = (unsigned)(R * K + C) * 2u; voffB[i] = (unsigned)(Rb * K + C) * 2u; }
    const size_t kstep = (size_t)(BK * 2);
    const size_t hstep = (size_t)HALF * K * 2;
    const size_t tstep = 2 * hstep;
    const unsigned ldsw = (unsigned)wid * 1024u;
    const int aoff = lds_byte(wr * 64 + fr, fq * 8), boff = lds_byte(wc * 32 + fr, fq * 8);
#define PG8_SA(b, h) (((b) * 2 + (h)) * HTB)
#define PG8_SB(b, h) ((4 + (b) * 2 + (h)) * HTB)
#define PG8_STAGE(bufoff, gbase, voff) do { _Pragma("unroll") for (int _i = 0; _i < 2; ++_i) \
        __builtin_amdgcn_global_load_lds((const unsigned*)((const char*)(gbase) + (voff)[_i]), (PG8_LAS unsigned*)(lds + (bufoff) + ldsw + _i * 8192), 16, 0, 0); } while (0)
#define PG8_LDA(dst, b, h) do { _Pragma("unroll") for (int m = 0; m < 4; ++m) _Pragma("unroll") for (int k = 0; k < 2; ++k) dst[m][k] = *(const PG8_LAS bf16x8*)(lds + PG8_SA(b, h) + aoff + m * 2048 + k * 1024); } while (0)
#define PG8_LDB(dst, b, h) do { _Pragma("unroll") for (int n = 0; n < 2; ++n) _Pragma("unroll") for (int k = 0; k < 2; ++k) dst[n][k] = *(const PG8_LAS bf16x8*)(lds + PG8_SB(b, h) + boff + n * 2048 + k * 1024); } while (0)
#define PG8_MMA(ai, bj, At, Bt) do { __builtin_amdgcn_s_setprio(1); _Pragma("unroll") for (int m = 0; m < 4; ++m) _Pragma("unroll") for (int n = 0; n < 2; ++n) _Pragma("unroll") for (int k = 0; k < 2; ++k) \
        acc[ai][bj][m][n] = __builtin_amdgcn_mfma_f32_16x16x32_bf16(Bt[n][k], At[m][k], acc[ai][bj][m][n], 0, 0, 0); __builtin_amdgcn_s_setprio(0); } while (0)
#define PG8_WAIT_V(n) asm volatile("s_waitcnt vmcnt(" #n ")" ::: "memory")
#define PG8_WAIT_L(n) asm volatile("s_waitcnt lgkmcnt(" #n ")" ::: "memory")
#define PG8_BAR __builtin_amdgcn_s_barrier()
#define PG8_SCHED __builtin_amdgcn_sched_barrier(0)
    Unit cur, nxt; int ui = 0;
    if (!S.next(0, cur)) return;
    f32x4 acc[2][2][4][2];
#pragma unroll
    for (int a = 0; a < 2; ++a)
#pragma unroll
        for (int b = 0; b < 2; ++b)
#pragma unroll
            for (int m = 0; m < 4; ++m)
#pragma unroll
                for (int n = 0; n < 2; ++n) acc[a][b][m][n] = (f32x4){0.f, 0.f, 0.f, 0.f};
    bf16x8 At[4][2], B0[2][2], B1[2][2];
    const char* cA = (const char*)g.A + (size_t)cur.pm * tstep; const char* cB = (const char*)g.Bt + (size_t)cur.pn * tstep;
    S.a_ready(cur);
    if constexpr (SP2) {
        PG8_STAGE(PG8_SB(0, 0), cB, voffB); PG8_STAGE(PG8_SB(0, 1), cB + hstep, voffB); PG8_STAGE(PG8_SA(0, 0), cA, voffA); PG8_STAGE(PG8_SA(0, 1), cA + hstep, voffA);
        if (wr == 1) PG8_BAR;
        PG8_WAIT_V(2); PG8_BAR;
        PG8_STAGE(PG8_SB(1, 0), cB + kstep, voffB); PG8_STAGE(PG8_SA(1, 0), cA + kstep, voffA); PG8_STAGE(PG8_SB(1, 1), cB + hstep + kstep, voffB);
        PG8_WAIT_V(6); PG8_BAR;
    } else {
        PG8_STAGE(PG8_SB(0, 0), cB, voffB); PG8_STAGE(PG8_SA(0, 0), cA, voffA); PG8_STAGE(PG8_SB(0, 1), cB + hstep, voffB); PG8_STAGE(PG8_SA(0, 1), cA + hstep, voffA);
        if (wr == 1) PG8_BAR;
        PG8_WAIT_V(4); PG8_BAR;
        PG8_STAGE(PG8_SB(1, 0), cB + kstep, voffB); PG8_STAGE(PG8_SA(1, 0), cA + kstep, voffA); PG8_STAGE(PG8_SB(1, 1), cB + hstep + kstep, voffB);
        PG8_WAIT_V(6); PG8_BAR;
    }
    for (;;) {
        const bool has_next = S.next(ui + 1, nxt);
        const char* nA = has_next ? (const char*)g.A + (size_t)nxt.pm * tstep : cA; const char* nB = has_next ? (const char*)g.Bt + (size_t)nxt.pn * tstep : cB;
        for (int t = 0; t < nt; t += 2) {
            const bool last = (t == nt - 2);
            const char* a1 = cA + (size_t)(t + 1) * kstep;
            const char* a2 = last ? nA : cA + (size_t)(t + 2) * kstep; const char* b2 = last ? nB : cB + (size_t)(t + 2) * kstep;
            const char* a3 = a2 + kstep; const char* b3 = b2 + kstep;
            if (last && has_next) S.a_ready(nxt);
            if constexpr (SP2) {
            PG8_LDB(B0, 0, 0); PG8_LDB(B1, 0, 1); PG8_SCHED; PG8_LDA(At, 0, 0); PG8_STAGE(PG8_SA(1, 1), a1 + hstep, voffA);
            PG8_WAIT_V(8); PG8_WAIT_L(0); PG8_BAR; PG8_MMA(0, 0, At, B0); PG8_MMA(0, 1, At, B1); PG8_BAR; PG8_SCHED;
            PG8_LDA(At, 0, 1); PG8_STAGE(PG8_SB(0, 0), b2, voffB); PG8_STAGE(PG8_SB(0, 1), b2 + hstep, voffB); PG8_STAGE(PG8_SA(0, 0), a2, voffA);
            PG8_WAIT_V(8); PG8_WAIT_L(0); PG8_BAR; PG8_MMA(1, 0, At, B0); PG8_MMA(1, 1, At, B1); PG8_BAR; PG8_SCHED;
            PG8_LDB(B0, 1, 0); PG8_LDB(B1, 1, 1); PG8_SCHED; PG8_LDA(At, 1, 0); PG8_STAGE(PG8_SA(0, 1), a2 + hstep, voffA);
            PG8_WAIT_V(8); PG8_WAIT_L(0); PG8_BAR; PG8_MMA(0, 0, At, B0); PG8_MMA(0, 1, At, B1); PG8_BAR; PG8_SCHED;
            PG8_LDA(At, 1, 1); PG8_STAGE(PG8_SB(1, 0), b3, voffB); PG8_STAGE(PG8_SB(1, 1), b3 + hstep, voffB); PG8_STAGE(PG8_SA(1, 0), a3, voffA);
            PG8_WAIT_V(8); PG8_WAIT_L(0); PG8_BAR; PG8_MMA(1, 0, At, B0); PG8_MMA(1, 1, At, B1); PG8_BAR; PG8_SCHED;
            } else {
            PG8_LDB(B0, 0, 0); PG8_SCHED; PG8_LDA(At, 0, 0); PG8_STAGE(PG8_SA(1, 1), a1 + hstep, voffA);
            PG8_WAIT_L(8); PG8_BAR; PG8_WAIT_L(0); PG8_MMA(0, 0, At, B0); PG8_BAR; PG8_SCHED;
            PG8_LDB(B1, 0, 1); PG8_STAGE(PG8_SB(0, 0), b2, voffB);
            PG8_BAR; PG8_WAIT_L(0); PG8_MMA(0, 1, At, B1); PG8_BAR;
            PG8_LDA(At, 0, 1); PG8_STAGE(PG8_SA(0, 0), a2, voffA);
            PG8_BAR; PG8_WAIT_L(0); PG8_MMA(1, 0, At, B0); PG8_BAR; PG8_SCHED;
            PG8_STAGE(PG8_SB(0, 1), b2 + hstep, voffB);
            PG8_WAIT_V(6); PG8_BAR; PG8_MMA(1, 1, At, B1); PG8_BAR;
            PG8_LDB(B0, 1, 0); PG8_SCHED; PG8_LDA(At, 1, 0); PG8_STAGE(PG8_SA(0, 1), a2 + hstep, voffA);
            PG8_WAIT_L(8); PG8_BAR; PG8_WAIT_L(0); PG8_MMA(0, 0, At, B0); PG8_BAR; PG8_SCHED;
            PG8_LDB(B1, 1, 1); PG8_STAGE(PG8_SB(1, 0), b3, voffB);
            PG8_BAR; PG8_WAIT_L(0); PG8_MMA(0, 1, At, B1); PG8_BAR;
            PG8_LDA(At, 1, 1); PG8_STAGE(PG8_SA(1, 0), a3, voffA);
            PG8_BAR; PG8_WAIT_L(0); PG8_MMA(1, 0, At, B0); PG8_BAR; PG8_SCHED;
            PG8_STAGE(PG8_SB(1, 1), b3 + hstep, voffB);
            PG8_WAIT_V(6); PG8_BAR; PG8_MMA(1, 1, At, B1); PG8_BAR;
            }
        }
        if constexpr (ALIGN_EPI) { if (wr == 0) PG8_BAR; }
        if constexpr (!Epi::AFTER_DRAIN) { E(acc, cur, wr, wc, fr, fq); S.done(cur); }
        if (!has_next) break;
#pragma unroll
        for (int a = 0; a < 2; ++a)
#pragma unroll
            for (int b = 0; b < 2; ++b)
#pragma unroll
                for (int m = 0; m < 4; ++m)
#pragma unroll
                    for (int n = 0; n < 2; ++n) acc[a][b][m][n] = (f32x4){0.f, 0.f, 0.f, 0.f};
        cur = nxt; cA = nA; cB = nB; ++ui;
        if constexpr (ALIGN_EPI) { if (wr == 1) PG8_BAR; }
    }
    PG8_WAIT_V(0);
    if constexpr (!ALIGN_EPI) { if (wr == 0) PG8_BAR; }
    PG8_BAR;
    if constexpr (Epi::AFTER_DRAIN) { E.fused(acc, cur, wr, wc, fr, fq, lds, wid, lane); S.done(cur); }
#undef PG8_SA
#undef PG8_SB
#undef PG8_STAGE
#undef PG8_LDA
#undef PG8_LDB
#undef PG8_MMA
#undef PG8_WAIT_V
#undef PG8_WAIT_L
#undef PG8_BAR
#undef PG8_SCHED
}
}

#define LAS __attribute__((address_space(3)))
typedef unsigned short bf16;
typedef short bf16x8 __attribute__((ext_vector_type(8)));
typedef short s16x4 __attribute__((ext_vector_type(4)));
typedef float f32x2 __attribute__((ext_vector_type(2)));
typedef float f32x4 __attribute__((ext_vector_type(4)));
typedef float f32x16 __attribute__((ext_vector_type(16)));
typedef unsigned u32x2 __attribute__((ext_vector_type(2)));
typedef unsigned u32x4 __attribute__((ext_vector_type(4)));
typedef __bf16 bf16x2_t __attribute__((ext_vector_type(2)));

constexpr int M_ = 65536, SEQ = 2048, DMODEL = 1024, DFF = 2816;
constexpr float EPS = 1e-6f, LOG2E = 1.4426950408889634f;
constexpr size_t MiB = 1u << 20;
constexpr size_t WS_BIAS = 0;
constexpr size_t WS_ROPE = 256 * 1024;
constexpr size_t WS_RSS = 1 * MiB;
constexpr size_t WS_SSQ = 3 * MiB;
constexpr size_t WS_SSKV = 3 * MiB + 256 * 1024;
constexpr size_t W_AIN = 4 * MiB, W_AOUT = 13 * MiB, W_BIN = 14 * MiB, W_BQUP = 16 * MiB, W_BKVUP = 18 * MiB, W_BOUT = 19 * MiB,
                 W_CIN = 21 * MiB, W_COUT = 27 * MiB, W_DIN = 29 * MiB, W_DOUT = 32 * MiB, W_FG = 34 * MiB, W_FU = 58 * MiB, W_FD = 82 * MiB, W_FSTR = 6 * MiB;
constexpr size_t WS_XB = 106 * MiB;
constexpr size_t WS_R = 234 * MiB;
constexpr size_t R_A_QKV = WS_R, R_A_O3 = WS_R + 576 * MiB, R_A_LSE = WS_R + 768 * MiB, R_A_OC = WS_R;
constexpr size_t R_B_CQ = WS_R, R_B_CKV = WS_R + 48 * MiB, R_B_KPE = WS_R + 80 * MiB, R_B_Q = WS_R + 128 * MiB, R_B_KV = WS_R + 320 * MiB, R_B_KH = WS_R + 576 * MiB, R_B_O = WS_R;
constexpr size_t R_C_QKV = WS_R, R_C_O = WS_R + 384 * MiB;
constexpr size_t R_D_QKV = WS_R, R_D_O = WS_R + 160 * MiB;
constexpr size_t R_GATE = WS_R, R_ACT = WS_R + 352 * MiB;
constexpr size_t WS_RSSP = WS_R + 774 * MiB;
constexpr size_t WS_SSQP = WS_R + 782 * MiB;
constexpr size_t WS_SSKVP = WS_R + 784 * MiB;
constexpr size_t WS_SSPE = 3 * MiB + 512 * 1024;
constexpr size_t R_B_RK = WS_R + 96 * MiB;
constexpr size_t WS_BAR = 512 * 1024;
constexpr size_t WS_NEED = WS_R + 786 * MiB;

constexpr int LDS_BYTES = 135168;

struct Args { const float* in[34]; float* out; unsigned char* ws; };

__device__ __forceinline__ unsigned pk2(float lo, float hi) { f32x2 v = {lo, hi}; bf16x2_t b = __builtin_convertvector(v, bf16x2_t); return __builtin_bit_cast(unsigned, b); }
__device__ __forceinline__ float bf2f(unsigned short h) { return __uint_as_float(((unsigned)h) << 16); }
__device__ __forceinline__ float bflo(unsigned w) { return __uint_as_float(w << 16); }
__device__ __forceinline__ float bfhi(unsigned w) { return __uint_as_float(w & 0xffff0000u); }
__device__ __forceinline__ float wave_sum(float v) {
#pragma unroll
    for (int o = 1; o < 64; o <<= 1) v += __shfl_xor(v, o);
    return v;
}
__device__ __forceinline__ float dot4(f32x4 a) { return (a[0] * a[0] + a[1] * a[1]) + (a[2] * a[2] + a[3] * a[3]); }
__device__ __forceinline__ float rowss_sum(const float* ss, int nvec, int row) {
    const f32x4* p = (const f32x4*)(ss + (size_t)row * 4 * nvec); float t = 0.f;
#pragma unroll
    for (int v = 0; v < 4; ++v) if (v < nvec) { const f32x4 q = p[v]; t += (q[0] + q[1]) + (q[2] + q[3]); }
    return t;
}

struct EpiProj {
    static constexpr bool PERM = true, AFTER_DRAIN = false;
    bf16* O; int ldc; const float* rs; int hm; const float* gq; const float* gk; float qscale;
    __device__ __forceinline__ void operator()(const f32x4 (&acc)[2][2][4][2], const pg8::Unit& u, int wr, int wc, int fr, int fq) const {
        const int hg = u.pn * 4 + wc;
        int kind = 2; const float* gain = gq;
        if (hm == 1) { const int t = (hg >> 3) % 3, gi = hg / 24; kind = t; gain = (t == 0 ? gq : gk) + gi * 64; }
        else if (hm == 2) { kind = hg < 16 ? 0 : (hg < 32 ? 1 : 2); gain = kind == 0 ? gq : gk; }
        else if (hm == 3) { kind = hg < 16 ? 0 : (hg < 18 ? 1 : 2); gain = kind == 0 ? gq : gk; }
        else if (hm == 4) { kind = (hg & 1) ? 2 : 3; gain = gk; }
        f32x4 gv[2][2];
#pragma unroll
        for (int bj = 0; bj < 2; ++bj)
#pragma unroll
            for (int n = 0; n < 2; ++n) {
                gv[bj][n] = (f32x4){1.f, 1.f, 1.f, 1.f};
                if (kind != 2) { gv[bj][n] = *(const f32x4*)(gain + 32 * bj + 8 * fq + 4 * n); if (kind == 0) gv[bj][n] = gv[bj][n] * qscale; }
            }
        bf16* colp = O + hg * 64 + 8 * fq;
        float rsv[2][4];
#pragma unroll
        for (int ai = 0; ai < 2; ++ai)
#pragma unroll
            for (int m = 0; m < 4; ++m) rsv[ai][m] = rs[u.pm * 256 + ai * 128 + wr * 64 + m * 16 + fr];
        if (kind == 3) {
#pragma unroll
            for (int ai = 0; ai < 2; ++ai)
#pragma unroll
                for (int m = 0; m < 4; ++m) {
                    const int row = u.pm * 256 + ai * 128 + wr * 64 + m * 16 + fr;
                    const float rstd = rsv[ai][m];
                    f32x4 v[2][2]; float s = 0.f;
#pragma unroll
                    for (int bj = 0; bj < 2; ++bj)
#pragma unroll
                        for (int n = 0; n < 2; ++n) { v[bj][n] = acc[ai][bj][m][n] * rstd; s += dot4(v[bj][n]); }
                    s += __shfl_xor(s, 16); s += __shfl_xor(s, 32);
                    const float rk_ = rsqrtf((s + ((const float*)((const unsigned char*)rs + (WS_SSPE - WS_SSKV)))[row]) * (1.0f / 96.0f) + EPS);
                    bf16* kp = (bf16*)((unsigned char*)O + (R_B_KH - R_B_KV)) + (size_t)row * 1536 + (hg >> 1) * 96 + 8 * fq;
#pragma unroll
                    for (int bj = 0; bj < 2; ++bj) {
                        const f32x4 a_ = v[bj][0] * rk_ * gv[bj][0], b_ = v[bj][1] * rk_ * gv[bj][1];
                        u32x4 w; w.x = pk2(a_[0], a_[1]); w.y = pk2(a_[2], a_[3]); w.z = pk2(b_[0], b_[1]); w.w = pk2(b_[2], b_[3]);
                        *(u32x4*)(kp + 32 * bj) = w;
                    }
                    const u32x4 r_ = *(const u32x4*)((const bf16*)((const unsigned char*)O - (R_B_KV - R_B_RK)) + (size_t)row * 32 + 8 * fq);
                    u32x4 w;
#pragma unroll
                    for (int j = 0; j < 4; ++j) w[j] = pk2(bflo(r_[j]) * rk_, bfhi(r_[j]) * rk_);
                    *(u32x4*)(kp + 64) = w;
                }
            return;
        }
#pragma unroll
        for (int ai = 0; ai < 2; ++ai)
#pragma unroll
            for (int m = 0; m < 4; ++m) {
                const int row = u.pm * 256 + ai * 128 + wr * 64 + m * 16 + fr;
                const float rstd = rsv[ai][m];
                f32x4 v[2][2]; float s = 0.f;
#pragma unroll
                for (int bj = 0; bj < 2; ++bj)
#pragma unroll
                    for (int n = 0; n < 2; ++n) { v[bj][n] = acc[ai][bj][m][n] * rstd; s += dot4(v[bj][n]); }
                if (kind < 2) {
                    s += __shfl_xor(s, 16); s += __shfl_xor(s, 32);
                    const float rs = rsqrtf(s * (1.0f / 64.0f) + EPS);
#pragma unroll
                    for (int bj = 0; bj < 2; ++bj)
#pragma unroll
                        for (int n = 0; n < 2; ++n) v[bj][n] = v[bj][n] * rs * gv[bj][n];
                }
#pragma unroll
                for (int bj = 0; bj < 2; ++bj) {
                    u32x4 w; w.x = pk2(v[bj][0][0], v[bj][0][1]); w.y = pk2(v[bj][0][2], v[bj][0][3]); w.z = pk2(v[bj][1][0], v[bj][1][1]); w.w = pk2(v[bj][1][2], v[bj][1][3]);
                    *(u32x4*)(colp + (size_t)row * ldc + 32 * bj) = w;
                }
            }
    }
};
struct EpiLat {
    static constexpr bool PERM = true, AFTER_DRAIN = false;
    bf16* CQ; bf16* CKV; bf16* KPE; const float* rs; float* ssq; float* sskv;
    __device__ __forceinline__ void operator()(const f32x4 (&acc)[2][2][4][2], const pg8::Unit& u, int wr, int wc, int fr, int fq) const {
        const int hg = u.pn * 4 + wc;
        if (hg > 10) return;
        bf16* dst; int ld; float* sacc = nullptr; int sst = 0;
        if (hg < 6) { dst = CQ + hg * 64; ld = 384; sacc = ssq + hg; sst = 8; } else if (hg < 10) { dst = CKV + (hg - 6) * 64; ld = 256; sacc = sskv + (hg - 6); sst = 4; } else { dst = KPE; ld = 64; }
        dst += 8 * fq;
        float rsv[2][4];
#pragma unroll
        for (int ai = 0; ai < 2; ++ai)
#pragma unroll
            for (int m = 0; m < 4; ++m) rsv[ai][m] = rs[u.pm * 256 + ai * 128 + wr * 64 + m * 16 + fr];
#pragma unroll
        for (int ai = 0; ai < 2; ++ai)
#pragma unroll
            for (int m = 0; m < 4; ++m) {
                const int row = u.pm * 256 + ai * 128 + wr * 64 + m * 16 + fr;
                const float rstd = rsv[ai][m];
                f32x4 v[2][2]; float s = 0.f;
#pragma unroll
                for (int bj = 0; bj < 2; ++bj)
#pragma unroll
                    for (int n = 0; n < 2; ++n) { v[bj][n] = acc[ai][bj][m][n] * rstd; s += dot4(v[bj][n]); }
                s += __shfl_xor(s, 16); s += __shfl_xor(s, 32);
                if (fq == 0) { if (sacc != nullptr) sacc[(size_t)row * sst] = s; else { float z_ = 0.f; asm volatile("" : "+v"(z_)); ssq[(size_t)row * 8 + 6] = z_; ssq[(size_t)row * 8 + 7] = z_; } }
#pragma unroll
                for (int bj = 0; bj < 2; ++bj) {
                    u32x4 w; w.x = pk2(v[bj][0][0], v[bj][0][1]); w.y = pk2(v[bj][0][2], v[bj][0][3]); w.z = pk2(v[bj][1][0], v[bj][1][1]); w.w = pk2(v[bj][1][2], v[bj][1][3]);
                    *(u32x4*)(dst + (size_t)row * ld + 32 * bj) = w;
                }
            }
    }
};
struct EpiRes {
    static constexpr bool PERM = false, AFTER_DRAIN = false;
    const float* base32; float* out32; bf16* xb; bf16* xbw; float* ssn;
    __device__ __forceinline__ void operator()(const f32x4 (&acc)[2][2][4][2], const pg8::Unit& u, int wr, int wc, int fr_, int fq_) const {
        int fr = fr_, fq = fq_; asm volatile("" : "+v"(fr), "+v"(fq));
        float* ssn_ = ssn; bf16* xbw_ = xbw; float* out_ = out32; const float* b32_ = base32; asm volatile("" : "+s"(ssn_), "+s"(xbw_), "+s"(out_), "+s"(b32_));
        const int col0 = u.pn * 256 + wc * 32 + 4 * fq;
#pragma unroll
        for (int ai = 0; ai < 2; ++ai) {
            f32x4 bv[4][2][2];
            if (b32_ != nullptr) {
#pragma unroll
                for (int m = 0; m < 4; ++m)
#pragma unroll
                    for (int bj = 0; bj < 2; ++bj)
#pragma unroll
                        for (int n = 0; n < 2; ++n) bv[m][bj][n] = *(const f32x4*)(b32_ + (size_t)(u.pm * 256 + ai * 128 + wr * 64 + m * 16 + fr) * DMODEL + col0 + bj * 128 + n * 16);
            } else {
                u32x2 rw[4][2][2];
#pragma unroll
                for (int m = 0; m < 4; ++m)
#pragma unroll
                    for (int bj = 0; bj < 2; ++bj)
#pragma unroll
                        for (int n = 0; n < 2; ++n) rw[m][bj][n] = *(const u32x2*)(xb + (size_t)(u.pm * 256 + ai * 128 + wr * 64 + m * 16 + fr) * DMODEL + col0 + bj * 128 + n * 16);
#pragma unroll
                for (int m = 0; m < 4; ++m)
#pragma unroll
                    for (int bj = 0; bj < 2; ++bj)
#pragma unroll
                        for (int n = 0; n < 2; ++n) bv[m][bj][n] = (f32x4){bflo(rw[m][bj][n].x), bfhi(rw[m][bj][n].x), bflo(rw[m][bj][n].y), bfhi(rw[m][bj][n].y)};
            }
            asm volatile("" ::: "memory");
#pragma unroll
            for (int m = 0; m < 4; ++m) {
                const int row = u.pm * 256 + ai * 128 + wr * 64 + m * 16 + fr;
                float s = 0.f;
#pragma unroll
                for (int bj = 0; bj < 2; ++bj)
#pragma unroll
                    for (int n = 0; n < 2; ++n) {
                        const size_t off = (size_t)row * DMODEL + col0 + bj * 128 + n * 16;
                        const f32x4 o = bv[m][bj][n] + acc[ai][bj][m][n];
                        if (out_ != nullptr) *(f32x4*)(out_ + off) = o;
                        if (xbw_ != nullptr) { u32x2 w; w.x = pk2(o[0], o[1]); w.y = pk2(o[2], o[3]); *(u32x2*)(xbw_ + off) = w; }
                        s += dot4(o);
                    }
                if (ssn_ != nullptr) { s += __shfl_xor(s, 16); s += __shfl_xor(s, 32); if (fq == 0) ssn_[(size_t)row * 16 + u.pn * 4 + wc] = s; }
            }
            asm volatile("" ::: "memory");
        }
    }
};
__device__ __forceinline__ u32x4 shfl4(u32x4 v, int src) { u32x4 r; r.x = __shfl(v.x, src, 16); r.y = __shfl(v.y, src, 16); r.z = __shfl(v.z, src, 16); r.w = __shfl(v.w, src, 16); return r; }
struct EpiGateUp {
    static constexpr bool PERM = true, AFTER_DRAIN = false;
    bf16* act; bf16* gedge; bf16* uedge; const float* rs; const float* cw; const float* cb;
    __device__ __forceinline__ void operator()(const f32x4 (&acc)[2][2][4][2], const pg8::Unit& u, int wr, int wc, int fr_, int fq_) const {
        int fr = fr_, fq = fq_; asm volatile("" : "+v"(fr), "+v"(fq));
        const int s1 = fr >= 1 ? fr - 1 : 15, s2 = fr >= 2 ? fr - 2 : 14 + fr;
        const int c0 = u.pn * 128 + wc * 32 + 8 * fq;
        f32x4 w0[2], w1[2], w2[2], b[2];
#pragma unroll
        for (int n = 0; n < 2; ++n) { w0[n] = *(const f32x4*)(cw + c0 + 4 * n); w1[n] = *(const f32x4*)(cw + DFF + c0 + 4 * n); w2[n] = *(const f32x4*)(cw + 2 * DFF + c0 + 4 * n); b[n] = *(const f32x4*)(cb + c0 + 4 * n); }
#pragma unroll
        for (int ai = 0; ai < 2; ++ai) {
            u32x4 g[4]; float rstd[4];
            const int strip = u.pm * 4 + ai * 2 + wr;
#pragma unroll
            for (int m = 0; m < 4; ++m) rstd[m] = rs[u.pm * 256 + ai * 128 + wr * 64 + m * 16 + fr];
#pragma unroll
            for (int m = 0; m < 4; ++m) {
                const f32x4 ga = acc[ai][0][m][0] * rstd[m], gb = acc[ai][0][m][1] * rstd[m];
                g[m].x = pk2(ga[0], ga[1]); g[m].y = pk2(ga[2], ga[3]); g[m].z = pk2(gb[0], gb[1]); g[m].w = pk2(gb[2], gb[3]);
            }
#pragma unroll
            for (int m = 0; m < 4; ++m) {
                const int row = u.pm * 256 + ai * 128 + wr * 64 + m * 16 + fr;
                const u32x4 g0 = g[m];
                const u32x4 a1 = shfl4(g0, s1), a2 = shfl4(g0, s2);
                u32x4 p1 = (u32x4){0u, 0u, 0u, 0u}, p2 = (u32x4){0u, 0u, 0u, 0u};
                if (m > 0) { p1 = shfl4(g[m - 1], s1); p2 = shfl4(g[m - 1], s2); }
                const u32x4 g1 = fr >= 1 ? a1 : p1, g2 = fr >= 2 ? a2 : p2;
                u32x4 w, uw;
#pragma unroll
                for (int n = 0; n < 2; ++n) {
                    float r[4], up[4];
#pragma unroll
                    for (int j = 0; j < 4; ++j) {
                        const unsigned q0 = g0[2 * n + (j >> 1)], q1 = g1[2 * n + (j >> 1)], q2 = g2[2 * n + (j >> 1)];
                        const float x0 = (j & 1) ? bfhi(q0) : bflo(q0), x1 = (j & 1) ? bfhi(q1) : bflo(q1), x2 = (j & 1) ? bfhi(q2) : bflo(q2);
                        const float cv = b[n][j] + w2[n][j] * x0 + w1[n][j] * x1 + w0[n][j] * x2;
                        const float sg = cv * __builtin_amdgcn_rcpf(1.0f + __builtin_amdgcn_exp2f(-LOG2E * cv));
                        up[j] = acc[ai][1][m][n][j] * rstd[m];
                        r[j] = sg * up[j];
                    }
                    w[2 * n] = pk2(r[0], r[1]); w[2 * n + 1] = pk2(r[2], r[3]);
                    uw[2 * n] = pk2(up[0], up[1]); uw[2 * n + 1] = pk2(up[2], up[3]);
                }
                if (m == 0) {
                    if (fr < 2) { *(u32x4*)(gedge + ((size_t)strip * 4 + fr) * DFF + c0) = g0; *(u32x4*)(uedge + ((size_t)strip * 2 + fr) * DFF + c0) = uw; }
                    else *(u32x4*)(act + (size_t)row * DFF + c0) = w;
                } else {
                    *(u32x4*)(act + (size_t)row * DFF + c0) = w;
                    if (m == 3 && fr >= 14) *(u32x4*)(gedge + ((size_t)strip * 4 + 2 + (fr - 14)) * DFF + c0) = g0;
                }
                asm volatile("" ::: "memory");
            }
        }
    }
};

__device__ __forceinline__ int crow(int r, int hi) { return (r & 3) + 8 * (r >> 2) + 4 * hi; }
struct TileGeo { int NT, TPS, ks0, res0, dil; };
template <int DQK, int DV, int KT> struct AttL {
    static constexpr int KSTR = DQK * 2 + 16, VSTR = DV * 2 + 64, KBUF = KT * KSTR, VBUF = KT * VSTR;
    static constexpr int OFF_K = 0, OFF_V = 2 * KBUF, OFF_TAB = OFF_V + 2 * VBUF;
};
template <int DQK, int DV, bool BIAS, int TABN, bool QRELOAD, int KT>
__device__ __forceinline__ void attn_pass(int qoff_, LAS unsigned char* lds, const bf16* Kb, int kpitch, const bf16* Vb, int vpitch, const TileGeo G, int my_tlo, int my_thi,
                                          int wslot_q0, int W, const bf16x8 (&qf_)[DQK / 16], float& m_, float& l_, f32x16 (&o)[DV / 32]) {
    typedef AttL<DQK, DV, KT> L;
    int tid = threadIdx.x; asm volatile("" : "+v"(tid)); const int lane = tid & 63, r32 = lane & 31, hi = lane >> 5;
    constexpr int SUB = KT / 64;
    constexpr int KCH = DQK / 8, VCH = DV / 8, NKC = KT * KCH, NVC = KT * VCH, NKL = (NKC + 511) / 512, NVL = (NVC + 511) / 512;
    u32x4 kr[NKL], vr[NVL];
    const LAS float* tab = (const LAS float*)(lds + L::OFF_TAB);
    const int slot_q = wslot_q0 + r32;
    const int vlane = (4 * hi + ((lane & 15) >> 2)) * L::VSTR + (16 * ((lane >> 4) & 1) + 4 * (lane & 3)) * 2;
#define ATT_LOAD(t) do { const int seg_ = ((t) * SUB) / G.TPS, tis_ = (t) * SUB - seg_ * G.TPS; const int tok0_ = G.res0 + seg_ + G.dil * (G.ks0 + 64 * tis_); \
        _Pragma("unroll") for (int i_ = 0; i_ < NKL; ++i_) { const int c_ = tid + 512 * i_; if ((NKC % 512 == 0) || c_ < NKC) { const int j_ = c_ / KCH, p_ = c_ - j_ * KCH; \
            kr[i_] = *(const u32x4*)(Kb + (size_t)(tok0_ + G.dil * j_) * kpitch + p_ * 8); } } \
        _Pragma("unroll") for (int i_ = 0; i_ < NVL; ++i_) { const int c_ = tid + 512 * i_; if ((NVC % 512 == 0) || c_ < NVC) { const int j_ = c_ / VCH, p_ = c_ - j_ * VCH; \
            vr[i_] = *(const u32x4*)(Vb + (size_t)(tok0_ + G.dil * j_) * vpitch + p_ * 8); } } } while (0)
#define ATT_STORE(buf) do { \
        _Pragma("unroll") for (int i_ = 0; i_ < NKL; ++i_) { const int c_ = tid + 512 * i_; if ((NKC % 512 == 0) || c_ < NKC) { const int j_ = c_ / KCH, p_ = c_ - j_ * KCH; \
            *(LAS u32x4*)(lds + L::OFF_K + (buf) * L::KBUF + j_ * L::KSTR + p_ * 16) = kr[i_]; } } \
        _Pragma("unroll") for (int i_ = 0; i_ < NVL; ++i_) { const int c_ = tid + 512 * i_; if ((NVC % 512 == 0) || c_ < NVC) { const int j_ = c_ / VCH, p_ = c_ - j_ * VCH; \
            *(LAS u32x4*)(lds + L::OFF_V + (buf) * L::VBUF + j_ * L::VSTR + p_ * 16) = vr[i_]; } } } while (0)
    ATT_LOAD(0);
    ATT_STORE(0);
    float m = m_, l = l_;
    const int NT2 = G.NT / SUB;
    for (int t = 0; t < NT2; ++t) {
        const int buf = t & 1;
        if (t + 1 < NT2) ATT_LOAD(t + 1);
        __syncthreads();
#pragma unroll
        for (int hf = 0; hf < SUB; ++hf) {
        const int st = t * SUB + hf;
        if (st >= my_tlo && st <= my_thi) {
            const int tis = st % G.TPS, slot0 = G.ks0 + 64 * tis;
            const LAS unsigned char* Kt = lds + L::OFF_K + buf * L::KBUF + (hf * 64 + r32) * L::KSTR + hi * 16;
            f32x16 s[2];
            const int dsb = slot_q - slot0 - 4 * hi;
            bf16x8 qf[DQK / 16];
            if (QRELOAD) {
#pragma unroll
                for (int ks = 0; ks < DQK / 16; ++ks) qf[ks] = *(const LAS bf16x8*)(lds + qoff_ + ks * 32); }
            else {
#pragma unroll
                for (int ks = 0; ks < DQK / 16; ++ks) qf[ks] = qf_[ks]; }
#pragma unroll
            for (int kb = 0; kb < 2; ++kb) {
#pragma unroll
                for (int r = 0; r < 16; ++r) s[kb][r] = BIAS ? tab[dsb + 128 - (32 * kb + (r & 3) + 8 * (r >> 2))] : 0.f;
            }
            if (DV == 64) {
                bf16x8 kf[2][DQK / 16];
#pragma unroll
                for (int kb = 0; kb < 2; ++kb)
#pragma unroll
                    for (int ks = 0; ks < DQK / 16; ++ks) kf[kb][ks] = *(const LAS bf16x8*)(Kt + kb * 32 * L::KSTR + ks * 32);
                asm volatile("" ::: "memory");
#pragma unroll
                for (int ks = 0; ks < DQK / 16; ++ks)
#pragma unroll
                    for (int kb = 0; kb < 2; ++kb) s[kb] = __builtin_amdgcn_mfma_f32_32x32x16_bf16(kf[kb][ks], qf[ks], s[kb], 0, 0, 0);
            } else {
#pragma unroll
                for (int kh = 0; kh < 2; ++kh) {
                    bf16x8 kf[2][DQK / 32];
#pragma unroll
                    for (int kb = 0; kb < 2; ++kb)
#pragma unroll
                        for (int k2 = 0; k2 < DQK / 32; ++k2) kf[kb][k2] = *(const LAS bf16x8*)(Kt + kb * 32 * L::KSTR + (kh * (DQK / 32) + k2) * 32);
                    asm volatile("" ::: "memory");
#pragma unroll
                    for (int k2 = 0; k2 < DQK / 32; ++k2)
#pragma unroll
                        for (int kb = 0; kb < 2; ++kb) s[kb] = __builtin_amdgcn_mfma_f32_32x32x16_bf16(kf[kb][k2], qf[kh * (DQK / 32) + k2], s[kb], 0, 0, 0);
                }
            }
            const bool full = (wslot_q0 - slot0 - 63 >= 0) && (wslot_q0 + 31 - slot0 <= W);
            if (!full && !BIAS) {
#pragma unroll
                for (int kb = 0; kb < 2; ++kb)
#pragma unroll
                    for (int r = 0; r < 16; ++r) {
                        const int ds = dsb - (32 * kb + (r & 3) + 8 * (r >> 2));
                        s[kb][r] = ((unsigned)ds <= (unsigned)W) ? s[kb][r] : -INFINITY;
                    }
            }
            float mx = s[0][0];
#pragma unroll
            for (int r = 1; r < 16; ++r) mx = fmaxf(mx, s[0][r]);
#pragma unroll
            for (int r = 0; r < 16; ++r) mx = fmaxf(mx, s[1][r]);
            mx = fmaxf(mx, __shfl_xor(mx, 32));
            const float mn = fmaxf(m, mx);
            const float base = (mn == -INFINITY) ? 0.f : mn;
            const float alpha = __builtin_amdgcn_exp2f(m - base);
            m = mn;
            float ps = 0.f;
#pragma unroll
            for (int kb = 0; kb < 2; ++kb)
#pragma unroll
                for (int r = 0; r < 16; ++r) { const float p = __builtin_amdgcn_exp2f(s[kb][r] - base); s[kb][r] = p; ps += p; }
            l = l * alpha + ps;
            if (__any(alpha != 1.0f)) {
#pragma unroll
                for (int c = 0; c < DV / 32; ++c)
#pragma unroll
                    for (int r = 0; r < 16; ++r) o[c][r] *= alpha;
            }
            const LAS unsigned char* Vt = lds + L::OFF_V + buf * L::VBUF + hf * 64 * L::VSTR + vlane;
#pragma unroll
            for (int kb = 0; kb < 2; ++kb) {
                bf16x8 pb[2];
#pragma unroll
                for (int k2 = 0; k2 < 2; ++k2) {
                    u32x4 pw; pw.x = pk2(s[kb][8 * k2 + 0], s[kb][8 * k2 + 1]); pw.y = pk2(s[kb][8 * k2 + 2], s[kb][8 * k2 + 3]);
                    pw.z = pk2(s[kb][8 * k2 + 4], s[kb][8 * k2 + 5]); pw.w = pk2(s[kb][8 * k2 + 6], s[kb][8 * k2 + 7]);
                    pb[k2] = __builtin_bit_cast(bf16x8, pw);
                }
#pragma unroll
                for (int ch = 0; ch < DV / 64; ++ch) {
                    bf16x8 vf[2][2];
#pragma unroll
                    for (int k2 = 0; k2 < 2; ++k2)
#pragma unroll
                        for (int c2 = 0; c2 < 2; ++c2) {
                            const LAS unsigned char* vp = Vt + (32 * kb + 16 * k2) * L::VSTR + 64 * (2 * ch + c2);
                            const s16x4 lo = __builtin_bit_cast(s16x4, __builtin_amdgcn_ds_read_tr16_b64_v4i16((LAS s16x4*)(vp)));
                            const s16x4 hh = __builtin_bit_cast(s16x4, __builtin_amdgcn_ds_read_tr16_b64_v4i16((LAS s16x4*)(vp + 8 * L::VSTR)));
                            vf[k2][c2] = (bf16x8){lo[0], lo[1], lo[2], lo[3], hh[0], hh[1], hh[2], hh[3]};
                        }
                    asm volatile("" ::: "memory");
#pragma unroll
                    for (int k2 = 0; k2 < 2; ++k2)
#pragma unroll
                        for (int c2 = 0; c2 < 2; ++c2) o[2 * ch + c2] = __builtin_amdgcn_mfma_f32_32x32x16_bf16(vf[k2][c2], pb[k2], o[2 * ch + c2], 0, 0, 0);
                }
            }
        }
        }
        if (t + 1 < NT2) ATT_STORE(buf ^ 1);
    }
    __syncthreads();
    m_ = m; l_ = l;
#undef ATT_LOAD
#undef ATT_STORE
}

template <int MODE>
__device__ __forceinline__ void attn_phase(LAS unsigned char* lds, const Args& a, int Gn, int cid) {
    constexpr int DQK = MODE == 1 ? 96 : 64, DV = MODE == 2 ? 128 : 64;
    constexpr bool BIAS = MODE != 1;
    constexpr int TABN = MODE == 2 ? 2048 + 256 : 512;
    constexpr int NU = MODE == 0 ? 6144 : (MODE == 2 ? 2048 : 4096);
    constexpr int KT = MODE == 2 ? 64 : 128;
    typedef AttL<DQK, DV, KT> L;
    int tid = threadIdx.x; asm volatile("" : "+v"(tid)); const int lane = tid & 63, r32 = lane & 31, hi = lane >> 5, wid = __builtin_amdgcn_readfirstlane(tid >> 6);
    unsigned char* ws = a.ws;
    const float* biasd = (const float*)(ws + WS_BIAS);
    LAS float* tab = (LAS float*)(lds + L::OFF_TAB);
    float lam = 0.f, lam_init = 0.f;
    if (MODE == 2) {
        float d1 = 0.f, d2 = 0.f;
        for (int i = 0; i < 64; ++i) { d1 += a.in[19][i] * a.in[20][i]; d2 += a.in[21][i] * a.in[22][i]; }
        lam_init = 0.8f - 0.6f * expf(-0.3f * 2.0f);
        lam = expf(d1) - expf(d2) + lam_init;
    }
    for (int u = cid; u < NU; u += Gn) {
        int b, h, dil = 1, res0 = 0, s0, nres = 1, W, qb = 0, g = 0;
        if (MODE == 0) { g = u >> 11; const int rem = u & 2047; b = rem >> 6; h = (rem >> 3) & 7; const int blk = rem & 7; W = 128;
            if (g == 0) { s0 = 256 * blk; } else if (g == 1) { dil = 4; res0 = blk >> 1; s0 = 256 * (blk & 1); } else { dil = 16; res0 = 2 * blk; s0 = 0; nres = 2; } }
        else if (MODE == 3) { b = u >> 7; h = (u >> 3) & 15; s0 = 256 * (u & 7); W = 127; }
        else if (MODE == 1) { const int bh = u & 511; qb = 7 - (u >> 9); b = bh >> 4; h = bh & 15; s0 = 256 * qb; W = 1 << 20; }
        else { const int bh = u & 255; qb = 7 - (u >> 8); b = bh >> 3; h = bh & 7; s0 = 256 * qb; W = 1 << 20; }
        TileGeo G;
        G.dil = dil; G.res0 = res0;
        const int Lseg = 256 / nres;
        if (MODE == 0 || MODE == 3) { G.ks0 = (nres == 1 && s0 >= 128) ? s0 - 128 : 0; } else { G.ks0 = 0; }
        G.TPS = (s0 + Lseg - G.ks0) >> 6; G.NT = G.TPS * nres;
        const int nws = 8 / nres, seg_w = wid / nws, wslot_q0 = s0 + 32 * (wid - seg_w * nws);
        int tl = 0;
        if (MODE == 0 || MODE == 3) { tl = wslot_q0 - W - G.ks0; tl = tl < 0 ? 0 : (tl >> 6); }
        const int th = (wslot_q0 + 31 - G.ks0) >> 6;
        const int my_tlo = seg_w * G.TPS + tl, my_thi = seg_w * G.TPS + th;
        const int qtok = res0 + seg_w + dil * (wslot_q0 + r32);
        const size_t row_q = (size_t)b * SEQ + qtok, row_b = (size_t)b * SEQ;
        const bf16 *Qp, *Kb, *Vb; int qpitch, kpitch, vpitch;
        if (MODE == 0) { const bf16* base = (const bf16*)(ws + R_A_QKV); qpitch = kpitch = vpitch = 4608;
            Qp = base + row_q * 4608 + g * 1536 + h * 64; Kb = base + row_b * 4608 + g * 1536 + 512 + h * 64; Vb = base + row_b * 4608 + g * 1536 + 1024 + h * 64; }
        else if (MODE == 1) { qpitch = 1536; kpitch = 1536; vpitch = 2048;
            Qp = (const bf16*)(ws + R_B_Q) + row_q * 1536 + h * 96; Kb = (const bf16*)(ws + R_B_KH) + row_b * 1536 + h * 96; Vb = (const bf16*)(ws + R_B_KV) + row_b * 2048 + h * 128 + 64; }
        else if (MODE == 2) { const bf16* base = (const bf16*)(ws + R_C_QKV); qpitch = kpitch = vpitch = 3072;
            Qp = base + row_q * 3072 + (2 * h) * 64; Kb = base + row_b * 3072 + 1024 + (2 * h) * 64; Vb = base + row_b * 3072 + 2048 + h * 128; }
        else { const bf16* base = (const bf16*)(ws + R_D_QKV); qpitch = kpitch = vpitch = 1280;
            Qp = base + row_q * 1280 + h * 64; Kb = base + row_b * 1280 + 1024 + (h >> 3) * 64; Vb = base + row_b * 1280 + 1152 + (h >> 3) * 64; }
        (void)qpitch;
        if (MODE == 0 || MODE == 3) { const int d_ = tid - 128; tab[tid] = (d_ >= 0 && d_ <= W) ? biasd[h * 2048 + d_ * dil] : -INFINITY; }
        if (MODE == 2) {
#pragma unroll
            for (int j = 0; j < 4; ++j) tab[128 + tid + 512 * j] = biasd[h * 2048 + tid + 512 * j];
            if (tid < 128) { tab[tid] = -INFINITY; tab[2176 + tid] = 0.f; } }
        bf16x8 qf[DQK / 16];
        constexpr int OFF_Q = L::OFF_TAB + TABN * 4, QSTR = DQK * 2 + 16;
        const int qoff = OFF_Q + (32 * wid + r32) * QSTR + hi * 16;
        int tq = tid; asm volatile("" : "+v"(tq));
        if (MODE == 2) {
            const bf16* qsrc = (const bf16*)(ws + R_C_QKV) + (row_b + s0) * 3072 + (2 * h) * 64;
#pragma unroll
            for (int j = 0; j < 4; ++j) { const int c_ = tq + 512 * j, rw = c_ >> 3, p_ = c_ & 7;
                *(LAS u32x4*)(lds + OFF_Q + rw * QSTR + p_ * 16) = *(const u32x4*)(qsrc + (size_t)rw * 3072 + p_ * 8); }
        } else {
#pragma unroll
            for (int ks = 0; ks < DQK / 16; ++ks) qf[ks] = *(const bf16x8*)(Qp + 16 * ks + 8 * hi);
            if (MODE == 1) {
                float x[DQK / 16][8]; float ss = 0.f;
#pragma unroll
                for (int ks = 0; ks < DQK / 16; ++ks) { const u32x4 raw = __builtin_bit_cast(u32x4, qf[ks]);
#pragma unroll
                    for (int j = 0; j < 4; ++j) { x[ks][2 * j] = bflo(raw[j]); x[ks][2 * j + 1] = bfhi(raw[j]); ss += x[ks][2 * j] * x[ks][2 * j] + x[ks][2 * j + 1] * x[ks][2 * j + 1]; } }
                ss += __shfl_xor(ss, 32);
                const float rsq = rsqrtf(ss * (1.0f / 96.0f) + EPS) * (0.10206207261596577f * LOG2E);
                const float* gq_ = a.in[13];
#pragma unroll
                for (int ks = 0; ks < DQK / 16; ++ks) { const f32x4 g0 = *(const f32x4*)(gq_ + 16 * ks + 8 * hi), g1 = *(const f32x4*)(gq_ + 16 * ks + 8 * hi + 4);
#pragma unroll
                    for (int j = 0; j < 4; ++j) { x[ks][j] *= rsq * g0[j]; x[ks][4 + j] *= rsq * g1[j]; } }
                const float* cs = (const float*)(ws + WS_ROPE) + ((size_t)qtok * 16 + 8 * hi) * 2;
#pragma unroll
                for (int j = 0; j < 8; ++j) { const float co = cs[2 * j], si = cs[2 * j + 1], x1 = x[4][j], x2 = x[5][j]; x[4][j] = x1 * co - x2 * si; x[5][j] = x2 * co + x1 * si; }
#pragma unroll
                for (int ks = 0; ks < DQK / 16; ++ks) { u32x4 w;
#pragma unroll
                    for (int j = 0; j < 4; ++j) w[j] = pk2(x[ks][2 * j], x[ks][2 * j + 1]);
                    qf[ks] = __builtin_bit_cast(bf16x8, w); }
            }
        }
        f32x16 o[DV / 32];
#pragma unroll
        for (int c = 0; c < DV / 32; ++c)
#pragma unroll
            for (int r = 0; r < 16; ++r) o[c][r] = 0.f;
        float m = -INFINITY, l = 0.f;
        if (MODE == 3) { m = a.in[28][h] * LOG2E; l = hi == 0 ? 1.f : 0.f; }
        attn_pass<DQK, DV, BIAS, TABN, MODE == 2, KT>(qoff, lds, Kb, kpitch, Vb, vpitch, G, my_tlo, my_thi, wslot_q0, W, qf, m, l, o);
        float lt = l + __shfl_xor(l, 32);
        float inv = 1.0f / lt;
        if (MODE != 2) {
            bf16* Op; int opitch;
            if (MODE == 0) { Op = (bf16*)(ws + R_A_O3) + ((size_t)g * M_ + row_q) * 512 + h * 64; opitch = 512;
                if (hi == 0) ((float*)(ws + R_A_LSE))[((size_t)g * M_ + row_q) * 8 + h] = m + __log2f(lt); }
            else if (MODE == 1) { Op = (bf16*)(ws + R_B_O) + row_q * 1024 + h * 64; opitch = 1024; }
            else { Op = (bf16*)(ws + R_D_O) + row_q * 1024 + h * 64; opitch = 1024; }
            (void)opitch;
#pragma unroll
            for (int c = 0; c < DV / 32; ++c)
#pragma unroll
                for (int gq = 0; gq < 4; ++gq) {
                    u32x2 w; w.x = pk2(o[c][4 * gq] * inv, o[c][4 * gq + 1] * inv); w.y = pk2(o[c][4 * gq + 2] * inv, o[c][4 * gq + 3] * inv);
                    *(u32x2*)(Op + 32 * c + 8 * gq + 4 * hi) = w;
                }
        } else {
            f32x16 o1[DV / 32];
#pragma unroll
            for (int c = 0; c < DV / 32; ++c)
#pragma unroll
                for (int r = 0; r < 16; ++r) { o1[c][r] = o[c][r] * inv; o[c][r] = 0.f; }
#pragma unroll
            for (int j = 0; j < 4; ++j) tab[128 + tid + 512 * j] = biasd[(8 + h) * 2048 + tid + 512 * j];
            { const bf16* qsrc = (const bf16*)(ws + R_C_QKV) + (row_b + s0) * 3072 + (2 * h + 1) * 64;
#pragma unroll
              for (int j = 0; j < 4; ++j) { const int c_ = tq + 512 * j, rw = c_ >> 3, p_ = c_ & 7;
                  *(LAS u32x4*)(lds + OFF_Q + rw * QSTR + p_ * 16) = *(const u32x4*)(qsrc + (size_t)rw * 3072 + p_ * 8); } }
            m = -INFINITY; l = 0.f;
            attn_pass<DQK, DV, BIAS, TABN, MODE == 2, KT>(qoff, lds, Kb + 64, kpitch, Vb, vpitch, G, my_tlo, my_thi, wslot_q0, W, qf, m, l, o);
            lt = l + __shfl_xor(l, 32);
            inv = lam / lt;
            float ssum = 0.f;
#pragma unroll
            for (int c = 0; c < DV / 32; ++c)
#pragma unroll
                for (int r = 0; r < 16; ++r) { const float d = o1[c][r] - o[c][r] * inv; o1[c][r] = d; ssum += d * d; }
            ssum += __shfl_xor(ssum, 32);
            const float rs = rsqrtf(ssum * (1.0f / 128.0f) + EPS) * (1.0f - lam_init);
            bf16* Op = (bf16*)(ws + R_C_O) + row_q * 1024 + h * 128;
            const float* sub = a.in[23];
#pragma unroll
            for (int c = 0; c < DV / 32; ++c)
#pragma unroll
                for (int gq = 0; gq < 4; ++gq) {
                    const f32x4 sv = *(const f32x4*)(sub + 32 * c + 8 * gq + 4 * hi);
                    u32x2 w; w.x = pk2(o1[c][4 * gq] * rs * sv[0], o1[c][4 * gq + 1] * rs * sv[1]); w.y = pk2(o1[c][4 * gq + 2] * rs * sv[2], o1[c][4 * gq + 3] * rs * sv[3]);
                    *(u32x2*)(Op + 32 * c + 8 * gq + 4 * hi) = w;
                }
        }
    }
}

__device__ __forceinline__ void transpose_item(const float* W, int ldw, int ncol0, int K, const float* ksc, bf16* WT, int mode, LAS float* scr, int nblk, int item, int lane) {
    const int kb = item / nblk, nb = item - kb * nblk, k0 = 64 * kb, n0 = 32 * nb;
#pragma unroll
    for (int i = 0; i < 32; ++i) { const int kk = 2 * i + (lane >> 5); float v = W[(size_t)(k0 + kk) * ldw + ncol0 + n0 + (lane & 31)]; if (ksc != nullptr) v *= ksc[k0 + kk]; scr[kk * 33 + (lane & 31)] = v; }
    asm volatile("s_waitcnt lgkmcnt(0)" ::: "memory");
    const int drow0 = mode == 1 ? (256 * (n0 >> 8) + 128 * ((n0 & 63) >> 5) + 32 * ((n0 >> 6) & 3)) : mode == 2 ? (n0 < DFF ? 256 * (n0 >> 7) + (n0 & 127) : 256 * ((n0 - DFF) >> 7) + 128 + ((n0 - DFF) & 127)) : n0;
    const int c = lane & 7;
#pragma unroll
    for (int j = 0; j < 4; ++j) { const int n = (lane >> 3) + 8 * j; const LAS float* s = scr + (8 * c) * 33 + n;
        u32x4 o; o.x = pk2(s[0 * 33], s[1 * 33]); o.y = pk2(s[2 * 33], s[3 * 33]); o.z = pk2(s[4 * 33], s[5 * 33]); o.w = pk2(s[6 * 33], s[7 * 33]);
        *(u32x4*)(WT + (size_t)(drow0 + n) * K + k0 + 8 * c) = o; }
    asm volatile("s_waitcnt lgkmcnt(0)" ::: "memory");
}
__device__ __forceinline__ void prologue(LAS unsigned char* lds, const Args& a, int Gn, int cid) {
    int tid = threadIdx.x; asm volatile("" : "+v"(tid)); const int lane = tid & 63, wid = __builtin_amdgcn_readfirstlane(tid >> 6);
    unsigned char* ws = a.ws;
    LAS float* scr = (LAS float*)(lds + wid * 16384);
    const int gw = cid * 8 + wid, NGW = Gn * 8;
#define MAT_DESC(id) \
        const float* W; int ldw, ncol0 = 0, K, N, mode; const float* ksc = nullptr; size_t dst; \
        if (id == 0) { W = a.in[4]; ldw = 4608; K = 1024; N = 4608; ksc = a.in[2]; dst = W_AIN; mode = 1; } \
        else if (id == 1) { W = a.in[7]; ldw = 1024; K = 512; N = 1024; dst = W_AOUT; mode = 0; } \
        else if (id == 2) { W = a.in[8]; ldw = 672; K = 1024; N = 672; ksc = a.in[2] + 1024; dst = W_BIN; mode = 1; } \
        else if (id == 3) { W = a.in[11]; ldw = 1536; K = 384; N = 1536; ksc = a.in[9]; dst = W_BQUP; mode = 1; } \
        else if (id == 4) { W = a.in[12]; ldw = 2048; K = 256; N = 2048; ksc = a.in[10]; dst = W_BKVUP; mode = 1; } \
        else if (id == 5) { W = a.in[15]; ldw = 1024; K = 1024; N = 1024; dst = W_BOUT; mode = 0; } \
        else if (id == 6) { W = a.in[16]; ldw = 3072; K = 1024; N = 3072; ksc = a.in[2] + 2048; dst = W_CIN; mode = 1; } \
        else if (id == 7) { W = a.in[24]; ldw = 1024; K = 1024; N = 1024; dst = W_COUT; mode = 0; } \
        else if (id == 8) { W = a.in[25]; ldw = 1280; K = 1024; N = 1280; ksc = a.in[2] + 3072; dst = W_DIN; mode = 1; } \
        else if (id == 9) { W = a.in[29]; ldw = 1024; K = 1024; N = 1024; dst = W_DOUT; mode = 0; } \
        else { const int l = (id - 10) / 3, k3 = (id - 10) - 3 * l; \
            if (k3 < 2) { W = a.in[30] + (size_t)l * 1024 * 5632; ldw = 5632; K = 1024; N = 5632; ksc = a.in[3] + 1024 * l; dst = W_FG + l * 2 * W_FSTR; mode = 2; } \
            else { W = a.in[33] + (size_t)l * 2816 * 1024; ldw = 1024; K = 2816; N = 1024; dst = W_FD + l * W_FSTR; mode = 0; } }
    constexpr int TOTAL_ITEMS = 2304 + 256 + 336 + 288 + 256 + 512 + 1536 + 512 + 640 + 512 + 4 * (1408 + 1408 + 1408);
    for (int it = gw; it < TOTAL_ITEMS; it += NGW) {
        int r = it, id = 0;
        for (; id < 21; ++id) {
            int n_;
            if (id < 10) { n_ = id == 0 ? 2304 : id == 1 ? 256 : id == 2 ? 336 : id == 3 ? 288 : id == 4 ? 256 : id == 5 ? 512 : id == 6 ? 1536 : id == 7 ? 512 : id == 8 ? 640 : 512; } else { const int k3_ = (id - 10) % 3; n_ = k3_ == 0 ? 2816 : (k3_ == 1 ? 0 : 1408); }
            if (r < n_) break;
            r -= n_;
        }
        MAT_DESC(id)
        const int nblk = N / 32;
        transpose_item(W, ldw, ncol0, K, ksc, (bf16*)(ws + dst), mode, scr, nblk, r, lane);
    }
#undef MAT_DESC
    const int gt = cid * 512 + tid, NT = Gn * 512;
    { float* biasd = (float*)(ws + WS_BIAS); const float* table = a.in[1];
      for (int i = gt; i < 16 * 2048; i += NT) { const int h = i >> 11, d = i & 2047; int bk = d;
          if (d >= 16) { float t = logf((float)d / 16.0f); t = t / 4.852030263919617f; t = t * 16.0f; int lg = 16 + (int)t; bk = lg < 31 ? lg : 31; }
          biasd[i] = table[bk * 16 + h] * LOG2E; } }
    { float* rope = (float*)(ws + WS_ROPE);
      for (int i = gt; i < 2048 * 16; i += NT) { const int pos = i >> 4, f = i & 15; const float inv = powf(10000.0f, -(float)(2 * f) / 32.0f); const float ang = (float)pos * inv;
          rope[2 * i] = cosf(ang); rope[2 * i + 1] = sinf(ang); } }
    { const float* x = a.in[0]; bf16* xb = (bf16*)(ws + WS_XB); float* rss = (float*)(ws + WS_RSS);
      for (int m0 = gw; m0 < M_; m0 += 4 * NGW) {
          f32x4 v[4][4];
#pragma unroll
          for (int k = 0; k < 4; ++k) { const int m = m0 + k * NGW; if (m < M_) { const f32x4* xr = (const f32x4*)(x + (size_t)m * DMODEL) + lane;
#pragma unroll
              for (int j = 0; j < 4; ++j) v[k][j] = xr[64 * j]; } }
#pragma unroll
          for (int k = 0; k < 4; ++k) { const int m = m0 + k * NGW; if (m < M_) { u32x2* o8 = (u32x2*)(xb + (size_t)m * DMODEL) + lane; float s = 0.f;
#pragma unroll
              for (int j = 0; j < 4; ++j) { s += dot4(v[k][j]); u32x2 w; w.x = pk2(v[k][j][0], v[k][j][1]); w.y = pk2(v[k][j][2], v[k][j][3]); o8[64 * j] = w; }
              s = wave_sum(s); if (lane == 0) rss[m] = rsqrtf(s * (1.0f / 1024.0f) + EPS); } } } }
}
__device__ __forceinline__ void combine_a(const Args& a, int Gn, int cid) {
    unsigned char* ws = a.ws;
    const bf16* o3 = (const bf16*)(ws + R_A_O3); const float* lse = (const float*)(ws + R_A_LSE); bf16* oc = (bf16*)(ws + R_A_OC);
    const size_t NT = (size_t)Gn * 512; int tid = threadIdx.x; asm volatile("" : "+v"(tid));
    for (size_t idx0 = (size_t)cid * 512 + tid; idx0 < (size_t)M_ * 64; idx0 += 4 * NT) {
        u32x4 a0[4], a1[4], a2[4]; float l0[4], l1[4], l2[4];
#pragma unroll
        for (int k = 0; k < 4; ++k) { const size_t idx = idx0 + k * NT; if (idx < (size_t)M_ * 64) {
            const size_t row = idx >> 6; const int ch = (int)(idx & 63), h = ch >> 3;
            l0[k] = lse[row * 8 + h]; l1[k] = lse[((size_t)M_ + row) * 8 + h]; l2[k] = lse[((size_t)2 * M_ + row) * 8 + h];
            a0[k] = *(const u32x4*)(o3 + row * 512 + ch * 8); a1[k] = *(const u32x4*)(o3 + ((size_t)M_ + row) * 512 + ch * 8); a2[k] = *(const u32x4*)(o3 + ((size_t)2 * M_ + row) * 512 + ch * 8); } }
#pragma unroll
        for (int k = 0; k < 4; ++k) { const size_t idx = idx0 + k * NT; if (idx < (size_t)M_ * 64) {
            const size_t row = idx >> 6; const int ch = (int)(idx & 63);
            const float mx = fmaxf(l0[k], fmaxf(l1[k], l2[k]));
            float w0 = __builtin_amdgcn_exp2f(l0[k] - mx), w1 = __builtin_amdgcn_exp2f(l1[k] - mx), w2 = __builtin_amdgcn_exp2f(l2[k] - mx);
            const float inv = 1.0f / (w0 + w1 + w2); w0 *= inv; w1 *= inv; w2 *= inv;
            u32x4 r;
#pragma unroll
            for (int j = 0; j < 4; ++j) r[j] = pk2(w0 * bflo(a0[k][j]) + w1 * bflo(a1[k][j]) + w2 * bflo(a2[k][j]), w0 * bfhi(a0[k][j]) + w1 * bfhi(a1[k][j]) + w2 * bfhi(a2[k][j]));
            *(u32x4*)(oc + row * 512 + ch * 8) = r; } }
    }
}
__device__ __forceinline__ void prep_b(const Args& a, int Gn, int cid) {
    unsigned char* ws = a.ws;
    int tid = threadIdx.x; asm volatile("" : "+v"(tid)); const int lane = tid & 63, wid = __builtin_amdgcn_readfirstlane(tid >> 6);
    bf16* Q = (bf16*)(ws + R_B_Q); const bf16* KV = (const bf16*)(ws + R_B_KV); const bf16* KPE = (const bf16*)(ws + R_B_KPE); bf16* KH = (bf16*)(ws + R_B_KH);
    const float* rope = (const float*)(ws + WS_ROPE);
    const int sub = lane >> 4, c = lane & 15;
    const float qscale = 0.10206207261596577f * LOG2E;
    const int gw = cid * 8 + wid, NGW = Gn * 8;
    const int TOT = 2 * M_ * 4;
    for (int it0 = M_ * 4 + gw; it0 < TOT; it0 += 4 * NGW) {
        u32x4 raw[4];
#pragma unroll
        for (int k = 0; k < 4; ++k) {
            const int it = it0 + k * NGW;
            raw[k] = (u32x4){0u, 0u, 0u, 0u};
            if (it < TOT && c < 12) {
                const bool isk = it >= M_ * 4; const int it2 = isk ? it - M_ * 4 : it;
                const int task = it2 * 4 + sub; const size_t row = (size_t)(task >> 4); const int h = task & 15;
                if (!isk) raw[k] = *(const u32x4*)(Q + row * 1536 + h * 96 + 8 * c);
                else if (c < 8) raw[k] = *(const u32x4*)(KV + row * 2048 + h * 128 + 8 * c);
                else raw[k] = *(const u32x4*)(KPE + row * 64 + 8 * (c - 8));
            }
        }
#pragma unroll
        for (int k = 0; k < 4; ++k) {
            const int it = it0 + k * NGW;
            if (it < TOT) {
                const bool isk = it >= M_ * 4; const int it2 = isk ? it - M_ * 4 : it;
                const int task = it2 * 4 + sub; const size_t row = (size_t)(task >> 4); const int h = task & 15; const int pos = (int)(row & 2047);
                float x[8];
#pragma unroll
                for (int j = 0; j < 4; ++j) { x[2 * j] = bflo(raw[k][j]); x[2 * j + 1] = bfhi(raw[k][j]); }
                float ss = 0.f;
#pragma unroll
                for (int e = 0; e < 8; ++e) ss += x[e] * x[e];
                ss += __shfl_xor(ss, 1); ss += __shfl_xor(ss, 2); ss += __shfl_xor(ss, 4); ss += __shfl_xor(ss, 8);
                const float rs = rsqrtf(ss * (1.0f / 96.0f) + EPS);
                const float* gain = (isk ? a.in[14] : a.in[13]) + 8 * (c < 12 ? c : 0);
                const float* cs = rope + ((size_t)pos * 16 + (c & 1) * 8) * 2;
                float y[8];
#pragma unroll
                for (int e = 0; e < 8; ++e) y[e] = x[e] * rs * gain[e];
#pragma unroll
                for (int e = 0; e < 8; ++e) {
                    const float z = __shfl_xor(y[e], 2);
                    if (c >= 8 && c < 12) { const float co = cs[2 * e], si = cs[2 * e + 1]; y[e] = (c < 10) ? (y[e] * co - z * si) : (y[e] * co + z * si); }
                }
                if (c < 12) {
                    u32x4 w;
                    if (!isk) {
#pragma unroll
                        for (int j = 0; j < 4; ++j) w[j] = pk2(y[2 * j] * qscale, y[2 * j + 1] * qscale);
                        *(u32x4*)(Q + row * 1536 + h * 96 + 8 * c) = w;
                    } else {
#pragma unroll
                        for (int j = 0; j < 4; ++j) w[j] = pk2(y[2 * j], y[2 * j + 1]);
                        *(u32x4*)(KH + row * 1536 + h * 96 + 8 * c) = w;
                    }
                }
            }
        }
    }
}

__device__ __forceinline__ void fixup_ffn(const bf16* gedge, const bf16* uedge, bf16* act, const float* cw, const float* cb, int Gn, int cid) {
    int tid = threadIdx.x; asm volatile("" : "+v"(tid));
    const int TOT = 1024 * 2 * 352;
    for (int idx = cid * 512 + tid; idx < TOT; idx += Gn * 512) {
        const int ch = idx % 352, sj = idx / 352, j = sj & 1, st = sj >> 1, c0 = ch * 8;
        const int row = st * 64 + j, t = row & (SEQ - 1);
        const u32x4 z = (u32x4){0u, 0u, 0u, 0u};
        const u32x4 g0 = *(const u32x4*)(gedge + ((size_t)st * 4 + j) * DFF + c0);
        u32x4 g1, g2;
        if (j == 0) { g1 = t >= 1 ? *(const u32x4*)(gedge + ((size_t)(st - 1) * 4 + 3) * DFF + c0) : z; g2 = t >= 2 ? *(const u32x4*)(gedge + ((size_t)(st - 1) * 4 + 2) * DFF + c0) : z; }
        else { g1 = *(const u32x4*)(gedge + ((size_t)st * 4 + 0) * DFF + c0); g2 = t >= 2 ? *(const u32x4*)(gedge + ((size_t)(st - 1) * 4 + 3) * DFF + c0) : z; }
        const u32x4 uw = *(const u32x4*)(uedge + ((size_t)st * 2 + j) * DFF + c0);
        u32x4 w;
#pragma unroll
        for (int n = 0; n < 2; ++n) {
            const f32x4 w0 = *(const f32x4*)(cw + c0 + 4 * n), w1 = *(const f32x4*)(cw + DFF + c0 + 4 * n), w2 = *(const f32x4*)(cw + 2 * DFF + c0 + 4 * n), b = *(const f32x4*)(cb + c0 + 4 * n);
            float r[4];
#pragma unroll
            for (int e = 0; e < 4; ++e) {
                const unsigned q0 = g0[2 * n + (e >> 1)], q1 = g1[2 * n + (e >> 1)], q2 = g2[2 * n + (e >> 1)], qu = uw[2 * n + (e >> 1)];
                const float x0 = (e & 1) ? bfhi(q0) : bflo(q0), x1 = (e & 1) ? bfhi(q1) : bflo(q1), x2 = (e & 1) ? bfhi(q2) : bflo(q2), up = (e & 1) ? bfhi(qu) : bflo(qu);
                const float cv = b[e] + w2[e] * x0 + w1[e] * x1 + w0[e] * x2;
                r[e] = cv * __builtin_amdgcn_rcpf(1.0f + __builtin_amdgcn_exp2f(-LOG2E * cv)) * up;
            }
            w[2 * n] = pk2(r[0], r[1]); w[2 * n + 1] = pk2(r[2], r[3]);
        }
        *(u32x4*)(act + (size_t)row * DFF + c0) = w;
    }
}
__device__ __forceinline__ void rstd_pass(const float* ssp, int nvec, float invdim, float* rs, int Gn, int cid) {
    int tid = threadIdx.x; asm volatile("" : "+v"(tid));
    for (int row = cid * 512 + tid; row < M_; row += Gn * 512) rs[row] = rsqrtf(rowss_sum(ssp, nvec, row) * invdim + EPS);
}
__device__ __forceinline__ void kpe_pass(const Args& a, int Gn, int cid) {
    unsigned char* ws = a.ws;
    int tid = threadIdx.x; asm volatile("" : "+v"(tid));
    const bf16* KPE = (const bf16*)(ws + R_B_KPE); bf16* RK = (bf16*)(ws + R_B_RK); float* sspe = (float*)(ws + WS_SSPE);
    const float* rope = (const float*)(ws + WS_ROPE); const float* gk = a.in[14] + 64;
    for (int row = cid * 512 + tid; row < M_; row += Gn * 512) {
        float x[32]; float ss = 0.f;
#pragma unroll
        for (int c = 0; c < 4; ++c) { const u32x4 raw = *(const u32x4*)(KPE + (size_t)row * 64 + 8 * c);
#pragma unroll
            for (int j = 0; j < 4; ++j) { x[8 * c + 2 * j] = bflo(raw[j]); x[8 * c + 2 * j + 1] = bfhi(raw[j]); } }
#pragma unroll
        for (int i = 0; i < 32; ++i) { ss += x[i] * x[i]; x[i] *= gk[i]; }
        sspe[row] = ss;
        const float* cs = rope + (size_t)(row & (SEQ - 1)) * 32;
#pragma unroll
        for (int i = 0; i < 16; ++i) { const float co = cs[2 * i], si = cs[2 * i + 1], x1 = x[i], x2 = x[16 + i]; x[i] = x1 * co - x2 * si; x[16 + i] = x2 * co + x1 * si; }
#pragma unroll
        for (int c = 0; c < 4; ++c) { u32x4 w;
#pragma unroll
            for (int j = 0; j < 4; ++j) w[j] = pk2(x[8 * c + 2 * j], x[8 * c + 2 * j + 1]);
            *(u32x4*)(RK + (size_t)row * 32 + 8 * c) = w; }
    }
}
__device__ __forceinline__ void rstd_local(const float* ssp, float* rs, const pg8::StaticOrder& S, int nunits) {
    int tid = threadIdx.x; asm volatile("" : "+v"(tid));
    const int TOT = nunits * 256;
    for (int k0 = tid; k0 < TOT; k0 += 4 * 512) {
        f32x4 p[4][4]; int rows[4];
#pragma unroll
        for (int j = 0; j < 4; ++j) { const int k = k0 + j * 512; rows[j] = -1;
            if (k < TOT) { pg8::Unit uu; S.next(k >> 8, uu); rows[j] = uu.pm * 256 + (k & 255); const f32x4* q = (const f32x4*)(ssp + (size_t)rows[j] * 16);
#pragma unroll
                for (int v = 0; v < 4; ++v) p[j][v] = q[v]; } }
#pragma unroll
        for (int j = 0; j < 4; ++j) if (rows[j] >= 0) { float t = 0.f;
#pragma unroll
            for (int v = 0; v < 4; ++v) t += (p[j][v][0] + p[j][v][1]) + (p[j][v][2] + p[j][v][3]);
            rs[rows[j]] = rsqrtf(t * (1.0f / 1024.0f) + EPS); }
    }
    asm volatile("s_waitcnt vmcnt(0)" ::: "memory");
    __syncthreads();
}
__device__ __forceinline__ void grid_barrier(unsigned* cnt, unsigned& epoch, unsigned G) {
    asm volatile("s_waitcnt vmcnt(0) lgkmcnt(0)" ::: "memory");
    __syncthreads();
    epoch += 1u;
    if (threadIdx.x == 0) {
        __builtin_amdgcn_fence(__ATOMIC_RELEASE, "agent");
        asm volatile("s_waitcnt vmcnt(0)" ::: "memory");
        __hip_atomic_fetch_add(cnt, 1u, __ATOMIC_RELAXED, __HIP_MEMORY_SCOPE_AGENT);
        const unsigned want = epoch * G;
        while (__hip_atomic_load(cnt, __ATOMIC_RELAXED, __HIP_MEMORY_SCOPE_AGENT) < want) __builtin_amdgcn_s_sleep(2);
        __builtin_amdgcn_fence(__ATOMIC_ACQUIRE, "agent");
        asm volatile("s_waitcnt vmcnt(0)" ::: "memory");
    }
    __syncthreads();
}
__global__ void __launch_bounds__(512) fwd_kernel(Args a) {
    extern __shared__ __attribute__((aligned(16))) unsigned char lds_raw[];
    LAS unsigned char* lds = (LAS unsigned char*)lds_raw;
    cg::grid_group grid = cg::this_grid();
    const int Gn = (int)gridDim.x, cid = (int)blockIdx.x;
    unsigned char* ws = a.ws;
    unsigned* barcnt = (unsigned*)(ws + WS_BAR); unsigned epoch = 0u;
    prologue(lds, a, Gn, cid);
    grid.sync();
    grid_barrier(barcnt, epoch, (unsigned)Gn);
    bf16* XB = (bf16*)(ws + WS_XB);
    float* RSS = (float*)(ws + WS_RSSP); float* RSTD = (float*)(ws + WS_RSS);
    for (int ph = 0; ph < 28; ++ph) {
        int type = 0, N = 1024, K = 1024, ldc = 0, hm = 0, layer = 0, sidx = 0, nvec = 4, pbuf = -1;
        const bf16 *A = XB, *Bt = nullptr; bf16* pO = nullptr; const float* pss = RSTD; const float *gq = nullptr, *gk = nullptr; float qs = 0.125f * LOG2E;
        const float* rbase = nullptr; float* rout = nullptr; bf16* rxb = XB; float* rssn = nullptr;
        int f = -1;
        switch (ph) {
        case 0: type = 0; Bt = (const bf16*)(ws + W_AIN); N = 4608; pO = (bf16*)(ws + R_A_QKV); ldc = 4608; hm = 1; gq = a.in[5]; gk = a.in[6]; break;
        case 1: type = 4; break;
        case 2: type = 8; break;
        case 3: type = 1; A = (const bf16*)(ws + R_A_OC); Bt = (const bf16*)(ws + W_AOUT); K = 512; rbase = a.in[0]; rssn = RSS + 1 * (size_t)M_ * 16; break;
        case 4: case 5: case 6: layer = 0; sidx = 1; f = ph - 4; break;
        case 7: type = 2; Bt = (const bf16*)(ws + W_BIN); N = 768; pbuf = 0; break;
        case 8: type = 0; A = (const bf16*)(ws + R_B_CQ); Bt = (const bf16*)(ws + W_BQUP); N = 1536; K = 384; pO = (bf16*)(ws + R_B_Q); ldc = 1536; pss = (const float*)(ws + WS_SSQ); break;
        case 9: type = 10; break;
        case 10: type = 10; break;
        case 11: type = 5; break;
        case 12: type = 1; A = (const bf16*)(ws + R_B_O); Bt = (const bf16*)(ws + W_BOUT); rssn = RSS + 1 * (size_t)M_ * 16; break;
        case 13: case 14: case 15: layer = 1; sidx = 3; f = ph - 13; break;
        case 16: type = 0; Bt = (const bf16*)(ws + W_CIN); N = 3072; pO = (bf16*)(ws + R_C_QKV); ldc = 3072; pbuf = 0; hm = 2; gq = a.in[17]; gk = a.in[18]; break;
        case 17: type = 6; break;
        case 18: type = 1; A = (const bf16*)(ws + R_C_O); Bt = (const bf16*)(ws + W_COUT); rssn = RSS + 1 * (size_t)M_ * 16; break;
        case 19: case 20: case 21: layer = 2; sidx = 5; f = ph - 19; break;
        case 22: type = 0; Bt = (const bf16*)(ws + W_DIN); N = 1280; pO = (bf16*)(ws + R_D_QKV); ldc = 1280; pbuf = 0; hm = 3; gq = a.in[26]; gk = a.in[27]; break;
        case 23: type = 7; break;
        case 24: type = 1; A = (const bf16*)(ws + R_D_O); Bt = (const bf16*)(ws + W_DOUT); rssn = RSS + 1 * (size_t)M_ * 16; break;
        default: layer = 3; sidx = 7; f = ph - 25; break;
        }
        if (f == 0) { type = 3; Bt = (const bf16*)(ws + W_FG + layer * 2 * W_FSTR); N = 2 * DFF; pbuf = 1; }
        else if (f == 1) { type = 11; }
        else if (f == 2) { type = 1; A = (const bf16*)(ws + R_ACT); Bt = (const bf16*)(ws + W_FD + layer * W_FSTR); K = DFF;
            if (layer < 3) { rssn = RSS + ((sidx + 1) & 1) * (size_t)M_ * 16; } else { rssn = nullptr; rxb = nullptr; rout = a.out; } }

        if (type == 10) continue;
        if (type <= 3) {
            pg8::Gemm g{A, Bt, M_, N, K}; pg8::StaticOrder S; S.init(M_, N, Gn, cid);
            if (pbuf >= 0) rstd_local(RSS + (size_t)pbuf * M_ * 16, RSTD, S, (S.nwg - cid + Gn - 1) / Gn);
            if (type == 0) {
                for (int sub = 0; sub < (ph == 8 ? 2 : 1); ++sub) {
                    const bool kv = (sub == 1);
                    const pg8::Gemm g2{kv ? (const bf16*)(ws + R_B_CKV) : A, kv ? (const bf16*)(ws + W_BKVUP) : Bt, M_, kv ? 2048 : N, kv ? 256 : K};
                    pg8::StaticOrder S2; S2.init(M_, kv ? 2048 : N, Gn, cid);
                    const EpiProj E{kv ? (bf16*)(ws + R_B_KV) : pO, kv ? 2048 : ldc, kv ? (const float*)(ws + WS_SSKV) : pss, kv ? 4 : hm, gq, kv ? a.in[14] : gk, qs};
                    pg8::gemm_phase<EpiProj, pg8::StaticOrder, true, true>(lds, g2, S2, E);
                }
            }
            else if (type == 1) { EpiRes E{rbase, rout, XB, rxb, rssn}; pg8::gemm_phase<EpiRes, pg8::StaticOrder, true, true>(lds, g, S, E); }
            else if (type == 2) { EpiLat E{(bf16*)(ws + R_B_CQ), (bf16*)(ws + R_B_CKV), (bf16*)(ws + R_B_KPE), pss, (float*)(ws + WS_SSQP), (float*)(ws + WS_SSKVP)}; pg8::gemm_phase<EpiLat, pg8::StaticOrder, true, true>(lds, g, S, E); }
            else { EpiGateUp E{(bf16*)(ws + R_ACT), (bf16*)(ws + R_GATE), (bf16*)(ws + R_GATE + 32 * MiB), pss, a.in[31] + (size_t)layer * 3 * DFF, a.in[32] + (size_t)layer * DFF}; pg8::gemm_phase<EpiGateUp, pg8::StaticOrder, true, true>(lds, g, S, E); }
        }
        else if (type == 4) attn_phase<0>(lds, a, Gn, cid);
        else if (type == 5) attn_phase<1>(lds, a, Gn, cid);
        else if (type == 6) attn_phase<2>(lds, a, Gn, cid);
        else if (type == 7) attn_phase<3>(lds, a, Gn, cid);
        else if (type == 8) combine_a(a, Gn, cid);
        else if (type == 11) fixup_ffn((const bf16*)(ws + R_GATE), (const bf16*)(ws + R_GATE + 32 * MiB), (bf16*)(ws + R_ACT), a.in[31] + (size_t)layer * 3 * DFF, a.in[32] + (size_t)layer * DFF, Gn, cid);
        else prep_b(a, Gn, cid);
        grid_barrier(barcnt, epoch, (unsigned)Gn);
        if (type == 2) { rstd_pass((const float*)(ws + WS_SSQP), 2, 1.0f / 384.0f, (float*)(ws + WS_SSQ), Gn, cid); rstd_pass((const float*)(ws + WS_SSKVP), 1, 1.0f / 256.0f, (float*)(ws + WS_SSKV), Gn, cid); kpe_pass(a, Gn, cid);
            grid_barrier(barcnt, epoch, (unsigned)Gn); }
    }
}

extern "C" void kernel_launch(void* const* d_in, const int* in_sizes, int n_in, void* d_out, int out_size, void* d_ws, size_t ws_size, hipStream_t stream) {
    static int grid = 0;
    if (grid == 0) {
        if (n_in != 34 || out_size != M_ * DMODEL || ws_size < WS_NEED) { fprintf(stderr, "kernel_launch: unexpected shapes (n_in %d out %d ws %zu)\n", n_in, out_size, ws_size); grid = -1; return; }
        int dev = 0, cus = 0, per_cu = 0;
        if (hipGetDevice(&dev) != hipSuccess || hipDeviceGetAttribute(&cus, hipDeviceAttributeMultiprocessorCount, dev) != hipSuccess) { grid = -1; return; }
        if (hipFuncSetAttribute((const void*)fwd_kernel, hipFuncAttributeMaxDynamicSharedMemorySize, LDS_BYTES) != hipSuccess) { fprintf(stderr, "kernel_launch: hipFuncSetAttribute failed\n"); grid = -1; return; }
        if (hipOccupancyMaxActiveBlocksPerMultiprocessor(&per_cu, (const void*)fwd_kernel, 512, LDS_BYTES) != hipSuccess || per_cu < 1) { fprintf(stderr, "kernel_launch: occupancy query says %d\n", per_cu); per_cu = 1; }
        (void)hipGetLastError();
        grid = cus;
    }
    if (grid < 0) return;
    if (hipMemsetAsync((unsigned char*)d_ws + WS_BAR, 0, 256, stream) != hipSuccess) { fprintf(stderr, "kernel_launch: memset failed\n"); return; }
    Args a{};
    for (int i = 0; i < 34; ++i) a.in[i] = (const float*)d_in[i];
    a.out = (float*)d_out; a.ws = (unsigned char*)d_ws;
    void* args[] = {&a};
    hipError_t e = hipLaunchCooperativeKernel((const void*)fwd_kernel, dim3(grid), dim3(512), args, LDS_BYTES, stream);
    if (e != hipSuccess) fprintf(stderr, "cooperative launch failed: %s (grid %d)\n", hipGetErrorString(e), grid);
}
```

```cpp
#include <hip/hip_runtime.h>
#include <hip/hip_cooperative_groups.h>
#include <cstdio>
#include <cstdint>
namespace cg = cooperative_groups;
namespace pg8 {
#define PG8_LAS __attribute__((address_space(3)))
typedef unsigned short bf16_t;
typedef short bf16x8 __attribute__((ext_vector_type(8)));
typedef float f32x4 __attribute__((ext_vector_type(4)));
typedef unsigned u32x4 __attribute__((ext_vector_type(4)));
constexpr int BM = 256, BK = 64, HALF = 128, HTB = HALF * BK * 2  , STAGE_BYTES = 8 * HTB, NXCD = 8, WGM = 8;

__host__ __device__ __forceinline__ int lds_byte(int r, int c) { const int st = (r >> 4) * 2 + (c >> 5), rr = r & 15, cc = c & 31, ob = rr * 64 + cc * 2; return st * 1024 + (ob ^ (((ob >> 9) & 1) << 5)); }
__host__ __device__ __forceinline__ void stage_rc(int b, int& R, int& C) { const int st = b / 1024, sb = b % 1024, swz = sb ^ (((sb >> 9) & 1) << 5); R = (st >> 1) * 16 + swz / 64; C = (st & 1) * 32 + (swz % 64) / 2; }
__host__ __device__ __forceinline__ int perm32(int rho) { const int n = rho >> 4, i = rho & 15; return 8 * (i >> 2) + 4 * n + (i & 3); }

struct Unit { int pm, pn; };
struct Gemm { const bf16_t* A; const bf16_t* Bt; int M, N, K; };

struct StaticOrder {
    int nM, nN, nwg, G, c;
    __host__ __device__ void init(int M, int N, int G_, int c_) { nM = M / BM; nN = N / BM; nwg = nM * nN; G = G_; c = c_; }
    __host__ __device__ bool next(int i, Unit& u) const {
        const long L = (long)i * G + c; if (L >= nwg) return false;
        int wgid = (int)L; { const int q = nwg / NXCD, r = nwg % NXCD, xcd = wgid % NXCD, off = wgid / NXCD; wgid = (xcd < r ? xcd * (q + 1) : r * (q + 1) + (xcd - r) * q) + off; }
        const int nig = WGM * nN, gid = wgid / nig, fm = gid * WGM, gsz = (nM - fm) < WGM ? (nM - fm) : WGM;
        u.pm = fm + ((wgid % nig) % gsz); u.pn = (wgid % nig) / gsz; return true;
    }
    __device__ __forceinline__ void a_ready(const Unit&) const {}
    __device__ __forceinline__ void done(const Unit&) const {}
};

__device__ __forceinline__ unsigned cvt_pk_bf16(float lo, float hi) { unsigned r; asm volatile("v_cvt_pk_bf16_f32 %0, %1, %2" : "=v"(r) : "v"(lo), "v"(hi)); return r; }
template <class Epi, class Sched, bool ALIGN_EPI = false, bool SP2 = false>
__device__ __forceinline__ void gemm_phase(PG8_LAS unsigned char* lds, const Gemm g, const Sched& S, const Epi& E) {
    int tid = threadIdx.x; asm volatile("" : "+v"(tid)); const int wid = __builtin_amdgcn_readfirstlane(tid >> 6), lane = tid & 63, wr = wid >> 2, wc = wid & 3, fr = lane & 15, fq = lane >> 4;
    const int K = g.K, nt = K / BK;
    unsigned voffA[2], voffB[2];
#pragma unroll
    for (int i = 0; i < 2; ++i) { int R, C; stage_rc(tid * 16 + i * 8192, R, C); const int Rb = Epi::PERM ? ((R & ~31) + perm32(R & 31)) : R;
        voffA[i] = (unsigned)(R * K + C) * 2u; voffB[i] = (unsigned)(Rb * K + C) * 2u; }
    const size_t kstep = (size_t)(BK * 2);
    const size_t hstep = (size_t)HALF * K * 2;
    const size_t tstep = 2 * hstep;
    const unsigned ldsw = (unsigned)wid * 1024u;
    const int aoff = lds_byte(wr * 64 + fr, fq * 8), boff = lds_byte(wc * 32 + fr, fq * 8);
#define PG8_SA(b, h) (((b) * 2 + (h)) * HTB)
#define PG8_SB(b, h) ((4 + (b) * 2 + (h)) * HTB)
#define PG8_STAGE(bufoff, gbase, voff) do { _Pragma("unroll") for (int _i = 0; _i < 2; ++_i) \
        __builtin_amdgcn_global_load_lds((const unsigned*)((const char*)(gbase) + (voff)[_i]), (PG8_LAS unsigned*)(lds + (bufoff) + ldsw + _i * 8192), 16, 0, 0); } while (0)
#define PG8_LDA(dst, b, h) do { _Pragma("unroll") for (int m = 0; m < 4; ++m) _Pragma("unroll") for (int k = 0; k < 2; ++k) dst[m][k] = *(const PG8_LAS bf16x8*)(lds + PG8_SA(b, h) + aoff + m * 2048 + k * 1024); } while (0)
#define PG8_LDB(dst, b, h) do { _Pragma("unroll") for (int n = 0; n < 2; ++n) _Pragma("unroll") for (int k = 0; k < 2; ++k) dst[n][k] = *(const PG8_LAS bf16x8*)(lds + PG8_SB(b, h) + boff + n * 2048 + k * 1024); } while (0)
#define PG8_MMA(ai, bj, At, Bt) do { __builtin_amdgcn_s_setprio(1); _Pragma("unroll") for (int m = 0; m < 4; ++m) _Pragma("unroll") for (int n = 0; n < 2; ++n) _Pragma("unroll") for (int k = 0; k < 2; ++k) \
        acc[ai][bj][m][n] = __builtin_amdgcn_mfma_f32_16x16x32_bf16(Bt[n][k], At[m][k], acc[ai][bj][m][n], 0, 0, 0); __builtin_amdgcn_s_setprio(0); } while (0)
#define PG8_WAIT_V(n) asm volatile("s_waitcnt vmcnt(" #n ")" ::: "memory")
#define PG8_WAIT_L(n) asm volatile("s_waitcnt lgkmcnt(" #n ")" ::: "memory")
#define PG8_BAR __builtin_amdgcn_s_barrier()
#define PG8_SCHED __builtin_amdgcn_sched_barrier(0)
    Unit cur, nxt; int ui = 0;
    if (!S.next(0, cur)) return;
    f32x4 acc[2][2][4][2];
#pragma unroll
    for (int a = 0; a < 2; ++a)
#pragma unroll
        for (int b = 0; b < 2; ++b)
#pragma unroll
            for (int m = 0; m < 4; ++m)
#pragma unroll
                for (int n = 0; n < 2; ++n) acc[a][b][m][n] = (f32x4){0.f, 0.f, 0.f, 0.f};
    bf16x8 At[4][2], B0[2][2], B1[2][2];
    const char* cA = (const char*)g.A + (size_t)cur.pm * tstep; const char* cB = (const char*)g.Bt + (size_t)cur.pn * tstep;
    S.a_ready(cur);
    if constexpr (SP2) {
        PG8_STAGE(PG8_SB(0, 0), cB, voffB); PG8_STAGE(PG8_SB(0, 1), cB + hstep, voffB); PG8_STAGE(PG8_SA(0, 0), cA, voffA); PG8_STAGE(PG8_SA(0, 1), cA + hstep, voffA);
        if (wr == 1) PG8_BAR;
        PG8_WAIT_V(2); PG8_BAR;
        PG8_STAGE(PG8_SB(1, 0), cB + kstep, voffB); PG8_STAGE(PG8_SA(1, 0), cA + kstep, voffA); PG8_STAGE(PG8_SB(1, 1), cB + hstep + kstep, voffB);
        PG8_WAIT_V(6); PG8_BAR;
    } else {
        PG8_STAGE(PG8_SB(0, 0), cB, voffB); PG8_STAGE(PG8_SA(0, 0), cA, voffA); PG8_STAGE(PG8_SB(0, 1), cB + hstep, voffB); PG8_STAGE(PG8_SA(0, 1), cA + hstep, voffA);
        if (wr == 1) PG8_BAR;
        PG8_WAIT_V(4); PG8_BAR;
        PG8_STAGE(PG8_SB(1, 0), cB + kstep, voffB); PG8_STAGE(PG8_SA(1, 0), cA + kstep, voffA); PG8_STAGE(PG8_SB(1, 1), cB + hstep + kstep, voffB);
        PG8_WAIT_V(6); PG8_BAR;
    }
    for (;;) {
        const bool has_next = S.next(ui + 1, nxt);
        const char* nA = has_next ? (const char*)g.A + (size_t)nxt.pm * tstep : cA; const char* nB = has_next ? (const char*)g.Bt + (size_t)nxt.pn * tstep : cB;
        for (int t = 0; t < nt; t += 2) {
            const bool last = (t == nt - 2);
            const char* a1 = cA + (size_t)(t + 1) * kstep;
            const char* a2 = last ? nA : cA + (size_t)(t + 2) * kstep; const char* b2 = last ? nB : cB + (size_t)(t + 2) * kstep;
            const char* a3 = a2 + kstep; const char* b3 = b2 + kstep;
            if (last && has_next) S.a_ready(nxt);
            if constexpr (SP2) {
            PG8_LDB(B0, 0, 0); PG8_LDB(B1, 0, 1); PG8_SCHED; PG8_LDA(At, 0, 0); PG8_STAGE(PG8_SA(1, 1), a1 + hstep, voffA);
            PG8_WAIT_V(8); PG8_WAIT_L(0); PG8_BAR; PG8_MMA(0, 0, At, B0); PG8_MMA(0, 1, At, B1); PG8_BAR; PG8_SCHED;
            PG8_LDA(At, 0, 1); PG8_STAGE(PG8_SB(0, 0), b2, voffB); PG8_STAGE(PG8_SB(0, 1), b2 + hstep, voffB); PG8_STAGE(PG8_SA(0, 0), a2, voffA);
            PG8_WAIT_V(8); PG8_WAIT_L(0); PG8_BAR; PG8_MMA(1, 0, At, B0); PG8_MMA(1, 1, At, B1); PG8_BAR; PG8_SCHED;
            PG8_LDB(B0, 1, 0); PG8_LDB(B1, 1, 1); PG8_SCHED; PG8_LDA(At, 1, 0); PG8_STAGE(PG8_SA(0, 1), a2 + hstep, voffA);
            PG8_WAIT_V(8); PG8_WAIT_L(0); PG8_BAR; PG8_MMA(0, 0, At, B0); PG8_MMA(0, 1, At, B1); PG8_BAR; PG8_SCHED;
            PG8_LDA(At, 1, 1); PG8_STAGE(PG8_SB(1, 0), b3, voffB); PG8_STAGE(PG8_SB(1, 1), b3 + hstep, voffB); PG8_STAGE(PG8_SA(1, 0), a3, voffA);
            PG8_WAIT_V(8); PG8_WAIT_L(0); PG8_BAR; PG8_MMA(1, 0, At, B0); PG8_MMA(1, 1, At, B1); PG8_BAR; PG8_SCHED;
            } else {
            PG8_LDB(B0, 0, 0); PG8_SCHED; PG8_LDA(At, 0, 0); PG8_STAGE(PG8_SA(1, 1), a1 + hstep, voffA);
            PG8_WAIT_L(8); PG8_BAR; PG8_WAIT_L(0); PG8_MMA(0, 0, At, B0); PG8_BAR; PG8_SCHED;
            PG8_LDB(B1, 0, 1); PG8_STAGE(PG8_SB(0, 0), b2, voffB);
            PG8_BAR; PG8_WAIT_L(0); PG8_MMA(0, 1, At, B1); PG8_BAR;
            PG8_LDA(At, 0, 1); PG8_STAGE(PG8_SA(0, 0), a2, voffA);
            PG8_BAR; PG8_WAIT_L(0); PG8_MMA(1, 0, At, B0); PG8_BAR; PG8_SCHED;
            PG8_STAGE(PG8_SB(0, 1), b2 + hstep, voffB);
            PG8_WAIT_V(6); PG8_BAR; PG8_MMA(1, 1, At, B1); PG8_BAR;
            PG8_LDB(B0, 1, 0); PG8_SCHED; PG8_LDA(At, 1, 0); PG8_STAGE(PG8_SA(0, 1), a2 + hstep, voffA);
            PG8_WAIT_L(8); PG8_BAR; PG8_WAIT_L(0); PG8_MMA(0, 0, At, B0); PG8_BAR; PG8_SCHED;
            PG8_LDB(B1, 1, 1); PG8_STAGE(PG8_SB(1, 0), b3, voffB);
            PG8_BAR; PG8_WAIT_L(0); PG8_MMA(0, 1, At, B1); PG8_BAR;
            PG8_LDA(At, 1, 1); PG8_STAGE(PG8_SA(1, 0), a3, voffA);
            PG8_BAR; PG8_WAIT_L(0); PG8_MMA(1, 0, At, B0); PG8_BAR; PG8_SCHED;
            PG8_STAGE(PG8_SB(1, 1), b3 + hstep, voffB);
            PG8_WAIT_V(6); PG8_BAR; PG8_MMA(1, 1, At, B1); PG8_BAR;
            }
        }
        if constexpr (ALIGN_EPI) { if (wr == 0) PG8_BAR; }
        if constexpr (!Epi::AFTER_DRAIN) { E(acc, cur, wr, wc, fr, fq); S.done(cur); }
        if (!has_next) break;
#pragma unroll
        for (int a = 0; a < 2; ++a)
#pragma unroll
            for (int b = 0; b < 2; ++b)
#pragma unroll
                for (int m = 0; m < 4; ++m)
#pragma unroll
                    for (int n = 0; n < 2; ++n) acc[a][b][m][n] = (f32x4){0.f, 0.f, 0.f, 0.f};
        cur = nxt; cA = nA; cB = nB; ++ui;
        if constexpr (ALIGN_EPI) { if (wr == 1) PG8_BAR; }
    }
    PG8_WAIT_V(0);
    if constexpr (!ALIGN_EPI) { if (wr == 0) PG8_BAR; }
    PG8_BAR;
    if constexpr (Epi::AFTER_DRAIN) { E.fused(acc, cur, wr, wc, fr, fq, lds, wid, lane); S.done(cur); }
#undef PG8_SA
#undef PG8_SB
#undef PG8_STAGE
#undef PG8_LDA
#undef PG8_LDB
#undef PG8_MMA
#undef PG8_WAIT_V
#undef PG8_WAIT_L
#undef PG8_BAR
#undef PG8_SCHED
}
}

#define LAS __attribute__((address_space(3)))
typedef unsigned short bf16;
typedef short bf16x8 __attribute__((ext_vector_type(8)));
typedef short s16x4 __attribute__((ext_vector_type(4)));
typedef float f32x2 __attribute__((ext_vector_type(2)));
typedef float f32x4 __attribute__((ext_vector_type(4)));
typedef float f32x16 __attribute__((ext_vector_type(16)));
typedef unsigned u32x2 __attribute__((ext_vector_type(2)));
typedef unsigned u32x4 __attribute__((ext_vector_type(4)));
typedef __bf16 bf16x2_t __attribute__((ext_vector_type(2)));

constexpr int M_ = 65536, SEQ = 2048, DMODEL = 1024, DFF = 2816;
constexpr float EPS = 1e-6f, LOG2E = 1.4426950408889634f;
constexpr size_t MiB = 1u << 20;
constexpr size_t WS_BIAS = 0;
constexpr size_t WS_ROPE = 256 * 1024;
constexpr size_t WS_RSS = 1 * MiB;
constexpr size_t WS_SSQ = 3 * MiB;
constexpr size_t WS_SSKV = 3 * MiB + 256 * 1024;
constexpr size_t W_AIN = 4 * MiB, W_AOUT = 13 * MiB, W_BIN = 14 * MiB, W_BQUP = 16 * MiB, W_BKVUP = 18 * MiB, W_BOUT = 19 * MiB,
                 W_CIN = 21 * MiB, W_COUT = 27 * MiB, W_DIN = 29 * MiB, W_DOUT = 32 * MiB, W_FG = 34 * MiB, W_FU = 58 * MiB, W_FD = 82 * MiB, W_FSTR = 6 * MiB;
constexpr size_t WS_XB = 106 * MiB;
constexpr size_t WS_R = 234 * MiB;
constexpr size_t R_A_QKV = WS_R, R_A_O3 = WS_R + 576 * MiB, R_A_LSE = WS_R + 768 * MiB, R_A_OC = WS_R;
constexpr size_t R_B_CQ = WS_R, R_B_CKV = WS_R + 48 * MiB, R_B_KPE = WS_R + 80 * MiB, R_B_Q = WS_R + 128 * MiB, R_B_KV = WS_R + 320 * MiB, R_B_KH = WS_R + 576 * MiB, R_B_O = WS_R;
constexpr size_t R_C_QKV = WS_R, R_C_O = WS_R + 384 * MiB;
constexpr size_t R_D_QKV = WS_R, R_D_O = WS_R + 160 * MiB;
constexpr size_t R_GATE = WS_R, R_ACT = WS_R + 352 * MiB;
constexpr size_t WS_RSSP = WS_R + 774 * MiB;
constexpr size_t WS_SSQP = WS_R + 782 * MiB;
constexpr size_t WS_SSKVP = WS_R + 784 * MiB;
constexpr size_t WS_SSPE = 3 * MiB + 512 * 1024;
constexpr size_t R_B_RK = WS_R + 96 * MiB;
constexpr size_t WS_BAR = 512 * 1024;
constexpr size_t WS_NEED = WS_R + 786 * MiB;

constexpr int LDS_BYTES = 135168;

struct Args { const float* in[34]; float* out; unsigned char* ws; };

__device__ __forceinline__ unsigned pk2(float lo, float hi) { f32x2 v = {lo, hi}; bf16x2_t b = __builtin_convertvector(v, bf16x2_t); return __builtin_bit_cast(unsigned, b); }
__device__ __forceinline__ float bf2f(unsigned short h) { return __uint_as_float(((unsigned)h) << 16); }
__device__ __forceinline__ float bflo(unsigned w) { return __uint_as_float(w << 16); }
__device__ __forceinline__ float bfhi(unsigned w) { return __uint_as_float(w & 0xffff0000u); }
__device__ __forceinline__ float wave_sum(float v) {
#pragma unroll
    for (int o = 1; o < 64; o <<= 1) v += __shfl_xor(v, o);
    return v;
}
__device__ __forceinline__ float dot4(f32x4 a) { return (a[0] * a[0] + a[1] * a[1]) + (a[2] * a[2] + a[3] * a[3]); }
__device__ __forceinline__ float rowss_sum(const float* ss, int nvec, int row) {
    const f32x4* p = (const f32x4*)(ss + (size_t)row * 4 * nvec); float t = 0.f;
#pragma unroll
    for (int v = 0; v < 4; ++v) if (v < nvec) { const f32x4 q = p[v]; t += (q[0] + q[1]) + (q[2] + q[3]); }
    return t;
}

struct EpiProj {
    static constexpr bool PERM = true, AFTER_DRAIN = false;
    bf16* O; int ldc; const float* rs; int hm; const float* gq; const float* gk; float qscale;
    __device__ __forceinline__ void operator()(const f32x4 (&acc)[2][2][4][2], const pg8::Unit& u, int wr, int wc, int fr, int fq) const {
        const int hg = u.pn * 4 + wc;
        int kind = 2; const float* gain = gq;
        if (hm == 1) { const int t = (hg >> 3) % 3, gi = hg / 24; kind = t; gain = (t == 0 ? gq : gk) + gi * 64; }
        else if (hm == 2) { kind = hg < 16 ? 0 : (hg < 32 ? 1 : 2); gain = kind == 0 ? gq : gk; }
        else if (hm == 3) { kind = hg < 16 ? 0 : (hg < 18 ? 1 : 2); gain = kind == 0 ? gq : gk; }
        else if (hm == 4) { kind = (hg & 1) ? 2 : 3; gain = gk; }
        f32x4 gv[2][2];
#pragma unroll
        for (int bj = 0; bj < 2; ++bj)
#pragma unroll
            for (int n = 0; n < 2; ++n) {
                gv[bj][n] = (f32x4){1.f, 1.f, 1.f, 1.f};
                if (kind != 2) { gv[bj][n] = *(const f32x4*)(gain + 32 * bj + 8 * fq + 4 * n); if (kind == 0) gv[bj][n] = gv[bj][n] * qscale; }
            }
        bf16* colp = O + hg * 64 + 8 * fq;
        float rsv[2][4];
#pragma unroll
        for (int ai = 0; ai < 2; ++ai)
#pragma unroll
            for (int m = 0; m < 4; ++m) rsv[ai][m] = rs[u.pm * 256 + ai * 128 + wr * 64 + m * 16 + fr];
        if (kind == 3) {
#pragma unroll
            for (int ai = 0; ai < 2; ++ai)
#pragma unroll
                for (int m = 0; m < 4; ++m) {
                    const int row = u.pm * 256 + ai * 128 + wr * 64 + m * 16 + fr;
                    const float rstd = rsv[ai][m];
                    f32x4 v[2][2]; float s = 0.f;
#pragma unroll
                    for (int bj = 0; bj < 2; ++bj)
#pragma unroll
                        for (int n = 0; n < 2; ++n) { v[bj][n] = acc[ai][bj][m][n] * rstd; s += dot4(v[bj][n]); }
                    s += __shfl_xor(s, 16); s += __shfl_xor(s, 32);
                    const float rk_ = rsqrtf((s + ((const float*)((const unsigned char*)rs + (WS_SSPE - WS_SSKV)))[row]) * (1.0f / 96.0f) + EPS);
                    bf16* kp = (bf16*)((unsigned char*)O + (R_B_KH - R_B_KV)) + (size_t)row * 1536 + (hg >> 1) * 96 + 8 * fq;
#pragma unroll
                    for (int bj = 0; bj < 2; ++bj) {
                        const f32x4 a_ = v[bj][0] * rk_ * gv[bj][0], b_ = v[bj][1] * rk_ * gv[bj][1];
                        u32x4 w; w.x = pk2(a_[0], a_[1]); w.y = pk2(a_[2], a_[3]); w.z = pk2(b_[0], b_[1]); w.w = pk2(b_[2], b_[3]);
                        *(u32x4*)(kp + 32 * bj) = w;
                    }
                    const u32x4 r_ = *(const u32x4*)((const bf16*)((const unsigned char*)O - (R_B_KV - R_B_RK)) + (size_t)row * 32 + 8 * fq);
                    u32x4 w;
#pragma unroll
                    for (int j = 0; j < 4; ++j) w[j] = pk2(bflo(r_[j]) * rk_, bfhi(r_[j]) * rk_);
                    *(u32x4*)(kp + 64) = w;
                }
            return;
        }
#pragma unroll
        for (int ai = 0; ai < 2; ++ai)
#pragma unroll
            for (int m = 0; m < 4; ++m) {
                const int row = u.pm * 256 + ai * 128 + wr * 64 + m * 16 + fr;
                const float rstd = rsv[ai][m];
                f32x4 v[2][2]; float s = 0.f;
#pragma unroll
                for (int bj = 0; bj < 2; ++bj)
#pragma unroll
                    for (int n = 0; n < 2; ++n) { v[bj][n] = acc[ai][bj][m][n] * rstd; s += dot4(v[bj][n]); }
                if (kind < 2) {
                    s += __shfl_xor(s, 16); s += __shfl_xor(s, 32);
                    const float rs = rsqrtf(s * (1.0f / 64.0f) + EPS);
#pragma unroll
                    for (int bj = 0; bj < 2; ++bj)
#pragma unroll
                        for (int n = 0; n < 2; ++n) v[bj][n] = v[bj][n] * rs * gv[bj][n];
                }
#pragma unroll
                for (int bj = 0; bj < 2; ++bj) {
                    u32x4 w; w.x = pk2(v[bj][0][0], v[bj][0][1]); w.y = pk2(v[bj][0][2], v[bj][0][3]); w.z = pk2(v[bj][1][0], v[bj][1][1]); w.w = pk2(v[bj][1][2], v[bj][1][3]);
                    *(u32x4*)(colp + (size_t)row * ldc + 32 * bj) = w;
                }
            }
    }
};
struct EpiLat {
    static constexpr bool PERM = true, AFTER_DRAIN = false;
    bf16* CQ; bf16* CKV; bf16* KPE; const float* rs; float* ssq; float* sskv;
    __device__ __forceinline__ void operator()(const f32x4 (&acc)[2][2][4][2], const pg8::Unit& u, int wr, int wc, int fr, int fq) const {
        const int hg = u.pn * 4 + wc;
        if (hg > 10) return;
        bf16* dst; int ld; float* sacc = nullptr; int sst = 0;
        if (hg < 6) { dst = CQ + hg * 64; ld = 384; sacc = ssq + hg; sst = 8; } else if (hg < 10) { dst = CKV + (hg - 6) * 64; ld = 256; sacc = sskv + (hg - 6); sst = 4; } else { dst = KPE; ld = 64; }
        dst += 8 * fq;
        float rsv[2][4];
#pragma unroll
        for (int ai = 0; ai < 2; ++ai)
#pragma unroll
            for (int m = 0; m < 4; ++m) rsv[ai][m] = rs[u.pm * 256 + ai * 128 + wr * 64 + m * 16 + fr];
#pragma unroll
        for (int ai = 0; ai < 2; ++ai)
#pragma unroll
            for (int m = 0; m < 4; ++m) {
                const int row = u.pm * 256 + ai * 128 + wr * 64 + m * 16 + fr;
                const float rstd = rsv[ai][m];
                f32x4 v[2][2]; float s = 0.f;
#pragma unroll
                for (int bj = 0; bj < 2; ++bj)
#pragma unroll
                    for (int n = 0; n < 2; ++n) { v[bj][n] = acc[ai][bj][m][n] * rstd; s += dot4(v[bj][n]); }
                s += __shfl_xor(s, 16); s += __shfl_xor(s, 32);
                if (fq == 0) { if (sacc != nullptr) sacc[(size_t)row * sst] = s; else { float z_ = 0.f; asm volatile("" : "+v"(z_)); ssq[(size_t)row * 8 + 6] = z_; ssq[(size_t)row * 8 + 7] = z_; } }
#pragma unroll
                for (int bj = 0; bj < 2; ++bj) {
                    u32x4 w; w.x = pk2(v[bj][0][0], v[bj][0][1]); w.y = pk2(v[bj][0][2], v[bj][0][3]); w.z = pk2(v[bj][1][0], v[bj][1][1]); w.w = pk2(v[bj][1][2], v[bj][1][3]);
                    *(u32x4*)(dst + (size_t)row * ld + 32 * bj) = w;
                }
            }
    }
};
struct EpiRes {
    static constexpr bool PERM = false, AFTER_DRAIN = false;
    const float* base32; float* out32; bf16* xb; bf16* xbw; float* ssn;
    __device__ __forceinline__ void operator()(const f32x4 (&acc)[2][2][4][2], const pg8::Unit& u, int wr, int wc, int fr_, int fq_) const {
        int fr = fr_, fq = fq_; asm volatile("" : "+v"(fr), "+v"(fq));
        float* ssn_ = ssn; bf16* xbw_ = xbw; float* out_ = out32; const float* b32_ = base32; asm volatile("" : "+s"(ssn_), "+s"(xbw_), "+s"(out_), "+s"(b32_));
        const int col0 = u.pn * 256 + wc * 32 + 4 * fq;
#pragma unroll
        for (int ai = 0; ai < 2; ++ai) {
            f32x4 bv[4][2][2];
            if (b32_ != nullptr) {
#pragma unroll
                for (int m = 0; m < 4; ++m)
#pragma unroll
                    for (int bj = 0; bj < 2; ++bj)
#pragma unroll
                        for (int n = 0; n < 2; ++n) bv[m][bj][n] = *(const f32x4*)(b32_ + (size_t)(u.pm * 256 + ai * 128 + wr * 64 + m * 16 + fr) * DMODEL + col0 + bj * 128 + n * 16);
            } else {
                u32x2 rw[4][2][2];
#pragma unroll
                for (int m = 0; m < 4; ++m)
#pragma unroll
                    for (int bj = 0; bj < 2; ++bj)
#pragma unroll
                        for (int n = 0; n < 2; ++n) rw[m][bj][n] = *(const u32x2*)(xb + (size_t)(u.pm * 256 + ai * 128 + wr * 64 + m * 16 + fr) * DMODEL + col0 + bj * 128 + n * 16);
#pragma unroll
                for (int m = 0; m < 4; ++m)
#pragma unroll
                    for (int bj = 0; bj < 2; ++bj)
#pragma unroll
                        for (int n = 0; n < 2; ++n) bv[m][bj][n] = (f32x4){bflo(rw[m][bj][n].x), bfhi(rw[m][bj][n].x), bflo(rw[m][bj][n].y), bfhi(rw[m][bj][n].y)};
            }
            asm volatile("" ::: "memory");
#pragma unroll
            for (int m = 0; m < 4; ++m) {
                const int row = u.pm * 256 + ai * 128 + wr * 64 + m * 16 + fr;
                float s = 0.f;
#pragma unroll
                for (int bj = 0; bj < 2; ++bj)
#pragma unroll
                    for (int n = 0; n < 2; ++n) {
                        const size_t off = (size_t)row * DMODEL + col0 + bj * 128 + n * 16;
                        const f32x4 o = bv[m][bj][n] + acc[ai][bj][m][n];
                        if (out_ != nullptr) *(f32x4*)(out_ + off) = o;
                        if (xbw_ != nullptr) { u32x2 w; w.x = pk2(o[0], o[1]); w.y = pk2(o[2], o[3]); *(u32x2*)(xbw_ + off) = w; }
                        s += dot4(o);
                    }
                if (ssn_ != nullptr) { s += __shfl_xor(s, 16); s += __shfl_xor(s, 32); if (fq == 0) ssn_[(size_t)row * 16 + u.pn * 4 + wc] = s; }
            }
            asm volatile("" ::: "memory");
        }
    }
};
__device__ __forceinline__ u32x4 shfl4(u32x4 v, int src) { u32x4 r; r.x = __shfl(v.x, src, 16); r.y = __shfl(v.y, src, 16); r.z = __shfl(v.z, src, 16); r.w = __shfl(v.w, src, 16); return r; }
struct EpiGateUp {
    static constexpr bool PERM = true, AFTER_DRAIN = false;
    bf16* act; bf16* gedge; bf16* uedge; const float* rs; const float* cw; const float* cb;
    __device__ __forceinline__ void operator()(const f32x4 (&acc)[2][2][4][2], const pg8::Unit& u, int wr, int wc, int fr_, int fq_) const {
        int fr = fr_, fq = fq_; asm volatile("" : "+v"(fr), "+v"(fq));
        const int c0 = u.pn * 128 + wc * 32 + 8 * fq;
        f32x4 w0[2], w1[2], w2[2], b[2];
#pragma unroll
        for (int n = 0; n < 2; ++n) { w0[n] = *(const f32x4*)(cw + c0 + 4 * n); w1[n] = *(const f32x4*)(cw + DFF + c0 + 4 * n); w2[n] = *(const f32x4*)(cw + 2 * DFF + c0 + 4 * n); b[n] = *(const f32x4*)(cb + c0 + 4 * n); }
#pragma unroll
        for (int ai = 0; ai < 2; ++ai) {
            u32x4 g[4]; float rstd[4];
            const int strip = u.pm * 4 + ai * 2 + wr;
#pragma unroll
            for (int m = 0; m < 4; ++m) rstd[m] = rs[u.pm * 256 + ai * 128 + wr * 64 + m * 16 + fr];
#pragma unroll
            for (int m = 0; m < 4; ++m) {
                const f32x4 ga = acc[ai][0][m][0] * rstd[m], gb = acc[ai][0][m][1] * rstd[m];
                g[m].x = pk2(ga[0], ga[1]); g[m].y = pk2(ga[2], ga[3]); g[m].z = pk2(gb[0], gb[1]); g[m].w = pk2(gb[2], gb[3]);
            }
#pragma unroll
            for (int m = 0; m < 4; ++m) {
                const int row = u.pm * 256 + ai * 128 + wr * 64 + m * 16 + fr;
                const u32x4 g0 = g[m];
                u32x4 g1, g2;
#pragma unroll
                for (int d = 0; d < 4; ++d) {
                    unsigned o1_ = 0u, o2_ = 0u;
                    if (m > 0) { o1_ = __builtin_amdgcn_update_dpp(0u, g[m - 1][d], 0x121, 0xf, 0xf, false); o2_ = __builtin_amdgcn_update_dpp(0u, g[m - 1][d], 0x122, 0xf, 0xf, false); }
                    g1[d] = __builtin_amdgcn_update_dpp(o1_, g0[d], 0x111, 0xf, 0xf, false);
                    g2[d] = __builtin_amdgcn_update_dpp(o2_, g0[d], 0x112, 0xf, 0xf, false);
                }
                u32x4 w, uw;
#pragma unroll
                for (int n = 0; n < 2; ++n) {
                    float r[4], up[4];
#pragma unroll
                    for (int j = 0; j < 4; ++j) {
                        const unsigned q0 = g0[2 * n + (j >> 1)], q1 = g1[2 * n + (j >> 1)], q2 = g2[2 * n + (j >> 1)];
                        const float x0 = (j & 1) ? bfhi(q0) : bflo(q0), x1 = (j & 1) ? bfhi(q1) : bflo(q1), x2 = (j & 1) ? bfhi(q2) : bflo(q2);
                        const float cv = b[n][j] + w2[n][j] * x0 + w1[n][j] * x1 + w0[n][j] * x2;
                        const float sg = cv * __builtin_amdgcn_rcpf(1.0f + __builtin_amdgcn_exp2f(-LOG2E * cv));
                        up[j] = acc[ai][1][m][n][j] * rstd[m];
                        r[j] = sg * up[j];
                    }
                    w[2 * n] = pk2(r[0], r[1]); w[2 * n + 1] = pk2(r[2], r[3]);
                    uw[2 * n] = pk2(up[0], up[1]); uw[2 * n + 1] = pk2(up[2], up[3]);
                }
                if (m == 0) {
                    if (fr < 2) { *(u32x4*)(gedge + ((size_t)strip * 4 + fr) * DFF + c0) = g0; *(u32x4*)(uedge + ((size_t)strip * 2 + fr) * DFF + c0) = uw; }
                    else *(u32x4*)(act + (size_t)row * DFF + c0) = w;
                } else {
                    *(u32x4*)(act + (size_t)row * DFF + c0) = w;
                    if (m == 3 && fr >= 14) *(u32x4*)(gedge + ((size_t)strip * 4 + 2 + (fr - 14)) * DFF + c0) = g0;
                }
                asm volatile("" ::: "memory");
            }
        }
    }
};

__device__ __forceinline__ int crow(int r, int hi) { return (r & 3) + 8 * (r >> 2) + 4 * hi; }
struct TileGeo { int NT, TPS, ks0, res0, dil; };
template <int DQK, int DV, int KT> struct AttL {
    static constexpr int KSTR = DQK * 2 + 16, VSTR = DV * 2 + 64, KBUF = KT * KSTR, VBUF = KT * VSTR;
    static constexpr int OFF_K = 0, OFF_V = 2 * KBUF, OFF_TAB = OFF_V + 2 * VBUF;
};
template <int DQK, int DV, bool BIAS, int TABN, bool QRELOAD, int KT>
__device__ __forceinline__ void attn_pass(int qoff_, LAS unsigned char* lds, const bf16* Kb, int kpitch, const bf16* Vb, int vpitch, const TileGeo G, int my_tlo, int my_thi,
                                          int wslot_q0, int W, const bf16x8 (&qf_)[DQK / 16], float& m_, float& l_, f32x16 (&o)[DV / 32]) {
    typedef AttL<DQK, DV, KT> L;
    int tid = threadIdx.x; asm volatile("" : "+v"(tid)); const int lane = tid & 63, r32 = lane & 31, hi = lane >> 5;
    constexpr int SUB = KT / 64;
    constexpr int KCH = DQK / 8, VCH = DV / 8, NKC = KT * KCH, NVC = KT * VCH, NKL = (NKC + 511) / 512, NVL = (NVC + 511) / 512;
    u32x4 kr[NKL], vr[NVL];
    const LAS float* tab = (const LAS float*)(lds + L::OFF_TAB);
    const int slot_q = wslot_q0 + r32;
    const int vlane = (4 * hi + ((lane & 15) >> 2)) * L::VSTR + (16 * ((lane >> 4) & 1) + 4 * (lane & 3)) * 2;
#define ATT_LOAD(t) do { const int seg_ = ((t) * SUB) / G.TPS, tis_ = (t) * SUB - seg_ * G.TPS; const int tok0_ = G.res0 + seg_ + G.dil * (G.ks0 + 64 * tis_); \
        _Pragma("unroll") for (int i_ = 0; i_ < NKL; ++i_) { const int c_ = tid + 512 * i_; if ((NKC % 512 == 0) || c_ < NKC) { const int j_ = c_ / KCH, p_ = c_ - j_ * KCH; \
            kr[i_] = *(const u32x4*)(Kb + (size_t)(tok0_ + G.dil * j_) * kpitch + p_ * 8); } } \
        _Pragma("unroll") for (int i_ = 0; i_ < NVL; ++i_) { const int c_ = tid + 512 * i_; if ((NVC % 512 == 0) || c_ < NVC) { const int j_ = c_ / VCH, p_ = c_ - j_ * VCH; \
            vr[i_] = *(const u32x4*)(Vb + (size_t)(tok0_ + G.dil * j_) * vpitch + p_ * 8); } } } while (0)
#define ATT_STORE(buf) do { \
        _Pragma("unroll") for (int i_ = 0; i_ < NKL; ++i_) { const int c_ = tid + 512 * i_; if ((NKC % 512 == 0) || c_ < NKC) { const int j_ = c_ / KCH, p_ = c_ - j_ * KCH; \
            *(LAS u32x4*)(lds + L::OFF_K + (buf) * L::KBUF + j_ * L::KSTR + p_ * 16) = kr[i_]; } } \
        _Pragma("unroll") for (int i_ = 0; i_ < NVL; ++i_) { const int c_ = tid + 512 * i_; if ((NVC % 512 == 0) || c_ < NVC) { const int j_ = c_ / VCH, p_ = c_ - j_ * VCH; \
            *(LAS u32x4*)(lds + L::OFF_V + (buf) * L::VBUF + j_ * L::VSTR + p_ * 16) = vr[i_]; } } } while (0)
    ATT_LOAD(0);
    ATT_STORE(0);
    float m = m_, l = l_;
    const int NT2 = G.NT / SUB;
    for (int t = 0; t < NT2; ++t) {
        const int buf = t & 1;
        if (t + 1 < NT2) ATT_LOAD(t + 1);
        __syncthreads();
#pragma unroll
        for (int hf = 0; hf < SUB; ++hf) {
        const int st = t * SUB + hf;
        if (st >= my_tlo && st <= my_thi) {
            const int tis = st % G.TPS, slot0 = G.ks0 + 64 * tis;
            const LAS unsigned char* Kt = lds + L::OFF_K + buf * L::KBUF + (hf * 64 + r32) * L::KSTR + hi * 16;
            f32x16 s[2];
            const int dsb = slot_q - slot0 - 4 * hi;
            bf16x8 qf[DQK / 16];
            if (QRELOAD) {
#pragma unroll
                for (int ks = 0; ks < DQK / 16; ++ks) qf[ks] = *(const LAS bf16x8*)(lds + qoff_ + ks * 32); }
            else {
#pragma unroll
                for (int ks = 0; ks < DQK / 16; ++ks) qf[ks] = qf_[ks]; }
#pragma unroll
            for (int kb = 0; kb < 2; ++kb) {
#pragma unroll
                for (int r = 0; r < 16; ++r) s[kb][r] = BIAS ? tab[dsb + 128 - (32 * kb + (r & 3) + 8 * (r >> 2))] : 0.f;
            }
            if (DV == 64) {
                bf16x8 kf[2][DQK / 16];
#pragma unroll
                for (int kb = 0; kb < 2; ++kb)
#pragma unroll
                    for (int ks = 0; ks < DQK / 16; ++ks) kf[kb][ks] = *(const LAS bf16x8*)(Kt + kb * 32 * L::KSTR + ks * 32);
                asm volatile("" ::: "memory");
#pragma unroll
                for (int ks = 0; ks < DQK / 16; ++ks)
#pragma unroll
                    for (int kb = 0; kb < 2; ++kb) s[kb] = __builtin_amdgcn_mfma_f32_32x32x16_bf16(kf[kb][ks], qf[ks], s[kb], 0, 0, 0);
            } else {
#pragma unroll
                for (int kh = 0; kh < 2; ++kh) {
                    bf16x8 kf[2][DQK / 32];
#pragma unroll
                    for (int kb = 0; kb < 2; ++kb)
#pragma unroll
                        for (int k2 = 0; k2 < DQK / 32; ++k2) kf[kb][k2] = *(const LAS bf16x8*)(Kt + kb * 32 * L::KSTR + (kh * (DQK / 32) + k2) * 32);
                    asm volatile("" ::: "memory");
#pragma unroll
                    for (int k2 = 0; k2 < DQK / 32; ++k2)
#pragma unroll
                        for (int kb = 0; kb < 2; ++kb) s[kb] = __builtin_amdgcn_mfma_f32_32x32x16_bf16(kf[kb][k2], qf[kh * (DQK / 32) + k2], s[kb], 0, 0, 0);
                }
            }
            const bool full = (wslot_q0 - slot0 - 63 >= 0) && (wslot_q0 + 31 - slot0 <= W);
            if (!full && !BIAS) {
#pragma unroll
                for (int kb = 0; kb < 2; ++kb)
#pragma unroll
                    for (int r = 0; r < 16; ++r) {
                        const int ds = dsb - (32 * kb + (r & 3) + 8 * (r >> 2));
                        s[kb][r] = ((unsigned)ds <= (unsigned)W) ? s[kb][r] : -INFINITY;
                    }
            }
            float mx = s[0][0];
#pragma unroll
            for (int r = 1; r < 16; ++r) mx = fmaxf(mx, s[0][r]);
#pragma unroll
            for (int r = 0; r < 16; ++r) mx = fmaxf(mx, s[1][r]);
            mx = fmaxf(mx, __shfl_xor(mx, 32));
            const float mn = fmaxf(m, mx);
            const float base = (mn == -INFINITY) ? 0.f : mn;
            const float alpha = __builtin_amdgcn_exp2f(m - base);
            m = mn;
            float ps = 0.f;
#pragma unroll
            for (int kb = 0; kb < 2; ++kb)
#pragma unroll
                for (int r = 0; r < 16; ++r) { const float p = __builtin_amdgcn_exp2f(s[kb][r] - base); s[kb][r] = p; ps += p; }
            l = l * alpha + ps;
            if (__any(alpha != 1.0f)) {
#pragma unroll
                for (int c = 0; c < DV / 32; ++c)
#pragma unroll
                    for (int r = 0; r < 16; ++r) o[c][r] *= alpha;
            }
            const LAS unsigned char* Vt = lds + L::OFF_V + buf * L::VBUF + hf * 64 * L::VSTR + vlane;
#pragma unroll
            for (int kb = 0; kb < 2; ++kb) {
                bf16x8 pb[2];
#pragma unroll
                for (int k2 = 0; k2 < 2; ++k2) {
                    u32x4 pw; pw.x = pk2(s[kb][8 * k2 + 0], s[kb][8 * k2 + 1]); pw.y = pk2(s[kb][8 * k2 + 2], s[kb][8 * k2 + 3]);
                    pw.z = pk2(s[kb][8 * k2 + 4], s[kb][8 * k2 + 5]); pw.w = pk2(s[kb][8 * k2 + 6], s[kb][8 * k2 + 7]);
                    pb[k2] = __builtin_bit_cast(bf16x8, pw);
                }
#pragma unroll
                for (int ch = 0; ch < DV / 64; ++ch) {
                    bf16x8 vf[2][2];
#pragma unroll
                    for (int k2 = 0; k2 < 2; ++k2)
#pragma unroll
                        for (int c2 = 0; c2 < 2; ++c2) {
                            const LAS unsigned char* vp = Vt + (32 * kb + 16 * k2) * L::VSTR + 64 * (2 * ch + c2);
                            const s16x4 lo = __builtin_bit_cast(s16x4, __builtin_amdgcn_ds_read_tr16_b64_v4i16((LAS s16x4*)(vp)));
                            const s16x4 hh = __builtin_bit_cast(s16x4, __builtin_amdgcn_ds_read_tr16_b64_v4i16((LAS s16x4*)(vp + 8 * L::VSTR)));
                            vf[k2][c2] = (bf16x8){lo[0], lo[1], lo[2], lo[3], hh[0], hh[1], hh[2], hh[3]};
                        }
                    asm volatile("" ::: "memory");
#pragma unroll
                    for (int k2 = 0; k2 < 2; ++k2)
#pragma unroll
                        for (int c2 = 0; c2 < 2; ++c2) o[2 * ch + c2] = __builtin_amdgcn_mfma_f32_32x32x16_bf16(vf[k2][c2], pb[k2], o[2 * ch + c2], 0, 0, 0);
                }
            }
        }
        }
        if (t + 1 < NT2) ATT_STORE(buf ^ 1);
    }
    __syncthreads();
    m_ = m; l_ = l;
#undef ATT_LOAD
#undef ATT_STORE
}

template <int MODE>
__device__ __forceinline__ void attn_phase(LAS unsigned char* lds, const Args& a, int Gn, int cid) {
    constexpr int DQK = MODE == 1 ? 96 : 64, DV = MODE == 2 ? 128 : 64;
    constexpr bool BIAS = MODE != 1;
    constexpr int TABN = MODE == 2 ? 2048 + 256 : 512;
    constexpr int NU = MODE == 0 ? 6144 : (MODE == 2 ? 2048 : 4096);
    constexpr int KT = MODE == 2 ? 64 : 128;
    typedef AttL<DQK, DV, KT> L;
    int tid = threadIdx.x; asm volatile("" : "+v"(tid)); const int lane = tid & 63, r32 = lane & 31, hi = lane >> 5, wid = __builtin_amdgcn_readfirstlane(tid >> 6);
    unsigned char* ws = a.ws;
    const float* biasd = (const float*)(ws + WS_BIAS);
    LAS float* tab = (LAS float*)(lds + L::OFF_TAB);
    float lam = 0.f, lam_init = 0.f;
    if (MODE == 2) {
        float d1 = 0.f, d2 = 0.f;
        for (int i = 0; i < 64; ++i) { d1 += a.in[19][i] * a.in[20][i]; d2 += a.in[21][i] * a.in[22][i]; }
        lam_init = 0.8f - 0.6f * expf(-0.3f * 2.0f);
        lam = expf(d1) - expf(d2) + lam_init;
    }
    for (int u = cid; u < NU; u += Gn) {
        int b, h, dil = 1, res0 = 0, s0, nres = 1, W, qb = 0, g = 0;
        if (MODE == 0) { g = u >> 11; const int rem = u & 2047; b = rem >> 6; h = (rem >> 3) & 7; const int blk = rem & 7; W = 128;
            if (g == 0) { s0 = 256 * blk; } else if (g == 1) { dil = 4; res0 = blk >> 1; s0 = 256 * (blk & 1); } else { dil = 16; res0 = 2 * blk; s0 = 0; nres = 2; } }
        else if (MODE == 3) { b = u >> 7; h = (u >> 3) & 15; s0 = 256 * (u & 7); W = 127; }
        else if (MODE == 1) { const int bh = u & 511; qb = 7 - (u >> 9); b = bh >> 4; h = bh & 15; s0 = 256 * qb; W = 1 << 20; }
        else { const int bh = u & 255; qb = 7 - (u >> 8); b = bh >> 3; h = bh & 7; s0 = 256 * qb; W = 1 << 20; }
        TileGeo G;
        G.dil = dil; G.res0 = res0;
        const int Lseg = 256 / nres;
        if (MODE == 0 || MODE == 3) { G.ks0 = (nres == 1 && s0 >= 128) ? s0 - 128 : 0; } else { G.ks0 = 0; }
        G.TPS = (s0 + Lseg - G.ks0) >> 6; G.NT = G.TPS * nres;
        const int nws = 8 / nres, seg_w = wid / nws, wslot_q0 = s0 + 32 * (wid - seg_w * nws);
        int tl = 0;
        if (MODE == 0 || MODE == 3) { tl = wslot_q0 - W - G.ks0; tl = tl < 0 ? 0 : (tl >> 6); }
        const int th = (wslot_q0 + 31 - G.ks0) >> 6;
        const int my_tlo = seg_w * G.TPS + tl, my_thi = seg_w * G.TPS + th;
        const int qtok = res0 + seg_w + dil * (wslot_q0 + r32);
        const size_t row_q = (size_t)b * SEQ + qtok, row_b = (size_t)b * SEQ;
        const bf16 *Qp, *Kb, *Vb; int qpitch, kpitch, vpitch;
        if (MODE == 0) { const bf16* base = (const bf16*)(ws + R_A_QKV); qpitch = kpitch = vpitch = 4608;
            Qp = base + row_q * 4608 + g * 1536 + h * 64; Kb = base + row_b * 4608 + g * 1536 + 512 + h * 64; Vb = base + row_b * 4608 + g * 1536 + 1024 + h * 64; }
        else if (MODE == 1) { qpitch = 1536; kpitch = 1536; vpitch = 2048;
            Qp = (const bf16*)(ws + R_B_Q) + row_q * 1536 + h * 96; Kb = (const bf16*)(ws + R_B_KH) + row_b * 1536 + h * 96; Vb = (const bf16*)(ws + R_B_KV) + row_b * 2048 + h * 128 + 64; }
        else if (MODE == 2) { const bf16* base = (const bf16*)(ws + R_C_QKV); qpitch = kpitch = vpitch = 3072;
            Qp = base + row_q * 3072 + (2 * h) * 64; Kb = base + row_b * 3072 + 1024 + (2 * h) * 64; Vb = base + row_b * 3072 + 2048 + h * 128; }
        else { const bf16* base = (const bf16*)(ws + R_D_QKV); qpitch = kpitch = vpitch = 1280;
            Qp = base + row_q * 1280 + h * 64; Kb = base + row_b * 1280 + 1024 + (h >> 3) * 64; Vb = base + row_b * 1280 + 1152 + (h >> 3) * 64; }
        (void)qpitch;
        if (MODE == 0 || MODE == 3) { const int d_ = tid - 128; tab[tid] = (d_ >= 0 && d_ <= W) ? biasd[h * 2048 + d_ * dil] : -INFINITY; }
        if (MODE == 2) {
#pragma unroll
            for (int j = 0; j < 4; ++j) tab[128 + tid + 512 * j] = biasd[h * 2048 + tid + 512 * j];
            if (tid < 128) { tab[tid] = -INFINITY; tab[2176 + tid] = 0.f; } }
        bf16x8 qf[DQK / 16];
        constexpr int OFF_Q = L::OFF_TAB + TABN * 4, QSTR = DQK * 2 + 16;
        const int qoff = OFF_Q + (32 * wid + r32) * QSTR + hi * 16;
        int tq = tid; asm volatile("" : "+v"(tq));
        if (MODE == 2) {
            const bf16* qsrc = (const bf16*)(ws + R_C_QKV) + (row_b + s0) * 3072 + (2 * h) * 64;
#pragma unroll
            for (int j = 0; j < 4; ++j) { const int c_ = tq + 512 * j, rw = c_ >> 3, p_ = c_ & 7;
                *(LAS u32x4*)(lds + OFF_Q + rw * QSTR + p_ * 16) = *(const u32x4*)(qsrc + (size_t)rw * 3072 + p_ * 8); }
        } else {
#pragma unroll
            for (int ks = 0; ks < DQK / 16; ++ks) qf[ks] = *(const bf16x8*)(Qp + 16 * ks + 8 * hi);
            if (MODE == 1) {
                float x[DQK / 16][8]; float ss = 0.f;
#pragma unroll
                for (int ks = 0; ks < DQK / 16; ++ks) { const u32x4 raw = __builtin_bit_cast(u32x4, qf[ks]);
#pragma unroll
                    for (int j = 0; j < 4; ++j) { x[ks][2 * j] = bflo(raw[j]); x[ks][2 * j + 1] = bfhi(raw[j]); ss += x[ks][2 * j] * x[ks][2 * j] + x[ks][2 * j + 1] * x[ks][2 * j + 1]; } }
                ss += __shfl_xor(ss, 32);
                const float rsq = rsqrtf(ss * (1.0f / 96.0f) + EPS) * (0.10206207261596577f * LOG2E);
                const float* gq_ = a.in[13];
#pragma unroll
                for (int ks = 0; ks < DQK / 16; ++ks) { const f32x4 g0 = *(const f32x4*)(gq_ + 16 * ks + 8 * hi), g1 = *(const f32x4*)(gq_ + 16 * ks + 8 * hi + 4);
#pragma unroll
                    for (int j = 0; j < 4; ++j) { x[ks][j] *= rsq * g0[j]; x[ks][4 + j] *= rsq * g1[j]; } }
                const float* cs = (const float*)(ws + WS_ROPE) + ((size_t)qtok * 16 + 8 * hi) * 2;
#pragma unroll
                for (int j = 0; j < 8; ++j) { const float co = cs[2 * j], si = cs[2 * j + 1], x1 = x[4][j], x2 = x[5][j]; x[4][j] = x1 * co - x2 * si; x[5][j] = x2 * co + x1 * si; }
#pragma unroll
                for (int ks = 0; ks < DQK / 16; ++ks) { u32x4 w;
#pragma unroll
                    for (int j = 0; j < 4; ++j) w[j] = pk2(x[ks][2 * j], x[ks][2 * j + 1]);
                    qf[ks] = __builtin_bit_cast(bf16x8, w); }
            }
        }
        f32x16 o[DV / 32];
#pragma unroll
        for (int c = 0; c < DV / 32; ++c)
#pragma unroll
            for (int r = 0; r < 16; ++r) o[c][r] = 0.f;
        float m = -INFINITY, l = 0.f;
        if (MODE == 3) { m = a.in[28][h] * LOG2E; l = hi == 0 ? 1.f : 0.f; }
        attn_pass<DQK, DV, BIAS, TABN, MODE == 2, KT>(qoff, lds, Kb, kpitch, Vb, vpitch, G, my_tlo, my_thi, wslot_q0, W, qf, m, l, o);
        float lt = l + __shfl_xor(l, 32);
        float inv = 1.0f / lt;
        if (MODE != 2) {
            bf16* Op; int opitch;
            if (MODE == 0) { Op = (bf16*)(ws + R_A_O3) + ((size_t)g * M_ + row_q) * 512 + h * 64; opitch = 512;
                if (hi == 0) ((float*)(ws + R_A_LSE))[((size_t)g * M_ + row_q) * 8 + h] = m + __log2f(lt); }
            else if (MODE == 1) { Op = (bf16*)(ws + R_B_O) + row_q * 1024 + h * 64; opitch = 1024; }
            else { Op = (bf16*)(ws + R_D_O) + row_q * 1024 + h * 64; opitch = 1024; }
            (void)opitch;
#pragma unroll
            for (int c = 0; c < DV / 32; ++c)
#pragma unroll
                for (int gq = 0; gq < 4; ++gq) {
                    u32x2 w; w.x = pk2(o[c][4 * gq] * inv, o[c][4 * gq + 1] * inv); w.y = pk2(o[c][4 * gq + 2] * inv, o[c][4 * gq + 3] * inv);
                    *(u32x2*)(Op + 32 * c + 8 * gq + 4 * hi) = w;
                }
        } else {
            f32x16 o1[DV / 32];
#pragma unroll
            for (int c = 0; c < DV / 32; ++c)
#pragma unroll
                for (int r = 0; r < 16; ++r) { o1[c][r] = o[c][r] * inv; o[c][r] = 0.f; }
#pragma unroll
            for (int j = 0; j < 4; ++j) tab[128 + tid + 512 * j] = biasd[(8 + h) * 2048 + tid + 512 * j];
            { const bf16* qsrc = (const bf16*)(ws + R_C_QKV) + (row_b + s0) * 3072 + (2 * h + 1) * 64;
#pragma unroll
              for (int j = 0; j < 4; ++j) { const int c_ = tq + 512 * j, rw = c_ >> 3, p_ = c_ & 7;
                  *(LAS u32x4*)(lds + OFF_Q + rw * QSTR + p_ * 16) = *(const u32x4*)(qsrc + (size_t)rw * 3072 + p_ * 8); } }
            m = -INFINITY; l = 0.f;
            attn_pass<DQK, DV, BIAS, TABN, MODE == 2, KT>(qoff, lds, Kb + 64, kpitch, Vb, vpitch, G, my_tlo, my_thi, wslot_q0, W, qf, m, l, o);
            lt = l + __shfl_xor(l, 32);
            inv = lam / lt;
            float ssum = 0.f;
#pragma unroll
            for (int c = 0; c < DV / 32; ++c)
#pragma unroll
                for (int r = 0; r < 16; ++r) { const float d = o1[c][r] - o[c][r] * inv; o1[c][r] = d; ssum += d * d; }
            ssum += __shfl_xor(ssum, 32);
            const float rs = rsqrtf(ssum * (1.0f / 128.0f) + EPS) * (1.0f - lam_init);
            bf16* Op = (bf16*)(ws + R_C_O) + row_q * 1024 + h * 128;
            const float* sub = a.in[23];
#pragma unroll
            for (int c = 0; c < DV / 32; ++c)
#pragma unroll
                for (int gq = 0; gq < 4; ++gq) {
                    const f32x4 sv = *(const f32x4*)(sub + 32 * c + 8 * gq + 4 * hi);
                    u32x2 w; w.x = pk2(o1[c][4 * gq] * rs * sv[0], o1[c][4 * gq + 1] * rs * sv[1]); w.y = pk2(o1[c][4 * gq + 2] * rs * sv[2], o1[c][4 * gq + 3] * rs * sv[3]);
                    *(u32x2*)(Op + 32 * c + 8 * gq + 4 * hi) = w;
                }
        }
    }
}

__device__ __forceinline__ void transpose_item(const float* W, int ldw, int ncol0, int K, const float* ksc, bf16* WT, int mode, LAS float* scr, int nblk, int item, int lane) {
    const int kb = item / nblk, nb = item - kb * nblk, k0 = 64 * kb, n0 = 32 * nb;
#pragma unroll
    for (int i = 0; i < 32; ++i) { const int kk = 2 * i + (lane >> 5); float v = W[(size_t)(k0 + kk) * ldw + ncol0 + n0 + (lane & 31)]; if (ksc != nullptr) v *= ksc[k0 + kk]; scr[kk * 33 + (lane & 31)] = v; }
    asm volatile("s_waitcnt lgkmcnt(0)" ::: "memory");
    const int drow0 = mode == 1 ? (256 * (n0 >> 8) + 128 * ((n0 & 63) >> 5) + 32 * ((n0 >> 6) & 3)) : mode == 2 ? (n0 < DFF ? 256 * (n0 >> 7) + (n0 & 127) : 256 * ((n0 - DFF) >> 7) + 128 + ((n0 - DFF) & 127)) : n0;
    const int c = lane & 7;
#pragma unroll
    for (int j = 0; j < 4; ++j) { const int n = (lane >> 3) + 8 * j; const LAS float* s = scr + (8 * c) * 33 + n;
        u32x4 o; o.x = pk2(s[0 * 33], s[1 * 33]); o.y = pk2(s[2 * 33], s[3 * 33]); o.z = pk2(s[4 * 33], s[5 * 33]); o.w = pk2(s[6 * 33], s[7 * 33]);
        *(u32x4*)(WT + (size_t)(drow0 + n) * K + k0 + 8 * c) = o; }
    asm volatile("s_waitcnt lgkmcnt(0)" ::: "memory");
}
__device__ __forceinline__ void prologue(LAS unsigned char* lds, const Args& a, int Gn, int cid) {
    int tid = threadIdx.x; asm volatile("" : "+v"(tid)); const int lane = tid & 63, wid = __builtin_amdgcn_readfirstlane(tid >> 6);
    unsigned char* ws = a.ws;
    LAS float* scr = (LAS float*)(lds + wid * 16384);
    const int gw = cid * 8 + wid, NGW = Gn * 8;
#define MAT_DESC(id) \
        const float* W; int ldw, ncol0 = 0, K, N, mode; const float* ksc = nullptr; size_t dst; \
        if (id == 0) { W = a.in[4]; ldw = 4608; K = 1024; N = 4608; ksc = a.in[2]; dst = W_AIN; mode = 1; } \
        else if (id == 1) { W = a.in[7]; ldw = 1024; K = 512; N = 1024; dst = W_AOUT; mode = 0; } \
        else if (id == 2) { W = a.in[8]; ldw = 672; K = 1024; N = 672; ksc = a.in[2] + 1024; dst = W_BIN; mode = 1; } \
        else if (id == 3) { W = a.in[11]; ldw = 1536; K = 384; N = 1536; ksc = a.in[9]; dst = W_BQUP; mode = 1; } \
        else if (id == 4) { W = a.in[12]; ldw = 2048; K = 256; N = 2048; ksc = a.in[10]; dst = W_BKVUP; mode = 1; } \
        else if (id == 5) { W = a.in[15]; ldw = 1024; K = 1024; N = 1024; dst = W_BOUT; mode = 0; } \
        else if (id == 6) { W = a.in[16]; ldw = 3072; K = 1024; N = 3072; ksc = a.in[2] + 2048; dst = W_CIN; mode = 1; } \
        else if (id == 7) { W = a.in[24]; ldw = 1024; K = 1024; N = 1024; dst = W_COUT; mode = 0; } \
        else if (id == 8) { W = a.in[25]; ldw = 1280; K = 1024; N = 1280; ksc = a.in[2] + 3072; dst = W_DIN; mode = 1; } \
        else if (id == 9) { W = a.in[29]; ldw = 1024; K = 1024; N = 1024; dst = W_DOUT; mode = 0; } \
        else { const int l = (id - 10) / 3, k3 = (id - 10) - 3 * l; \
            if (k3 < 2) { W = a.in[30] + (size_t)l * 1024 * 5632; ldw = 5632; K = 1024; N = 5632; ksc = a.in[3] + 1024 * l; dst = W_FG + l * 2 * W_FSTR; mode = 2; } \
            else { W = a.in[33] + (size_t)l * 2816 * 1024; ldw = 1024; K = 2816; N = 1024; dst = W_FD + l * W_FSTR; mode = 0; } }
    constexpr int TOTAL_ITEMS = 2304 + 256 + 336 + 288 + 256 + 512 + 1536 + 512 + 640 + 512 + 4 * (1408 + 1408 + 1408);
    for (int it = gw; it < TOTAL_ITEMS; it += NGW) {
        int r = it, id = 0;
        for (; id < 21; ++id) {
            int n_;
            if (id < 10) { n_ = id == 0 ? 2304 : id == 1 ? 256 : id == 2 ? 336 : id == 3 ? 288 : id == 4 ? 256 : id == 5 ? 512 : id == 6 ? 1536 : id == 7 ? 512 : id == 8 ? 640 : 512; } else { const int k3_ = (id - 10) % 3; n_ = k3_ == 0 ? 2816 : (k3_ == 1 ? 0 : 1408); }
            if (r < n_) break;
            r -= n_;
        }
        MAT_DESC(id)
        const int nblk = N / 32;
        transpose_item(W, ldw, ncol0, K, ksc, (bf16*)(ws + dst), mode, scr, nblk, r, lane);
    }
#undef MAT_DESC
    const int gt = cid * 512 + tid, NT = Gn * 512;
    { float* biasd = (float*)(ws + WS_BIAS); const float* table = a.in[1];
      for (int i = gt; i < 16 * 2048; i += NT) { const int h = i >> 11, d = i & 2047; int bk = d;
          if (d >= 16) { float t = logf((float)d / 16.0f); t = t / 4.852030263919617f; t = t * 16.0f; int lg = 16 + (int)t; bk = lg < 31 ? lg : 31; }
          biasd[i] = table[bk * 16 + h] * LOG2E; } }
    { float* rope = (float*)(ws + WS_ROPE);
      for (int i = gt; i < 2048 * 16; i += NT) { const int pos = i >> 4, f = i & 15; const float inv = powf(10000.0f, -(float)(2 * f) / 32.0f); const float ang = (float)pos * inv;
          rope[2 * i] = cosf(ang); rope[2 * i + 1] = sinf(ang); } }
    { const float* x = a.in[0]; bf16* xb = (bf16*)(ws + WS_XB); float* rss = (float*)(ws + WS_RSS);
      for (int m0 = gw; m0 < M_; m0 += 4 * NGW) {
          f32x4 v[4][4];
#pragma unroll
          for (int k = 0; k < 4; ++k) { const int m = m0 + k * NGW; if (m < M_) { const f32x4* xr = (const f32x4*)(x + (size_t)m * DMODEL) + lane;
#pragma unroll
              for (int j = 0; j < 4; ++j) v[k][j] = xr[64 * j]; } }
#pragma unroll
          for (int k = 0; k < 4; ++k) { const int m = m0 + k * NGW; if (m < M_) { u32x2* o8 = (u32x2*)(xb + (size_t)m * DMODEL) + lane; float s = 0.f;
#pragma unroll
              for (int j = 0; j < 4; ++j) { s += dot4(v[k][j]); u32x2 w; w.x = pk2(v[k][j][0], v[k][j][1]); w.y = pk2(v[k][j][2], v[k][j][3]); o8[64 * j] = w; }
              s = wave_sum(s); if (lane == 0) rss[m] = rsqrtf(s * (1.0f / 1024.0f) + EPS); } } } }
}
__device__ __forceinline__ void combine_a(const Args& a, int Gn, int cid) {
    unsigned char* ws = a.ws;
    const bf16* o3 = (const bf16*)(ws + R_A_O3); const float* lse = (const float*)(ws + R_A_LSE); bf16* oc = (bf16*)(ws + R_A_OC);
    const size_t NT = (size_t)Gn * 512; int tid = threadIdx.x; asm volatile("" : "+v"(tid));
    for (size_t idx0 = (size_t)cid * 512 + tid; idx0 < (size_t)M_ * 64; idx0 += 4 * NT) {
        u32x4 a0[4], a1[4], a2[4]; float l0[4], l1[4], l2[4];
#pragma unroll
        for (int k = 0; k < 4; ++k) { const size_t idx = idx0 + k * NT; if (idx < (size_t)M_ * 64) {
            const size_t row = idx >> 6; const int ch = (int)(idx & 63), h = ch >> 3;
            l0[k] = lse[row * 8 + h]; l1[k] = lse[((size_t)M_ + row) * 8 + h]; l2[k] = lse[((size_t)2 * M_ + row) * 8 + h];
            a0[k] = *(const u32x4*)(o3 + row * 512 + ch * 8); a1[k] = *(const u32x4*)(o3 + ((size_t)M_ + row) * 512 + ch * 8); a2[k] = *(const u32x4*)(o3 + ((size_t)2 * M_ + row) * 512 + ch * 8); } }
#pragma unroll
        for (int k = 0; k < 4; ++k) { const size_t idx = idx0 + k * NT; if (idx < (size_t)M_ * 64) {
            const size_t row = idx >> 6; const int ch = (int)(idx & 63);
            const float mx = fmaxf(l0[k], fmaxf(l1[k], l2[k]));
            float w0 = __builtin_amdgcn_exp2f(l0[k] - mx), w1 = __builtin_amdgcn_exp2f(l1[k] - mx), w2 = __builtin_amdgcn_exp2f(l2[k] - mx);
            const float inv = 1.0f / (w0 + w1 + w2); w0 *= inv; w1 *= inv; w2 *= inv;
            u32x4 r;
#pragma unroll
            for (int j = 0; j < 4; ++j) r[j] = pk2(w0 * bflo(a0[k][j]) + w1 * bflo(a1[k][j]) + w2 * bflo(a2[k][j]), w0 * bfhi(a0[k][j]) + w1 * bfhi(a1[k][j]) + w2 * bfhi(a2[k][j]));
            *(u32x4*)(oc + row * 512 + ch * 8) = r; } }
    }
}
__device__ __forceinline__ void prep_b(const Args& a, int Gn, int cid) {
    unsigned char* ws = a.ws;
    int tid = threadIdx.x; asm volatile("" : "+v"(tid)); const int lane = tid & 63, wid = __builtin_amdgcn_readfirstlane(tid >> 6);
    bf16* Q = (bf16*)(ws + R_B_Q); const bf16* KV = (const bf16*)(ws + R_B_KV); const bf16* KPE = (const bf16*)(ws + R_B_KPE); bf16* KH = (bf16*)(ws + R_B_KH);
    const float* rope = (const float*)(ws + WS_ROPE);
    const int sub = lane >> 4, c = lane & 15;
    const float qscale = 0.10206207261596577f * LOG2E;
    const int gw = cid * 8 + wid, NGW = Gn * 8;
    const int TOT = 2 * M_ * 4;
    for (int it0 = M_ * 4 + gw; it0 < TOT; it0 += 4 * NGW) {
        u32x4 raw[4];
#pragma unroll
        for (int k = 0; k < 4; ++k) {
            const int it = it0 + k * NGW;
            raw[k] = (u32x4){0u, 0u, 0u, 0u};
            if (it < TOT && c < 12) {
                const bool isk = it >= M_ * 4; const int it2 = isk ? it - M_ * 4 : it;
                const int task = it2 * 4 + sub; const size_t row = (size_t)(task >> 4); const int h = task & 15;
                if (!isk) raw[k] = *(const u32x4*)(Q + row * 1536 + h * 96 + 8 * c);
                else if (c < 8) raw[k] = *(const u32x4*)(KV + row * 2048 + h * 128 + 8 * c);
                else raw[k] = *(const u32x4*)(KPE + row * 64 + 8 * (c - 8));
            }
        }
#pragma unroll
        for (int k = 0; k < 4; ++k) {
            const int it = it0 + k * NGW;
            if (it < TOT) {
                const bool isk = it >= M_ * 4; const int it2 = isk ? it - M_ * 4 : it;
                const int task = it2 * 4 + sub; const size_t row = (size_t)(task >> 4); const int h = task & 15; const int pos = (int)(row & 2047);
                float x[8];
#pragma unroll
                for (int j = 0; j < 4; ++j) { x[2 * j] = bflo(raw[k][j]); x[2 * j + 1] = bfhi(raw[k][j]); }
                float ss = 0.f;
#pragma unroll
                for (int e = 0; e < 8; ++e) ss += x[e] * x[e];
                ss += __shfl_xor(ss, 1); ss += __shfl_xor(ss, 2); ss += __shfl_xor(ss, 4); ss += __shfl_xor(ss, 8);
                const float rs = rsqrtf(ss * (1.0f / 96.0f) + EPS);
                const float* gain = (isk ? a.in[14] : a.in[13]) + 8 * (c < 12 ? c : 0);
                const float* cs = rope + ((size_t)pos * 16 + (c & 1) * 8) * 2;
                float y[8];
#pragma unroll
                for (int e = 0; e < 8; ++e) y[e] = x[e] * rs * gain[e];
#pragma unroll
                for (int e = 0; e < 8; ++e) {
                    const float z = __shfl_xor(y[e], 2);
                    if (c >= 8 && c < 12) { const float co = cs[2 * e], si = cs[2 * e + 1]; y[e] = (c < 10) ? (y[e] * co - z * si) : (y[e] * co + z * si); }
                }
                if (c < 12) {
                    u32x4 w;
                    if (!isk) {
#pragma unroll
                        for (int j = 0; j < 4; ++j) w[j] = pk2(y[2 * j] * qscale, y[2 * j + 1] * qscale);
                        *(u32x4*)(Q + row * 1536 + h * 96 + 8 * c) = w;
                    } else {
#pragma unroll
                        for (int j = 0; j < 4; ++j) w[j] = pk2(y[2 * j], y[2 * j + 1]);
                        *(u32x4*)(KH + row * 1536 + h * 96 + 8 * c) = w;
                    }
                }
            }
        }
    }
}

__device__ __forceinline__ void fixup_ffn(const bf16* gedge, const bf16* uedge, bf16* act, const float* cw, const float* cb, int Gn, int cid) {
    int tid = threadIdx.x; asm volatile("" : "+v"(tid));
    const int TOT = 1024 * 2 * 352;
    for (int idx = cid * 512 + tid; idx < TOT; idx += Gn * 512) {
        const int ch = idx % 352, sj = idx / 352, j = sj & 1, st = sj >> 1, c0 = ch * 8;
        const int row = st * 64 + j, t = row & (SEQ - 1);
        const u32x4 z = (u32x4){0u, 0u, 0u, 0u};
        const u32x4 g0 = *(const u32x4*)(gedge + ((size_t)st * 4 + j) * DFF + c0);
        u32x4 g1, g2;
        if (j == 0) { g1 = t >= 1 ? *(const u32x4*)(gedge + ((size_t)(st - 1) * 4 + 3) * DFF + c0) : z; g2 = t >= 2 ? *(const u32x4*)(gedge + ((size_t)(st - 1) * 4 + 2) * DFF + c0) : z; }
        else { g1 = *(const u32x4*)(gedge + ((size_t)st * 4 + 0) * DFF + c0); g2 = t >= 2 ? *(const u32x4*)(gedge + ((size_t)(st - 1) * 4 + 3) * DFF + c0) : z; }
        const u32x4 uw = *(const u32x4*)(uedge + ((size_t)st * 2 + j) * DFF + c0);
        u32x4 w;
#pragma unroll
        for (int n = 0; n < 2; ++n) {
            const f32x4 w0 = *(const f32x4*)(cw + c0 + 4 * n), w1 = *(const f32x4*)(cw + DFF + c0 + 4 * n), w2 = *(const f32x4*)(cw + 2 * DFF + c0 + 4 * n), b = *(const f32x4*)(cb + c0 + 4 * n);
            float r[4];
#pragma unroll
            for (int e = 0; e < 4; ++e) {
                const unsigned q0 = g0[2 * n + (e >> 1)], q1 = g1[2 * n + (e >> 1)], q2 = g2[2 * n + (e >> 1)], qu = uw[2 * n + (e >> 1)];
                const float x0 = (e & 1) ? bfhi(q0) : bflo(q0), x1 = (e & 1) ? bfhi(q1) : bflo(q1), x2 = (e & 1) ? bfhi(q2) : bflo(q2), up = (e & 1) ? bfhi(qu) : bflo(qu);
                const float cv = b[e] + w2[e] * x0 + w1[e] * x1 + w0[e] * x2;
                r[e] = cv * __builtin_amdgcn_rcpf(1.0f + __builtin_amdgcn_exp2f(-LOG2E * cv)) * up;
            }
            w[2 * n] = pk2(r[0], r[1]); w[2 * n + 1] = pk2(r[2], r[3]);
        }
        *(u32x4*)(act + (size_t)row * DFF + c0) = w;
    }
}
__device__ __forceinline__ void rstd_pass(const float* ssp, int nvec, float invdim, float* rs, int Gn, int cid) {
    int tid = threadIdx.x; asm volatile("" : "+v"(tid));
    for (int row = cid * 512 + tid; row < M_; row += Gn * 512) rs[row] = rsqrtf(rowss_sum(ssp, nvec, row) * invdim + EPS);
}
__device__ __forceinline__ void kpe_pass(const Args& a, int Gn, int cid) {
    unsigned char* ws = a.ws;
    int tid = threadIdx.x; asm volatile("" : "+v"(tid));
    const bf16* KPE = (const bf16*)(ws + R_B_KPE); bf16* RK = (bf16*)(ws + R_B_RK); float* sspe = (float*)(ws + WS_SSPE);
    const float* rope = (const float*)(ws + WS_ROPE); const float* gk = a.in[14] + 64;
    for (int row = cid * 512 + tid; row < M_; row += Gn * 512) {
        float x[32]; float ss = 0.f;
#pragma unroll
        for (int c = 0; c < 4; ++c) { const u32x4 raw = *(const u32x4*)(KPE + (size_t)row * 64 + 8 * c);
#pragma unroll
            for (int j = 0; j < 4; ++j) { x[8 * c + 2 * j] = bflo(raw[j]); x[8 * c + 2 * j + 1] = bfhi(raw[j]); } }
#pragma unroll
        for (int i = 0; i < 32; ++i) { ss += x[i] * x[i]; x[i] *= gk[i]; }
        sspe[row] = ss;
        const float* cs = rope + (size_t)(row & (SEQ - 1)) * 32;
#pragma unroll
        for (int i = 0; i < 16; ++i) { const float co = cs[2 * i], si = cs[2 * i + 1], x1 = x[i], x2 = x[16 + i]; x[i] = x1 * co - x2 * si; x[16 + i] = x2 * co + x1 * si; }
#pragma unroll
        for (int c = 0; c < 4; ++c) { u32x4 w;
#pragma unroll
            for (int j = 0; j < 4; ++j) w[j] = pk2(x[8 * c + 2 * j], x[8 * c + 2 * j + 1]);
            *(u32x4*)(RK + (size_t)row * 32 + 8 * c) = w; }
    }
}
__device__ __forceinline__ void rstd_local(const float* ssp, float* rs, const pg8::StaticOrder& S, int nunits) {
    int tid = threadIdx.x; asm volatile("" : "+v"(tid));
    const int TOT = nunits * 256;
    for (int k0 = tid; k0 < TOT; k0 += 4 * 512) {
        f32x4 p[4][4]; int rows[4];
#pragma unroll
        for (int j = 0; j < 4; ++j) { const int k = k0 + j * 512; rows[j] = -1;
            if (k < TOT) { pg8::Unit uu; S.next(k >> 8, uu); rows[j] = uu.pm * 256 + (k & 255); const f32x4* q = (const f32x4*)(ssp + (size_t)rows[j] * 16);
#pragma unroll
                for (int v = 0; v < 4; ++v) p[j][v] = q[v]; } }
#pragma unroll
        for (int j = 0; j < 4; ++j) if (rows[j] >= 0) { float t = 0.f;
#pragma unroll
            for (int v = 0; v < 4; ++v) t += (p[j][v][0] + p[j][v][1]) + (p[j][v][2] + p[j][v][3]);
            rs[rows[j]] = rsqrtf(t * (1.0f / 1024.0f) + EPS); }
    }
    asm volatile("s_waitcnt vmcnt(0)" ::: "memory");
    __syncthreads();
}
__device__ __forceinline__ void grid_barrier(unsigned* cnt, unsigned& epoch, unsigned G) {
    asm volatile("s_waitcnt vmcnt(0) lgkmcnt(0)" ::: "memory");
    __syncthreads();
    epoch += 1u;
    if (threadIdx.x == 0) {
        __builtin_amdgcn_fence(__ATOMIC_RELEASE, "agent");
        asm volatile("s_waitcnt vmcnt(0)" ::: "memory");
        __hip_atomic_fetch_add(cnt, 1u, __ATOMIC_RELAXED, __HIP_MEMORY_SCOPE_AGENT);
        const unsigned want = epoch * G;
        while (__hip_atomic_load(cnt, __ATOMIC_RELAXED, __HIP_MEMORY_SCOPE_AGENT) < want) __builtin_amdgcn_s_sleep(2);
        __builtin_amdgcn_fence(__ATOMIC_ACQUIRE, "agent");
        asm volatile("s_waitcnt vmcnt(0)" ::: "memory");
    }
    __syncthreads();
}
__global__ void __launch_bounds__(512) fwd_kernel(Args a) {
    extern __shared__ __attribute__((aligned(16))) unsigned char lds_raw[];
    LAS unsigned char* lds = (LAS unsigned char*)lds_raw;
    cg::grid_group grid = cg::this_grid();
    const int Gn = (int)gridDim.x, cid = (int)blockIdx.x;
    unsigned char* ws = a.ws;
    unsigned* barcnt = (unsigned*)(ws + WS_BAR); unsigned epoch = 0u;
    prologue(lds, a, Gn, cid);
    grid.sync();
    grid_barrier(barcnt, epoch, (unsigned)Gn);
    bf16* XB = (bf16*)(ws + WS_XB);
    float* RSS = (float*)(ws + WS_RSSP); float* RSTD = (float*)(ws + WS_RSS);
    for (int ph = 0; ph < 28; ++ph) {
        int type = 0, N = 1024, K = 1024, ldc = 0, hm = 0, layer = 0, sidx = 0, nvec = 4, pbuf = -1;
        const bf16 *A = XB, *Bt = nullptr; bf16* pO = nullptr; const float* pss = RSTD; const float *gq = nullptr, *gk = nullptr; float qs = 0.125f * LOG2E;
        const float* rbase = nullptr; float* rout = nullptr; bf16* rxb = XB; float* rssn = nullptr;
        int f = -1;
        switch (ph) {
        case 0: type = 0; Bt = (const bf16*)(ws + W_AIN); N = 4608; pO = (bf16*)(ws + R_A_QKV); ldc = 4608; hm = 1; gq = a.in[5]; gk = a.in[6]; break;
        case 1: type = 4; break;
        case 2: type = 8; break;
        case 3: type = 1; A = (const bf16*)(ws + R_A_OC); Bt = (const bf16*)(ws + W_AOUT); K = 512; rbase = a.in[0]; rssn = RSS + 1 * (size_t)M_ * 16; break;
        case 4: case 5: case 6: layer = 0; sidx = 1; f = ph - 4; break;
        case 7: type = 2; Bt = (const bf16*)(ws + W_BIN); N = 768; pbuf = 0; break;
        case 8: type = 0; A = (const bf16*)(ws + R_B_CQ); Bt = (const bf16*)(ws + W_BQUP); N = 1536; K = 384; pO = (bf16*)(ws + R_B_Q); ldc = 1536; pss = (const float*)(ws + WS_SSQ); break;
        case 9: type = 10; break;
        case 10: type = 10; break;
        case 11: type = 5; break;
        case 12: type = 1; A = (const bf16*)(ws + R_B_O); Bt = (const bf16*)(ws + W_BOUT); rssn = RSS + 1 * (size_t)M_ * 16; break;
        case 13: case 14: case 15: layer = 1; sidx = 3; f = ph - 13; break;
        case 16: type = 0; Bt = (const bf16*)(ws + W_CIN); N = 3072; pO = (bf16*)(ws + R_C_QKV); ldc = 3072; pbuf = 0; hm = 2; gq = a.in[17]; gk = a.in[18]; break;
        case 17: type = 6; break;
        case 18: type = 1; A = (const bf16*)(ws + R_C_O); Bt = (const bf16*)(ws + W_COUT); rssn = RSS + 1 * (size_t)M_ * 16; break;
        case 19: case 20: case 21: layer = 2; sidx = 5; f = ph - 19; break;
        case 22: type = 0; Bt = (const bf16*)(ws + W_DIN); N = 1280; pO = (bf16*)(ws + R_D_QKV); ldc = 1280; pbuf = 0; hm = 3; gq = a.in[26]; gk = a.in[27]; break;
        case 23: type = 7; break;
        case 24: type = 1; A = (const bf16*)(ws + R_D_O); Bt = (const bf16*)(ws + W_DOUT); rssn = RSS + 1 * (size_t)M_ * 16; break;
        default: layer = 3; sidx = 7; f = ph - 25; break;
        }
        if (f == 0) { type = 3; Bt = (const bf16*)(ws + W_FG + layer * 2 * W_FSTR); N = 2 * DFF; pbuf = 1; }
        else if (f == 1) { type = 11; }
        else if (f == 2) { type = 1; A = (const bf16*)(ws + R_ACT); Bt = (const bf16*)(ws + W_FD + layer * W_FSTR); K = DFF;
            if (layer < 3) { rssn = RSS + ((sidx + 1) & 1) * (size_t)M_ * 16; } else { rssn = nullptr; rxb = nullptr; rout = a.out; } }

        if (type == 10) continue;
        if (type <= 3) {
            pg8::Gemm g{A, Bt, M_, N, K}; pg8::StaticOrder S; S.init(M_, N, Gn, cid);
            if (pbuf >= 0) rstd_local(RSS + (size_t)pbuf * M_ * 16, RSTD, S, (S.nwg - cid + Gn - 1) / Gn);
            if (type == 0) {
                for (int sub = 0; sub < (ph == 8 ? 2 : 1); ++sub) {
                    const bool kv = (sub == 1);
                    const pg8::Gemm g2{kv ? (const bf16*)(ws + R_B_CKV) : A, kv ? (const bf16*)(ws + W_BKVUP) : Bt, M_, kv ? 2048 : N, kv ? 256 : K};
                    pg8::StaticOrder S2; S2.init(M_, kv ? 2048 : N, Gn, cid);
                    const EpiProj E{kv ? (bf16*)(ws + R_B_KV) : pO, kv ? 2048 : ldc, kv ? (const float*)(ws + WS_SSKV) : pss, kv ? 4 : hm, gq, kv ? a.in[14] : gk, qs};
                    pg8::gemm_phase<EpiProj, pg8::StaticOrder, true, true>(lds, g2, S2, E);
                }
            }
            else if (type == 1) { EpiRes E{rbase, rout, XB, rxb, rssn}; pg8::gemm_phase<EpiRes, pg8::StaticOrder, true, true>(lds, g, S, E); }
            else if (type == 2) { EpiLat E{(bf16*)(ws + R_B_CQ), (bf16*)(ws + R_B_CKV), (bf16*)(ws + R_B_KPE), pss, (float*)(ws + WS_SSQP), (float*)(ws + WS_SSKVP)}; pg8::gemm_phase<EpiLat, pg8::StaticOrder, true, true>(lds, g, S, E); }
            else { EpiGateUp E{(bf16*)(ws + R_ACT), (bf16*)(ws + R_GATE), (bf16*)(ws + R_GATE + 32 * MiB), pss, a.in[31] + (size_t)layer * 3 * DFF, a.in[32] + (size_t)layer * DFF}; pg8::gemm_phase<EpiGateUp, pg8::StaticOrder, true, true>(lds, g, S, E); }
        }
        else if (type == 4) attn_phase<0>(lds, a, Gn, cid);
        else if (type == 5) attn_phase<1>(lds, a, Gn, cid);
        else if (type == 6) attn_phase<2>(lds, a, Gn, cid);
        else if (type == 7) attn_phase<3>(lds, a, Gn, cid);
        else if (type == 8) combine_a(a, Gn, cid);
        else if (type == 11) fixup_ffn((const bf16*)(ws + R_GATE), (const bf16*)(ws + R_GATE + 32 * MiB), (bf16*)(ws + R_ACT), a.in[31] + (size_t)layer * 3 * DFF, a.in[32] + (size_t)layer * DFF, Gn, cid);
        else prep_b(a, Gn, cid);
        grid_barrier(barcnt, epoch, (unsigned)Gn);
        if (type == 2) { rstd_pass((const float*)(ws + WS_SSQP), 2, 1.0f / 384.0f, (float*)(ws + WS_SSQ), Gn, cid); rstd_pass((const float*)(ws + WS_SSKVP), 1, 1.0f / 256.0f, (float*)(ws + WS_SSKV), Gn, cid); kpe_pass(a, Gn, cid);
            grid_barrier(barcnt, epoch, (unsigned)Gn); }
    }
}

extern "C" void kernel_launch(void* const* d_in, const int* in_sizes, int n_in, void* d_out, int out_size, void* d_ws, size_t ws_size, hipStream_t stream) {
    static int grid = 0;
    if (grid == 0) {
        if (n_in != 34 || out_size != M_ * DMODEL || ws_size < WS_NEED) { fprintf(stderr, "kernel_launch: unexpected shapes (n_in %d out %d ws %zu)\n", n_in, out_size, ws_size); grid = -1; return; }
        int dev = 0, cus = 0, per_cu = 0;
        if (hipGetDevice(&dev) != hipSuccess || hipDeviceGetAttribute(&cus, hipDeviceAttributeMultiprocessorCount, dev) != hipSuccess) { grid = -1; return; }
        if (hipFuncSetAttribute((const void*)fwd_kernel, hipFuncAttributeMaxDynamicSharedMemorySize, LDS_BYTES) != hipSuccess) { fprintf(stderr, "kernel_launch: hipFuncSetAttribute failed\n"); grid = -1; return; }
        if (hipOccupancyMaxActiveBlocksPerMultiprocessor(&per_cu, (const void*)fwd_kernel, 512, LDS_BYTES) != hipSuccess || per_cu < 1) { fprintf(stderr, "kernel_launch: occupancy query says %d\n", per_cu); per_cu = 1; }
        (void)hipGetLastError();
        grid = cus;
    }
    if (grid < 0) return;
    if (hipMemsetAsync((unsigned char*)d_ws + WS_BAR, 0, 256, stream) != hipSuccess) { fprintf(stderr, "kernel_launch: memset failed\n"); return; }
    Args a{};
    for (int i = 0; i < 34; ++i) a.in[i] = (const float*)d_in[i];
    a.out = (float*)d_out; a.ws = (unsigned char*)d_ws;
    void* args[] = {&a};
    hipError_t e = hipLaunchCooperativeKernel((const void*)fwd_kernel, dim3(grid), dim3(512), args, LDS_BYTES, stream);
    if (e != hipSuccess) fprintf(stderr, "cooperative launch failed: %s (grid %d)\n", hipGetErrorString(e), grid);
}
```

```cpp
#include <hip/hip_runtime.h>
#include <hip/hip_cooperative_groups.h>
#include <cstdio>
#include <cstdint>
namespace cg = cooperative_groups;
namespace pg8 {
#define PG8_LAS __attribute__((address_space(3)))
typedef unsigned short bf16_t;
typedef short bf16x8 __attribute__((ext_vector_type(8)));
typedef float f32x4 __attribute__((ext_vector_type(4)));
typedef unsigned u32x4 __attribute__((ext_vector_type(4)));
constexpr int BM = 256, BK = 64, HALF = 128, HTB = HALF * BK * 2  , STAGE_BYTES = 8 * HTB, NXCD = 8, WGM = 8;

__host__ __device__ __forceinline__ int lds_byte(int r, int c) { const int st = (r >> 4) * 2 + (c >> 5), rr = r & 15, cc = c & 31, ob = rr * 64 + cc * 2; return st * 1024 + (ob ^ (((ob >> 9) & 1) << 5)); }
__host__ __device__ __forceinline__ void stage_rc(int b, int& R, int& C) { const int st = b / 1024, sb = b % 1024, swz = sb ^ (((sb >> 9) & 1) << 5); R = (st >> 1) * 16 + swz / 64; C = (st & 1) * 32 + (swz % 64) / 2; }
__host__ __device__ __forceinline__ int perm32(int rho) { const int n = rho >> 4, i = rho & 15; return 8 * (i >> 2) + 4 * n + (i & 3); }

struct Unit { int pm, pn; };
struct Gemm { const bf16_t* A; const bf16_t* Bt; int M, N, K; };

struct StaticOrder {
    int nM, nN, nwg, G, c;
    __host__ __device__ void init(int M, int N, int G_, int c_) { nM = M / BM; nN = N / BM; nwg = nM * nN; G = G_; c = c_; }
    __host__ __device__ bool next(int i, Unit& u) const {
        const long L = (long)i * G + c; if (L >= nwg) return false;
        int wgid = (int)L; { const int q = nwg / NXCD, r = nwg % NXCD, xcd = wgid % NXCD, off = wgid / NXCD; wgid = (xcd < r ? xcd * (q + 1) : r * (q + 1) + (xcd - r) * q) + off; }
        const int nig = WGM * nN, gid = wgid / nig, fm = gid * WGM, gsz = (nM - fm) < WGM ? (nM - fm) : WGM;
        u.pm = fm + ((wgid % nig) % gsz); u.pn = (wgid % nig) / gsz; return true;
    }
    __device__ __forceinline__ void a_ready(const Unit&) const {}
    __device__ __forceinline__ void done(const Unit&) const {}
};

__device__ __forceinline__ unsigned cvt_pk_bf16(float lo, float hi) { unsigned r; asm volatile("v_cvt_pk_bf16_f32 %0, %1, %2" : "=v"(r) : "v"(lo), "v"(hi)); return r; }
template <class Epi, class Sched, bool ALIGN_EPI = false, bool SP2 = false>
__device__ __forceinline__ void gemm_phase(PG8_LAS unsigned char* lds, const Gemm g, const Sched& S, const Epi& E) {
    int tid = threadIdx.x; asm volatile("" : "+v"(tid)); const int wid = __builtin_amdgcn_readfirstlane(tid >> 6), lane = tid & 63, wr = wid >> 2, wc = wid & 3, fr = lane & 15, fq = lane >> 4;
    const int K = g.K, nt = K / BK;
    unsigned voffA[2], voffB[2];
#pragma unroll
    for (int i = 0; i < 2; ++i) { int R, C; stage_rc(tid * 16 + i * 8192, R, C); const int Rb = Epi::PERM ? ((R & ~31) + perm32(R & 31)) : R;
        voffA[i] = (unsigned)(R * K + C) * 2u; voffB[i] = (unsigned)(Rb * K + C) * 2u; }
    const size_t kstep = (size_t)(BK * 2);
    const size_t hstep = (size_t)HALF * K * 2;
    const size_t tstep = 2 * hstep;
    const unsigned ldsw = (unsigned)wid * 1024u;
    const int aoff = lds_byte(wr * 64 + fr, fq * 8), boff = lds_byte(wc * 32 + fr, fq * 8);
#define PG8_SA(b, h) (((b) * 2 + (h)) * HTB)
#define PG8_SB(b, h) ((4 + (b) * 2 + (h)) * HTB)
#define PG8_STAGE(bufoff, gbase, voff) do { _Pragma("unroll") for (int _i = 0; _i < 2; ++_i) \
        __builtin_amdgcn_global_load_lds((const unsigned*)((const char*)(gbase) + (voff)[_i]), (PG8_LAS unsigned*)(lds + (bufoff) + ldsw + _i * 8192), 16, 0, 0); } while (0)
#define PG8_LDA(dst, b, h) do { _Pragma("unroll") for (int m = 0; m < 4; ++m) _Pragma("unroll") for (int k = 0; k < 2; ++k) dst[m][k] = *(const PG8_LAS bf16x8*)(lds + PG8_SA(b, h) + aoff + m * 2048 + k * 1024); } while (0)
#define PG8_LDB(dst, b, h) do { _Pragma("unroll") for (int n = 0; n < 2; ++n) _Pragma("unroll") for (int k = 0; k < 2; ++k) dst[n][k] = *(const PG8_LAS bf16x8*)(lds + PG8_SB(b, h) + boff + n * 2048 + k * 1024); } while (0)
#define PG8_MMA(ai, bj, At, Bt) do { __builtin_amdgcn_s_setprio(1); _Pragma("unroll") for (int m = 0; m < 4; ++m) _Pragma("unroll") for (int n = 0; n < 2; ++n) _Pragma("unroll") for (int k = 0; k < 2; ++k) \
        acc[ai][bj][m][n] = __builtin_amdgcn_mfma_f32_16x16x32_bf16(Bt[n][k], At[m][k], acc[ai][bj][m][n], 0, 0, 0); __builtin_amdgcn_s_setprio(0); } while (0)
#define PG8_WAIT_V(n) asm volatile("s_waitcnt vmcnt(" #n ")" ::: "memory")
#define PG8_WAIT_L(n) asm volatile("s_waitcnt lgkmcnt(" #n ")" ::: "memory")
#define PG8_BAR __builtin_amdgcn_s_barrier()
#define PG8_SCHED __builtin_amdgcn_sched_barrier(0)
    Unit cur, nxt; int ui = 0;
    if (!S.next(0, cur)) return;
    f32x4 acc[2][2][4][2];
#pragma unroll
    for (int a = 0; a < 2; ++a)
#pragma unroll
        for (int b = 0; b < 2; ++b)
#pragma unroll
            for (int m = 0; m < 4; ++m)
#pragma unroll
                for (int n = 0; n < 2; ++n) acc[a][b][m][n] = (f32x4){0.f, 0.f, 0.f, 0.f};
    bf16x8 At[4][2], B0[2][2], B1[2][2];
    const char* cA = (const char*)g.A + (size_t)cur.pm * tstep; const char* cB = (const char*)g.Bt + (size_t)cur.pn * tstep;
    S.a_ready(cur);
    if constexpr (SP2) {
        PG8_STAGE(PG8_SB(0, 0), cB, voffB); PG8_STAGE(PG8_SB(0, 1), cB + hstep, voffB); PG8_STAGE(PG8_SA(0, 0), cA, voffA); PG8_STAGE(PG8_SA(0, 1), cA + hstep, voffA);
        if (wr == 1) PG8_BAR;
        PG8_WAIT_V(2); PG8_BAR;
        PG8_STAGE(PG8_SB(1, 0), cB + kstep, voffB); PG8_STAGE(PG8_SA(1, 0), cA + kstep, voffA); PG8_STAGE(PG8_SB(1, 1), cB + hstep + kstep, voffB);
        PG8_WAIT_V(6); PG8_BAR;
    } else {
        PG8_STAGE(PG8_SB(0, 0), cB, voffB); PG8_STAGE(PG8_SA(0, 0), cA, voffA); PG8_STAGE(PG8_SB(0, 1), cB + hstep, voffB); PG8_STAGE(PG8_SA(0, 1), cA + hstep, voffA);
        if (wr == 1) PG8_BAR;
        PG8_WAIT_V(4); PG8_BAR;
        PG8_STAGE(PG8_SB(1, 0), cB + kstep, voffB); PG8_STAGE(PG8_SA(1, 0), cA + kstep, voffA); PG8_STAGE(PG8_SB(1, 1), cB + hstep + kstep, voffB);
        PG8_WAIT_V(6); PG8_BAR;
    }
    for (;;) {
        const bool has_next = S.next(ui + 1, nxt);
        const char* nA = has_next ? (const char*)g.A + (size_t)nxt.pm * tstep : cA; const char* nB = has_next ? (const char*)g.Bt + (size_t)nxt.pn * tstep : cB;
        for (int t = 0; t < nt; t += 2) {
            const bool last = (t == nt - 2);
            const char* a1 = cA + (size_t)(t + 1) * kstep;
            const char* a2 = last ? nA : cA + (size_t)(t + 2) * kstep; const char* b2 = last ? nB : cB + (size_t)(t + 2) * kstep;
            const char* a3 = a2 + kstep; const char* b3 = b2 + kstep;
            if (last && has_next) S.a_ready(nxt);
            if constexpr (SP2) {
            PG8_LDB(B0, 0, 0); PG8_LDB(B1, 0, 1); PG8_SCHED; PG8_LDA(At, 0, 0); PG8_STAGE(PG8_SA(1, 1), a1 + hstep, voffA);
            PG8_WAIT_V(8); PG8_WAIT_L(0); PG8_BAR; PG8_MMA(0, 0, At, B0); PG8_MMA(0, 1, At, B1); PG8_BAR; PG8_SCHED;
            PG8_LDA(At, 0, 1); PG8_STAGE(PG8_SB(0, 0), b2, voffB); PG8_STAGE(PG8_SB(0, 1), b2 + hstep, voffB); PG8_STAGE(PG8_SA(0, 0), a2, voffA);
            PG8_WAIT_V(8); PG8_WAIT_L(0); PG8_BAR; PG8_MMA(1, 0, At, B0); PG8_MMA(1, 1, At, B1); PG8_BAR; PG8_SCHED;
            PG8_LDB(B0, 1, 0); PG8_LDB(B1, 1, 1); PG8_SCHED; PG8_LDA(At, 1, 0); PG8_STAGE(PG8_SA(0, 1), a2 + hstep, voffA);
            PG8_WAIT_V(8); PG8_WAIT_L(0); PG8_BAR; PG8_MMA(0, 0, At, B0); PG8_MMA(0, 1, At, B1); PG8_BAR; PG8_SCHED;
            PG8_LDA(At, 1, 1); PG8_STAGE(PG8_SB(1, 0), b3, voffB); PG8_STAGE(PG8_SB(1, 1), b3 + hstep, voffB); PG8_STAGE(PG8_SA(1, 0), a3, voffA);
            PG8_WAIT_V(8); PG8_WAIT_L(0); PG8_BAR; PG8_MMA(1, 0, At, B0); PG8_MMA(1, 1, At, B1); PG8_BAR; PG8_SCHED;
            } else {
            PG8_LDB(B0, 0, 0); PG8_SCHED; PG8_LDA(At, 0, 0); PG8_STAGE(PG8_SA(1, 1), a1 + hstep, voffA);
            PG8_WAIT_L(8); PG8_BAR; PG8_WAIT_L(0); PG8_MMA(0, 0, At, B0); PG8_BAR; PG8_SCHED;
            PG8_LDB(B1, 0, 1); PG8_STAGE(PG8_SB(0, 0), b2, voffB);
            PG8_BAR; PG8_WAIT_L(0); PG8_MMA(0, 1, At, B1); PG8_BAR;
            PG8_LDA(At, 0, 1); PG8_STAGE(PG8_SA(0, 0), a2, voffA);
            PG8_BAR; PG8_WAIT_L(0); PG8_MMA(1, 0, At, B0); PG8_BAR; PG8_SCHED;
            PG8_STAGE(PG8_SB(0, 1), b2 + hstep, voffB);
            PG8_WAIT_V(6); PG8_BAR; PG8_MMA(1, 1, At, B1); PG8_BAR;
            PG8_LDB(B0, 1, 0); PG8_SCHED; PG8_LDA(At, 1, 0); PG8_STAGE(PG8_SA(0, 1), a2 + hstep, voffA);
            PG8_WAIT_L(8); PG8_BAR; PG8_WAIT_L(0); PG8_MMA(0, 0, At, B0); PG8_BAR; PG8_SCHED;
            PG8_LDB(B1, 1, 1); PG8_STAGE(PG8_SB(1, 0), b3, voffB);
            PG8_BAR; PG8_WAIT_L(0); PG8_MMA(0, 1, At, B1); PG8_BAR;
            PG8_LDA(At, 1, 1); PG8_STAGE(PG8_SA(1, 0), a3, voffA);
            PG8_BAR; PG8_WAIT_L(0); PG8_MMA(1, 0, At, B0); PG8_BAR; PG8_SCHED;
            PG8_STAGE(PG8_SB(1, 1), b3 + hstep, voffB);
            PG8_WAIT_V(6); PG8_BAR; PG8_MMA(1, 1, At, B1); PG8_BAR;
            }
        }
        if constexpr (ALIGN_EPI) { if (wr == 0) PG8_BAR; }
        if constexpr (!Epi::AFTER_DRAIN) { E(acc, cur, wr, wc, fr, fq); S.done(cur); }
        if (!has_next) break;
#pragma unroll
        for (int a = 0; a < 2; ++a)
#pragma unroll
            for (int b = 0; b < 2; ++b)
#pragma unroll
                for (int m = 0; m < 4; ++m)
#pragma unroll
                    for (int n = 0; n < 2; ++n) acc[a][b][m][n] = (f32x4){0.f, 0.f, 0.f, 0.f};
        cur = nxt; cA = nA; cB = nB; ++ui;
        if constexpr (ALIGN_EPI) { if (wr == 1) PG8_BAR; }
    }
    PG8_WAIT_V(0);
    if constexpr (!ALIGN_EPI) { if (wr == 0) PG8_BAR; }
    PG8_BAR;
    if constexpr (Epi::AFTER_DRAIN) { E.fused(acc, cur, wr, wc, fr, fq, lds, wid, lane); S.done(cur); }
#undef PG8_SA
#undef PG8_SB
#undef PG8_STAGE
#undef PG8_LDA
#undef PG8_LDB
#undef PG8_MMA
#undef PG8_WAIT_V
#undef PG8_WAIT_L
#undef PG8_BAR
#undef PG8_SCHED
}
}

#define LAS __attribute__((address_space(3)))
typedef unsigned short bf16;
typedef short bf16x8 __attribute__((ext_vector_type(8)));
typedef short s16x4 __attribute__((ext_vector_type(4)));
typedef float f32x2 __attribute__((ext_vector_type(2)));
typedef float f32x4 __attribute__((ext_vector_type(4)));
typedef float f32x16 __attribute__((ext_vector_type(16)));
typedef unsigned u32x2 __attribute__((ext_vector_type(2)));
typedef unsigned u32x4 __attribute__((ext_vector_type(4)));
typedef __bf16 bf16x2_t __attribute__((ext_vector_type(2)));

constexpr int M_ = 65536, SEQ = 2048, DMODEL = 1024, DFF = 2816;
constexpr float EPS = 1e-6f, LOG2E = 1.4426950408889634f;
constexpr size_t MiB = 1u << 20;
constexpr size_t WS_BIAS = 0;
constexpr size_t WS_ROPE = 256 * 1024;
constexpr size_t WS_RSS = 1 * MiB;
constexpr size_t WS_SSQ = 3 * MiB;
constexpr size_t WS_SSKV = 3 * MiB + 256 * 1024;
constexpr size_t W_AIN = 4 * MiB, W_AOUT = 13 * MiB, W_BIN = 14 * MiB, W_BQUP = 16 * MiB, W_BKVUP = 18 * MiB, W_BOUT = 19 * MiB,
                 W_CIN = 21 * MiB, W_COUT = 27 * MiB, W_DIN = 29 * MiB, W_DOUT = 32 * MiB, W_FG = 34 * MiB, W_FU = 58 * MiB, W_FD = 82 * MiB, W_FSTR = 6 * MiB;
constexpr size_t WS_XB = 106 * MiB;
constexpr size_t WS_R = 234 * MiB;
constexpr size_t R_A_QKV = WS_R, R_A_O3 = WS_R + 576 * MiB, R_A_LSE = WS_R + 768 * MiB, R_A_OC = WS_R;
constexpr size_t R_B_CQ = WS_R, R_B_CKV = WS_R + 48 * MiB, R_B_KPE = WS_R + 80 * MiB, R_B_Q = WS_R + 128 * MiB, R_B_KV = WS_R + 320 * MiB, R_B_KH = WS_R + 576 * MiB, R_B_O = WS_R;
constexpr size_t R_C_QKV = WS_R, R_C_O = WS_R + 384 * MiB;
constexpr size_t R_D_QKV = WS_R, R_D_O = WS_R + 160 * MiB;
constexpr size_t R_GATE = WS_R, R_ACT = WS_R + 352 * MiB;
constexpr size_t WS_RSSP = WS_R + 774 * MiB;
constexpr size_t WS_SSQP = WS_R + 782 * MiB;
constexpr size_t WS_SSKVP = WS_R + 784 * MiB;
constexpr size_t WS_SSPE = 3 * MiB + 512 * 1024;
constexpr size_t R_B_RK = WS_R + 96 * MiB;
constexpr size_t WS_BAR = 512 * 1024;
constexpr size_t WS_NEED = WS_R + 786 * MiB;

constexpr int LDS_BYTES = 135168;

struct Args { const float* in[34]; float* out; unsigned char* ws; };

__device__ __forceinline__ unsigned pk2(float lo, float hi) { f32x2 v = {lo, hi}; bf16x2_t b = __builtin_convertvector(v, bf16x2_t); return __builtin_bit_cast(unsigned, b); }
__device__ __forceinline__ float bf2f(unsigned short h) { return __uint_as_float(((unsigned)h) << 16); }
__device__ __forceinline__ float bflo(unsigned w) { return __uint_as_float(w << 16); }
__device__ __forceinline__ float bfhi(unsigned w) { return __uint_as_float(w & 0xffff0000u); }
__device__ __forceinline__ float wave_sum(float v) {
#pragma unroll
    for (int o = 1; o < 64; o <<= 1) v += __shfl_xor(v, o);
    return v;
}
__device__ __forceinline__ float dot4(f32x4 a) { return (a[0] * a[0] + a[1] * a[1]) + (a[2] * a[2] + a[3] * a[3]); }
__device__ __forceinline__ float rowss_sum(const float* ss, int nvec, int row) {
    const f32x4* p = (const f32x4*)(ss + (size_t)row * 4 * nvec); float t = 0.f;
#pragma unroll
    for (int v = 0; v < 4; ++v) if (v < nvec) { const f32x4 q = p[v]; t += (q[0] + q[1]) + (q[2] + q[3]); }
    return t;
}

struct EpiProj {
    static constexpr bool PERM = true, AFTER_DRAIN = false;
    bf16* O; int ldc; const float* rs; int hm; const float* gq; const float* gk; float qscale;
    __device__ __forceinline__ void operator()(const f32x4 (&acc)[2][2][4][2], const pg8::Unit& u, int wr, int wc, int fr, int fq) const {
        const int hg = u.pn * 4 + wc;
        int kind = 2; const float* gain = gq;
        if (hm == 1) { const int t = (hg >> 3) % 3, gi = hg / 24; kind = t; gain = (t == 0 ? gq : gk) + gi * 64; }
        else if (hm == 2) { kind = hg < 16 ? 0 : (hg < 32 ? 1 : 2); gain = kind == 0 ? gq : gk; }
        else if (hm == 3) { kind = hg < 16 ? 0 : (hg < 18 ? 1 : 2); gain = kind == 0 ? gq : gk; }
        else if (hm == 4) { kind = (hg & 1) ? 2 : 3; gain = gk; }
        f32x4 gv[2][2];
#pragma unroll
        for (int bj = 0; bj < 2; ++bj)
#pragma unroll
            for (int n = 0; n < 2; ++n) {
                gv[bj][n] = (f32x4){1.f, 1.f, 1.f, 1.f};
                if (kind != 2) { gv[bj][n] = *(const f32x4*)(gain + 32 * bj + 8 * fq + 4 * n); if (kind == 0) gv[bj][n] = gv[bj][n] * qscale; }
            }
        bf16* colp = O + hg * 64 + 8 * fq;
        float rsv[2][4];
#pragma unroll
        for (int ai = 0; ai < 2; ++ai)
#pragma unroll
            for (int m = 0; m < 4; ++m) rsv[ai][m] = rs[u.pm * 256 + ai * 128 + wr * 64 + m * 16 + fr];
        if (kind == 3) {
#pragma unroll
            for (int ai = 0; ai < 2; ++ai)
#pragma unroll
                for (int m = 0; m < 4; ++m) {
                    const int row = u.pm * 256 + ai * 128 + wr * 64 + m * 16 + fr;
                    const float rstd = rsv[ai][m];
                    f32x4 v[2][2]; float s = 0.f;
#pragma unroll
                    for (int bj = 0; bj < 2; ++bj)
#pragma unroll
                        for (int n = 0; n < 2; ++n) { v[bj][n] = acc[ai][bj][m][n] * rstd; s += dot4(v[bj][n]); }
                    s += __shfl_xor(s, 16); s += __shfl_xor(s, 32);
                    const float rk_ = rsqrtf((s + ((const float*)((const unsigned char*)rs + (WS_SSPE - WS_SSKV)))[row]) * (1.0f / 96.0f) + EPS);
                    bf16* kp = (bf16*)((unsigned char*)O + (R_B_KH - R_B_KV)) + (size_t)row * 1536 + (hg >> 1) * 96 + 8 * fq;
#pragma unroll
                    for (int bj = 0; bj < 2; ++bj) {
                        const f32x4 a_ = v[bj][0] * rk_ * gv[bj][0], b_ = v[bj][1] * rk_ * gv[bj][1];
                        u32x4 w; w.x = pk2(a_[0], a_[1]); w.y = pk2(a_[2], a_[3]); w.z = pk2(b_[0], b_[1]); w.w = pk2(b_[2], b_[3]);
                        *(u32x4*)(kp + 32 * bj) = w;
                    }
                    const u32x4 r_ = *(const u32x4*)((const bf16*)((const unsigned char*)O - (R_B_KV - R_B_RK)) + (size_t)row * 32 + 8 * fq);
                    u32x4 w;
#pragma unroll
                    for (int j = 0; j < 4; ++j) w[j] = pk2(bflo(r_[j]) * rk_, bfhi(r_[j]) * rk_);
                    *(u32x4*)(kp + 64) = w;
                }
            return;
        }
#pragma unroll
        for (int ai = 0; ai < 2; ++ai)
#pragma unroll
            for (int m = 0; m < 4; ++m) {
                const int row = u.pm * 256 + ai * 128 + wr * 64 + m * 16 + fr;
                const float rstd = rsv[ai][m];
                f32x4 v[2][2]; float s = 0.f;
#pragma unroll
                for (int bj = 0; bj < 2; ++bj)
#pragma unroll
                    for (int n = 0; n < 2; ++n) { v[bj][n] = acc[ai][bj][m][n] * rstd; s += dot4(v[bj][n]); }
                if (kind < 2) {
                    s += __shfl_xor(s, 16); s += __shfl_xor(s, 32);
                    const float rs = rsqrtf(s * (1.0f / 64.0f) + EPS);
#pragma unroll
                    for (int bj = 0; bj < 2; ++bj)
#pragma unroll
                        for (int n = 0; n < 2; ++n) v[bj][n] = v[bj][n] * rs * gv[bj][n];
                }
#pragma unroll
                for (int bj = 0; bj < 2; ++bj) {
                    u32x4 w; w.x = pk2(v[bj][0][0], v[bj][0][1]); w.y = pk2(v[bj][0][2], v[bj][0][3]); w.z = pk2(v[bj][1][0], v[bj][1][1]); w.w = pk2(v[bj][1][2], v[bj][1][3]);
                    *(u32x4*)(colp + (size_t)row * ldc + 32 * bj) = w;
                }
            }
    }
};
struct EpiLat {
    static constexpr bool PERM = true, AFTER_DRAIN = false;
    bf16* CQ; bf16* CKV; bf16* KPE; const float* rs; float* ssq; float* sskv;
    __device__ __forceinline__ void operator()(const f32x4 (&acc)[2][2][4][2], const pg8::Unit& u, int wr, int wc, int fr, int fq) const {
        const int hg = u.pn * 4 + wc;
        if (hg > 10) return;
        bf16* dst; int ld; float* sacc = nullptr; int sst = 0;
        if (hg < 6) { dst = CQ + hg * 64; ld = 384; sacc = ssq + hg; sst = 8; } else if (hg < 10) { dst = CKV + (hg - 6) * 64; ld = 256; sacc = sskv + (hg - 6); sst = 4; } else { dst = KPE; ld = 64; }
        dst += 8 * fq;
        float rsv[2][4];
#pragma unroll
        for (int ai = 0; ai < 2; ++ai)
#pragma unroll
            for (int m = 0; m < 4; ++m) rsv[ai][m] = rs[u.pm * 256 + ai * 128 + wr * 64 + m * 16 + fr];
#pragma unroll
        for (int ai = 0; ai < 2; ++ai)
#pragma unroll
            for (int m = 0; m < 4; ++m) {
                const int row = u.pm * 256 + ai * 128 + wr * 64 + m * 16 + fr;
                const float rstd = rsv[ai][m];
                f32x4 v[2][2]; float s = 0.f;
#pragma unroll
                for (int bj = 0; bj < 2; ++bj)
#pragma unroll
                    for (int n = 0; n < 2; ++n) { v[bj][n] = acc[ai][bj][m][n] * rstd; s += dot4(v[bj][n]); }
                s += __shfl_xor(s, 16); s += __shfl_xor(s, 32);
                if (fq == 0) { if (sacc != nullptr) sacc[(size_t)row * sst] = s; else { float z_ = 0.f; asm volatile("" : "+v"(z_)); ssq[(size_t)row * 8 + 6] = z_; ssq[(size_t)row * 8 + 7] = z_; } }
#pragma unroll
                for (int bj = 0; bj < 2; ++bj) {
                    u32x4 w; w.x = pk2(v[bj][0][0], v[bj][0][1]); w.y = pk2(v[bj][0][2], v[bj][0][3]); w.z = pk2(v[bj][1][0], v[bj][1][1]); w.w = pk2(v[bj][1][2], v[bj][1][3]);
                    *(u32x4*)(dst + (size_t)row * ld + 32 * bj) = w;
                }
            }
    }
};
struct EpiRes {
    static constexpr bool PERM = true, AFTER_DRAIN = false;
    const float* base32; float* out32; bf16* xb; bf16* xbw; float* ssn;
    __device__ __forceinline__ void operator()(const f32x4 (&acc)[2][2][4][2], const pg8::Unit& u, int wr, int wc, int fr_, int fq_) const {
        int fr = fr_, fq = fq_; asm volatile("" : "+v"(fr), "+v"(fq));
        float* ssn_ = ssn; bf16* xbw_ = xbw; float* out_ = out32; const float* b32_ = base32; asm volatile("" : "+s"(ssn_), "+s"(xbw_), "+s"(out_), "+s"(b32_));
        const int col0 = u.pn * 256 + wc * 32 + 8 * fq;
#pragma unroll
        for (int ai = 0; ai < 2; ++ai) {
            f32x4 bv[4][2][2];
            if (b32_ != nullptr) {
#pragma unroll
                for (int m = 0; m < 4; ++m)
#pragma unroll
                    for (int bj = 0; bj < 2; ++bj)
#pragma unroll
                        for (int n = 0; n < 2; ++n) bv[m][bj][n] = *(const f32x4*)(b32_ + (size_t)(u.pm * 256 + ai * 128 + wr * 64 + m * 16 + fr) * DMODEL + col0 + bj * 128 + n * 4);
            } else {
                u32x4 rw[4][2];
#pragma unroll
                for (int m = 0; m < 4; ++m)
#pragma unroll
                    for (int bj = 0; bj < 2; ++bj) rw[m][bj] = *(const u32x4*)(xb + (size_t)(u.pm * 256 + ai * 128 + wr * 64 + m * 16 + fr) * DMODEL + col0 + bj * 128);
#pragma unroll
                for (int m = 0; m < 4; ++m)
#pragma unroll
                    for (int bj = 0; bj < 2; ++bj) {
                        bv[m][bj][0] = (f32x4){bflo(rw[m][bj].x), bfhi(rw[m][bj].x), bflo(rw[m][bj].y), bfhi(rw[m][bj].y)};
                        bv[m][bj][1] = (f32x4){bflo(rw[m][bj].z), bfhi(rw[m][bj].z), bflo(rw[m][bj].w), bfhi(rw[m][bj].w)};
                    }
            }
            asm volatile("" ::: "memory");
#pragma unroll
            for (int m = 0; m < 4; ++m) {
                const int row = u.pm * 256 + ai * 128 + wr * 64 + m * 16 + fr;
                float s = 0.f;
#pragma unroll
                for (int bj = 0; bj < 2; ++bj) {
                    const size_t off = (size_t)row * DMODEL + col0 + bj * 128;
                    const f32x4 o0 = bv[m][bj][0] + acc[ai][bj][m][0], o1 = bv[m][bj][1] + acc[ai][bj][m][1];
                    if (out_ != nullptr) { *(f32x4*)(out_ + off) = o0; *(f32x4*)(out_ + off + 4) = o1; }
                    if (xbw_ != nullptr) { u32x4 w; w.x = pk2(o0[0], o0[1]); w.y = pk2(o0[2], o0[3]); w.z = pk2(o1[0], o1[1]); w.w = pk2(o1[2], o1[3]); *(u32x4*)(xbw_ + off) = w; }
                    s += dot4(o0) + dot4(o1);
                }
                if (ssn_ != nullptr) { s += __shfl_xor(s, 16); s += __shfl_xor(s, 32); if (fq == 0) ssn_[(size_t)row * 16 + u.pn * 4 + wc] = s; }
            }
            asm volatile("" ::: "memory");
        }
    }
};
__device__ __forceinline__ u32x4 shfl4(u32x4 v, int src) { u32x4 r; r.x = __shfl(v.x, src, 16); r.y = __shfl(v.y, src, 16); r.z = __shfl(v.z, src, 16); r.w = __shfl(v.w, src, 16); return r; }
struct EpiGateUp {
    static constexpr bool PERM = true, AFTER_DRAIN = false;
    bf16* act; bf16* gedge; bf16* uedge; const float* rs; const float* cw; const float* cb;
    __device__ __forceinline__ void operator()(const f32x4 (&acc)[2][2][4][2], const pg8::Unit& u, int wr, int wc, int fr_, int fq_) const {
        int fr = fr_, fq = fq_; asm volatile("" : "+v"(fr), "+v"(fq));
        const int c0 = u.pn * 128 + wc * 32 + 8 * fq;
        f32x4 w0[2], w1[2], w2[2], b[2];
#pragma unroll
        for (int n = 0; n < 2; ++n) { w0[n] = *(const f32x4*)(cw + c0 + 4 * n); w1[n] = *(const f32x4*)(cw + DFF + c0 + 4 * n); w2[n] = *(const f32x4*)(cw + 2 * DFF + c0 + 4 * n); b[n] = *(const f32x4*)(cb + c0 + 4 * n); }
#pragma unroll
        for (int ai = 0; ai < 2; ++ai) {
            u32x4 g[4]; float rstd[4];
            const int strip = u.pm * 4 + ai * 2 + wr;
#pragma unroll
            for (int m = 0; m < 4; ++m) rstd[m] = rs[u.pm * 256 + ai * 128 + wr * 64 + m * 16 + fr];
#pragma unroll
            for (int m = 0; m < 4; ++m) {
                const f32x4 ga = acc[ai][0][m][0] * rstd[m], gb = acc[ai][0][m][1] * rstd[m];
                g[m].x = pk2(ga[0], ga[1]); g[m].y = pk2(ga[2], ga[3]); g[m].z = pk2(gb[0], gb[1]); g[m].w = pk2(gb[2], gb[3]);
            }
#pragma unroll
            for (int m = 0; m < 4; ++m) {
                const int row = u.pm * 256 + ai * 128 + wr * 64 + m * 16 + fr;
                const u32x4 g0 = g[m];
                u32x4 g1, g2;
#pragma unroll
                for (int d = 0; d < 4; ++d) {
                    unsigned o1_ = 0u, o2_ = 0u;
                    if (m > 0) { o1_ = __builtin_amdgcn_update_dpp(0u, g[m - 1][d], 0x121, 0xf, 0xf, false); o2_ = __builtin_amdgcn_update_dpp(0u, g[m - 1][d], 0x122, 0xf, 0xf, false); }
                    g1[d] = __builtin_amdgcn_update_dpp(o1_, g0[d], 0x111, 0xf, 0xf, false);
                    g2[d] = __builtin_amdgcn_update_dpp(o2_, g0[d], 0x112, 0xf, 0xf, false);
                }
                u32x4 w, uw;
#pragma unroll
                for (int n = 0; n < 2; ++n) {
                    float r[4], up[4];
#pragma unroll
                    for (int j = 0; j < 4; ++j) {
                        const unsigned q0 = g0[2 * n + (j >> 1)], q1 = g1[2 * n + (j >> 1)], q2 = g2[2 * n + (j >> 1)];
                        const float x0 = (j & 1) ? bfhi(q0) : bflo(q0), x1 = (j & 1) ? bfhi(q1) : bflo(q1), x2 = (j & 1) ? bfhi(q2) : bflo(q2);
                        const float cv = b[n][j] + w2[n][j] * x0 + w1[n][j] * x1 + w0[n][j] * x2;
                        const float sg = cv * __builtin_amdgcn_rcpf(1.0f + __builtin_amdgcn_exp2f(-LOG2E * cv));
                        up[j] = acc[ai][1][m][n][j] * rstd[m];
                        r[j] = sg * up[j];
                    }
                    w[2 * n] = pk2(r[0], r[1]); w[2 * n + 1] = pk2(r[2], r[3]);
                    uw[2 * n] = pk2(up[0], up[1]); uw[2 * n + 1] = pk2(up[2], up[3]);
                }
                if (m == 0) {
                    if (fr < 2) { *(u32x4*)(gedge + ((size_t)strip * 4 + fr) * DFF + c0) = g0; *(u32x4*)(uedge + ((size_t)strip * 2 + fr) * DFF + c0) = uw; }
                    else *(u32x4*)(act + (size_t)row * DFF + c0) = w;
                } else {
                    *(u32x4*)(act + (size_t)row * DFF + c0) = w;
                    if (m == 3 && fr >= 14) *(u32x4*)(gedge + ((size_t)strip * 4 + 2 + (fr - 14)) * DFF + c0) = g0;
                }
                asm volatile("" ::: "memory");
            }
        }
    }
};

__device__ __forceinline__ int crow(int r, int hi) { return (r & 3) + 8 * (r >> 2) + 4 * hi; }
struct TileGeo { int NT, TPS, ks0, res0, dil; };
template <int DQK, int DV, int KT> struct AttL {
    static constexpr int KSTR = DQK * 2 + 16, VSTR = DV * 2 + 64, KBUF = KT * KSTR, VBUF = KT * VSTR;
    static constexpr int OFF_K = 0, OFF_V = 2 * KBUF, OFF_TAB = OFF_V + 2 * VBUF;
};
template <int DQK, int DV, bool BIAS, int TABN, bool QRELOAD, int KT>
__device__ __forceinline__ void attn_pass(int qoff_, LAS unsigned char* lds, const bf16* Kb, int kpitch, const bf16* Vb, int vpitch, const TileGeo G, int my_tlo, int my_thi,
                                          int wslot_q0, int W, const bf16x8 (&qf_)[DQK / 16], float& m_, float& l_, f32x16 (&o)[DV / 32]) {
    typedef AttL<DQK, DV, KT> L;
    int tid = threadIdx.x; asm volatile("" : "+v"(tid)); const int lane = tid & 63, r32 = lane & 31, hi = lane >> 5;
    constexpr int SUB = KT / 64;
    constexpr int KCH = DQK / 8, VCH = DV / 8, NKC = KT * KCH, NVC = KT * VCH, NKL = (NKC + 511) / 512, NVL = (NVC + 511) / 512;
    u32x4 kr[NKL], vr[NVL];
    const LAS float* tab = (const LAS float*)(lds + L::OFF_TAB);
    const int slot_q = wslot_q0 + r32;
    const int vlane = (4 * hi + ((lane & 15) >> 2)) * L::VSTR + (16 * ((lane >> 4) & 1) + 4 * (lane & 3)) * 2;
#define ATT_LOAD(t) do { const int seg_ = ((t) * SUB) / G.TPS, tis_ = (t) * SUB - seg_ * G.TPS; const int tok0_ = G.res0 + seg_ + G.dil * (G.ks0 + 64 * tis_); \
        _Pragma("unroll") for (int i_ = 0; i_ < NKL; ++i_) { const int c_ = tid + 512 * i_; if ((NKC % 512 == 0) || c_ < NKC) { const int j_ = c_ / KCH, p_ = c_ - j_ * KCH; \
            kr[i_] = *(const u32x4*)(Kb + (size_t)(tok0_ + G.dil * j_) * kpitch + p_ * 8); } } \
        _Pragma("unroll") for (int i_ = 0; i_ < NVL; ++i_) { const int c_ = tid + 512 * i_; if ((NVC % 512 == 0) || c_ < NVC) { const int j_ = c_ / VCH, p_ = c_ - j_ * VCH; \
            vr[i_] = *(const u32x4*)(Vb + (size_t)(tok0_ + G.dil * j_) * vpitch + p_ * 8); } } } while (0)
#define ATT_STORE(buf) do { \
        _Pragma("unroll") for (int i_ = 0; i_ < NKL; ++i_) { const int c_ = tid + 512 * i_; if ((NKC % 512 == 0) || c_ < NKC) { const int j_ = c_ / KCH, p_ = c_ - j_ * KCH; \
            *(LAS u32x4*)(lds + L::OFF_K + (buf) * L::KBUF + j_ * L::KSTR + p_ * 16) = kr[i_]; } } \
        _Pragma("unroll") for (int i_ = 0; i_ < NVL; ++i_) { const int c_ = tid + 512 * i_; if ((NVC % 512 == 0) || c_ < NVC) { const int j_ = c_ / VCH, p_ = c_ - j_ * VCH; \
            *(LAS u32x4*)(lds + L::OFF_V + (buf) * L::VBUF + j_ * L::VSTR + p_ * 16) = vr[i_]; } } } while (0)
    ATT_LOAD(0);
    ATT_STORE(0);
    float m = m_, l = l_;
    const int NT2 = G.NT / SUB;
    for (int t = 0; t < NT2; ++t) {
        const int buf = t & 1;
        if (t + 1 < NT2) ATT_LOAD(t + 1);
        __syncthreads();
#pragma unroll
        for (int hf = 0; hf < SUB; ++hf) {
        const int st = t * SUB + hf;
        if (st >= my_tlo && st <= my_thi) {
            const int tis = st % G.TPS, slot0 = G.ks0 + 64 * tis;
            const LAS unsigned char* Kt = lds + L::OFF_K + buf * L::KBUF + (hf * 64 + r32) * L::KSTR + hi * 16;
            f32x16 s[2];
            const int dsb = slot_q - slot0 - 4 * hi;
            bf16x8 qf[DQK / 16];
            if (QRELOAD) {
#pragma unroll
                for (int ks = 0; ks < DQK / 16; ++ks) qf[ks] = *(const LAS bf16x8*)(lds + qoff_ + ks * 32); }
            else {
#pragma unroll
                for (int ks = 0; ks < DQK / 16; ++ks) qf[ks] = qf_[ks]; }
#pragma unroll
            for (int kb = 0; kb < 2; ++kb) {
#pragma unroll
                for (int r = 0; r < 16; ++r) s[kb][r] = BIAS ? tab[dsb + 128 - (32 * kb + (r & 3) + 8 * (r >> 2))] : 0.f;
            }
            if (DV == 64) {
                bf16x8 kf[2][DQK / 16];
#pragma unroll
                for (int kb = 0; kb < 2; ++kb)
#pragma unroll
                    for (int ks = 0; ks < DQK / 16; ++ks) kf[kb][ks] = *(const LAS bf16x8*)(Kt + kb * 32 * L::KSTR + ks * 32);
                asm volatile("" ::: "memory");
#pragma unroll
                for (int ks = 0; ks < DQK / 16; ++ks)
#pragma unroll
                    for (int kb = 0; kb < 2; ++kb) s[kb] = __builtin_amdgcn_mfma_f32_32x32x16_bf16(kf[kb][ks], qf[ks], s[kb], 0, 0, 0);
            } else {
#pragma unroll
                for (int kh = 0; kh < 2; ++kh) {
                    bf16x8 kf[2][DQK / 32];
#pragma unroll
                    for (int kb = 0; kb < 2; ++kb)
#pragma unroll
                        for (int k2 = 0; k2 < DQK / 32; ++k2) kf[kb][k2] = *(const LAS bf16x8*)(Kt + kb * 32 * L::KSTR + (kh * (DQK / 32) + k2) * 32);
                    asm volatile("" ::: "memory");
#pragma unroll
                    for (int k2 = 0; k2 < DQK / 32; ++k2)
#pragma unroll
                        for (int kb = 0; kb < 2; ++kb) s[kb] = __builtin_amdgcn_mfma_f32_32x32x16_bf16(kf[kb][k2], qf[kh * (DQK / 32) + k2], s[kb], 0, 0, 0);
                }
            }
            const bool full = (wslot_q0 - slot0 - 63 >= 0) && (wslot_q0 + 31 - slot0 <= W);
            if (!full && !BIAS) {
#pragma unroll
                for (int kb = 0; kb < 2; ++kb)
#pragma unroll
                    for (int r = 0; r < 16; ++r) {
                        const int ds = dsb - (32 * kb + (r & 3) + 8 * (r >> 2));
                        s[kb][r] = ((unsigned)ds <= (unsigned)W) ? s[kb][r] : -INFINITY;
                    }
            }
            float mx = s[0][0];
#pragma unroll
            for (int r = 1; r < 16; ++r) mx = fmaxf(mx, s[0][r]);
#pragma unroll
            for (int r = 0; r < 16; ++r) mx = fmaxf(mx, s[1][r]);
            mx = fmaxf(mx, __shfl_xor(mx, 32));
            const float mn = fmaxf(m, mx);
            const float base = (mn == -INFINITY) ? 0.f : mn;
            const float alpha = __builtin_amdgcn_exp2f(m - base);
            m = mn;
            float ps = 0.f;
#pragma unroll
            for (int kb = 0; kb < 2; ++kb)
#pragma unroll
                for (int r = 0; r < 16; ++r) { const float p = __builtin_amdgcn_exp2f(s[kb][r] - base); s[kb][r] = p; ps += p; }
            l = l * alpha + ps;
            if (__any(alpha != 1.0f)) {
#pragma unroll
                for (int c = 0; c < DV / 32; ++c)
#pragma unroll
                    for (int r = 0; r < 16; ++r) o[c][r] *= alpha;
            }
            const LAS unsigned char* Vt = lds + L::OFF_V + buf * L::VBUF + hf * 64 * L::VSTR + vlane;
#pragma unroll
            for (int kb = 0; kb < 2; ++kb) {
                bf16x8 pb[2];
#pragma unroll
                for (int k2 = 0; k2 < 2; ++k2) {
                    u32x4 pw; pw.x = pk2(s[kb][8 * k2 + 0], s[kb][8 * k2 + 1]); pw.y = pk2(s[kb][8 * k2 + 2], s[kb][8 * k2 + 3]);
                    pw.z = pk2(s[kb][8 * k2 + 4], s[kb][8 * k2 + 5]); pw.w = pk2(s[kb][8 * k2 + 6], s[kb][8 * k2 + 7]);
                    pb[k2] = __builtin_bit_cast(bf16x8, pw);
                }
#pragma unroll
                for (int ch = 0; ch < DV / 64; ++ch) {
                    bf16x8 vf[2][2];
#pragma unroll
                    for (int k2 = 0; k2 < 2; ++k2)
#pragma unroll
                        for (int c2 = 0; c2 < 2; ++c2) {
                            const LAS unsigned char* vp = Vt + (32 * kb + 16 * k2) * L::VSTR + 64 * (2 * ch + c2);
                            const s16x4 lo = __builtin_bit_cast(s16x4, __builtin_amdgcn_ds_read_tr16_b64_v4i16((LAS s16x4*)(vp)));
                            const s16x4 hh = __builtin_bit_cast(s16x4, __builtin_amdgcn_ds_read_tr16_b64_v4i16((LAS s16x4*)(vp + 8 * L::VSTR)));
                            vf[k2][c2] = (bf16x8){lo[0], lo[1], lo[2], lo[3], hh[0], hh[1], hh[2], hh[3]};
                        }
                    asm volatile("" ::: "memory");
#pragma unroll
                    for (int k2 = 0; k2 < 2; ++k2)
#pragma unroll
                        for (int c2 = 0; c2 < 2; ++c2) o[2 * ch + c2] = __builtin_amdgcn_mfma_f32_32x32x16_bf16(vf[k2][c2], pb[k2], o[2 * ch + c2], 0, 0, 0);
                }
            }
        }
        }
        if (t + 1 < NT2) ATT_STORE(buf ^ 1);
    }
    __syncthreads();
    m_ = m; l_ = l;
#undef ATT_LOAD
#undef ATT_STORE
}

template <int MODE>
__device__ __forceinline__ void attn_phase(LAS unsigned char* lds, const Args& a, int Gn, int cid) {
    constexpr int DQK = MODE == 1 ? 96 : 64, DV = MODE == 2 ? 128 : 64;
    constexpr bool BIAS = MODE != 1;
    constexpr int TABN = MODE == 2 ? 2048 + 256 : 512;
    constexpr int NU = MODE == 0 ? 6144 : (MODE == 2 ? 2048 : 4096);
    constexpr int KT = MODE == 2 ? 64 : 128;
    typedef AttL<DQK, DV, KT> L;
    int tid = threadIdx.x; asm volatile("" : "+v"(tid)); const int lane = tid & 63, r32 = lane & 31, hi = lane >> 5, wid = __builtin_amdgcn_readfirstlane(tid >> 6);
    unsigned char* ws = a.ws;
    const float* biasd = (const float*)(ws + WS_BIAS);
    LAS float* tab = (LAS float*)(lds + L::OFF_TAB);
    float lam = 0.f, lam_init = 0.f;
    if (MODE == 2) {
        float d1 = 0.f, d2 = 0.f;
        for (int i = 0; i < 64; ++i) { d1 += a.in[19][i] * a.in[20][i]; d2 += a.in[21][i] * a.in[22][i]; }
        lam_init = 0.8f - 0.6f * expf(-0.3f * 2.0f);
        lam = expf(d1) - expf(d2) + lam_init;
    }
    for (int u = cid; u < NU; u += Gn) {
        int b, h, dil = 1, res0 = 0, s0, nres = 1, W, qb = 0, g = 0;
        if (MODE == 0) { g = u >> 11; const int rem = u & 2047; b = rem >> 6; h = (rem >> 3) & 7; const int blk = rem & 7; W = 128;
            if (g == 0) { s0 = 256 * blk; } else if (g == 1) { dil = 4; res0 = blk >> 1; s0 = 256 * (blk & 1); } else { dil = 16; res0 = 2 * blk; s0 = 0; nres = 2; } }
        else if (MODE == 3) { b = u >> 7; h = (u >> 3) & 15; s0 = 256 * (u & 7); W = 127; }
        else if (MODE == 1) { const int bh = u & 511; qb = 7 - (u >> 9); b = bh >> 4; h = bh & 15; s0 = 256 * qb; W = 1 << 20; }
        else { const int bh = u & 255; qb = 7 - (u >> 8); b = bh >> 3; h = bh & 7; s0 = 256 * qb; W = 1 << 20; }
        TileGeo G;
        G.dil = dil; G.res0 = res0;
        const int Lseg = 256 / nres;
        if (MODE == 0 || MODE == 3) { G.ks0 = (nres == 1 && s0 >= 128) ? s0 - 128 : 0; } else { G.ks0 = 0; }
        G.TPS = (s0 + Lseg - G.ks0) >> 6; G.NT = G.TPS * nres;
        const int nws = 8 / nres, seg_w = wid / nws, wslot_q0 = s0 + 32 * (wid - seg_w * nws);
        int tl = 0;
        if (MODE == 0 || MODE == 3) { tl = wslot_q0 - W - G.ks0; tl = tl < 0 ? 0 : (tl >> 6); }
        const int th = (wslot_q0 + 31 - G.ks0) >> 6;
        const int my_tlo = seg_w * G.TPS + tl, my_thi = seg_w * G.TPS + th;
        const int qtok = res0 + seg_w + dil * (wslot_q0 + r32);
        const size_t row_q = (size_t)b * SEQ + qtok, row_b = (size_t)b * SEQ;
        const bf16 *Qp, *Kb, *Vb; int qpitch, kpitch, vpitch;
        if (MODE == 0) { const bf16* base = (const bf16*)(ws + R_A_QKV); qpitch = kpitch = vpitch = 4608;
            Qp = base + row_q * 4608 + g * 1536 + h * 64; Kb = base + row_b * 4608 + g * 1536 + 512 + h * 64; Vb = base + row_b * 4608 + g * 1536 + 1024 + h * 64; }
        else if (MODE == 1) { qpitch = 1536; kpitch = 1536; vpitch = 2048;
            Qp = (const bf16*)(ws + R_B_Q) + row_q * 1536 + h * 96; Kb = (const bf16*)(ws + R_B_KH) + row_b * 1536 + h * 96; Vb = (const bf16*)(ws + R_B_KV) + row_b * 2048 + h * 128 + 64; }
        else if (MODE == 2) { const bf16* base = (const bf16*)(ws + R_C_QKV); qpitch = kpitch = vpitch = 3072;
            Qp = base + row_q * 3072 + (2 * h) * 64; Kb = base + row_b * 3072 + 1024 + (2 * h) * 64; Vb = base + row_b * 3072 + 2048 + h * 128; }
        else { const bf16* base = (const bf16*)(ws + R_D_QKV); qpitch = kpitch = vpitch = 1280;
            Qp = base + row_q * 1280 + h * 64; Kb = base + row_b * 1280 + 1024 + (h >> 3) * 64; Vb = base + row_b * 1280 + 1152 + (h >> 3) * 64; }
        (void)qpitch;
        if (MODE == 0 || MODE == 3) { const int d_ = tid - 128; tab[tid] = (d_ >= 0 && d_ <= W) ? biasd[h * 2048 + d_ * dil] : -INFINITY; }
        if (MODE == 2) {
#pragma unroll
            for (int j = 0; j < 4; ++j) tab[128 + tid + 512 * j] = biasd[h * 2048 + tid + 512 * j];
            if (tid < 128) { tab[tid] = -INFINITY; tab[2176 + tid] = 0.f; } }
        bf16x8 qf[DQK / 16];
        constexpr int OFF_Q = L::OFF_TAB + TABN * 4, QSTR = DQK * 2 + 16;
        const int qoff = OFF_Q + (32 * wid + r32) * QSTR + hi * 16;
        int tq = tid; asm volatile("" : "+v"(tq));
        if (MODE == 2) {
            const bf16* qsrc = (const bf16*)(ws + R_C_QKV) + (row_b + s0) * 3072 + (2 * h) * 64;
#pragma unroll
            for (int j = 0; j < 4; ++j) { const int c_ = tq + 512 * j, rw = c_ >> 3, p_ = c_ & 7;
                *(LAS u32x4*)(lds + OFF_Q + rw * QSTR + p_ * 16) = *(const u32x4*)(qsrc + (size_t)rw * 3072 + p_ * 8); }
        } else {
#pragma unroll
            for (int ks = 0; ks < DQK / 16; ++ks) qf[ks] = *(const bf16x8*)(Qp + 16 * ks + 8 * hi);
            if (MODE == 1) {
                float x[DQK / 16][8]; float ss = 0.f;
#pragma unroll
                for (int ks = 0; ks < DQK / 16; ++ks) { const u32x4 raw = __builtin_bit_cast(u32x4, qf[ks]);
#pragma unroll
                    for (int j = 0; j < 4; ++j) { x[ks][2 * j] = bflo(raw[j]); x[ks][2 * j + 1] = bfhi(raw[j]); ss += x[ks][2 * j] * x[ks][2 * j] + x[ks][2 * j + 1] * x[ks][2 * j + 1]; } }
                ss += __shfl_xor(ss, 32);
                const float rsq = rsqrtf(ss * (1.0f / 96.0f) + EPS) * (0.10206207261596577f * LOG2E);
                const float* gq_ = a.in[13];
#pragma unroll
                for (int ks = 0; ks < DQK / 16; ++ks) { const f32x4 g0 = *(const f32x4*)(gq_ + 16 * ks + 8 * hi), g1 = *(const f32x4*)(gq_ + 16 * ks + 8 * hi + 4);
#pragma unroll
                    for (int j = 0; j < 4; ++j) { x[ks][j] *= rsq * g0[j]; x[ks][4 + j] *= rsq * g1[j]; } }
                const float* cs = (const float*)(ws + WS_ROPE) + ((size_t)qtok * 16 + 8 * hi) * 2;
#pragma unroll
                for (int j = 0; j < 8; ++j) { const float co = cs[2 * j], si = cs[2 * j + 1], x1 = x[4][j], x2 = x[5][j]; x[4][j] = x1 * co - x2 * si; x[5][j] = x2 * co + x1 * si; }
#pragma unroll
                for (int ks = 0; ks < DQK / 16; ++ks) { u32x4 w;
#pragma unroll
                    for (int j = 0; j < 4; ++j) w[j] = pk2(x[ks][2 * j], x[ks][2 * j + 1]);
                    qf[ks] = __builtin_bit_cast(bf16x8, w); }
            }
        }
        f32x16 o[DV / 32];
#pragma unroll
        for (int c = 0; c < DV / 32; ++c)
#pragma unroll
            for (int r = 0; r < 16; ++r) o[c][r] = 0.f;
        float m = -INFINITY, l = 0.f;
        if (MODE == 3) { m = a.in[28][h] * LOG2E; l = hi == 0 ? 1.f : 0.f; }
        attn_pass<DQK, DV, BIAS, TABN, MODE == 2, KT>(qoff, lds, Kb, kpitch, Vb, vpitch, G, my_tlo, my_thi, wslot_q0, W, qf, m, l, o);
        float lt = l + __shfl_xor(l, 32);
        float inv = 1.0f / lt;
        if (MODE != 2) {
            bf16* Op; int opitch;
            if (MODE == 0) { Op = (bf16*)(ws + R_A_O3) + ((size_t)g * M_ + row_q) * 512 + h * 64; opitch = 512;
                if (hi == 0) ((float*)(ws + R_A_LSE))[((size_t)g * M_ + row_q) * 8 + h] = m + __log2f(lt); }
            else if (MODE == 1) { Op = (bf16*)(ws + R_B_O) + row_q * 1024 + h * 64; opitch = 1024; }
            else { Op = (bf16*)(ws + R_D_O) + row_q * 1024 + h * 64; opitch = 1024; }
            (void)opitch;
#pragma unroll
            for (int c = 0; c < DV / 32; ++c)
#pragma unroll
                for (int gq = 0; gq < 4; ++gq) {
                    u32x2 w; w.x = pk2(o[c][4 * gq] * inv, o[c][4 * gq + 1] * inv); w.y = pk2(o[c][4 * gq + 2] * inv, o[c][4 * gq + 3] * inv);
                    *(u32x2*)(Op + 32 * c + 8 * gq + 4 * hi) = w;
                }
        } else {
            f32x16 o1[DV / 32];
#pragma unroll
            for (int c = 0; c < DV / 32; ++c)
#pragma unroll
                for (int r = 0; r < 16; ++r) { o1[c][r] = o[c][r] * inv; o[c][r] = 0.f; }
#pragma unroll
            for (int j = 0; j < 4; ++j) tab[128 + tid + 512 * j] = biasd[(8 + h) * 2048 + tid + 512 * j];
            { const bf16* qsrc = (const bf16*)(ws + R_C_QKV) + (row_b + s0) * 3072 + (2 * h + 1) * 64;
#pragma unroll
              for (int j = 0; j < 4; ++j) { const int c_ = tq + 512 * j, rw = c_ >> 3, p_ = c_ & 7;
                  *(LAS u32x4*)(lds + OFF_Q + rw * QSTR + p_ * 16) = *(const u32x4*)(qsrc + (size_t)rw * 3072 + p_ * 8); } }
            m = -INFINITY; l = 0.f;
            attn_pass<DQK, DV, BIAS, TABN, MODE == 2, KT>(qoff, lds, Kb + 64, kpitch, Vb, vpitch, G, my_tlo, my_thi, wslot_q0, W, qf, m, l, o);
            lt = l + __shfl_xor(l, 32);
            inv = lam / lt;
            float ssum = 0.f;
#pragma unroll
            for (int c = 0; c < DV / 32; ++c)
#pragma unroll
                for (int r = 0; r < 16; ++r) { const float d = o1[c][r] - o[c][r] * inv; o1[c][r] = d; ssum += d * d; }
            ssum += __shfl_xor(ssum, 32);
            const float rs = rsqrtf(ssum * (1.0f / 128.0f) + EPS) * (1.0f - lam_init);
            bf16* Op = (bf16*)(ws + R_C_O) + row_q * 1024 + h * 128;
            const float* sub = a.in[23];
#pragma unroll
            for (int c = 0; c < DV / 32; ++c)
#pragma unroll
                for (int gq = 0; gq < 4; ++gq) {
                    const f32x4 sv = *(const f32x4*)(sub + 32 * c + 8 * gq + 4 * hi);
                    u32x2 w; w.x = pk2(o1[c][4 * gq] * rs * sv[0], o1[c][4 * gq + 1] * rs * sv[1]); w.y = pk2(o1[c][4 * gq + 2] * rs * sv[2], o1[c][4 * gq + 3] * rs * sv[3]);
                    *(u32x2*)(Op + 32 * c + 8 * gq + 4 * hi) = w;
                }
        }
    }
}

__device__ __forceinline__ void transpose_item(const float* W, int ldw, int ncol0, int K, const float* ksc, bf16* WT, int mode, LAS float* scr, int nblk, int item, int lane) {
    const int kb = item / nblk, nb = item - kb * nblk, k0 = 64 * kb, n0 = 32 * nb;
#pragma unroll
    for (int i = 0; i < 32; ++i) { const int kk = 2 * i + (lane >> 5); float v = W[(size_t)(k0 + kk) * ldw + ncol0 + n0 + (lane & 31)]; if (ksc != nullptr) v *= ksc[k0 + kk]; scr[kk * 33 + (lane & 31)] = v; }
    asm volatile("s_waitcnt lgkmcnt(0)" ::: "memory");
    const int drow0 = mode == 1 ? (256 * (n0 >> 8) + 128 * ((n0 & 63) >> 5) + 32 * ((n0 >> 6) & 3)) : mode == 2 ? (n0 < DFF ? 256 * (n0 >> 7) + (n0 & 127) : 256 * ((n0 - DFF) >> 7) + 128 + ((n0 - DFF) & 127)) : n0;
    const int c = lane & 7;
#pragma unroll
    for (int j = 0; j < 4; ++j) { const int n = (lane >> 3) + 8 * j; const LAS float* s = scr + (8 * c) * 33 + n;
        u32x4 o; o.x = pk2(s[0 * 33], s[1 * 33]); o.y = pk2(s[2 * 33], s[3 * 33]); o.z = pk2(s[4 * 33], s[5 * 33]); o.w = pk2(s[6 * 33], s[7 * 33]);
        *(u32x4*)(WT + (size_t)(drow0 + n) * K + k0 + 8 * c) = o; }
    asm volatile("s_waitcnt lgkmcnt(0)" ::: "memory");
}
__device__ __forceinline__ void prologue(LAS unsigned char* lds, const Args& a, int Gn, int cid) {
    int tid = threadIdx.x; asm volatile("" : "+v"(tid)); const int lane = tid & 63, wid = __builtin_amdgcn_readfirstlane(tid >> 6);
    unsigned char* ws = a.ws;
    LAS float* scr = (LAS float*)(lds + wid * 16384);
    const int gw = cid * 8 + wid, NGW = Gn * 8;
#define MAT_DESC(id) \
        const float* W; int ldw, ncol0 = 0, K, N, mode; const float* ksc = nullptr; size_t dst; \
        if (id == 0) { W = a.in[4]; ldw = 4608; K = 1024; N = 4608; ksc = a.in[2]; dst = W_AIN; mode = 1; } \
        else if (id == 1) { W = a.in[7]; ldw = 1024; K = 512; N = 1024; dst = W_AOUT; mode = 0; } \
        else if (id == 2) { W = a.in[8]; ldw = 672; K = 1024; N = 672; ksc = a.in[2] + 1024; dst = W_BIN; mode = 1; } \
        else if (id == 3) { W = a.in[11]; ldw = 1536; K = 384; N = 1536; ksc = a.in[9]; dst = W_BQUP; mode = 1; } \
        else if (id == 4) { W = a.in[12]; ldw = 2048; K = 256; N = 2048; ksc = a.in[10]; dst = W_BKVUP; mode = 1; } \
        else if (id == 5) { W = a.in[15]; ldw = 1024; K = 1024; N = 1024; dst = W_BOUT; mode = 0; } \
        else if (id == 6) { W = a.in[16]; ldw = 3072; K = 1024; N = 3072; ksc = a.in[2] + 2048; dst = W_CIN; mode = 1; } \
        else if (id == 7) { W = a.in[24]; ldw = 1024; K = 1024; N = 1024; dst = W_COUT; mode = 0; } \
        else if (id == 8) { W = a.in[25]; ldw = 1280; K = 1024; N = 1280; ksc = a.in[2] + 3072; dst = W_DIN; mode = 1; } \
        else if (id == 9) { W = a.in[29]; ldw = 1024; K = 1024; N = 1024; dst = W_DOUT; mode = 0; } \
        else { const int l = (id - 10) / 3, k3 = (id - 10) - 3 * l; \
            if (k3 < 2) { W = a.in[30] + (size_t)l * 1024 * 5632; ldw = 5632; K = 1024; N = 5632; ksc = a.in[3] + 1024 * l; dst = W_FG + l * 2 * W_FSTR; mode = 2; } \
            else { W = a.in[33] + (size_t)l * 2816 * 1024; ldw = 1024; K = 2816; N = 1024; dst = W_FD + l * W_FSTR; mode = 0; } }
    constexpr int TOTAL_ITEMS = 2304 + 256 + 336 + 288 + 256 + 512 + 1536 + 512 + 640 + 512 + 4 * (1408 + 1408 + 1408);
    for (int it = gw; it < TOTAL_ITEMS; it += NGW) {
        int r = it, id = 0;
        for (; id < 21; ++id) {
            int n_;
            if (id < 10) { n_ = id == 0 ? 2304 : id == 1 ? 256 : id == 2 ? 336 : id == 3 ? 288 : id == 4 ? 256 : id == 5 ? 512 : id == 6 ? 1536 : id == 7 ? 512 : id == 8 ? 640 : 512; } else { const int k3_ = (id - 10) % 3; n_ = k3_ == 0 ? 2816 : (k3_ == 1 ? 0 : 1408); }
            if (r < n_) break;
            r -= n_;
        }
        MAT_DESC(id)
        const int nblk = N / 32;
        transpose_item(W, ldw, ncol0, K, ksc, (bf16*)(ws + dst), mode, scr, nblk, r, lane);
    }
#undef MAT_DESC
    const int gt = cid * 512 + tid, NT = Gn * 512;
    { float* biasd = (float*)(ws + WS_BIAS); const float* table = a.in[1];
      for (int i = gt; i < 16 * 2048; i += NT) { const int h = i >> 11, d = i & 2047; int bk = d;
          if (d >= 16) { float t = logf((float)d / 16.0f); t = t / 4.852030263919617f; t = t * 16.0f; int lg = 16 + (int)t; bk = lg < 31 ? lg : 31; }
          biasd[i] = table[bk * 16 + h] * LOG2E; } }
    { float* rope = (float*)(ws + WS_ROPE);
      for (int i = gt; i < 2048 * 16; i += NT) { const int pos = i >> 4, f = i & 15; const float inv = powf(10000.0f, -(float)(2 * f) / 32.0f); const float ang = (float)pos * inv;
          rope[2 * i] = cosf(ang); rope[2 * i + 1] = sinf(ang); } }
    { const float* x = a.in[0]; bf16* xb = (bf16*)(ws + WS_XB); float* rss = (float*)(ws + WS_RSS);
      for (int m0 = gw; m0 < M_; m0 += 4 * NGW) {
          f32x4 v[4][4];
#pragma unroll
          for (int k = 0; k < 4; ++k) { const int m = m0 + k * NGW; if (m < M_) { const f32x4* xr = (const f32x4*)(x + (size_t)m * DMODEL) + lane;
#pragma unroll
              for (int j = 0; j < 4; ++j) v[k][j] = xr[64 * j]; } }
#pragma unroll
          for (int k = 0; k < 4; ++k) { const int m = m0 + k * NGW; if (m < M_) { u32x2* o8 = (u32x2*)(xb + (size_t)m * DMODEL) + lane; float s = 0.f;
#pragma unroll
              for (int j = 0; j < 4; ++j) { s += dot4(v[k][j]); u32x2 w; w.x = pk2(v[k][j][0], v[k][j][1]); w.y = pk2(v[k][j][2], v[k][j][3]); o8[64 * j] = w; }
              s = wave_sum(s); if (lane == 0) rss[m] = rsqrtf(s * (1.0f / 1024.0f) + EPS); } } } }
}
__device__ __forceinline__ void combine_a(const Args& a, int Gn, int cid) {
    unsigned char* ws = a.ws;
    const bf16* o3 = (const bf16*)(ws + R_A_O3); const float* lse = (const float*)(ws + R_A_LSE); bf16* oc = (bf16*)(ws + R_A_OC);
    const size_t NT = (size_t)Gn * 512; int tid = threadIdx.x; asm volatile("" : "+v"(tid));
    for (size_t idx0 = (size_t)cid * 512 + tid; idx0 < (size_t)M_ * 64; idx0 += 4 * NT) {
        u32x4 a0[4], a1[4], a2[4]; float l0[4], l1[4], l2[4];
#pragma unroll
        for (int k = 0; k < 4; ++k) { const size_t idx = idx0 + k * NT; if (idx < (size_t)M_ * 64) {
            const size_t row = idx >> 6; const int ch = (int)(idx & 63), h = ch >> 3;
            l0[k] = lse[row * 8 + h]; l1[k] = lse[((size_t)M_ + row) * 8 + h]; l2[k] = lse[((size_t)2 * M_ + row) * 8 + h];
            a0[k] = *(const u32x4*)(o3 + row * 512 + ch * 8); a1[k] = *(const u32x4*)(o3 + ((size_t)M_ + row) * 512 + ch * 8); a2[k] = *(const u32x4*)(o3 + ((size_t)2 * M_ + row) * 512 + ch * 8); } }
#pragma unroll
        for (int k = 0; k < 4; ++k) { const size_t idx = idx0 + k * NT; if (idx < (size_t)M_ * 64) {
            const size_t row = idx >> 6; const int ch = (int)(idx & 63);
            const float mx = fmaxf(l0[k], fmaxf(l1[k], l2[k]));
            float w0 = __builtin_amdgcn_exp2f(l0[k] - mx), w1 = __builtin_amdgcn_exp2f(l1[k] - mx), w2 = __builtin_amdgcn_exp2f(l2[k] - mx);
            const float inv = 1.0f / (w0 + w1 + w2); w0 *= inv; w1 *= inv; w2 *= inv;
            u32x4 r;
#pragma unroll
            for (int j = 0; j < 4; ++j) r[j] = pk2(w0 * bflo(a0[k][j]) + w1 * bflo(a1[k][j]) + w2 * bflo(a2[k][j]), w0 * bfhi(a0[k][j]) + w1 * bfhi(a1[k][j]) + w2 * bfhi(a2[k][j]));
            *(u32x4*)(oc + row * 512 + ch * 8) = r; } }
    }
}
__device__ __forceinline__ void prep_b(const Args& a, int Gn, int cid) {
    unsigned char* ws = a.ws;
    int tid = threadIdx.x; asm volatile("" : "+v"(tid)); const int lane = tid & 63, wid = __builtin_amdgcn_readfirstlane(tid >> 6);
    bf16* Q = (bf16*)(ws + R_B_Q); const bf16* KV = (const bf16*)(ws + R_B_KV); const bf16* KPE = (const bf16*)(ws + R_B_KPE); bf16* KH = (bf16*)(ws + R_B_KH);
    const float* rope = (const float*)(ws + WS_ROPE);
    const int sub = lane >> 4, c = lane & 15;
    const float qscale = 0.10206207261596577f * LOG2E;
    const int gw = cid * 8 + wid, NGW = Gn * 8;
    const int TOT = 2 * M_ * 4;
    for (int it0 = M_ * 4 + gw; it0 < TOT; it0 += 4 * NGW) {
        u32x4 raw[4];
#pragma unroll
        for (int k = 0; k < 4; ++k) {
            const int it = it0 + k * NGW;
            raw[k] = (u32x4){0u, 0u, 0u, 0u};
            if (it < TOT && c < 12) {
                const bool isk = it >= M_ * 4; const int it2 = isk ? it - M_ * 4 : it;
                const int task = it2 * 4 + sub; const size_t row = (size_t)(task >> 4); const int h = task & 15;
                if (!isk) raw[k] = *(const u32x4*)(Q + row * 1536 + h * 96 + 8 * c);
                else if (c < 8) raw[k] = *(const u32x4*)(KV + row * 2048 + h * 128 + 8 * c);
                else raw[k] = *(const u32x4*)(KPE + row * 64 + 8 * (c - 8));
            }
        }
#pragma unroll
        for (int k = 0; k < 4; ++k) {
            const int it = it0 + k * NGW;
            if (it < TOT) {
                const bool isk = it >= M_ * 4; const int it2 = isk ? it - M_ * 4 : it;
                const int task = it2 * 4 + sub; const size_t row = (size_t)(task >> 4); const int h = task & 15; const int pos = (int)(row & 2047);
                float x[8];
#pragma unroll
                for (int j = 0; j < 4; ++j) { x[2 * j] = bflo(raw[k][j]); x[2 * j + 1] = bfhi(raw[k][j]); }
                float ss = 0.f;
#pragma unroll
                for (int e = 0; e < 8; ++e) ss += x[e] * x[e];
                ss += __shfl_xor(ss, 1); ss += __shfl_xor(ss, 2); ss += __shfl_xor(ss, 4); ss += __shfl_xor(ss, 8);
                const float rs = rsqrtf(ss * (1.0f / 96.0f) + EPS);
                const float* gain = (isk ? a.in[14] : a.in[13]) + 8 * (c < 12 ? c : 0);
                const float* cs = rope + ((size_t)pos * 16 + (c & 1) * 8) * 2;
                float y[8];
#pragma unroll
                for (int e = 0; e < 8; ++e) y[e] = x[e] * rs * gain[e];
#pragma unroll
                for (int e = 0; e < 8; ++e) {
                    const float z = __shfl_xor(y[e], 2);
                    if (c >= 8 && c < 12) { const float co = cs[2 * e], si = cs[2 * e + 1]; y[e] = (c < 10) ? (y[e] * co - z * si) : (y[e] * co + z * si); }
                }
                if (c < 12) {
                    u32x4 w;
                    if (!isk) {
#pragma unroll
                        for (int j = 0; j < 4; ++j) w[j] = pk2(y[2 * j] * qscale, y[2 * j + 1] * qscale);
                        *(u32x4*)(Q + row * 1536 + h * 96 + 8 * c) = w;
                    } else {
#pragma unroll
                        for (int j = 0; j < 4; ++j) w[j] = pk2(y[2 * j], y[2 * j + 1]);
                        *(u32x4*)(KH + row * 1536 + h * 96 + 8 * c) = w;
                    }
                }
            }
        }
    }
}

__device__ __forceinline__ void fixup_ffn(const bf16* gedge, const bf16* uedge, bf16* act, const float* cw, const float* cb, int Gn, int cid) {
    int tid = threadIdx.x; asm volatile("" : "+v"(tid));
    const int TOT = 1024 * 2 * 352;
    for (int idx = cid * 512 + tid; idx < TOT; idx += Gn * 512) {
        const int ch = idx % 352, sj = idx / 352, j = sj & 1, st = sj >> 1, c0 = ch * 8;
        const int row = st * 64 + j, t = row & (SEQ - 1);
        const u32x4 z = (u32x4){0u, 0u, 0u, 0u};
        const u32x4 g0 = *(const u32x4*)(gedge + ((size_t)st * 4 + j) * DFF + c0);
        u32x4 g1, g2;
        if (j == 0) { g1 = t >= 1 ? *(const u32x4*)(gedge + ((size_t)(st - 1) * 4 + 3) * DFF + c0) : z; g2 = t >= 2 ? *(const u32x4*)(gedge + ((size_t)(st - 1) * 4 + 2) * DFF + c0) : z; }
        else { g1 = *(const u32x4*)(gedge + ((size_t)st * 4 + 0) * DFF + c0); g2 = t >= 2 ? *(const u32x4*)(gedge + ((size_t)(st - 1) * 4 + 3) * DFF + c0) : z; }
        const u32x4 uw = *(const u32x4*)(uedge + ((size_t)st * 2 + j) * DFF + c0);
        u32x4 w;
#pragma unroll
        for (int n = 0; n < 2; ++n) {
            const f32x4 w0 = *(const f32x4*)(cw + c0 + 4 * n), w1 = *(const f32x4*)(cw + DFF + c0 + 4 * n), w2 = *(const f32x4*)(cw + 2 * DFF + c0 + 4 * n), b = *(const f32x4*)(cb + c0 + 4 * n);
            float r[4];
#pragma unroll
            for (int e = 0; e < 4; ++e) {
                const unsigned q0 = g0[2 * n + (e >> 1)], q1 = g1[2 * n + (e >> 1)], q2 = g2[2 * n + (e >> 1)], qu = uw[2 * n + (e >> 1)];
                const float x0 = (e & 1) ? bfhi(q0) : bflo(q0), x1 = (e & 1) ? bfhi(q1) : bflo(q1), x2 = (e & 1) ? bfhi(q2) : bflo(q2), up = (e & 1) ? bfhi(qu) : bflo(qu);
                const float cv = b[e] + w2[e] * x0 + w1[e] * x1 + w0[e] * x2;
                r[e] = cv * __builtin_amdgcn_rcpf(1.0f + __builtin_amdgcn_exp2f(-LOG2E * cv)) * up;
            }
            w[2 * n] = pk2(r[0], r[1]); w[2 * n + 1] = pk2(r[2], r[3]);
        }
        *(u32x4*)(act + (size_t)row * DFF + c0) = w;
    }
}
__device__ __forceinline__ void rstd_pass(const float* ssp, int nvec, float invdim, float* rs, int Gn, int cid) {
    int tid = threadIdx.x; asm volatile("" : "+v"(tid));
    for (int row = cid * 512 + tid; row < M_; row += Gn * 512) rs[row] = rsqrtf(rowss_sum(ssp, nvec, row) * invdim + EPS);
}
__device__ __forceinline__ void kpe_pass(const Args& a, int Gn, int cid) {
    unsigned char* ws = a.ws;
    int tid = threadIdx.x; asm volatile("" : "+v"(tid));
    const bf16* KPE = (const bf16*)(ws + R_B_KPE); bf16* RK = (bf16*)(ws + R_B_RK); float* sspe = (float*)(ws + WS_SSPE);
    const float* rope = (const float*)(ws + WS_ROPE); const float* gk = a.in[14] + 64;
    for (int row = cid * 512 + tid; row < M_; row += Gn * 512) {
        float x[32]; float ss = 0.f;
#pragma unroll
        for (int c = 0; c < 4; ++c) { const u32x4 raw = *(const u32x4*)(KPE + (size_t)row * 64 + 8 * c);
#pragma unroll
            for (int j = 0; j < 4; ++j) { x[8 * c + 2 * j] = bflo(raw[j]); x[8 * c + 2 * j + 1] = bfhi(raw[j]); } }
#pragma unroll
        for (int i = 0; i < 32; ++i) { ss += x[i] * x[i]; x[i] *= gk[i]; }
        sspe[row] = ss;
        const float* cs = rope + (size_t)(row & (SEQ - 1)) * 32;
#pragma unroll
        for (int i = 0; i < 16; ++i) { const float co = cs[2 * i], si = cs[2 * i + 1], x1 = x[i], x2 = x[16 + i]; x[i] = x1 * co - x2 * si; x[16 + i] = x2 * co + x1 * si; }
#pragma unroll
        for (int c = 0; c < 4; ++c) { u32x4 w;
#pragma unroll
            for (int j = 0; j < 4; ++j) w[j] = pk2(x[8 * c + 2 * j], x[8 * c + 2 * j + 1]);
            *(u32x4*)(RK + (size_t)row * 32 + 8 * c) = w; }
    }
}
__device__ __forceinline__ void rstd_local(const float* ssp, float* rs, const pg8::StaticOrder& S, int nunits) {
    int tid = threadIdx.x; asm volatile("" : "+v"(tid));
    const int TOT = nunits * 256;
    for (int k0 = tid; k0 < TOT; k0 += 4 * 512) {
        f32x4 p[4][4]; int rows[4];
#pragma unroll
        for (int j = 0; j < 4; ++j) { const int k = k0 + j * 512; rows[j] = -1;
            if (k < TOT) { pg8::Unit uu; S.next(k >> 8, uu); rows[j] = uu.pm * 256 + (k & 255); const f32x4* q = (const f32x4*)(ssp + (size_t)rows[j] * 16);
#pragma unroll
                for (int v = 0; v < 4; ++v) p[j][v] = q[v]; } }
#pragma unroll
        for (int j = 0; j < 4; ++j) if (rows[j] >= 0) { float t = 0.f;
#pragma unroll
            for (int v = 0; v < 4; ++v) t += (p[j][v][0] + p[j][v][1]) + (p[j][v][2] + p[j][v][3]);
            rs[rows[j]] = rsqrtf(t * (1.0f / 1024.0f) + EPS); }
    }
    asm volatile("s_waitcnt vmcnt(0)" ::: "memory");
    __syncthreads();
}
__device__ __forceinline__ void grid_barrier(unsigned* cnt, unsigned& epoch, unsigned G) {
    asm volatile("s_waitcnt vmcnt(0) lgkmcnt(0)" ::: "memory");
    __syncthreads();
    epoch += 1u;
    if (threadIdx.x == 0) {
        __builtin_amdgcn_fence(__ATOMIC_RELEASE, "agent");
        asm volatile("s_waitcnt vmcnt(0)" ::: "memory");
        __hip_atomic_fetch_add(cnt, 1u, __ATOMIC_RELAXED, __HIP_MEMORY_SCOPE_AGENT);
        const unsigned want = epoch * G;
        while (__hip_atomic_load(cnt, __ATOMIC_RELAXED, __HIP_MEMORY_SCOPE_AGENT) < want) __builtin_amdgcn_s_sleep(2);
        __builtin_amdgcn_fence(__ATOMIC_ACQUIRE, "agent");
        asm volatile("s_waitcnt vmcnt(0)" ::: "memory");
    }
    __syncthreads();
}
__global__ void __launch_bounds__(512) fwd_kernel(Args a) {
    extern __shared__ __attribute__((aligned(16))) unsigned char lds_raw[];
    LAS unsigned char* lds = (LAS unsigned char*)lds_raw;
    cg::grid_group grid = cg::this_grid();
    const int Gn = (int)gridDim.x, cid = (int)blockIdx.x;
    unsigned char* ws = a.ws;
    unsigned* barcnt = (unsigned*)(ws + WS_BAR); unsigned epoch = 0u;
    prologue(lds, a, Gn, cid);
    grid.sync();
    grid_barrier(barcnt, epoch, (unsigned)Gn);
    bf16* XB = (bf16*)(ws + WS_XB);
    float* RSS = (float*)(ws + WS_RSSP); float* RSTD = (float*)(ws + WS_RSS);
    for (int ph = 0; ph < 28; ++ph) {
        int type = 0, N = 1024, K = 1024, ldc = 0, hm = 0, layer = 0, sidx = 0, nvec = 4, pbuf = -1;
        const bf16 *A = XB, *Bt = nullptr; bf16* pO = nullptr; const float* pss = RSTD; const float *gq = nullptr, *gk = nullptr; float qs = 0.125f * LOG2E;
        const float* rbase = nullptr; float* rout = nullptr; bf16* rxb = XB; float* rssn = nullptr;
        int f = -1;
        switch (ph) {
        case 0: type = 0; Bt = (const bf16*)(ws + W_AIN); N = 4608; pO = (bf16*)(ws + R_A_QKV); ldc = 4608; hm = 1; gq = a.in[5]; gk = a.in[6]; break;
        case 1: type = 4; break;
        case 2: type = 8; break;
        case 3: type = 1; A = (const bf16*)(ws + R_A_OC); Bt = (const bf16*)(ws + W_AOUT); K = 512; rbase = a.in[0]; rssn = RSS + 1 * (size_t)M_ * 16; break;
        case 4: case 5: case 6: layer = 0; sidx = 1; f = ph - 4; break;
        case 7: type = 2; Bt = (const bf16*)(ws + W_BIN); N = 768; pbuf = 0; break;
        case 8: type = 0; A = (const bf16*)(ws + R_B_CQ); Bt = (const bf16*)(ws + W_BQUP); N = 1536; K = 384; pO = (bf16*)(ws + R_B_Q); ldc = 1536; pss = (const float*)(ws + WS_SSQ); break;
        case 9: type = 10; break;
        case 10: type = 10; break;
        case 11: type = 5; break;
        case 12: type = 1; A = (const bf16*)(ws + R_B_O); Bt = (const bf16*)(ws + W_BOUT); rssn = RSS + 1 * (size_t)M_ * 16; break;
        case 13: case 14: case 15: layer = 1; sidx = 3; f = ph - 13; break;
        case 16: type = 0; Bt = (const bf16*)(ws + W_CIN); N = 3072; pO = (bf16*)(ws + R_C_QKV); ldc = 3072; pbuf = 0; hm = 2; gq = a.in[17]; gk = a.in[18]; break;
        case 17: type = 6; break;
        case 18: type = 1; A = (const bf16*)(ws + R_C_O); Bt = (const bf16*)(ws + W_COUT); rssn = RSS + 1 * (size_t)M_ * 16; break;
        case 19: case 20: case 21: layer = 2; sidx = 5; f = ph - 19; break;
        case 22: type = 0; Bt = (const bf16*)(ws + W_DIN); N = 1280; pO = (bf16*)(ws + R_D_QKV); ldc = 1280; pbuf = 0; hm = 3; gq = a.in[26]; gk = a.in[27]; break;
        case 23: type = 7; break;
        case 24: type = 1; A = (const bf16*)(ws + R_D_O); Bt = (const bf16*)(ws + W_DOUT); rssn = RSS + 1 * (size_t)M_ * 16; break;
        default: layer = 3; sidx = 7; f = ph - 25; break;
        }
        if (f == 0) { type = 3; Bt = (const bf16*)(ws + W_FG + layer * 2 * W_FSTR); N = 2 * DFF; pbuf = 1; }
        else if (f == 1) { type = 11; }
        else if (f == 2) { type = 1; A = (const bf16*)(ws + R_ACT); Bt = (const bf16*)(ws + W_FD + layer * W_FSTR); K = DFF;
            if (layer < 3) { rssn = RSS + ((sidx + 1) & 1) * (size_t)M_ * 16; } else { rssn = nullptr; rxb = nullptr; rout = a.out; } }

        if (type == 10) continue;
        if (type <= 3) {
            pg8::Gemm g{A, Bt, M_, N, K}; pg8::StaticOrder S; S.init(M_, N, Gn, cid);
            if (pbuf >= 0) rstd_local(RSS + (size_t)pbuf * M_ * 16, RSTD, S, (S.nwg - cid + Gn - 1) / Gn);
            if (type == 0) {
                for (int sub = 0; sub < (ph == 8 ? 2 : 1); ++sub) {
                    const bool kv = (sub == 1);
                    const pg8::Gemm g2{kv ? (const bf16*)(ws + R_B_CKV) : A, kv ? (const bf16*)(ws + W_BKVUP) : Bt, M_, kv ? 2048 : N, kv ? 256 : K};
                    pg8::StaticOrder S2; S2.init(M_, kv ? 2048 : N, Gn, cid);
                    const EpiProj E{kv ? (bf16*)(ws + R_B_KV) : pO, kv ? 2048 : ldc, kv ? (const float*)(ws + WS_SSKV) : pss, kv ? 4 : hm, gq, kv ? a.in[14] : gk, qs};
                    pg8::gemm_phase<EpiProj, pg8::StaticOrder, true, true>(lds, g2, S2, E);
                }
            }
            else if (type == 1) { EpiRes E{rbase, rout, XB, rxb, rssn}; pg8::gemm_phase<EpiRes, pg8::StaticOrder, true, true>(lds, g, S, E); }
            else if (type == 2) { EpiLat E{(bf16*)(ws + R_B_CQ), (bf16*)(ws + R_B_CKV), (bf16*)(ws + R_B_KPE), pss, (float*)(ws + WS_SSQP), (float*)(ws + WS_SSKVP)}; pg8::gemm_phase<EpiLat, pg8::StaticOrder, true, true>(lds, g, S, E); }
            else { EpiGateUp E{(bf16*)(ws + R_ACT), (bf16*)(ws + R_GATE), (bf16*)(ws + R_GATE + 32 * MiB), pss, a.in[31] + (size_t)layer * 3 * DFF, a.in[32] + (size_t)layer * DFF}; pg8::gemm_phase<EpiGateUp, pg8::StaticOrder, true, true>(lds, g, S, E); }
        }
        else if (type == 4) attn_phase<0>(lds, a, Gn, cid);
        else if (type == 5) attn_phase<1>(lds, a, Gn, cid);
        else if (type == 6) attn_phase<2>(lds, a, Gn, cid);
        else if (type == 7) attn_phase<3>(lds, a, Gn, cid);
        else if (type == 8) combine_a(a, Gn, cid);
        else if (type == 11) fixup_ffn((const bf16*)(ws + R_GATE), (const bf16*)(ws + R_GATE + 32 * MiB), (bf16*)(ws + R_ACT), a.in[31] + (size_t)layer * 3 * DFF, a.in[32] + (size_t)layer * DFF, Gn, cid);
        else prep_b(a, Gn, cid);
        grid_barrier(barcnt, epoch, (unsigned)Gn);
        if (type == 2) { rstd_pass((const float*)(ws + WS_SSQP), 2, 1.0f / 384.0f, (float*)(ws + WS_SSQ), Gn, cid); rstd_pass((const float*)(ws + WS_SSKVP), 1, 1.0f / 256.0f, (float*)(ws + WS_SSKV), Gn, cid); kpe_pass(a, Gn, cid);
            grid_barrier(barcnt, epoch, (unsigned)Gn); }
    }
}

extern "C" void kernel_launch(void* const* d_in, const int* in_sizes, int n_in, void* d_out, int out_size, void* d_ws, size_t ws_size, hipStream_t stream) {
    static int grid = 0;
    if (grid == 0) {
        if (n_in != 34 || out_size != M_ * DMODEL || ws_size < WS_NEED) { fprintf(stderr, "kernel_launch: unexpected shapes (n_in %d out %d ws %zu)\n", n_in, out_size, ws_size); grid = -1; return; }
        int dev = 0, cus = 0, per_cu = 0;
        if (hipGetDevice(&dev) != hipSuccess || hipDeviceGetAttribute(&cus, hipDeviceAttributeMultiprocessorCount, dev) != hipSuccess) { grid = -1; return; }
        if (hipFuncSetAttribute((const void*)fwd_kernel, hipFuncAttributeMaxDynamicSharedMemorySize, LDS_BYTES) != hipSuccess) { fprintf(stderr, "kernel_launch: hipFuncSetAttribute failed\n"); grid = -1; return; }
        if (hipOccupancyMaxActiveBlocksPerMultiprocessor(&per_cu, (const void*)fwd_kernel, 512, LDS_BYTES) != hipSuccess || per_cu < 1) { fprintf(stderr, "kernel_launch: occupancy query says %d\n", per_cu); per_cu = 1; }
        (void)hipGetLastError();
        grid = cus;
    }
    if (grid < 0) return;
    if (hipMemsetAsync((unsigned char*)d_ws + WS_BAR, 0, 256, stream) != hipSuccess) { fprintf(stderr, "kernel_launch: memset failed\n"); return; }
    Args a{};
    for (int i = 0; i < 34; ++i) a.in[i] = (const float*)d_in[i];
    a.out = (float*)d_out; a.ws = (unsigned char*)d_ws;
    void* args[] = {&a};
    hipError_t e = hipLaunchCooperativeKernel((const void*)fwd_kernel, dim3(grid), dim3(512), args, LDS_BYTES, stream);
    if (e != hipSuccess) fprintf(stderr, "cooperative launch failed: %s (grid %d)\n", hipGetErrorString(e), grid);
}
```

```cpp
#include <hip/hip_runtime.h>
#include <hip/hip_cooperative_groups.h>
#include <cstdio>
#include <cstdint>
namespace cg = cooperative_groups;
namespace pg8 {
#define PG8_LAS __attribute__((address_space(3)))
typedef unsigned short bf16_t;
typedef short bf16x8 __attribute__((ext_vector_type(8)));
typedef float f32x4 __attribute__((ext_vector_type(4)));
typedef unsigned u32x4 __attribute__((ext_vector_type(4)));
constexpr int BM = 256, BK = 64, HALF = 128, HTB = HALF * BK * 2  , STAGE_BYTES = 8 * HTB, NXCD = 8, WGM = 8;

__host__ __device__ __forceinline__ int lds_byte(int r, int c) { const int st = (r >> 4) * 2 + (c >> 5), rr = r & 15, cc = c & 31, ob = rr * 64 + cc * 2; return st * 1024 + (ob ^ (((ob >> 9) & 1) << 5)); }
__host__ __device__ __forceinline__ void stage_rc(int b, int& R, int& C) { const int st = b / 1024, sb = b % 1024, swz = sb ^ (((sb >> 9) & 1) << 5); R = (st >> 1) * 16 + swz / 64; C = (st & 1) * 32 + (swz % 64) / 2; }
__host__ __device__ __forceinline__ int perm32(int rho) { const int n = rho >> 4, i = rho & 15; return 8 * (i >> 2) + 4 * n + (i & 3); }

struct Unit { int pm, pn; };
struct Gemm { const bf16_t* A; const bf16_t* Bt; int M, N, K; };

struct StaticOrder {
    int nM, nN, nwg, G, c;
    __host__ __device__ void init(int M, int N, int G_, int c_) { nM = M / BM; nN = N / BM; nwg = nM * nN; G = G_; c = c_; }
    __host__ __device__ bool next(int i, Unit& u) const {
        const long L = (long)i * G + c; if (L >= nwg) return false;
        int wgid = (int)L; { const int q = nwg / NXCD, r = nwg % NXCD, xcd = wgid % NXCD, off = wgid / NXCD; wgid = (xcd < r ? xcd * (q + 1) : r * (q + 1) + (xcd - r) * q) + off; }
        const int nig = WGM * nN, gid = wgid / nig, fm = gid * WGM, gsz = (nM - fm) < WGM ? (nM - fm) : WGM;
        u.pm = fm + ((wgid % nig) % gsz); u.pn = (wgid % nig) / gsz; return true;
    }
    __device__ __forceinline__ void a_ready(const Unit&) const {}
    __device__ __forceinline__ void done(const Unit&) const {}
};

__device__ __forceinline__ unsigned cvt_pk_bf16(float lo, float hi) { unsigned r; asm volatile("v_cvt_pk_bf16_f32 %0, %1, %2" : "=v"(r) : "v"(lo), "v"(hi)); return r; }
template <class Epi, class Sched, bool ALIGN_EPI = false, bool SP2 = false>
__device__ __forceinline__ void gemm_phase(PG8_LAS unsigned char* lds, const Gemm g, const Sched& S, const Epi& E) {
    int tid = threadIdx.x; asm volatile("" : "+v"(tid)); const int wid = __builtin_amdgcn_readfirstlane(tid >> 6), lane = tid & 63, wr = wid >> 2, wc = wid & 3, fr = lane & 15, fq = lane >> 4;
    const int K = g.K, nt = K / BK;
    unsigned voffA[2], voffB[2];
#pragma unroll
    for (int i = 0; i < 2; ++i) { int R, C; stage_rc(tid * 16 + i * 8192, R, C); const int Rb = Epi::PERM ? ((R & ~31) + perm32(R & 31)) : R;
        voffA[i] = (unsigned)(R * K + C) * 2u; voffB[i] = (unsigned)(Rb * K + C) * 2u; }
    const size_t kstep = (size_t)(BK * 2);
    const size_t hstep = (size_t)HALF * K * 2;
    const size_t tstep = 2 * hstep;
    const unsigned ldsw = (unsigned)wid * 1024u;
    const int aoff = lds_byte(wr * 64 + fr, fq * 8), boff = lds_byte(wc * 32 + fr, fq * 8);
#define PG8_SA(b, h) (((b) * 2 + (h)) * HTB)
#define PG8_SB(b, h) ((4 + (b) * 2 + (h)) * HTB)
#define PG8_STAGE(bufoff, gbase, voff) do { _Pragma("unroll") for (int _i = 0; _i < 2; ++_i) \
        __builtin_amdgcn_global_load_lds((const unsigned*)((const char*)(gbase) + (voff)[_i]), (PG8_LAS unsigned*)(lds + (bufoff) + ldsw + _i * 8192), 16, 0, 0); } while (0)
#define PG8_LDA(dst, b, h) do { _Pragma("unroll") for (int m = 0; m < 4; ++m) _Pragma("unroll") for (int k = 0; k < 2; ++k) dst[m][k] = *(const PG8_LAS bf16x8*)(lds + PG8_SA(b, h) + aoff + m * 2048 + k * 1024); } while (0)
#define PG8_LDB(dst, b, h) do { _Pragma("unroll") for (int n = 0; n < 2; ++n) _Pragma("unroll") for (int k = 0; k < 2; ++k) dst[n][k] = *(const PG8_LAS bf16x8*)(lds + PG8_SB(b, h) + boff + n * 2048 + k * 1024); } while (0)
#define PG8_MMA(ai, bj, At, Bt) do { __builtin_amdgcn_s_setprio(1); _Pragma("unroll") for (int m = 0; m < 4; ++m) _Pragma("unroll") for (int n = 0; n < 2; ++n) _Pragma("unroll") for (int k = 0; k < 2; ++k) \
        acc[ai][bj][m][n] = __builtin_amdgcn_mfma_f32_16x16x32_bf16(Bt[n][k], At[m][k], acc[ai][bj][m][n], 0, 0, 0); __builtin_amdgcn_s_setprio(0); } while (0)
#define PG8_WAIT_V(n) asm volatile("s_waitcnt vmcnt(" #n ")" ::: "memory")
#define PG8_WAIT_L(n) asm volatile("s_waitcnt lgkmcnt(" #n ")" ::: "memory")
#define PG8_BAR __builtin_amdgcn_s_barrier()
#define PG8_SCHED __builtin_amdgcn_sched_barrier(0)
    Unit cur, nxt; int ui = 0;
    if (!S.next(0, cur)) return;
    f32x4 acc[2][2][4][2];
#pragma unroll
    for (int a = 0; a < 2; ++a)
#pragma unroll
        for (int b = 0; b < 2; ++b)
#pragma unroll
            for (int m = 0; m < 4; ++m)
#pragma unroll
                for (int n = 0; n < 2; ++n) acc[a][b][m][n] = (f32x4){0.f, 0.f, 0.f, 0.f};
    bf16x8 At[4][2], B0[2][2], B1[2][2];
    const char* cA = (const char*)g.A + (size_t)cur.pm * tstep; const char* cB = (const char*)g.Bt + (size_t)cur.pn * tstep;
    S.a_ready(cur);
    if constexpr (SP2) {
        PG8_STAGE(PG8_SB(0, 0), cB, voffB); PG8_STAGE(PG8_SB(0, 1), cB + hstep, voffB); PG8_STAGE(PG8_SA(0, 0), cA, voffA); PG8_STAGE(PG8_SA(0, 1), cA + hstep, voffA);
        if (wr == 1) PG8_BAR;
        PG8_WAIT_V(2); PG8_BAR;
        PG8_STAGE(PG8_SB(1, 0), cB + kstep, voffB); PG8_STAGE(PG8_SA(1, 0), cA + kstep, voffA); PG8_STAGE(PG8_SB(1, 1), cB + hstep + kstep, voffB);
        PG8_WAIT_V(6); PG8_BAR;
    } else {
        PG8_STAGE(PG8_SB(0, 0), cB, voffB); PG8_STAGE(PG8_SA(0, 0), cA, voffA); PG8_STAGE(PG8_SB(0, 1), cB + hstep, voffB); PG8_STAGE(PG8_SA(0, 1), cA + hstep, voffA);
        if (wr == 1) PG8_BAR;
        PG8_WAIT_V(4); PG8_BAR;
        PG8_STAGE(PG8_SB(1, 0), cB + kstep, voffB); PG8_STAGE(PG8_SA(1, 0), cA + kstep, voffA); PG8_STAGE(PG8_SB(1, 1), cB + hstep + kstep, voffB);
        PG8_WAIT_V(6); PG8_BAR;
    }
    for (;;) {
        const bool has_next = S.next(ui + 1, nxt);
        const char* nA = has_next ? (const char*)g.A + (size_t)nxt.pm * tstep : cA; const char* nB = has_next ? (const char*)g.Bt + (size_t)nxt.pn * tstep : cB;
        for (int t = 0; t < nt; t += 2) {
            const bool last = (t == nt - 2);
            const char* a1 = cA + (size_t)(t + 1) * kstep;
            const char* a2 = last ? nA : cA + (size_t)(t + 2) * kstep; const char* b2 = last ? nB : cB + (size_t)(t + 2) * kstep;
            const char* a3 = a2 + kstep; const char* b3 = b2 + kstep;
            if (last && has_next) S.a_ready(nxt);
            if constexpr (SP2) {
            PG8_LDB(B0, 0, 0); PG8_LDB(B1, 0, 1); PG8_SCHED; PG8_LDA(At, 0, 0); PG8_STAGE(PG8_SA(1, 1), a1 + hstep, voffA);
            PG8_WAIT_V(8); PG8_WAIT_L(0); PG8_BAR; PG8_MMA(0, 0, At, B0); PG8_MMA(0, 1, At, B1); PG8_BAR; PG8_SCHED;
            PG8_LDA(At, 0, 1); PG8_STAGE(PG8_SB(0, 0), b2, voffB); PG8_STAGE(PG8_SB(0, 1), b2 + hstep, voffB); PG8_STAGE(PG8_SA(0, 0), a2, voffA);
            PG8_WAIT_V(8); PG8_WAIT_L(0); PG8_BAR; PG8_MMA(1, 0, At, B0); PG8_MMA(1, 1, At, B1); PG8_BAR; PG8_SCHED;
            PG8_LDB(B0, 1, 0); PG8_LDB(B1, 1, 1); PG8_SCHED; PG8_LDA(At, 1, 0); PG8_STAGE(PG8_SA(0, 1), a2 + hstep, voffA);
            PG8_WAIT_V(8); PG8_WAIT_L(0); PG8_BAR; PG8_MMA(0, 0, At, B0); PG8_MMA(0, 1, At, B1); PG8_BAR; PG8_SCHED;
            PG8_LDA(At, 1, 1); PG8_STAGE(PG8_SB(1, 0), b3, voffB); PG8_STAGE(PG8_SB(1, 1), b3 + hstep, voffB); PG8_STAGE(PG8_SA(1, 0), a3, voffA);
            PG8_WAIT_V(8); PG8_WAIT_L(0); PG8_BAR; PG8_MMA(1, 0, At, B0); PG8_MMA(1, 1, At, B1); PG8_BAR; PG8_SCHED;
            } else {
            PG8_LDB(B0, 0, 0); PG8_SCHED; PG8_LDA(At, 0, 0); PG8_STAGE(PG8_SA(1, 1), a1 + hstep, voffA);
            PG8_WAIT_L(8); PG8_BAR; PG8_WAIT_L(0); PG8_MMA(0, 0, At, B0); PG8_BAR; PG8_SCHED;
            PG8_LDB(B1, 0, 1); PG8_STAGE(PG8_SB(0, 0), b2, voffB);
            PG8_BAR; PG8_WAIT_L(0); PG8_MMA(0, 1, At, B1); PG8_BAR;
            PG8_LDA(At, 0, 1); PG8_STAGE(PG8_SA(0, 0), a2, voffA);
            PG8_BAR; PG8_WAIT_L(0); PG8_MMA(1, 0, At, B0); PG8_BAR; PG8_SCHED;
            PG8_STAGE(PG8_SB(0, 1), b2 + hstep, voffB);
            PG8_WAIT_V(6); PG8_BAR; PG8_MMA(1, 1, At, B1); PG8_BAR;
            PG8_LDB(B0, 1, 0); PG8_SCHED; PG8_LDA(At, 1, 0); PG8_STAGE(PG8_SA(0, 1), a2 + hstep, voffA);
            PG8_WAIT_L(8); PG8_BAR; PG8_WAIT_L(0); PG8_MMA(0, 0, At, B0); PG8_BAR; PG8_SCHED;
            PG8_LDB(B1, 1, 1); PG8_STAGE(PG8_SB(1, 0), b3, voffB);
            PG8_BAR; PG8_WAIT_L(0); PG8_MMA(0, 1, At, B1); PG8_BAR;
            PG8_LDA(At, 1, 1); PG8_STAGE(PG8_SA(1, 0), a3, voffA);
            PG8_BAR; PG8_WAIT_L(0); PG8_MMA(1, 0, At, B0); PG8_BAR; PG8_SCHED;
            PG8_STAGE(PG8_SB(1, 1), b3 + hstep, voffB);
            PG8_WAIT_V(6); PG8_BAR; PG8_MMA(1, 1, At, B1); PG8_BAR;
            }
        }
        if constexpr (ALIGN_EPI) { if (wr == 0) PG8_BAR; }
        if constexpr (!Epi::AFTER_DRAIN) { E(acc, cur, wr, wc, fr, fq); S.done(cur); }
        if (!has_next) break;
#pragma unroll
        for (int a = 0; a < 2; ++a)
#pragma unroll
            for (int b = 0; b < 2; ++b)
#pragma unroll
                for (int m = 0; m < 4; ++m)
#pragma unroll
                    for (int n = 0; n < 2; ++n) acc[a][b][m][n] = (f32x4){0.f, 0.f, 0.f, 0.f};
        cur = nxt; cA = nA; cB = nB; ++ui;
        if constexpr (ALIGN_EPI) { if (wr == 1) PG8_BAR; }
    }
    PG8_WAIT_V(0);
    if constexpr (!ALIGN_EPI) { if (wr == 0) PG8_BAR; }
    PG8_BAR;
    if constexpr (Epi::AFTER_DRAIN) { E.fused(acc, cur, wr, wc, fr, fq, lds, wid, lane); S.done(cur); }
#undef PG8_SA
#undef PG8_SB
#undef PG8_STAGE
#undef PG8_LDA
#undef PG8_LDB
#undef PG8_MMA
#undef PG8_WAIT_V
#undef PG8_WAIT_L
#undef PG8_BAR
#undef PG8_SCHED
}
}

#define LAS __attribute__((address_space(3)))
typedef unsigned short bf16;
typedef short bf16x8 __attribute__((ext_vector_type(8)));
typedef short s16x4 __attribute__((ext_vector_type(4)));
typedef float f32x2 __attribute__((ext_vector_type(2)));
typedef float f32x4 __attribute__((ext_vector_type(4)));
typedef float f32x16 __attribute__((ext_vector_type(16)));
typedef unsigned u32x2 __attribute__((ext_vector_type(2)));
typedef unsigned u32x4 __attribute__((ext_vector_type(4)));
typedef __bf16 bf16x2_t __attribute__((ext_vector_type(2)));

constexpr int M_ = 65536, SEQ = 2048, DMODEL = 1024, DFF = 2816;
constexpr float EPS = 1e-6f, LOG2E = 1.4426950408889634f;
constexpr size_t MiB = 1u << 20;
constexpr size_t WS_BIAS = 0;
constexpr size_t WS_ROPE = 256 * 1024;
constexpr size_t WS_RSS = 1 * MiB;
constexpr size_t WS_SSQ = 3 * MiB;
constexpr size_t WS_SSKV = 3 * MiB + 256 * 1024;
constexpr size_t W_AIN = 4 * MiB, W_AOUT = 13 * MiB, W_BIN = 14 * MiB, W_BQUP = 16 * MiB, W_BKVUP = 18 * MiB, W_BOUT = 19 * MiB,
                 W_CIN = 21 * MiB, W_COUT = 27 * MiB, W_DIN = 29 * MiB, W_DOUT = 32 * MiB, W_FG = 34 * MiB, W_FU = 58 * MiB, W_FD = 82 * MiB, W_FSTR = 6 * MiB;
constexpr size_t WS_XB = 106 * MiB;
constexpr size_t WS_R = 234 * MiB;
constexpr size_t R_A_QKV = WS_R, R_A_O3 = WS_R + 576 * MiB, R_A_LSE = WS_R + 768 * MiB, R_A_OC = WS_R;
constexpr size_t R_B_CQ = WS_R, R_B_CKV = WS_R + 48 * MiB, R_B_KPE = WS_R + 80 * MiB, R_B_Q = WS_R + 128 * MiB, R_B_KV = WS_R + 320 * MiB, R_B_KH = WS_R + 576 * MiB, R_B_O = WS_R;
constexpr size_t R_C_QKV = WS_R, R_C_O = WS_R + 384 * MiB;
constexpr size_t R_D_QKV = WS_R, R_D_O = WS_R + 160 * MiB;
constexpr size_t R_GATE = WS_R, R_ACT = WS_R + 352 * MiB;
constexpr size_t WS_RSSP = WS_R + 774 * MiB;
constexpr size_t WS_SSQP = WS_R + 782 * MiB;
constexpr size_t WS_SSKVP = WS_R + 784 * MiB;
constexpr size_t WS_SSPE = 3 * MiB + 512 * 1024;
constexpr size_t R_B_RK = WS_R + 96 * MiB;
constexpr size_t WS_BAR = 512 * 1024;
constexpr size_t WS_NEED = WS_R + 786 * MiB;

constexpr int LDS_BYTES = 135168;

struct Args { const float* in[34]; float* out; unsigned char* ws; };

__device__ __forceinline__ unsigned pk2(float lo, float hi) { f32x2 v = {lo, hi}; bf16x2_t b = __builtin_convertvector(v, bf16x2_t); return __builtin_bit_cast(unsigned, b); }
__device__ __forceinline__ float bf2f(unsigned short h) { return __uint_as_float(((unsigned)h) << 16); }
__device__ __forceinline__ float bflo(unsigned w) { return __uint_as_float(w << 16); }
__device__ __forceinline__ float bfhi(unsigned w) { return __uint_as_float(w & 0xffff0000u); }
__device__ __forceinline__ float wave_sum(float v) {
#pragma unroll
    for (int o = 1; o < 64; o <<= 1) v += __shfl_xor(v, o);
    return v;
}
__device__ __forceinline__ float dot4(f32x4 a) { return (a[0] * a[0] + a[1] * a[1]) + (a[2] * a[2] + a[3] * a[3]); }
__device__ __forceinline__ float rowss_sum(const float* ss, int nvec, int row) {
    const f32x4* p = (const f32x4*)(ss + (size_t)row * 4 * nvec); float t = 0.f;
#pragma unroll
    for (int v = 0; v < 4; ++v) if (v < nvec) { const f32x4 q = p[v]; t += (q[0] + q[1]) + (q[2] + q[3]); }
    return t;
}

struct EpiProj {
    static constexpr bool PERM = true, AFTER_DRAIN = false;
    bf16* O; int ldc; const float* rs; int hm; const float* gq; const float* gk; float qscale;
    __device__ __forceinline__ void operator()(const f32x4 (&acc)[2][2][4][2], const pg8::Unit& u, int wr, int wc, int fr, int fq) const {
        const int hg = u.pn * 4 + wc;
        int kind = 2; const float* gain = gq;
        if (hm == 1) { const int t = (hg >> 3) % 3, gi = hg / 24; kind = t; gain = (t == 0 ? gq : gk) + gi * 64; }
        else if (hm == 2) { kind = hg < 16 ? 0 : (hg < 32 ? 1 : 2); gain = kind == 0 ? gq : gk; }
        else if (hm == 3) { kind = hg < 16 ? 0 : (hg < 18 ? 1 : 2); gain = kind == 0 ? gq : gk; }
        else if (hm == 4) { kind = (hg & 1) ? 2 : 3; gain = gk; }
        f32x4 gv[2][2];
#pragma unroll
        for (int bj = 0; bj < 2; ++bj)
#pragma unroll
            for (int n = 0; n < 2; ++n) {
                gv[bj][n] = (f32x4){1.f, 1.f, 1.f, 1.f};
                if (kind != 2) { gv[bj][n] = *(const f32x4*)(gain + 32 * bj + 8 * fq + 4 * n); if (kind == 0) gv[bj][n] = gv[bj][n] * qscale; }
            }
        bf16* colp = O + hg * 64 + 8 * fq;
        float rsv[2][4];
#pragma unroll
        for (int ai = 0; ai < 2; ++ai)
#pragma unroll
            for (int m = 0; m < 4; ++m) rsv[ai][m] = rs[u.pm * 256 + ai * 128 + wr * 64 + m * 16 + fr];
        if (kind == 3) {
#pragma unroll
            for (int ai = 0; ai < 2; ++ai)
#pragma unroll
                for (int m = 0; m < 4; ++m) {
                    const int row = u.pm * 256 + ai * 128 + wr * 64 + m * 16 + fr;
                    const float rstd = rsv[ai][m];
                    f32x4 v[2][2]; float s = 0.f;
#pragma unroll
                    for (int bj = 0; bj < 2; ++bj)
#pragma unroll
                        for (int n = 0; n < 2; ++n) { v[bj][n] = acc[ai][bj][m][n] * rstd; s += dot4(v[bj][n]); }
                    s += __shfl_xor(s, 16); s += __shfl_xor(s, 32);
                    const float rk_ = rsqrtf((s + ((const float*)((const unsigned char*)rs + (WS_SSPE - WS_SSKV)))[row]) * (1.0f / 96.0f) + EPS);
                    bf16* kp = (bf16*)((unsigned char*)O + (R_B_KH - R_B_KV)) + (size_t)row * 1536 + (hg >> 1) * 96 + 8 * fq;
#pragma unroll
                    for (int bj = 0; bj < 2; ++bj) {
                        const f32x4 a_ = v[bj][0] * rk_ * gv[bj][0], b_ = v[bj][1] * rk_ * gv[bj][1];
                        u32x4 w; w.x = pk2(a_[0], a_[1]); w.y = pk2(a_[2], a_[3]); w.z = pk2(b_[0], b_[1]); w.w = pk2(b_[2], b_[3]);
                        *(u32x4*)(kp + 32 * bj) = w;
                    }
                    const u32x4 r_ = *(const u32x4*)((const bf16*)((const unsigned char*)O - (R_B_KV - R_B_RK)) + (size_t)row * 32 + 8 * fq);
                    u32x4 w;
#pragma unroll
                    for (int j = 0; j < 4; ++j) w[j] = pk2(bflo(r_[j]) * rk_, bfhi(r_[j]) * rk_);
                    *(u32x4*)(kp + 64) = w;
                }
            return;
        }
#pragma unroll
        for (int ai = 0; ai < 2; ++ai)
#pragma unroll
            for (int m = 0; m < 4; ++m) {
                const int row = u.pm * 256 + ai * 128 + wr * 64 + m * 16 + fr;
                const float rstd = rsv[ai][m];
                f32x4 v[2][2]; float s = 0.f;
#pragma unroll
                for (int bj = 0; bj < 2; ++bj)
#pragma unroll
                    for (int n = 0; n < 2; ++n) { v[bj][n] = acc[ai][bj][m][n] * rstd; s += dot4(v[bj][n]); }
                if (kind < 2) {
                    s += __shfl_xor(s, 16); s += __shfl_xor(s, 32);
                    const float rs = rsqrtf(s * (1.0f / 64.0f) + EPS);
#pragma unroll
                    for (int bj = 0; bj < 2; ++bj)
#pragma unroll
                        for (int n = 0; n < 2; ++n) v[bj][n] = v[bj][n] * rs * gv[bj][n];
                }
#pragma unroll
                for (int bj = 0; bj < 2; ++bj) {
                    u32x4 w; w.x = pk2(v[bj][0][0], v[bj][0][1]); w.y = pk2(v[bj][0][2], v[bj][0][3]); w.z = pk2(v[bj][1][0], v[bj][1][1]); w.w = pk2(v[bj][1][2], v[bj][1][3]);
                    *(u32x4*)(colp + (size_t)row * ldc + 32 * bj) = w;
                }
            }
    }
};
struct EpiLat {
    static constexpr bool PERM = true, AFTER_DRAIN = false;
    bf16* CQ; bf16* CKV; bf16* KPE; const float* rs; float* ssq; float* sskv;
    __device__ __forceinline__ void operator()(const f32x4 (&acc)[2][2][4][2], const pg8::Unit& u, int wr, int wc, int fr, int fq) const {
        const int hg = u.pn * 4 + wc;
        if (hg > 10) return;
        bf16* dst; int ld; float* sacc = nullptr; int sst = 0;
        if (hg < 6) { dst = CQ + hg * 64; ld = 384; sacc = ssq + hg; sst = 8; } else if (hg < 10) { dst = CKV + (hg - 6) * 64; ld = 256; sacc = sskv + (hg - 6); sst = 4; } else { dst = KPE; ld = 64; }
        dst += 8 * fq;
        float rsv[2][4];
#pragma unroll
        for (int ai = 0; ai < 2; ++ai)
#pragma unroll
            for (int m = 0; m < 4; ++m) rsv[ai][m] = rs[u.pm * 256 + ai * 128 + wr * 64 + m * 16 + fr];
#pragma unroll
        for (int ai = 0; ai < 2; ++ai)
#pragma unroll
            for (int m = 0; m < 4; ++m) {
                const int row = u.pm * 256 + ai * 128 + wr * 64 + m * 16 + fr;
                const float rstd = rsv[ai][m];
                f32x4 v[2][2]; float s = 0.f;
#pragma unroll
                for (int bj = 0; bj < 2; ++bj)
#pragma unroll
                    for (int n = 0; n < 2; ++n) { v[bj][n] = acc[ai][bj][m][n] * rstd; s += dot4(v[bj][n]); }
                s += __shfl_xor(s, 16); s += __shfl_xor(s, 32);
                if (fq == 0) { if (sacc != nullptr) sacc[(size_t)row * sst] = s; else { float z_ = 0.f; asm volatile("" : "+v"(z_)); ssq[(size_t)row * 8 + 6] = z_; ssq[(size_t)row * 8 + 7] = z_; } }
#pragma unroll
                for (int bj = 0; bj < 2; ++bj) {
                    u32x4 w; w.x = pk2(v[bj][0][0], v[bj][0][1]); w.y = pk2(v[bj][0][2], v[bj][0][3]); w.z = pk2(v[bj][1][0], v[bj][1][1]); w.w = pk2(v[bj][1][2], v[bj][1][3]);
                    *(u32x4*)(dst + (size_t)row * ld + 32 * bj) = w;
                }
            }
    }
};
struct EpiRes {
    static constexpr bool PERM = true, AFTER_DRAIN = false;
    const float* base32; float* out32; bf16* xb; bf16* xbw; float* ssn;
    __device__ __forceinline__ void operator()(const f32x4 (&acc)[2][2][4][2], const pg8::Unit& u, int wr, int wc, int fr_, int fq_) const {
        int fr = fr_, fq = fq_; asm volatile("" : "+v"(fr), "+v"(fq));
        float* ssn_ = ssn; bf16* xbw_ = xbw; float* out_ = out32; const float* b32_ = base32; asm volatile("" : "+s"(ssn_), "+s"(xbw_), "+s"(out_), "+s"(b32_));
        const int col0 = u.pn * 256 + wc * 32 + 8 * fq;
#pragma unroll
        for (int ai = 0; ai < 2; ++ai) {
            f32x4 bv[4][2][2];
            if (b32_ != nullptr) {
#pragma unroll
                for (int m = 0; m < 4; ++m)
#pragma unroll
                    for (int bj = 0; bj < 2; ++bj)
#pragma unroll
                        for (int n = 0; n < 2; ++n) bv[m][bj][n] = *(const f32x4*)(b32_ + (size_t)(u.pm * 256 + ai * 128 + wr * 64 + m * 16 + fr) * DMODEL + col0 + bj * 128 + n * 4);
            } else {
                u32x4 rw[4][2];
#pragma unroll
                for (int m = 0; m < 4; ++m)
#pragma unroll
                    for (int bj = 0; bj < 2; ++bj) rw[m][bj] = *(const u32x4*)(xb + (size_t)(u.pm * 256 + ai * 128 + wr * 64 + m * 16 + fr) * DMODEL + col0 + bj * 128);
#pragma unroll
                for (int m = 0; m < 4; ++m)
#pragma unroll
                    for (int bj = 0; bj < 2; ++bj) {
                        bv[m][bj][0] = (f32x4){bflo(rw[m][bj].x), bfhi(rw[m][bj].x), bflo(rw[m][bj].y), bfhi(rw[m][bj].y)};
                        bv[m][bj][1] = (f32x4){bflo(rw[m][bj].z), bfhi(rw[m][bj].z), bflo(rw[m][bj].w), bfhi(rw[m][bj].w)};
                    }
            }
            asm volatile("" ::: "memory");
#pragma unroll
            for (int m = 0; m < 4; ++m) {
                const int row = u.pm * 256 + ai * 128 + wr * 64 + m * 16 + fr;
                float s = 0.f;
#pragma unroll
                for (int bj = 0; bj < 2; ++bj) {
                    const size_t off = (size_t)row * DMODEL + col0 + bj * 128;
                    const f32x4 o0 = bv[m][bj][0] + acc[ai][bj][m][0], o1 = bv[m][bj][1] + acc[ai][bj][m][1];
                    if (out_ != nullptr) { *(f32x4*)(out_ + off) = o0; *(f32x4*)(out_ + off + 4) = o1; }
                    if (xbw_ != nullptr) { u32x4 w; w.x = pk2(o0[0], o0[1]); w.y = pk2(o0[2], o0[3]); w.z = pk2(o1[0], o1[1]); w.w = pk2(o1[2], o1[3]); *(u32x4*)(xbw_ + off) = w; }
                    s += dot4(o0) + dot4(o1);
                }
                if (ssn_ != nullptr) { s += __shfl_xor(s, 16); s += __shfl_xor(s, 32); if (fq == 0) ssn_[(size_t)row * 16 + u.pn * 4 + wc] = s; }
            }
            asm volatile("" ::: "memory");
        }
    }
};
__device__ __forceinline__ u32x4 shfl4(u32x4 v, int src) { u32x4 r; r.x = __shfl(v.x, src, 16); r.y = __shfl(v.y, src, 16); r.z = __shfl(v.z, src, 16); r.w = __shfl(v.w, src, 16); return r; }
struct EpiGateUp {
    static constexpr bool PERM = true, AFTER_DRAIN = false;
    bf16* act; bf16* gedge; bf16* uedge; const float* rs; const float* cw; const float* cb;
    __device__ __forceinline__ void operator()(const f32x4 (&acc)[2][2][4][2], const pg8::Unit& u, int wr, int wc, int fr_, int fq_) const {
        int fr = fr_, fq = fq_; asm volatile("" : "+v"(fr), "+v"(fq));
        const int c0 = u.pn * 128 + wc * 32 + 8 * fq;
        f32x4 w0[2], w1[2], w2[2], b[2];
#pragma unroll
        for (int n = 0; n < 2; ++n) { w0[n] = *(const f32x4*)(cw + c0 + 4 * n); w1[n] = *(const f32x4*)(cw + DFF + c0 + 4 * n); w2[n] = *(const f32x4*)(cw + 2 * DFF + c0 + 4 * n); b[n] = *(const f32x4*)(cb + c0 + 4 * n); }
#pragma unroll
        for (int ai = 0; ai < 2; ++ai) {
            u32x4 g[4]; float rstd[4];
            const int strip = u.pm * 4 + ai * 2 + wr;
#pragma unroll
            for (int m = 0; m < 4; ++m) rstd[m] = rs[u.pm * 256 + ai * 128 + wr * 64 + m * 16 + fr];
#pragma unroll
            for (int m = 0; m < 4; ++m) {
                const f32x4 ga = acc[ai][0][m][0] * rstd[m], gb = acc[ai][0][m][1] * rstd[m];
                g[m].x = pk2(ga[0], ga[1]); g[m].y = pk2(ga[2], ga[3]); g[m].z = pk2(gb[0], gb[1]); g[m].w = pk2(gb[2], gb[3]);
            }
#pragma unroll
            for (int m = 0; m < 4; ++m) {
                const int row = u.pm * 256 + ai * 128 + wr * 64 + m * 16 + fr;
                const u32x4 g0 = g[m];
                u32x4 g1, g2;
#pragma unroll
                for (int d = 0; d < 4; ++d) {
                    unsigned o1_ = 0u, o2_ = 0u;
                    if (m > 0) { o1_ = __builtin_amdgcn_update_dpp(0u, g[m - 1][d], 0x121, 0xf, 0xf, false); o2_ = __builtin_amdgcn_update_dpp(0u, g[m - 1][d], 0x122, 0xf, 0xf, false); }
                    g1[d] = __builtin_amdgcn_update_dpp(o1_, g0[d], 0x111, 0xf, 0xf, false);
                    g2[d] = __builtin_amdgcn_update_dpp(o2_, g0[d], 0x112, 0xf, 0xf, false);
                }
                u32x4 w, uw;
#pragma unroll
                for (int n = 0; n < 2; ++n) {
                    float r[4], up[4];
#pragma unroll
                    for (int j = 0; j < 4; ++j) {
                        const unsigned q0 = g0[2 * n + (j >> 1)], q1 = g1[2 * n + (j >> 1)], q2 = g2[2 * n + (j >> 1)];
                        const float x0 = (j & 1) ? bfhi(q0) : bflo(q0), x1 = (j & 1) ? bfhi(q1) : bflo(q1), x2 = (j & 1) ? bfhi(q2) : bflo(q2);
                        const float cv = b[n][j] + w2[n][j] * x0 + w1[n][j] * x1 + w0[n][j] * x2;
                        const float sg = cv * __builtin_amdgcn_rcpf(1.0f + __builtin_amdgcn_exp2f(-LOG2E * cv));
                        up[j] = acc[ai][1][m][n][j] * rstd[m];
                        r[j] = sg * up[j];
                    }
                    w[2 * n] = pk2(r[0], r[1]); w[2 * n + 1] = pk2(r[2], r[3]);
                    uw[2 * n] = pk2(up[0], up[1]); uw[2 * n + 1] = pk2(up[2], up[3]);
                }
                if (m == 0) {
                    if (fr < 2) { *(u32x4*)(gedge + ((size_t)strip * 4 + fr) * DFF + c0) = g0; *(u32x4*)(uedge + ((size_t)strip * 2 + fr) * DFF + c0) = uw; }
                    else *(u32x4*)(act + (size_t)row * DFF + c0) = w;
                } else {
                    *(u32x4*)(act + (size_t)row * DFF + c0) = w;
                    if (m == 3 && fr >= 14) *(u32x4*)(gedge + ((size_t)strip * 4 + 2 + (fr - 14)) * DFF + c0) = g0;
                }
                asm volatile("" ::: "memory");
            }
        }
    }
};

__device__ __forceinline__ int crow(int r, int hi) { return (r & 3) + 8 * (r >> 2) + 4 * hi; }
struct TileGeo { int NT, TPS, ks0, res0, dil; };
template <int DQK, int DV, int KT> struct AttL {
    static constexpr int KSTR = DQK * 2 + 16, VSTR = DV * 2 + 64, KBUF = KT * KSTR, VBUF = KT * VSTR;
    static constexpr int OFF_K = 0, OFF_V = 2 * KBUF, OFF_TAB = OFF_V + 2 * VBUF;
};
template <int DQK, int DV, bool BIAS, int TABN, bool QRELOAD, int KT>
__device__ __forceinline__ void attn_pass(int qoff_, LAS unsigned char* lds, const bf16* Kb, int kpitch, const bf16* Vb, int vpitch, const TileGeo G, int my_tlo, int my_thi,
                                          int wslot_q0, int W, const bf16x8 (&qf_)[DQK / 16], float& m_, float& l_, f32x16 (&o)[DV / 32]) {
    typedef AttL<DQK, DV, KT> L;
    int tid = threadIdx.x; asm volatile("" : "+v"(tid)); const int lane = tid & 63, r32 = lane & 31, hi = lane >> 5;
    constexpr int SUB = KT / 64;
    constexpr int KCH = DQK / 8, VCH = DV / 8, NKC = KT * KCH, NVC = KT * VCH, NKL = (NKC + 511) / 512, NVL = (NVC + 511) / 512;
    u32x4 kr[NKL], vr[NVL];
    const LAS float* tab = (const LAS float*)(lds + L::OFF_TAB);
    const int slot_q = wslot_q0 + r32;
    const int vlane = (4 * hi + ((lane & 15) >> 2)) * L::VSTR + (16 * ((lane >> 4) & 1) + 4 * (lane & 3)) * 2;
#define ATT_LOAD(t) do { const int seg_ = ((t) * SUB) / G.TPS, tis_ = (t) * SUB - seg_ * G.TPS; const int tok0_ = G.res0 + seg_ + G.dil * (G.ks0 + 64 * tis_); \
        _Pragma("unroll") for (int i_ = 0; i_ < NKL; ++i_) { const int c_ = tid + 512 * i_; if ((NKC % 512 == 0) || c_ < NKC) { const int j_ = c_ / KCH, p_ = c_ - j_ * KCH; \
            kr[i_] = *(const u32x4*)(Kb + (size_t)(tok0_ + G.dil * j_) * kpitch + p_ * 8); } } \
        _Pragma("unroll") for (int i_ = 0; i_ < NVL; ++i_) { const int c_ = tid + 512 * i_; if ((NVC % 512 == 0) || c_ < NVC) { const int j_ = c_ / VCH, p_ = c_ - j_ * VCH; \
            vr[i_] = *(const u32x4*)(Vb + (size_t)(tok0_ + G.dil * j_) * vpitch + p_ * 8); } } } while (0)
#define ATT_STORE(buf) do { \
        _Pragma("unroll") for (int i_ = 0; i_ < NKL; ++i_) { const int c_ = tid + 512 * i_; if ((NKC % 512 == 0) || c_ < NKC) { const int j_ = c_ / KCH, p_ = c_ - j_ * KCH; \
            *(LAS u32x4*)(lds + L::OFF_K + (buf) * L::KBUF + j_ * L::KSTR + p_ * 16) = kr[i_]; } } \
        _Pragma("unroll") for (int i_ = 0; i_ < NVL; ++i_) { const int c_ = tid + 512 * i_; if ((NVC % 512 == 0) || c_ < NVC) { const int j_ = c_ / VCH, p_ = c_ - j_ * VCH; \
            *(LAS u32x4*)(lds + L::OFF_V + (buf) * L::VBUF + j_ * L::VSTR + p_ * 16) = vr[i_]; } } } while (0)
    ATT_LOAD(0);
    ATT_STORE(0);
    float m = m_, l = l_;
    const int NT2 = G.NT / SUB;
    for (int t = 0; t < NT2; ++t) {
        const int buf = t & 1;
        if (t + 1 < NT2) ATT_LOAD(t + 1);
        __syncthreads();
#pragma unroll
        for (int hf = 0; hf < SUB; ++hf) {
        const int st = t * SUB + hf;
        if (st >= my_tlo && st <= my_thi) {
            const int tis = st % G.TPS, slot0 = G.ks0 + 64 * tis;
            const LAS unsigned char* Kt = lds + L::OFF_K + buf * L::KBUF + (hf * 64 + r32) * L::KSTR + hi * 16;
            f32x16 s[2];
            const int dsb = slot_q - slot0 - 4 * hi;
            bf16x8 qf[DQK / 16];
            if (QRELOAD) {
#pragma unroll
                for (int ks = 0; ks < DQK / 16; ++ks) qf[ks] = *(const LAS bf16x8*)(lds + qoff_ + ks * 32); }
            else {
#pragma unroll
                for (int ks = 0; ks < DQK / 16; ++ks) qf[ks] = qf_[ks]; }
#pragma unroll
            for (int kb = 0; kb < 2; ++kb) {
#pragma unroll
                for (int r = 0; r < 16; ++r) s[kb][r] = BIAS ? tab[dsb + 128 - (32 * kb + (r & 3) + 8 * (r >> 2))] : 0.f;
            }
            if (DV == 64) {
                bf16x8 kf[2][DQK / 16];
#pragma unroll
                for (int kb = 0; kb < 2; ++kb)
#pragma unroll
                    for (int ks = 0; ks < DQK / 16; ++ks) kf[kb][ks] = *(const LAS bf16x8*)(Kt + kb * 32 * L::KSTR + ks * 32);
                asm volatile("" ::: "memory");
#pragma unroll
                for (int ks = 0; ks < DQK / 16; ++ks)
#pragma unroll
                    for (int kb = 0; kb < 2; ++kb) s[kb] = __builtin_amdgcn_mfma_f32_32x32x16_bf16(kf[kb][ks], qf[ks], s[kb], 0, 0, 0);
            } else {
#pragma unroll
                for (int kh = 0; kh < 2; ++kh) {
                    bf16x8 kf[2][DQK / 32];
#pragma unroll
                    for (int kb = 0; kb < 2; ++kb)
#pragma unroll
                        for (int k2 = 0; k2 < DQK / 32; ++k2) kf[kb][k2] = *(const LAS bf16x8*)(Kt + kb * 32 * L::KSTR + (kh * (DQK / 32) + k2) * 32);
                    asm volatile("" ::: "memory");
#pragma unroll
                    for (int k2 = 0; k2 < DQK / 32; ++k2)
#pragma unroll
                        for (int kb = 0; kb < 2; ++kb) s[kb] = __builtin_amdgcn_mfma_f32_32x32x16_bf16(kf[kb][k2], qf[kh * (DQK / 32) + k2], s[kb], 0, 0, 0);
                }
            }
            const bool full = (wslot_q0 - slot0 - 63 >= 0) && (wslot_q0 + 31 - slot0 <= W);
            if (!full && !BIAS) {
#pragma unroll
                for (int kb = 0; kb < 2; ++kb)
#pragma unroll
                    for (int r = 0; r < 16; ++r) {
                        const int ds = dsb - (32 * kb + (r & 3) + 8 * (r >> 2));
                        s[kb][r] = ((unsigned)ds <= (unsigned)W) ? s[kb][r] : -INFINITY;
                    }
            }
            float mx = s[0][0];
#pragma unroll
            for (int r = 1; r < 16; ++r) mx = fmaxf(mx, s[0][r]);
#pragma unroll
            for (int r = 0; r < 16; ++r) mx = fmaxf(mx, s[1][r]);
            mx = fmaxf(mx, __shfl_xor(mx, 32));
            const float mn = fmaxf(m, mx);
            const float base = (mn == -INFINITY) ? 0.f : mn;
            const float alpha = __builtin_amdgcn_exp2f(m - base);
            m = mn;
            float ps = 0.f;
#pragma unroll
            for (int kb = 0; kb < 2; ++kb)
#pragma unroll
                for (int r = 0; r < 16; ++r) { const float p = __builtin_amdgcn_exp2f(s[kb][r] - base); s[kb][r] = p; ps += p; }
            l = l * alpha + ps;
            if (__any(alpha != 1.0f)) {
#pragma unroll
                for (int c = 0; c < DV / 32; ++c)
#pragma unroll
                    for (int r = 0; r < 16; ++r) o[c][r] *= alpha;
            }
            const LAS unsigned char* Vt = lds + L::OFF_V + buf * L::VBUF + hf * 64 * L::VSTR + vlane;
#pragma unroll
            for (int kb = 0; kb < 2; ++kb) {
                bf16x8 pb[2];
#pragma unroll
                for (int k2 = 0; k2 < 2; ++k2) {
                    u32x4 pw; pw.x = pk2(s[kb][8 * k2 + 0], s[kb][8 * k2 + 1]); pw.y = pk2(s[kb][8 * k2 + 2], s[kb][8 * k2 + 3]);
                    pw.z = pk2(s[kb][8 * k2 + 4], s[kb][8 * k2 + 5]); pw.w = pk2(s[kb][8 * k2 + 6], s[kb][8 * k2 + 7]);
                    pb[k2] = __builtin_bit_cast(bf16x8, pw);
                }
#pragma unroll
                for (int ch = 0; ch < DV / 64; ++ch) {
                    bf16x8 vf[2][2];
#pragma unroll
                    for (int k2 = 0; k2 < 2; ++k2)
#pragma unroll
                        for (int c2 = 0; c2 < 2; ++c2) {
                            const LAS unsigned char* vp = Vt + (32 * kb + 16 * k2) * L::VSTR + 64 * (2 * ch + c2);
                            const s16x4 lo = __builtin_bit_cast(s16x4, __builtin_amdgcn_ds_read_tr16_b64_v4i16((LAS s16x4*)(vp)));
                            const s16x4 hh = __builtin_bit_cast(s16x4, __builtin_amdgcn_ds_read_tr16_b64_v4i16((LAS s16x4*)(vp + 8 * L::VSTR)));
                            vf[k2][c2] = (bf16x8){lo[0], lo[1], lo[2], lo[3], hh[0], hh[1], hh[2], hh[3]};
                        }
                    asm volatile("" ::: "memory");
#pragma unroll
                    for (int k2 = 0; k2 < 2; ++k2)
#pragma unroll
                        for (int c2 = 0; c2 < 2; ++c2) o[2 * ch + c2] = __builtin_amdgcn_mfma_f32_32x32x16_bf16(vf[k2][c2], pb[k2], o[2 * ch + c2], 0, 0, 0);
                }
            }
        }
        }
        if (t + 1 < NT2) ATT_STORE(buf ^ 1);
    }
    __syncthreads();
    m_ = m; l_ = l;
#undef ATT_LOAD
#undef ATT_STORE
}

template <int MODE>
__device__ __forceinline__ void attn_phase(LAS unsigned char* lds, const Args& a, int Gn, int cid) {
    constexpr int DQK = MODE == 1 ? 96 : 64, DV = MODE == 2 ? 128 : 64;
    constexpr bool BIAS = MODE != 1;
    constexpr int TABN = MODE == 2 ? 2048 + 256 : 512;
    constexpr int NU = MODE == 0 ? 6144 : (MODE == 2 ? 2048 : 4096);
    constexpr int KT = MODE == 2 ? 64 : 128;
    typedef AttL<DQK, DV, KT> L;
    int tid = threadIdx.x; asm volatile("" : "+v"(tid)); const int lane = tid & 63, r32 = lane & 31, hi = lane >> 5, wid = __builtin_amdgcn_readfirstlane(tid >> 6);
    unsigned char* ws = a.ws;
    const float* biasd = (const float*)(ws + WS_BIAS);
    LAS float* tab = (LAS float*)(lds + L::OFF_TAB);
    float lam = 0.f, lam_init = 0.f;
    if (MODE == 2) {
        float d1 = 0.f, d2 = 0.f;
        for (int i = 0; i < 64; ++i) { d1 += a.in[19][i] * a.in[20][i]; d2 += a.in[21][i] * a.in[22][i]; }
        lam_init = 0.8f - 0.6f * expf(-0.3f * 2.0f);
        lam = expf(d1) - expf(d2) + lam_init;
    }
    for (int u = cid; u < NU; u += Gn) {
        int b, h, dil = 1, res0 = 0, s0, nres = 1, W, qb = 0, g = 0;
        if (MODE == 0) { g = u >> 11; const int rem = u & 2047; b = rem >> 6; h = (rem >> 3) & 7; const int blk = rem & 7; W = 128;
            if (g == 0) { s0 = 256 * blk; } else if (g == 1) { dil = 4; res0 = blk >> 1; s0 = 256 * (blk & 1); } else { dil = 16; res0 = 2 * blk; s0 = 0; nres = 2; } }
        else if (MODE == 3) { b = u >> 7; h = (u >> 3) & 15; s0 = 256 * (u & 7); W = 127; }
        else if (MODE == 1) { const int bh = u & 511; qb = 7 - (u >> 9); b = bh >> 4; h = bh & 15; s0 = 256 * qb; W = 1 << 20; }
        else { const int bh = u & 255; qb = 7 - (u >> 8); b = bh >> 3; h = bh & 7; s0 = 256 * qb; W = 1 << 20; }
        TileGeo G;
        G.dil = dil; G.res0 = res0;
        const int Lseg = 256 / nres;
        if (MODE == 0 || MODE == 3) { G.ks0 = (nres == 1 && s0 >= 128) ? s0 - 128 : 0; } else { G.ks0 = 0; }
        G.TPS = (s0 + Lseg - G.ks0) >> 6; G.NT = G.TPS * nres;
        const int nws = 8 / nres, seg_w = wid / nws, wslot_q0 = s0 + 32 * (wid - seg_w * nws);
        int tl = 0;
        if (MODE == 0 || MODE == 3) { tl = wslot_q0 - W - G.ks0; tl = tl < 0 ? 0 : (tl >> 6); }
        const int th = (wslot_q0 + 31 - G.ks0) >> 6;
        const int my_tlo = seg_w * G.TPS + tl, my_thi = seg_w * G.TPS + th;
        const int qtok = res0 + seg_w + dil * (wslot_q0 + r32);
        const size_t row_q = (size_t)b * SEQ + qtok, row_b = (size_t)b * SEQ;
        const bf16 *Qp, *Kb, *Vb; int qpitch, kpitch, vpitch;
        if (MODE == 0) { const bf16* base = (const bf16*)(ws + R_A_QKV); qpitch = kpitch = vpitch = 4608;
            Qp = base + row_q * 4608 + g * 1536 + h * 64; Kb = base + row_b * 4608 + g * 1536 + 512 + h * 64; Vb = base + row_b * 4608 + g * 1536 + 1024 + h * 64; }
        else if (MODE == 1) { qpitch = 1536; kpitch = 1536; vpitch = 2048;
            Qp = (const bf16*)(ws + R_B_Q) + row_q * 1536 + h * 96; Kb = (const bf16*)(ws + R_B_KH) + row_b * 1536 + h * 96; Vb = (const bf16*)(ws + R_B_KV) + row_b * 2048 + h * 128 + 64; }
        else if (MODE == 2) { const bf16* base = (const bf16*)(ws + R_C_QKV); qpitch = kpitch = vpitch = 3072;
            Qp = base + row_q * 3072 + (2 * h) * 64; Kb = base + row_b * 3072 + 1024 + (2 * h) * 64; Vb = base + row_b * 3072 + 2048 + h * 128; }
        else { const bf16* base = (const bf16*)(ws + R_D_QKV); qpitch = kpitch = vpitch = 1280;
            Qp = base + row_q * 1280 + h * 64; Kb = base + row_b * 1280 + 1024 + (h >> 3) * 64; Vb = base + row_b * 1280 + 1152 + (h >> 3) * 64; }
        (void)qpitch;
        if (MODE == 0 || MODE == 3) { const int d_ = tid - 128; tab[tid] = (d_ >= 0 && d_ <= W) ? biasd[h * 2048 + d_ * dil] : -INFINITY; }
        if (MODE == 2) {
#pragma unroll
            for (int j = 0; j < 4; ++j) tab[128 + tid + 512 * j] = biasd[h * 2048 + tid + 512 * j];
            if (tid < 128) { tab[tid] = -INFINITY; tab[2176 + tid] = 0.f; } }
        bf16x8 qf[DQK / 16];
        constexpr int OFF_Q = L::OFF_TAB + TABN * 4, QSTR = DQK * 2 + 16;
        const int qoff = OFF_Q + (32 * wid + r32) * QSTR + hi * 16;
        int tq = tid; asm volatile("" : "+v"(tq));
        if (MODE == 2) {
            const bf16* qsrc = (const bf16*)(ws + R_C_QKV) + (row_b + s0) * 3072 + (2 * h) * 64;
#pragma unroll
            for (int j = 0; j < 4; ++j) { const int c_ = tq + 512 * j, rw = c_ >> 3, p_ = c_ & 7;
                *(LAS u32x4*)(lds + OFF_Q + rw * QSTR + p_ * 16) = *(const u32x4*)(qsrc + (size_t)rw * 3072 + p_ * 8); }
        } else {
#pragma unroll
            for (int ks = 0; ks < DQK / 16; ++ks) qf[ks] = *(const bf16x8*)(Qp + 16 * ks + 8 * hi);
            if (MODE == 1) {
                float x[DQK / 16][8]; float ss = 0.f;
#pragma unroll
                for (int ks = 0; ks < DQK / 16; ++ks) { const u32x4 raw = __builtin_bit_cast(u32x4, qf[ks]);
#pragma unroll
                    for (int j = 0; j < 4; ++j) { x[ks][2 * j] = bflo(raw[j]); x[ks][2 * j + 1] = bfhi(raw[j]); ss += x[ks][2 * j] * x[ks][2 * j] + x[ks][2 * j + 1] * x[ks][2 * j + 1]; } }
                ss += __shfl_xor(ss, 32);
                const float rsq = rsqrtf(ss * (1.0f / 96.0f) + EPS) * (0.10206207261596577f * LOG2E);
                const float* gq_ = a.in[13];
#pragma unroll
                for (int ks = 0; ks < DQK / 16; ++ks) { const f32x4 g0 = *(const f32x4*)(gq_ + 16 * ks + 8 * hi), g1 = *(const f32x4*)(gq_ + 16 * ks + 8 * hi + 4);
#pragma unroll
                    for (int j = 0; j < 4; ++j) { x[ks][j] *= rsq * g0[j]; x[ks][4 + j] *= rsq * g1[j]; } }
                const float* cs = (const float*)(ws + WS_ROPE) + ((size_t)qtok * 16 + 8 * hi) * 2;
#pragma unroll
                for (int j = 0; j < 8; ++j) { const float co = cs[2 * j], si = cs[2 * j + 1], x1 = x[4][j], x2 = x[5][j]; x[4][j] = x1 * co - x2 * si; x[5][j] = x2 * co + x1 * si; }
#pragma unroll
                for (int ks = 0; ks < DQK / 16; ++ks) { u32x4 w;
#pragma unroll
                    for (int j = 0; j < 4; ++j) w[j] = pk2(x[ks][2 * j], x[ks][2 * j + 1]);
                    qf[ks] = __builtin_bit_cast(bf16x8, w); }
            }
        }
        f32x16 o[DV / 32];
#pragma unroll
        for (int c = 0; c < DV / 32; ++c)
#pragma unroll
            for (int r = 0; r < 16; ++r) o[c][r] = 0.f;
        float m = -INFINITY, l = 0.f;
        if (MODE == 3) { m = a.in[28][h] * LOG2E; l = hi == 0 ? 1.f : 0.f; }
        attn_pass<DQK, DV, BIAS, TABN, MODE == 2, KT>(qoff, lds, Kb, kpitch, Vb, vpitch, G, my_tlo, my_thi, wslot_q0, W, qf, m, l, o);
        float lt = l + __shfl_xor(l, 32);
        float inv = 1.0f / lt;
        if (MODE != 2) {
            bf16* Op; int opitch;
            if (MODE == 0) { Op = (bf16*)(ws + R_A_O3) + ((size_t)g * M_ + row_q) * 512 + h * 64; opitch = 512;
                if (hi == 0) ((float*)(ws + R_A_LSE))[((size_t)g * M_ + row_q) * 8 + h] = m + __log2f(lt); }
            else if (MODE == 1) { Op = (bf16*)(ws + R_B_O) + row_q * 1024 + h * 64; opitch = 1024; }
            else { Op = (bf16*)(ws + R_D_O) + row_q * 1024 + h * 64; opitch = 1024; }
            (void)opitch;
#pragma unroll
            for (int c = 0; c < DV / 32; ++c)
#pragma unroll
                for (int k = 0; k < 2; ++k) {
                    u32x2 we, wo; we.x = pk2(o[c][8 * k] * inv, o[c][8 * k + 1] * inv); we.y = pk2(o[c][8 * k + 2] * inv, o[c][8 * k + 3] * inv);
                    wo.x = pk2(o[c][8 * k + 4] * inv, o[c][8 * k + 5] * inv); wo.y = pk2(o[c][8 * k + 6] * inv, o[c][8 * k + 7] * inv);
                    const u32x2 snd = hi ? we : wo, mine = hi ? wo : we;
                    u32x2 rcv; rcv.x = __shfl_xor(snd.x, 32); rcv.y = __shfl_xor(snd.y, 32);
                    u32x4 w; if (hi) { w.x = rcv.x; w.y = rcv.y; w.z = mine.x; w.w = mine.y; } else { w.x = mine.x; w.y = mine.y; w.z = rcv.x; w.w = rcv.y; }
                    *(u32x4*)(Op + 32 * c + 8 * (2 * k + hi)) = w;
                }
        } else {
            f32x16 o1[DV / 32];
#pragma unroll
            for (int c = 0; c < DV / 32; ++c)
#pragma unroll
                for (int r = 0; r < 16; ++r) { o1[c][r] = o[c][r] * inv; o[c][r] = 0.f; }
#pragma unroll
            for (int j = 0; j < 4; ++j) tab[128 + tid + 512 * j] = biasd[(8 + h) * 2048 + tid + 512 * j];
            { const bf16* qsrc = (const bf16*)(ws + R_C_QKV) + (row_b + s0) * 3072 + (2 * h + 1) * 64;
#pragma unroll
              for (int j = 0; j < 4; ++j) { const int c_ = tq + 512 * j, rw = c_ >> 3, p_ = c_ & 7;
                  *(LAS u32x4*)(lds + OFF_Q + rw * QSTR + p_ * 16) = *(const u32x4*)(qsrc + (size_t)rw * 3072 + p_ * 8); } }
            m = -INFINITY; l = 0.f;
            attn_pass<DQK, DV, BIAS, TABN, MODE == 2, KT>(qoff, lds, Kb + 64, kpitch, Vb, vpitch, G, my_tlo, my_thi, wslot_q0, W, qf, m, l, o);
            lt = l + __shfl_xor(l, 32);
            inv = lam / lt;
            float ssum = 0.f;
#pragma unroll
            for (int c = 0; c < DV / 32; ++c)
#pragma unroll
                for (int r = 0; r < 16; ++r) { const float d = o1[c][r] - o[c][r] * inv; o1[c][r] = d; ssum += d * d; }
            ssum += __shfl_xor(ssum, 32);
            const float rs = rsqrtf(ssum * (1.0f / 128.0f) + EPS) * (1.0f - lam_init);
            bf16* Op = (bf16*)(ws + R_C_O) + row_q * 1024 + h * 128;
            const float* sub = a.in[23];
#pragma unroll
            for (int c = 0; c < DV / 32; ++c)
#pragma unroll
                for (int k = 0; k < 2; ++k) {
                    const f32x4 se = *(const f32x4*)(sub + 32 * c + 16 * k + 4 * hi), so = *(const f32x4*)(sub + 32 * c + 16 * k + 8 + 4 * hi);
                    u32x2 we, wo; we.x = pk2(o1[c][8 * k] * rs * se[0], o1[c][8 * k + 1] * rs * se[1]); we.y = pk2(o1[c][8 * k + 2] * rs * se[2], o1[c][8 * k + 3] * rs * se[3]);
                    wo.x = pk2(o1[c][8 * k + 4] * rs * so[0], o1[c][8 * k + 5] * rs * so[1]); wo.y = pk2(o1[c][8 * k + 6] * rs * so[2], o1[c][8 * k + 7] * rs * so[3]);
                    const u32x2 snd = hi ? we : wo, mine = hi ? wo : we;
                    u32x2 rcv; rcv.x = __shfl_xor(snd.x, 32); rcv.y = __shfl_xor(snd.y, 32);
                    u32x4 w; if (hi) { w.x = rcv.x; w.y = rcv.y; w.z = mine.x; w.w = mine.y; } else { w.x = mine.x; w.y = mine.y; w.z = rcv.x; w.w = rcv.y; }
                    *(u32x4*)(Op + 32 * c + 8 * (2 * k + hi)) = w;
                }
        }
    }
}

__device__ __forceinline__ void transpose_item(const float* W, int ldw, int ncol0, int K, const float* ksc, bf16* WT, int mode, LAS float* scr, int nblk, int item, int lane) {
    const int kb = item / nblk, nb = item - kb * nblk, k0 = 64 * kb, n0 = 32 * nb;
#pragma unroll
    for (int i = 0; i < 32; ++i) { const int kk = 2 * i + (lane >> 5); float v = W[(size_t)(k0 + kk) * ldw + ncol0 + n0 + (lane & 31)]; if (ksc != nullptr) v *= ksc[k0 + kk]; scr[kk * 33 + (lane & 31)] = v; }
    asm volatile("s_waitcnt lgkmcnt(0)" ::: "memory");
    const int drow0 = mode == 1 ? (256 * (n0 >> 8) + 128 * ((n0 & 63) >> 5) + 32 * ((n0 >> 6) & 3)) : mode == 2 ? (n0 < DFF ? 256 * (n0 >> 7) + (n0 & 127) : 256 * ((n0 - DFF) >> 7) + 128 + ((n0 - DFF) & 127)) : n0;
    const int c = lane & 7;
#pragma unroll
    for (int j = 0; j < 4; ++j) { const int n = (lane >> 3) + 8 * j; const LAS float* s = scr + (8 * c) * 33 + n;
        u32x4 o; o.x = pk2(s[0 * 33], s[1 * 33]); o.y = pk2(s[2 * 33], s[3 * 33]); o.z = pk2(s[4 * 33], s[5 * 33]); o.w = pk2(s[6 * 33], s[7 * 33]);
        *(u32x4*)(WT + (size_t)(drow0 + n) * K + k0 + 8 * c) = o; }
    asm volatile("s_waitcnt lgkmcnt(0)" ::: "memory");
}
__device__ __forceinline__ void prologue(LAS unsigned char* lds, const Args& a, int Gn, int cid) {
    int tid = threadIdx.x; asm volatile("" : "+v"(tid)); const int lane = tid & 63, wid = __builtin_amdgcn_readfirstlane(tid >> 6);
    unsigned char* ws = a.ws;
    LAS float* scr = (LAS float*)(lds + wid * 16384);
    const int gw = cid * 8 + wid, NGW = Gn * 8;
#define MAT_DESC(id) \
        const float* W; int ldw, ncol0 = 0, K, N, mode; const float* ksc = nullptr; size_t dst; \
        if (id == 0) { W = a.in[4]; ldw = 4608; K = 1024; N = 4608; ksc = a.in[2]; dst = W_AIN; mode = 1; } \
        else if (id == 1) { W = a.in[7]; ldw = 1024; K = 512; N = 1024; dst = W_AOUT; mode = 0; } \
        else if (id == 2) { W = a.in[8]; ldw = 672; K = 1024; N = 672; ksc = a.in[2] + 1024; dst = W_BIN; mode = 1; } \
        else if (id == 3) { W = a.in[11]; ldw = 1536; K = 384; N = 1536; ksc = a.in[9]; dst = W_BQUP; mode = 1; } \
        else if (id == 4) { W = a.in[12]; ldw = 2048; K = 256; N = 2048; ksc = a.in[10]; dst = W_BKVUP; mode = 1; } \
        else if (id == 5) { W = a.in[15]; ldw = 1024; K = 1024; N = 1024; dst = W_BOUT; mode = 0; } \
        else if (id == 6) { W = a.in[16]; ldw = 3072; K = 1024; N = 3072; ksc = a.in[2] + 2048; dst = W_CIN; mode = 1; } \
        else if (id == 7) { W = a.in[24]; ldw = 1024; K = 1024; N = 1024; dst = W_COUT; mode = 0; } \
        else if (id == 8) { W = a.in[25]; ldw = 1280; K = 1024; N = 1280; ksc = a.in[2] + 3072; dst = W_DIN; mode = 1; } \
        else if (id == 9) { W = a.in[29]; ldw = 1024; K = 1024; N = 1024; dst = W_DOUT; mode = 0; } \
        else { const int l = (id - 10) / 3, k3 = (id - 10) - 3 * l; \
            if (k3 < 2) { W = a.in[30] + (size_t)l * 1024 * 5632; ldw = 5632; K = 1024; N = 5632; ksc = a.in[3] + 1024 * l; dst = W_FG + l * 2 * W_FSTR; mode = 2; } \
            else { W = a.in[33] + (size_t)l * 2816 * 1024; ldw = 1024; K = 2816; N = 1024; dst = W_FD + l * W_FSTR; mode = 0; } }
    constexpr int TOTAL_ITEMS = 2304 + 256 + 336 + 288 + 256 + 512 + 1536 + 512 + 640 + 512 + 4 * (1408 + 1408 + 1408);
    for (int it = gw; it < TOTAL_ITEMS; it += NGW) {
        int r = it, id = 0;
        for (; id < 21; ++id) {
            int n_;
            if (id < 10) { n_ = id == 0 ? 2304 : id == 1 ? 256 : id == 2 ? 336 : id == 3 ? 288 : id == 4 ? 256 : id == 5 ? 512 : id == 6 ? 1536 : id == 7 ? 512 : id == 8 ? 640 : 512; } else { const int k3_ = (id - 10) % 3; n_ = k3_ == 0 ? 2816 : (k3_ == 1 ? 0 : 1408); }
            if (r < n_) break;
            r -= n_;
        }
        MAT_DESC(id)
        const int nblk = N / 32;
        transpose_item(W, ldw, ncol0, K, ksc, (bf16*)(ws + dst), mode, scr, nblk, r, lane);
    }
#undef MAT_DESC
    const int gt = cid * 512 + tid, NT = Gn * 512;
    { float* biasd = (float*)(ws + WS_BIAS); const float* table = a.in[1];
      for (int i = gt; i < 16 * 2048; i += NT) { const int h = i >> 11, d = i & 2047; int bk = d;
          if (d >= 16) { float t = logf((float)d / 16.0f); t = t / 4.852030263919617f; t = t * 16.0f; int lg = 16 + (int)t; bk = lg < 31 ? lg : 31; }
          biasd[i] = table[bk * 16 + h] * LOG2E; } }
    { float* rope = (float*)(ws + WS_ROPE);
      for (int i = gt; i < 2048 * 16; i += NT) { const int pos = i >> 4, f = i & 15; const float inv = powf(10000.0f, -(float)(2 * f) / 32.0f); const float ang = (float)pos * inv;
          rope[2 * i] = cosf(ang); rope[2 * i + 1] = sinf(ang); } }
    { const float* x = a.in[0]; bf16* xb = (bf16*)(ws + WS_XB); float* rss = (float*)(ws + WS_RSS);
      for (int m0 = gw; m0 < M_; m0 += 4 * NGW) {
          f32x4 v[4][4];
#pragma unroll
          for (int k = 0; k < 4; ++k) { const int m = m0 + k * NGW; if (m < M_) { const f32x4* xr = (const f32x4*)(x + (size_t)m * DMODEL) + lane;
#pragma unroll
              for (int j = 0; j < 4; ++j) v[k][j] = xr[64 * j]; } }
#pragma unroll
          for (int k = 0; k < 4; ++k) { const int m = m0 + k * NGW; if (m < M_) { u32x2* o8 = (u32x2*)(xb + (size_t)m * DMODEL) + lane; float s = 0.f;
#pragma unroll
              for (int j = 0; j < 4; ++j) { s += dot4(v[k][j]); u32x2 w; w.x = pk2(v[k][j][0], v[k][j][1]); w.y = pk2(v[k][j][2], v[k][j][3]); o8[64 * j] = w; }
              s = wave_sum(s); if (lane == 0) rss[m] = rsqrtf(s * (1.0f / 1024.0f) + EPS); } } } }
}
__device__ __forceinline__ void combine_a(const Args& a, int Gn, int cid) {
    unsigned char* ws = a.ws;
    const bf16* o3 = (const bf16*)(ws + R_A_O3); const float* lse = (const float*)(ws + R_A_LSE); bf16* oc = (bf16*)(ws + R_A_OC);
    const size_t NT = (size_t)Gn * 512; int tid = threadIdx.x; asm volatile("" : "+v"(tid));
    for (size_t idx0 = (size_t)cid * 512 + tid; idx0 < (size_t)M_ * 64; idx0 += 4 * NT) {
        u32x4 a0[4], a1[4], a2[4]; float l0[4], l1[4], l2[4];
#pragma unroll
        for (int k = 0; k < 4; ++k) { const size_t idx = idx0 + k * NT; if (idx < (size_t)M_ * 64) {
            const size_t row = idx >> 6; const int ch = (int)(idx & 63), h = ch >> 3;
            l0[k] = lse[row * 8 + h]; l1[k] = lse[((size_t)M_ + row) * 8 + h]; l2[k] = lse[((size_t)2 * M_ + row) * 8 + h];
            a0[k] = *(const u32x4*)(o3 + row * 512 + ch * 8); a1[k] = *(const u32x4*)(o3 + ((size_t)M_ + row) * 512 + ch * 8); a2[k] = *(const u32x4*)(o3 + ((size_t)2 * M_ + row) * 512 + ch * 8); } }
#pragma unroll
        for (int k = 0; k < 4; ++k) { const size_t idx = idx0 + k * NT; if (idx < (size_t)M_ * 64) {
            const size_t row = idx >> 6; const int ch = (int)(idx & 63);
            const float mx = fmaxf(l0[k], fmaxf(l1[k], l2[k]));
            float w0 = __builtin_amdgcn_exp2f(l0[k] - mx), w1 = __builtin_amdgcn_exp2f(l1[k] - mx), w2 = __builtin_amdgcn_exp2f(l2[k] - mx);
            const float inv = 1.0f / (w0 + w1 + w2); w0 *= inv; w1 *= inv; w2 *= inv;
            u32x4 r;
#pragma unroll
            for (int j = 0; j < 4; ++j) r[j] = pk2(w0 * bflo(a0[k][j]) + w1 * bflo(a1[k][j]) + w2 * bflo(a2[k][j]), w0 * bfhi(a0[k][j]) + w1 * bfhi(a1[k][j]) + w2 * bfhi(a2[k][j]));
            *(u32x4*)(oc + row * 512 + ch * 8) = r; } }
    }
}
__device__ __forceinline__ void prep_b(const Args& a, int Gn, int cid) {
    unsigned char* ws = a.ws;
    int tid = threadIdx.x; asm volatile("" : "+v"(tid)); const int lane = tid & 63, wid = __builtin_amdgcn_readfirstlane(tid >> 6);
    bf16* Q = (bf16*)(ws + R_B_Q); const bf16* KV = (const bf16*)(ws + R_B_KV); const bf16* KPE = (const bf16*)(ws + R_B_KPE); bf16* KH = (bf16*)(ws + R_B_KH);
    const float* rope = (const float*)(ws + WS_ROPE);
    const int sub = lane >> 4, c = lane & 15;
    const float qscale = 0.10206207261596577f * LOG2E;
    const int gw = cid * 8 + wid, NGW = Gn * 8;
    const int TOT = 2 * M_ * 4;
    for (int it0 = M_ * 4 + gw; it0 < TOT; it0 += 4 * NGW) {
        u32x4 raw[4];
#pragma unroll
        for (int k = 0; k < 4; ++k) {
            const int it = it0 + k * NGW;
            raw[k] = (u32x4){0u, 0u, 0u, 0u};
            if (it < TOT && c < 12) {
                const bool isk = it >= M_ * 4; const int it2 = isk ? it - M_ * 4 : it;
                const int task = it2 * 4 + sub; const size_t row = (size_t)(task >> 4); const int h = task & 15;
                if (!isk) raw[k] = *(const u32x4*)(Q + row * 1536 + h * 96 + 8 * c);
                else if (c < 8) raw[k] = *(const u32x4*)(KV + row * 2048 + h * 128 + 8 * c);
                else raw[k] = *(const u32x4*)(KPE + row * 64 + 8 * (c - 8));
            }
        }
#pragma unroll
        for (int k = 0; k < 4; ++k) {
            const int it = it0 + k * NGW;
            if (it < TOT) {
                const bool isk = it >= M_ * 4; const int it2 = isk ? it - M_ * 4 : it;
                const int task = it2 * 4 + sub; const size_t row = (size_t)(task >> 4); const int h = task & 15; const int pos = (int)(row & 2047);
                float x[8];
#pragma unroll
                for (int j = 0; j < 4; ++j) { x[2 * j] = bflo(raw[k][j]); x[2 * j + 1] = bfhi(raw[k][j]); }
                float ss = 0.f;
#pragma unroll
                for (int e = 0; e < 8; ++e) ss += x[e] * x[e];
                ss += __shfl_xor(ss, 1); ss += __shfl_xor(ss, 2); ss += __shfl_xor(ss, 4); ss += __shfl_xor(ss, 8);
                const float rs = rsqrtf(ss * (1.0f / 96.0f) + EPS);
                const float* gain = (isk ? a.in[14] : a.in[13]) + 8 * (c < 12 ? c : 0);
                const float* cs = rope + ((size_t)pos * 16 + (c & 1) * 8) * 2;
                float y[8];
#pragma unroll
                for (int e = 0; e < 8; ++e) y[e] = x[e] * rs * gain[e];
#pragma unroll
                for (int e = 0; e < 8; ++e) {
                    const float z = __shfl_xor(y[e], 2);
                    if (c >= 8 && c < 12) { const float co = cs[2 * e], si = cs[2 * e + 1]; y[e] = (c < 10) ? (y[e] * co - z * si) : (y[e] * co + z * si); }
                }
                if (c < 12) {
                    u32x4 w;
                    if (!isk) {
#pragma unroll
                        for (int j = 0; j < 4; ++j) w[j] = pk2(y[2 * j] * qscale, y[2 * j + 1] * qscale);
                        *(u32x4*)(Q + row * 1536 + h * 96 + 8 * c) = w;
                    } else {
#pragma unroll
                        for (int j = 0; j < 4; ++j) w[j] = pk2(y[2 * j], y[2 * j + 1]);
                        *(u32x4*)(KH + row * 1536 + h * 96 + 8 * c) = w;
                    }
                }
            }
        }
    }
}

__device__ __forceinline__ void fixup_ffn(const bf16* gedge, const bf16* uedge, bf16* act, const float* cw, const float* cb, int Gn, int cid) {
    int tid = threadIdx.x; asm volatile("" : "+v"(tid));
    const int TOT = 1024 * 2 * 352;
    for (int idx = cid * 512 + tid; idx < TOT; idx += Gn * 512) {
        const int ch = idx % 352, sj = idx / 352, j = sj & 1, st = sj >> 1, c0 = ch * 8;
        const int row = st * 64 + j, t = row & (SEQ - 1);
        const u32x4 z = (u32x4){0u, 0u, 0u, 0u};
        const u32x4 g0 = *(const u32x4*)(gedge + ((size_t)st * 4 + j) * DFF + c0);
        u32x4 g1, g2;
        if (j == 0) { g1 = t >= 1 ? *(const u32x4*)(gedge + ((size_t)(st - 1) * 4 + 3) * DFF + c0) : z; g2 = t >= 2 ? *(const u32x4*)(gedge + ((size_t)(st - 1) * 4 + 2) * DFF + c0) : z; }
        else { g1 = *(const u32x4*)(gedge + ((size_t)st * 4 + 0) * DFF + c0); g2 = t >= 2 ? *(const u32x4*)(gedge + ((size_t)(st - 1) * 4 + 3) * DFF + c0) : z; }
        const u32x4 uw = *(const u32x4*)(uedge + ((size_t)st * 2 + j) * DFF + c0);
        u32x4 w;
#pragma unroll
        for (int n = 0; n < 2; ++n) {
            const f32x4 w0 = *(const f32x4*)(cw + c0 + 4 * n), w1 = *(const f32x4*)(cw + DFF + c0 + 4 * n), w2 = *(const f32x4*)(cw + 2 * DFF + c0 + 4 * n), b = *(const f32x4*)(cb + c0 + 4 * n);
            float r[4];
#pragma unroll
            for (int e = 0; e < 4; ++e) {
                const unsigned q0 = g0[2 * n + (e >> 1)], q1 = g1[2 * n + (e >> 1)], q2 = g2[2 * n + (e >> 1)], qu = uw[2 * n + (e >> 1)];
                const float x0 = (e & 1) ? bfhi(q0) : bflo(q0), x1 = (e & 1) ? bfhi(q1) : bflo(q1), x2 = (e & 1) ? bfhi(q2) : bflo(q2), up = (e & 1) ? bfhi(qu) : bflo(qu);
                const float cv = b[e] + w2[e] * x0 + w1[e] * x1 + w0[e] * x2;
                r[e] = cv * __builtin_amdgcn_rcpf(1.0f + __builtin_amdgcn_exp2f(-LOG2E * cv)) * up;
            }
            w[2 * n] = pk2(r[0], r[1]); w[2 * n + 1] = pk2(r[2], r[3]);
        }
        *(u32x4*)(act + (size_t)row * DFF + c0) = w;
    }
}
__device__ __forceinline__ void rstd_pass(const float* ssp, int nvec, float invdim, float* rs, int Gn, int cid) {
    int tid = threadIdx.x; asm volatile("" : "+v"(tid));
    for (int row = cid * 512 + tid; row < M_; row += Gn * 512) rs[row] = rsqrtf(rowss_sum(ssp, nvec, row) * invdim + EPS);
}
__device__ __forceinline__ void kpe_pass(const Args& a, int Gn, int cid) {
    unsigned char* ws = a.ws;
    int tid = threadIdx.x; asm volatile("" : "+v"(tid));
    const bf16* KPE = (const bf16*)(ws + R_B_KPE); bf16* RK = (bf16*)(ws + R_B_RK); float* sspe = (float*)(ws + WS_SSPE);
    const float* rope = (const float*)(ws + WS_ROPE); const float* gk = a.in[14] + 64;
    for (int row = cid * 512 + tid; row < M_; row += Gn * 512) {
        float x[32]; float ss = 0.f;
#pragma unroll
        for (int c = 0; c < 4; ++c) { const u32x4 raw = *(const u32x4*)(KPE + (size_t)row * 64 + 8 * c);
#pragma unroll
            for (int j = 0; j < 4; ++j) { x[8 * c + 2 * j] = bflo(raw[j]); x[8 * c + 2 * j + 1] = bfhi(raw[j]); } }
#pragma unroll
        for (int i = 0; i < 32; ++i) { ss += x[i] * x[i]; x[i] *= gk[i]; }
        sspe[row] = ss;
        const float* cs = rope + (size_t)(row & (SEQ - 1)) * 32;
#pragma unroll
        for (int i = 0; i < 16; ++i) { const float co = cs[2 * i], si = cs[2 * i + 1], x1 = x[i], x2 = x[16 + i]; x[i] = x1 * co - x2 * si; x[16 + i] = x2 * co + x1 * si; }
#pragma unroll
        for (int c = 0; c < 4; ++c) { u32x4 w;
#pragma unroll
            for (int j = 0; j < 4; ++j) w[j] = pk2(x[8 * c + 2 * j], x[8 * c + 2 * j + 1]);
            *(u32x4*)(RK + (size_t)row * 32 + 8 * c) = w; }
    }
}
__device__ __forceinline__ void rstd_local(const float* ssp, float* rs, const pg8::StaticOrder& S, int nunits) {
    int tid = threadIdx.x; asm volatile("" : "+v"(tid));
    const int TOT = nunits * 256;
    for (int k0 = tid; k0 < TOT; k0 += 4 * 512) {
        f32x4 p[4][4]; int rows[4];
#pragma unroll
        for (int j = 0; j < 4; ++j) { const int k = k0 + j * 512; rows[j] = -1;
            if (k < TOT) { pg8::Unit uu; S.next(k >> 8, uu); rows[j] = uu.pm * 256 + (k & 255); const f32x4* q = (const f32x4*)(ssp + (size_t)rows[j] * 16);
#pragma unroll
                for (int v = 0; v < 4; ++v) p[j][v] = q[v]; } }
#pragma unroll
        for (int j = 0; j < 4; ++j) if (rows[j] >= 0) { float t = 0.f;
#pragma unroll
            for (int v = 0; v < 4; ++v) t += (p[j][v][0] + p[j][v][1]) + (p[j][v][2] + p[j][v][3]);
            rs[rows[j]] = rsqrtf(t * (1.0f / 1024.0f) + EPS); }
    }
    asm volatile("s_waitcnt vmcnt(0)" ::: "memory");
    __syncthreads();
}
__device__ __forceinline__ void grid_barrier(unsigned* cnt, unsigned& epoch, unsigned G) {
    asm volatile("s_waitcnt vmcnt(0) lgkmcnt(0)" ::: "memory");
    __syncthreads();
    epoch += 1u;
    if (threadIdx.x == 0) {
        __builtin_amdgcn_fence(__ATOMIC_RELEASE, "agent");
        asm volatile("s_waitcnt vmcnt(0)" ::: "memory");
        __hip_atomic_fetch_add(cnt, 1u, __ATOMIC_RELAXED, __HIP_MEMORY_SCOPE_AGENT);
        const unsigned want = epoch * G;
        while (__hip_atomic_load(cnt, __ATOMIC_RELAXED, __HIP_MEMORY_SCOPE_AGENT) < want) __builtin_amdgcn_s_sleep(2);
        __builtin_amdgcn_fence(__ATOMIC_ACQUIRE, "agent");
        asm volatile("s_waitcnt vmcnt(0)" ::: "memory");
    }
    __syncthreads();
}
__global__ void __launch_bounds__(512) fwd_kernel(Args a) {
    extern __shared__ __attribute__((aligned(16))) unsigned char lds_raw[];
    LAS unsigned char* lds = (LAS unsigned char*)lds_raw;
    cg::grid_group grid = cg::this_grid();
    const int Gn = (int)gridDim.x, cid = (int)blockIdx.x;
    unsigned char* ws = a.ws;
    unsigned* barcnt = (unsigned*)(ws + WS_BAR); unsigned epoch = 0u;
    prologue(lds, a, Gn, cid);
    grid.sync();
    grid_barrier(barcnt, epoch, (unsigned)Gn);
    bf16* XB = (bf16*)(ws + WS_XB);
    float* RSS = (float*)(ws + WS_RSSP); float* RSTD = (float*)(ws + WS_RSS);
    for (int ph = 0; ph < 28; ++ph) {
        int type = 0, N = 1024, K = 1024, ldc = 0, hm = 0, layer = 0, sidx = 0, nvec = 4, pbuf = -1;
        const bf16 *A = XB, *Bt = nullptr; bf16* pO = nullptr; const float* pss = RSTD; const float *gq = nullptr, *gk = nullptr; float qs = 0.125f * LOG2E;
        const float* rbase = nullptr; float* rout = nullptr; bf16* rxb = XB; float* rssn = nullptr;
        int f = -1;
        switch (ph) {
        case 0: type = 0; Bt = (const bf16*)(ws + W_AIN); N = 4608; pO = (bf16*)(ws + R_A_QKV); ldc = 4608; hm = 1; gq = a.in[5]; gk = a.in[6]; break;
        case 1: type = 4; break;
        case 2: type = 8; break;
        case 3: type = 1; A = (const bf16*)(ws + R_A_OC); Bt = (const bf16*)(ws + W_AOUT); K = 512; rbase = a.in[0]; rssn = RSS + 1 * (size_t)M_ * 16; break;
        case 4: case 5: case 6: layer = 0; sidx = 1; f = ph - 4; break;
        case 7: type = 2; Bt = (const bf16*)(ws + W_BIN); N = 768; pbuf = 0; break;
        case 8: type = 0; A = (const bf16*)(ws + R_B_CQ); Bt = (const bf16*)(ws + W_BQUP); N = 1536; K = 384; pO = (bf16*)(ws + R_B_Q); ldc = 1536; pss = (const float*)(ws + WS_SSQ); break;
        case 9: type = 10; break;
        case 10: type = 10; break;
        case 11: type = 5; break;
        case 12: type = 1; A = (const bf16*)(ws + R_B_O); Bt = (const bf16*)(ws + W_BOUT); rssn = RSS + 1 * (size_t)M_ * 16; break;
        case 13: case 14: case 15: layer = 1; sidx = 3; f = ph - 13; break;
        case 16: type = 0; Bt = (const bf16*)(ws + W_CIN); N = 3072; pO = (bf16*)(ws + R_C_QKV); ldc = 3072; pbuf = 0; hm = 2; gq = a.in[17]; gk = a.in[18]; break;
        case 17: type = 6; break;
        case 18: type = 1; A = (const bf16*)(ws + R_C_O); Bt = (const bf16*)(ws + W_COUT); rssn = RSS + 1 * (size_t)M_ * 16; break;
        case 19: case 20: case 21: layer = 2; sidx = 5; f = ph - 19; break;
        case 22: type = 0; Bt = (const bf16*)(ws + W_DIN); N = 1280; pO = (bf16*)(ws + R_D_QKV); ldc = 1280; pbuf = 0; hm = 3; gq = a.in[26]; gk = a.in[27]; break;
        case 23: type = 7; break;
        case 24: type = 1; A = (const bf16*)(ws + R_D_O); Bt = (const bf16*)(ws + W_DOUT); rssn = RSS + 1 * (size_t)M_ * 16; break;
        default: layer = 3; sidx = 7; f = ph - 25; break;
        }
        if (f == 0) { type = 3; Bt = (const bf16*)(ws + W_FG + layer * 2 * W_FSTR); N = 2 * DFF; pbuf = 1; }
        else if (f == 1) { type = 11; }
        else if (f == 2) { type = 1; A = (const bf16*)(ws + R_ACT); Bt = (const bf16*)(ws + W_FD + layer * W_FSTR); K = DFF;
            if (layer < 3) { rssn = RSS + ((sidx + 1) & 1) * (size_t)M_ * 16; } else { rssn = nullptr; rxb = nullptr; rout = a.out; } }

        if (type == 10) continue;
        if (type <= 3) {
            pg8::Gemm g{A, Bt, M_, N, K}; pg8::StaticOrder S; S.init(M_, N, Gn, cid);
            if (pbuf >= 0) rstd_local(RSS + (size_t)pbuf * M_ * 16, RSTD, S, (S.nwg - cid + Gn - 1) / Gn);
            if (type == 0) {
                for (int sub = 0; sub < (ph == 8 ? 2 : 1); ++sub) {
                    const bool kv = (sub == 1);
                    const pg8::Gemm g2{kv ? (const bf16*)(ws + R_B_CKV) : A, kv ? (const bf16*)(ws + W_BKVUP) : Bt, M_, kv ? 2048 : N, kv ? 256 : K};
                    pg8::StaticOrder S2; S2.init(M_, kv ? 2048 : N, Gn, cid);
                    const EpiProj E{kv ? (bf16*)(ws + R_B_KV) : pO, kv ? 2048 : ldc, kv ? (const float*)(ws + WS_SSKV) : pss, kv ? 4 : hm, gq, kv ? a.in[14] : gk, qs};
                    pg8::gemm_phase<EpiProj, pg8::StaticOrder, true, true>(lds, g2, S2, E);
                }
            }
            else if (type == 1) { EpiRes E{rbase, rout, XB, rxb, rssn}; pg8::gemm_phase<EpiRes, pg8::StaticOrder, true, true>(lds, g, S, E); }
            else if (type == 2) { EpiLat E{(bf16*)(ws + R_B_CQ), (bf16*)(ws + R_B_CKV), (bf16*)(ws + R_B_KPE), pss, (float*)(ws + WS_SSQP), (float*)(ws + WS_SSKVP)}; pg8::gemm_phase<EpiLat, pg8::StaticOrder, true, true>(lds, g, S, E); }
            else { EpiGateUp E{(bf16*)(ws + R_ACT), (bf16*)(ws + R_GATE), (bf16*)(ws + R_GATE + 32 * MiB), pss, a.in[31] + (size_t)layer * 3 * DFF, a.in[32] + (size_t)layer * DFF}; pg8::gemm_phase<EpiGateUp, pg8::StaticOrder, true, true>(lds, g, S, E); }
        }
        else if (type == 4) attn_phase<0>(lds, a, Gn, cid);
        else if (type == 5) attn_phase<1>(lds, a, Gn, cid);
        else if (type == 6) attn_phase<2>(lds, a, Gn, cid);
        else if (type == 7) attn_phase<3>(lds, a, Gn, cid);
        else if (type == 8) combine_a(a, Gn, cid);
        else if (type == 11) fixup_ffn((const bf16*)(ws + R_GATE), (const bf16*)(ws + R_GATE + 32 * MiB), (bf16*)(ws + R_ACT), a.in[31] + (size_t)layer * 3 * DFF, a.in[32] + (size_t)layer * DFF, Gn, cid);
        else prep_b(a, Gn, cid);
        grid_barrier(barcnt, epoch, (unsigned)Gn);
        if (type == 2) { rstd_pass((const float*)(ws + WS_SSQP), 2, 1.0f / 384.0f, (float*)(ws + WS_SSQ), Gn, cid); rstd_pass((const float*)(ws + WS_SSKVP), 1, 1.0f / 256.0f, (float*)(ws + WS_SSKV), Gn, cid); kpe_pass(a, Gn, cid);
            grid_barrier(barcnt, epoch, (unsigned)Gn); }
    }
}

extern "C" void kernel_launch(void* const* d_in, const int* in_sizes, int n_in, void* d_out, int out_size, void* d_ws, size_t ws_size, hipStream_t stream) {
    static int grid = 0;
    if (grid == 0) {
        if (n_in != 34 || out_size != M_ * DMODEL || ws_size < WS_NEED) { fprintf(stderr, "kernel_launch: unexpected shapes (n_in %d out %d ws %zu)\n", n_in, out_size, ws_size); grid = -1; return; }
        int dev = 0, cus = 0, per_cu = 0;
        if (hipGetDevice(&dev) != hipSuccess || hipDeviceGetAttribute(&cus, hipDeviceAttributeMultiprocessorCount, dev) != hipSuccess) { grid = -1; return; }
        if (hipFuncSetAttribute((const void*)fwd_kernel, hipFuncAttributeMaxDynamicSharedMemorySize, LDS_BYTES) != hipSuccess) { fprintf(stderr, "kernel_launch: hipFuncSetAttribute failed\n"); grid = -1; return; }
        if (hipOccupancyMaxActiveBlocksPerMultiprocessor(&per_cu, (const void*)fwd_kernel, 512, LDS_BYTES) != hipSuccess || per_cu < 1) { fprintf(stderr, "kernel_launch: occupancy query says %d\n", per_cu); per_cu = 1; }
        (void)hipGetLastError();
        grid = cus;
    }
    if (grid < 0) return;
    if (hipMemsetAsync((unsigned char*)d_ws + WS_BAR, 0, 256, stream) != hipSuccess) { fprintf(stderr, "kernel_launch: memset failed\n"); return; }
    Args a{};
    for (int i = 0; i < 34; ++i) a.in[i] = (const float*)d_in[i];
    a.out = (float*)d_out; a.ws = (unsigned char*)d_ws;
    void* args[] = {&a};
    hipError_t e = hipLaunchCooperativeKernel((const void*)fwd_kernel, dim3(grid), dim3(512), args, LDS_BYTES, stream);
    if (e != hipSuccess) fprintf(stderr, "cooperative launch failed: %s (grid %d)\n", hipGetErrorString(e), grid);
}
```

```cpp
#include <hip/hip_runtime.h>
#include <hip/hip_cooperative_groups.h>
#include <cstdio>
#include <cstdint>
namespace cg = cooperative_groups;
namespace pg8 {
#define PG8_LAS __attribute__((address_space(3)))
typedef unsigned short bf16_t;
typedef short bf16x8 __attribute__((ext_vector_type(8)));
typedef float f32x4 __attribute__((ext_vector_type(4)));
typedef unsigned u32x4 __attribute__((ext_vector_type(4)));
constexpr int BM = 256, BK = 64, HALF = 128, HTB = HALF * BK * 2  , STAGE_BYTES = 8 * HTB, NXCD = 8, WGM = 8;

__host__ __device__ __forceinline__ int lds_byte(int r, int c) { const int st = (r >> 4) * 2 + (c >> 5), rr = r & 15, cc = c & 31, ob = rr * 64 + cc * 2; return st * 1024 + (ob ^ (((ob >> 9) & 1) << 5)); }
__host__ __device__ __forceinline__ void stage_rc(int b, int& R, int& C) { const int st = b / 1024, sb = b % 1024, swz = sb ^ (((sb >> 9) & 1) << 5); R = (st >> 1) * 16 + swz / 64; C = (st & 1) * 32 + (swz % 64) / 2; }
__host__ __device__ __forceinline__ int perm32(int rho) { const int n = rho >> 4, i = rho & 15; return 8 * (i >> 2) + 4 * n + (i & 3); }

struct Unit { int pm, pn; };
struct Gemm { const bf16_t* A; const bf16_t* Bt; int M, N, K; };

struct StaticOrder {
    int nM, nN, nwg, G, c;
    __host__ __device__ void init(int M, int N, int G_, int c_) { nM = M / BM; nN = N / BM; nwg = nM * nN; G = G_; c = c_; }
    __host__ __device__ bool next(int i, Unit& u) const {
        const long L = (long)i * G + c; if (L >= nwg) return false;
        int wgid = (int)L; { const int q = nwg / NXCD, r = nwg % NXCD, xcd = wgid % NXCD, off = wgid / NXCD; wgid = (xcd < r ? xcd * (q + 1) : r * (q + 1) + (xcd - r) * q) + off; }
        const int nig = WGM * nN, gid = wgid / nig, fm = gid * WGM, gsz = (nM - fm) < WGM ? (nM - fm) : WGM;
        u.pm = fm + ((wgid % nig) % gsz); u.pn = (wgid % nig) / gsz; return true;
    }
    __device__ __forceinline__ void a_ready(const Unit&) const {}
    __device__ __forceinline__ void done(const Unit&) const {}
};

__device__ __forceinline__ unsigned cvt_pk_bf16(float lo, float hi) { unsigned r; asm volatile("v_cvt_pk_bf16_f32 %0, %1, %2" : "=v"(r) : "v"(lo), "v"(hi)); return r; }
template <class Epi, class Sched, bool ALIGN_EPI = false, bool SP2 = false>
__device__ __forceinline__ void gemm_phase(PG8_LAS unsigned char* lds, const Gemm g, const Sched& S, const Epi& E) {
    int tid = threadIdx.x; asm volatile("" : "+v"(tid)); const int wid = __builtin_amdgcn_readfirstlane(tid >> 6), lane = tid & 63, wr = wid >> 2, wc = wid & 3, fr = lane & 15, fq = lane >> 4;
    const int K = g.K, nt = K / BK;
    unsigned voffA[2], voffB[2];
#pragma unroll
    for (int i = 0; i < 2; ++i) { int R, C; stage_rc(tid * 16 + i * 8192, R, C); const int Rb = Epi::PERM ? ((R & ~31) + perm32(R & 31)) : R;
        voffA[i] = (unsigned)(R * K + C) * 2u; voffB[i] = (unsigned)(Rb * K + C) * 2u; }
    const size_t kstep = (size_t)(BK * 2);
    const size_t hstep = (size_t)HALF * K * 2;
    const size_t tstep = 2 * hstep;
    const unsigned ldsw = (unsigned)wid * 1024u;
    const int aoff = lds_byte(wr * 64 + fr, fq * 8), boff = lds_byte(wc * 32 + fr, fq * 8);
#define PG8_SA(b, h) (((b) * 2 + (h)) * HTB)
#define PG8_SB(b, h) ((4 + (b) * 2 + (h)) * HTB)
#define PG8_STAGE(bufoff, gbase, voff) do { _Pragma("unroll") for (int _i = 0; _i < 2; ++_i) \
        __builtin_amdgcn_global_load_lds((const unsigned*)((const char*)(gbase) + (voff)[_i]), (PG8_LAS unsigned*)(lds + (bufoff) + ldsw + _i * 8192), 16, 0, 0); } while (0)
#define PG8_LDA(dst, b, h) do { _Pragma("unroll") for (int m = 0; m < 4; ++m) _Pragma("unroll") for (int k = 0; k < 2; ++k) dst[m][k] = *(const PG8_LAS bf16x8*)(lds + PG8_SA(b, h) + aoff + m * 2048 + k * 1024); } while (0)
#define PG8_LDB(dst, b, h) do { _Pragma("unroll") for (int n = 0; n < 2; ++n) _Pragma("unroll") for (int k = 0; k < 2; ++k) dst[n][k] = *(const PG8_LAS bf16x8*)(lds + PG8_SB(b, h) + boff + n * 2048 + k * 1024); } while (0)
#define PG8_MMA(ai, bj, At, Bt) do { __builtin_amdgcn_s_setprio(1); _Pragma("unroll") for (int m = 0; m < 4; ++m) _Pragma("unroll") for (int n = 0; n < 2; ++n) _Pragma("unroll") for (int k = 0; k < 2; ++k) \
        acc[ai][bj][m][n] = __builtin_amdgcn_mfma_f32_16x16x32_bf16(Bt[n][k], At[m][k], acc[ai][bj][m][n], 0, 0, 0); __builtin_amdgcn_s_setprio(0); } while (0)
#define PG8_WAIT_V(n) asm volatile("s_waitcnt vmcnt(" #n ")" ::: "memory")
#define PG8_WAIT_L(n) asm volatile("s_waitcnt lgkmcnt(" #n ")" ::: "memory")
#define PG8_BAR __builtin_amdgcn_s_barrier()
#define PG8_SCHED __builtin_amdgcn_sched_barrier(0)
    Unit cur, nxt; int ui = 0;
    if (!S.next(0, cur)) return;
    f32x4 acc[2][2][4][2];
#pragma unroll
    for (int a = 0; a < 2; ++a)
#pragma unroll
        for (int b = 0; b < 2; ++b)
#pragma unroll
            for (int m = 0; m < 4; ++m)
#pragma unroll
                for (int n = 0; n < 2; ++n) acc[a][b][m][n] = (f32x4){0.f, 0.f, 0.f, 0.f};
    bf16x8 At[4][2], B0[2][2], B1[2][2];
    const char* cA = (const char*)g.A + (size_t)cur.pm * tstep; const char* cB = (const char*)g.Bt + (size_t)cur.pn * tstep;
    S.a_ready(cur);
    if constexpr (SP2) {
        PG8_STAGE(PG8_SB(0, 0), cB, voffB); PG8_STAGE(PG8_SB(0, 1), cB + hstep, voffB); PG8_STAGE(PG8_SA(0, 0), cA, voffA); PG8_STAGE(PG8_SA(0, 1), cA + hstep, voffA);
        if (wr == 1) PG8_BAR;
        PG8_WAIT_V(2); PG8_BAR;
        PG8_STAGE(PG8_SB(1, 0), cB + kstep, voffB); PG8_STAGE(PG8_SA(1, 0), cA + kstep, voffA); PG8_STAGE(PG8_SB(1, 1), cB + hstep + kstep, voffB);
        PG8_WAIT_V(6); PG8_BAR;
    } else {
        PG8_STAGE(PG8_SB(0, 0), cB, voffB); PG8_STAGE(PG8_SA(0, 0), cA, voffA); PG8_STAGE(PG8_SB(0, 1), cB + hstep, voffB); PG8_STAGE(PG8_SA(0, 1), cA + hstep, voffA);
        if (wr == 1) PG8_BAR;
        PG8_WAIT_V(4); PG8_BAR;
        PG8_STAGE(PG8_SB(1, 0), cB + kstep, voffB); PG8_STAGE(PG8_SA(1, 0), cA + kstep, voffA); PG8_STAGE(PG8_SB(1, 1), cB + hstep + kstep, voffB);
        PG8_WAIT_V(6); PG8_BAR;
    }
    for (;;) {
        const bool has_next = S.next(ui + 1, nxt);
        const char* nA = has_next ? (const char*)g.A + (size_t)nxt.pm * tstep : cA; const char* nB = has_next ? (const char*)g.Bt + (size_t)nxt.pn * tstep : cB;
        for (int t = 0; t < nt; t += 2) {
            const bool last = (t == nt - 2);
            const char* a1 = cA + (size_t)(t + 1) * kstep;
            const char* a2 = last ? nA : cA + (size_t)(t + 2) * kstep; const char* b2 = last ? nB : cB + (size_t)(t + 2) * kstep;
            const char* a3 = a2 + kstep; const char* b3 = b2 + kstep;
            if (last && has_next) S.a_ready(nxt);
            if constexpr (SP2) {
            PG8_LDB(B0, 0, 0); PG8_LDB(B1, 0, 1); PG8_SCHED; PG8_LDA(At, 0, 0); PG8_STAGE(PG8_SA(1, 1), a1 + hstep, voffA);
            PG8_WAIT_V(8); PG8_WAIT_L(0); PG8_BAR; PG8_MMA(0, 0, At, B0); PG8_MMA(0, 1, At, B1); PG8_BAR; PG8_SCHED;
            PG8_LDA(At, 0, 1); PG8_STAGE(PG8_SB(0, 0), b2, voffB); PG8_STAGE(PG8_SB(0, 1), b2 + hstep, voffB); PG8_STAGE(PG8_SA(0, 0), a2, voffA);
            PG8_WAIT_V(8); PG8_WAIT_L(0); PG8_BAR; PG8_MMA(1, 0, At, B0); PG8_MMA(1, 1, At, B1); PG8_BAR; PG8_SCHED;
            PG8_LDB(B0, 1, 0); PG8_LDB(B1, 1, 1); PG8_SCHED; PG8_LDA(At, 1, 0); PG8_STAGE(PG8_SA(0, 1), a2 + hstep, voffA);
            PG8_WAIT_V(8); PG8_WAIT_L(0); PG8_BAR; PG8_MMA(0, 0, At, B0); PG8_MMA(0, 1, At, B1); PG8_BAR; PG8_SCHED;
            PG8_LDA(At, 1, 1); PG8_STAGE(PG8_SB(1, 0), b3, voffB); PG8_STAGE(PG8_SB(1, 1), b3 + hstep, voffB); PG8_STAGE(PG8_SA(1, 0), a3, voffA);
            PG8_WAIT_V(8); PG8_WAIT_L(0); PG8_BAR; PG8_MMA(1, 0, At, B0); PG8_MMA(1, 1, At, B1); PG8_BAR; PG8_SCHED;
            } else {
            PG8_LDB(B0, 0, 0); PG8_SCHED; PG8_LDA(At, 0, 0); PG8_STAGE(PG8_SA(1, 1), a1 + hstep, voffA);
            PG8_WAIT_L(8); PG8_BAR; PG8_WAIT_L(0); PG8_MMA(0, 0, At, B0); PG8_BAR; PG8_SCHED;
            PG8_LDB(B1, 0, 1); PG8_STAGE(PG8_SB(0, 0), b2, voffB);
            PG8_BAR; PG8_WAIT_L(0); PG8_MMA(0, 1, At, B1); PG8_BAR;
            PG8_LDA(At, 0, 1); PG8_STAGE(PG8_SA(0, 0), a2, voffA);
            PG8_BAR; PG8_WAIT_L(0); PG8_MMA(1, 0, At, B0); PG8_BAR; PG8_SCHED;
            PG8_STAGE(PG8_SB(0, 1), b2 + hstep, voffB);
            PG8_WAIT_V(6); PG8_BAR; PG8_MMA(1, 1, At, B1); PG8_BAR;
            PG8_LDB(B0, 1, 0); PG8_SCHED; PG8_LDA(At, 1, 0); PG8_STAGE(PG8_SA(0, 1), a2 + hstep, voffA);
            PG8_WAIT_L(8); PG8_BAR; PG8_WAIT_L(0); PG8_MMA(0, 0, At, B0); PG8_BAR; PG8_SCHED;
            PG8_LDB(B1, 1, 1); PG8_STAGE(PG8_SB(1, 0), b3, voffB);
            PG8_BAR; PG8_WAIT_L(0); PG8_MMA(0, 1, At, B1); PG8_BAR;
            PG8_LDA(At, 1, 1); PG8_STAGE(PG8_SA(1, 0), a3, voffA);
            PG8_BAR; PG8_WAIT_L(0); PG8_MMA(1, 0, At, B0); PG8_BAR; PG8_SCHED;
            PG8_STAGE(PG8_SB(1, 1), b3 + hstep, voffB);
            PG8_WAIT_V(6); PG8_BAR; PG8_MMA(1, 1, At, B1); PG8_BAR;
            }
        }
        if constexpr (ALIGN_EPI) { if (wr == 0) PG8_BAR; }
        if constexpr (!Epi::AFTER_DRAIN) { E(acc, cur, wr, wc, fr, fq); S.done(cur); }
        if (!has_next) break;
#pragma unroll
        for (int a = 0; a < 2; ++a)
#pragma unroll
            for (int b = 0; b < 2; ++b)
#pragma unroll
                for (int m = 0; m < 4; ++m)
#pragma unroll
                    for (int n = 0; n < 2; ++n) acc[a][b][m][n] = (f32x4){0.f, 0.f, 0.f, 0.f};
        cur = nxt; cA = nA; cB = nB; ++ui;
        if constexpr (ALIGN_EPI) { if (wr == 1) PG8_BAR; }
    }
    PG8_WAIT_V(0);
    if constexpr (!ALIGN_EPI) { if (wr == 0) PG8_BAR; }
    PG8_BAR;
    if constexpr (Epi::AFTER_DRAIN) { E.fused(acc, cur, wr, wc, fr, fq, lds, wid, lane); S.done(cur); }
#undef PG8_SA
#undef PG8_SB
#undef PG8_STAGE
#undef PG8_LDA
#undef PG8_LDB
#undef PG8_MMA
#undef PG8_WAIT_V
#undef PG8_WAIT_L
#undef PG8_BAR
#undef PG8_SCHED
}
}

#define LAS __attribute__((address_space(3)))
typedef unsigned short bf16;
typedef short bf16x8 __attribute__((ext_vector_type(8)));
typedef short s16x4 __attribute__((ext_vector_type(4)));
typedef float f32x2 __attribute__((ext_vector_type(2)));
typedef float f32x4 __attribute__((ext_vector_type(4)));
typedef float f32x16 __attribute__((ext_vector_type(16)));
typedef unsigned u32x2 __attribute__((ext_vector_type(2)));
typedef unsigned u32x4 __attribute__((ext_vector_type(4)));
typedef __bf16 bf16x2_t __attribute__((ext_vector_type(2)));

constexpr int M_ = 65536, SEQ = 2048, DMODEL = 1024, DFF = 2816;
constexpr float EPS = 1e-6f, LOG2E = 1.4426950408889634f;
constexpr size_t MiB = 1u << 20;
constexpr size_t WS_BIAS = 0;
constexpr size_t WS_ROPE = 256 * 1024;
constexpr size_t WS_RSS = 1 * MiB;
constexpr size_t WS_SSQ = 3 * MiB;
constexpr size_t WS_SSKV = 3 * MiB + 256 * 1024;
constexpr size_t W_AIN = 4 * MiB, W_AOUT = 13 * MiB, W_BIN = 14 * MiB, W_BQUP = 16 * MiB, W_BKVUP = 18 * MiB, W_BOUT = 19 * MiB,
                 W_CIN = 21 * MiB, W_COUT = 27 * MiB, W_DIN = 29 * MiB, W_DOUT = 32 * MiB, W_FG = 34 * MiB, W_FU = 58 * MiB, W_FD = 82 * MiB, W_FSTR = 6 * MiB;
constexpr size_t WS_XB = 106 * MiB;
constexpr size_t WS_R = 234 * MiB;
constexpr size_t R_A_QKV = WS_R, R_A_O3 = WS_R + 576 * MiB, R_A_LSE = WS_R + 768 * MiB, R_A_OC = WS_R;
constexpr size_t R_B_CQ = WS_R, R_B_CKV = WS_R + 48 * MiB, R_B_KPE = WS_R + 80 * MiB, R_B_Q = WS_R + 128 * MiB, R_B_KV = WS_R + 320 * MiB, R_B_KH = WS_R + 576 * MiB, R_B_O = WS_R;
constexpr size_t R_C_QKV = WS_R, R_C_O = WS_R + 384 * MiB;
constexpr size_t R_D_QKV = WS_R, R_D_O = WS_R + 160 * MiB;
constexpr size_t R_GATE = WS_R, R_ACT = WS_R + 352 * MiB;
constexpr size_t WS_RSSP = WS_R + 774 * MiB;
constexpr size_t WS_SSQP = WS_R + 782 * MiB;
constexpr size_t WS_SSKVP = WS_R + 784 * MiB;
constexpr size_t WS_SSPE = 3 * MiB + 512 * 1024;
constexpr size_t R_B_RK = WS_R + 96 * MiB;
constexpr size_t WS_BAR = 512 * 1024;
constexpr size_t WS_NEED = WS_R + 786 * MiB;

constexpr int LDS_BYTES = 135168;

struct Args { const float* in[34]; float* out; unsigned char* ws; };

__device__ __forceinline__ unsigned pk2(float lo, float hi) { f32x2 v = {lo, hi}; bf16x2_t b = __builtin_convertvector(v, bf16x2_t); return __builtin_bit_cast(unsigned, b); }
__device__ __forceinline__ float bf2f(unsigned short h) { return __uint_as_float(((unsigned)h) << 16); }
__device__ __forceinline__ float bflo(unsigned w) { return __uint_as_float(w << 16); }
__device__ __forceinline__ float bfhi(unsigned w) { return __uint_as_float(w & 0xffff0000u); }
__device__ __forceinline__ float wave_sum(float v) {
#pragma unroll
    for (int o = 1; o < 64; o <<= 1) v += __shfl_xor(v, o);
    return v;
}
__device__ __forceinline__ float dot4(f32x4 a) { return (a[0] * a[0] + a[1] * a[1]) + (a[2] * a[2] + a[3] * a[3]); }
__device__ __forceinline__ float rowss_sum(const float* ss, int nvec, int row) {
    const f32x4* p = (const f32x4*)(ss + (size_t)row * 4 * nvec); float t = 0.f;
#pragma unroll
    for (int v = 0; v < 4; ++v) if (v < nvec) { const f32x4 q = p[v]; t += (q[0] + q[1]) + (q[2] + q[3]); }
    return t;
}

struct EpiProj {
    static constexpr bool PERM = true, AFTER_DRAIN = false;
    bf16* O; int ldc; const float* rs; int hm; const float* gq; const float* gk; float qscale;
    __device__ __forceinline__ void operator()(const f32x4 (&acc)[2][2][4][2], const pg8::Unit& u, int wr, int wc, int fr, int fq) const {
        const int hg = u.pn * 4 + wc;
        int kind = 2; const float* gain = gq;
        if (hm == 1) { const int t = (hg >> 3) % 3, gi = hg / 24; kind = t; gain = (t == 0 ? gq : gk) + gi * 64; }
        else if (hm == 2) { kind = hg < 16 ? 0 : (hg < 32 ? 1 : 2); gain = kind == 0 ? gq : gk; }
        else if (hm == 3) { kind = hg < 16 ? 0 : (hg < 18 ? 1 : 2); gain = kind == 0 ? gq : gk; }
        else if (hm == 4) { kind = (hg & 1) ? 2 : 3; gain = gk; }
        f32x4 gv[2][2];
#pragma unroll
        for (int bj = 0; bj < 2; ++bj)
#pragma unroll
            for (int n = 0; n < 2; ++n) {
                gv[bj][n] = (f32x4){1.f, 1.f, 1.f, 1.f};
                if (kind != 2) { gv[bj][n] = *(const f32x4*)(gain + 32 * bj + 8 * fq + 4 * n); if (kind == 0) gv[bj][n] = gv[bj][n] * qscale; }
            }
        bf16* colp = O + hg * 64 + 8 * fq;
        float rsv[2][4];
#pragma unroll
        for (int ai = 0; ai < 2; ++ai)
#pragma unroll
            for (int m = 0; m < 4; ++m) rsv[ai][m] = rs[u.pm * 256 + ai * 128 + wr * 64 + m * 16 + fr];
        if (kind == 3) {
#pragma unroll
            for (int ai = 0; ai < 2; ++ai)
#pragma unroll
                for (int m = 0; m < 4; ++m) {
                    const int row = u.pm * 256 + ai * 128 + wr * 64 + m * 16 + fr;
                    const float rstd = rsv[ai][m];
                    f32x4 v[2][2]; float s = 0.f;
#pragma unroll
                    for (int bj = 0; bj < 2; ++bj)
#pragma unroll
                        for (int n = 0; n < 2; ++n) { v[bj][n] = acc[ai][bj][m][n] * rstd; s += dot4(v[bj][n]); }
                    s += __shfl_xor(s, 16); s += __shfl_xor(s, 32);
                    const float rk_ = rsqrtf((s + ((const float*)((const unsigned char*)rs + (WS_SSPE - WS_SSKV)))[row]) * (1.0f / 96.0f) + EPS);
                    bf16* kp = (bf16*)((unsigned char*)O + (R_B_KH - R_B_KV)) + (size_t)row * 1536 + (hg >> 1) * 96 + 8 * fq;
#pragma unroll
                    for (int bj = 0; bj < 2; ++bj) {
                        const f32x4 a_ = v[bj][0] * rk_ * gv[bj][0], b_ = v[bj][1] * rk_ * gv[bj][1];
                        u32x4 w; w.x = pk2(a_[0], a_[1]); w.y = pk2(a_[2], a_[3]); w.z = pk2(b_[0], b_[1]); w.w = pk2(b_[2], b_[3]);
                        *(u32x4*)(kp + 32 * bj) = w;
                    }
                    const u32x4 r_ = *(const u32x4*)((const bf16*)((const unsigned char*)O - (R_B_KV - R_B_RK)) + (size_t)row * 32 + 8 * fq);
                    u32x4 w;
#pragma unroll
                    for (int j = 0; j < 4; ++j) w[j] = pk2(bflo(r_[j]) * rk_, bfhi(r_[j]) * rk_);
                    *(u32x4*)(kp + 64) = w;
                }
            return;
        }
#pragma unroll
        for (int ai = 0; ai < 2; ++ai)
#pragma unroll
            for (int m = 0; m < 4; ++m) {
                const int row = u.pm * 256 + ai * 128 + wr * 64 + m * 16 + fr;
                const float rstd = rsv[ai][m];
                f32x4 v[2][2]; float s = 0.f;
#pragma unroll
                for (int bj = 0; bj < 2; ++bj)
#pragma unroll
                    for (int n = 0; n < 2; ++n) { v[bj][n] = acc[ai][bj][m][n] * rstd; s += dot4(v[bj][n]); }
                if (kind < 2) {
                    s += __shfl_xor(s, 16); s += __shfl_xor(s, 32);
                    const float rs = rsqrtf(s * (1.0f / 64.0f) + EPS);
#pragma unroll
                    for (int bj = 0; bj < 2; ++bj)
#pragma unroll
                        for (int n = 0; n < 2; ++n) v[bj][n] = v[bj][n] * rs * gv[bj][n];
                }
#pragma unroll
                for (int bj = 0; bj < 2; ++bj) {
                    u32x4 w; w.x = pk2(v[bj][0][0], v[bj][0][1]); w.y = pk2(v[bj][0][2], v[bj][0][3]); w.z = pk2(v[bj][1][0], v[bj][1][1]); w.w = pk2(v[bj][1][2], v[bj][1][3]);
                    *(u32x4*)(colp + (size_t)row * ldc + 32 * bj) = w;
                }
            }
    }
};
struct EpiLat {
    static constexpr bool PERM = true, AFTER_DRAIN = false;
    bf16* CQ; bf16* CKV; bf16* KPE; const float* rs; float* ssq; float* sskv;
    __device__ __forceinline__ void operator()(const f32x4 (&acc)[2][2][4][2], const pg8::Unit& u, int wr, int wc, int fr, int fq) const {
        const int hg = u.pn * 4 + wc;
        if (hg > 10) return;
        bf16* dst; int ld; float* sacc = nullptr; int sst = 0;
        if (hg < 6) { dst = CQ + hg * 64; ld = 384; sacc = ssq + hg; sst = 8; } else if (hg < 10) { dst = CKV + (hg - 6) * 64; ld = 256; sacc = sskv + (hg - 6); sst = 4; } else { dst = KPE; ld = 64; }
        dst += 8 * fq;
        float rsv[2][4];
#pragma unroll
        for (int ai = 0; ai < 2; ++ai)
#pragma unroll
            for (int m = 0; m < 4; ++m) rsv[ai][m] = rs[u.pm * 256 + ai * 128 + wr * 64 + m * 16 + fr];
#pragma unroll
        for (int ai = 0; ai < 2; ++ai)
#pragma unroll
            for (int m = 0; m < 4; ++m) {
                const int row = u.pm * 256 + ai * 128 + wr * 64 + m * 16 + fr;
                const float rstd = rsv[ai][m];
                f32x4 v[2][2]; float s = 0.f;
#pragma unroll
                for (int bj = 0; bj < 2; ++bj)
#pragma unroll
                    for (int n = 0; n < 2; ++n) { v[bj][n] = acc[ai][bj][m][n] * rstd; s += dot4(v[bj][n]); }
                s += __shfl_xor(s, 16); s += __shfl_xor(s, 32);
                if (fq == 0) { if (sacc != nullptr) sacc[(size_t)row * sst] = s; else { float z_ = 0.f; asm volatile("" : "+v"(z_)); ssq[(size_t)row * 8 + 6] = z_; ssq[(size_t)row * 8 + 7] = z_; } }
#pragma unroll
                for (int bj = 0; bj < 2; ++bj) {
                    u32x4 w; w.x = pk2(v[bj][0][0], v[bj][0][1]); w.y = pk2(v[bj][0][2], v[bj][0][3]); w.z = pk2(v[bj][1][0], v[bj][1][1]); w.w = pk2(v[bj][1][2], v[bj][1][3]);
                    *(u32x4*)(dst + (size_t)row * ld + 32 * bj) = w;
                }
            }
    }
};
struct EpiRes {
    static constexpr bool PERM = true, AFTER_DRAIN = false;
    const float* base32; float* out32; bf16* xb; bf16* xbw; float* ssn;
    __device__ __forceinline__ void operator()(const f32x4 (&acc)[2][2][4][2], const pg8::Unit& u, int wr, int wc, int fr_, int fq_) const {
        int fr = fr_, fq = fq_; asm volatile("" : "+v"(fr), "+v"(fq));
        float* ssn_ = ssn; bf16* xbw_ = xbw; float* out_ = out32; const float* b32_ = base32; asm volatile("" : "+s"(ssn_), "+s"(xbw_), "+s"(out_), "+s"(b32_));
        const int col0 = u.pn * 256 + wc * 32 + 8 * fq;
#pragma unroll
        for (int ai = 0; ai < 2; ++ai) {
            f32x4 bv[4][2][2];
            if (b32_ != nullptr) {
#pragma unroll
                for (int m = 0; m < 4; ++m)
#pragma unroll
                    for (int bj = 0; bj < 2; ++bj)
#pragma unroll
                        for (int n = 0; n < 2; ++n) bv[m][bj][n] = *(const f32x4*)(b32_ + (size_t)(u.pm * 256 + ai * 128 + wr * 64 + m * 16 + fr) * DMODEL + col0 + bj * 128 + n * 4);
            } else {
                u32x4 rw[4][2];
#pragma unroll
                for (int m = 0; m < 4; ++m)
#pragma unroll
                    for (int bj = 0; bj < 2; ++bj) rw[m][bj] = *(const u32x4*)(xb + (size_t)(u.pm * 256 + ai * 128 + wr * 64 + m * 16 + fr) * DMODEL + col0 + bj * 128);
#pragma unroll
                for (int m = 0; m < 4; ++m)
#pragma unroll
                    for (int bj = 0; bj < 2; ++bj) {
                        bv[m][bj][0] = (f32x4){bflo(rw[m][bj].x), bfhi(rw[m][bj].x), bflo(rw[m][bj].y), bfhi(rw[m][bj].y)};
                        bv[m][bj][1] = (f32x4){bflo(rw[m][bj].z), bfhi(rw[m][bj].z), bflo(rw[m][bj].w), bfhi(rw[m][bj].w)};
                    }
            }
            asm volatile("" ::: "memory");
#pragma unroll
            for (int m = 0; m < 4; ++m) {
                const int row = u.pm * 256 + ai * 128 + wr * 64 + m * 16 + fr;
                float s = 0.f;
#pragma unroll
                for (int bj = 0; bj < 2; ++bj) {
                    const size_t off = (size_t)row * DMODEL + col0 + bj * 128;
                    const f32x4 o0 = bv[m][bj][0] + acc[ai][bj][m][0], o1 = bv[m][bj][1] + acc[ai][bj][m][1];
                    if (out_ != nullptr) { *(f32x4*)(out_ + off) = o0; *(f32x4*)(out_ + off + 4) = o1; }
                    if (xbw_ != nullptr) { u32x4 w; w.x = pk2(o0[0], o0[1]); w.y = pk2(o0[2], o0[3]); w.z = pk2(o1[0], o1[1]); w.w = pk2(o1[2], o1[3]); *(u32x4*)(xbw_ + off) = w; }
                    s += dot4(o0) + dot4(o1);
                }
                if (ssn_ != nullptr) { s += __shfl_xor(s, 16); s += __shfl_xor(s, 32); if (fq == 0) ssn_[(size_t)row * 16 + u.pn * 4 + wc] = s; }
            }
            asm volatile("" ::: "memory");
        }
    }
};
__device__ __forceinline__ u32x4 shfl4(u32x4 v, int src) { u32x4 r; r.x = __shfl(v.x, src, 16); r.y = __shfl(v.y, src, 16); r.z = __shfl(v.z, src, 16); r.w = __shfl(v.w, src, 16); return r; }
struct EpiGateUp {
    static constexpr bool PERM = true, AFTER_DRAIN = false;
    bf16* act; bf16* gedge; bf16* uedge; const float* rs; const float* cw; const float* cb;
    __device__ __forceinline__ void operator()(const f32x4 (&acc)[2][2][4][2], const pg8::Unit& u, int wr, int wc, int fr_, int fq_) const {
        int fr = fr_, fq = fq_; asm volatile("" : "+v"(fr), "+v"(fq));
        const int c0 = u.pn * 128 + wc * 32 + 8 * fq;
        f32x4 w0[2], w1[2], w2[2], b[2];
#pragma unroll
        for (int n = 0; n < 2; ++n) { w0[n] = *(const f32x4*)(cw + c0 + 4 * n); w1[n] = *(const f32x4*)(cw + DFF + c0 + 4 * n); w2[n] = *(const f32x4*)(cw + 2 * DFF + c0 + 4 * n); b[n] = *(const f32x4*)(cb + c0 + 4 * n); }
#pragma unroll
        for (int ai = 0; ai < 2; ++ai) {
            u32x4 g[4]; float rstd[4];
            const int strip = u.pm * 4 + ai * 2 + wr;
#pragma unroll
            for (int m = 0; m < 4; ++m) rstd[m] = rs[u.pm * 256 + ai * 128 + wr * 64 + m * 16 + fr];
#pragma unroll
            for (int m = 0; m < 4; ++m) {
                const f32x4 ga = acc[ai][0][m][0] * rstd[m], gb = acc[ai][0][m][1] * rstd[m];
                g[m].x = pk2(ga[0], ga[1]); g[m].y = pk2(ga[2], ga[3]); g[m].z = pk2(gb[0], gb[1]); g[m].w = pk2(gb[2], gb[3]);
            }
#pragma unroll
            for (int m = 0; m < 4; ++m) {
                const int row = u.pm * 256 + ai * 128 + wr * 64 + m * 16 + fr;
                const u32x4 g0 = g[m];
                u32x4 g1, g2;
#pragma unroll
                for (int d = 0; d < 4; ++d) {
                    unsigned o1_ = 0u, o2_ = 0u;
                    if (m > 0) { o1_ = __builtin_amdgcn_update_dpp(0u, g[m - 1][d], 0x121, 0xf, 0xf, false); o2_ = __builtin_amdgcn_update_dpp(0u, g[m - 1][d], 0x122, 0xf, 0xf, false); }
                    g1[d] = __builtin_amdgcn_update_dpp(o1_, g0[d], 0x111, 0xf, 0xf, false);
                    g2[d] = __builtin_amdgcn_update_dpp(o2_, g0[d], 0x112, 0xf, 0xf, false);
                }
                u32x4 w, uw;
#pragma unroll
                for (int n = 0; n < 2; ++n) {
                    float r[4], up[4];
#pragma unroll
                    for (int j = 0; j < 4; ++j) {
                        const unsigned q0 = g0[2 * n + (j >> 1)], q1 = g1[2 * n + (j >> 1)], q2 = g2[2 * n + (j >> 1)];
                        const float x0 = (j & 1) ? bfhi(q0) : bflo(q0), x1 = (j & 1) ? bfhi(q1) : bflo(q1), x2 = (j & 1) ? bfhi(q2) : bflo(q2);
                        const float cv = b[n][j] + w2[n][j] * x0 + w1[n][j] * x1 + w0[n][j] * x2;
                        const float sg = cv * __builtin_amdgcn_rcpf(1.0f + __builtin_amdgcn_exp2f(-LOG2E * cv));
                        up[j] = acc[ai][1][m][n][j] * rstd[m];
                        r[j] = sg * up[j];
                    }
                    w[2 * n] = pk2(r[0], r[1]); w[2 * n + 1] = pk2(r[2], r[3]);
                    uw[2 * n] = pk2(up[0], up[1]); uw[2 * n + 1] = pk2(up[2], up[3]);
                }
                if (m == 0) {
                    if (fr < 2) { *(u32x4*)(gedge + ((size_t)strip * 4 + fr) * DFF + c0) = g0; *(u32x4*)(uedge + ((size_t)strip * 2 + fr) * DFF + c0) = uw; }
                    else *(u32x4*)(act + (size_t)row * DFF + c0) = w;
                } else {
                    *(u32x4*)(act + (size_t)row * DFF + c0) = w;
                    if (m == 3 && fr >= 14) *(u32x4*)(gedge + ((size_t)strip * 4 + 2 + (fr - 14)) * DFF + c0) = g0;
                }
                asm volatile("" ::: "memory");
            }
        }
    }
};

__device__ __forceinline__ int crow(int r, int hi) { return (r & 3) + 8 * (r >> 2) + 4 * hi; }
struct TileGeo { int NT, TPS, ks0, res0, dil; };
template <int DQK, int DV, int KT> struct AttL {
    static constexpr int KSTR = DQK * 2 + 16, VSTR = DV * 2 + 64, KBUF = KT * KSTR, VBUF = KT * VSTR;
    static constexpr int OFF_K = 0, OFF_V = 2 * KBUF, OFF_TAB = OFF_V + 2 * VBUF;
};
template <int DQK, int DV, bool BIAS, int TABN, bool QRELOAD, int KT>
__device__ __forceinline__ void attn_pass(int qoff_, LAS unsigned char* lds, const bf16* Kb, int kpitch, const bf16* Vb, int vpitch, const TileGeo G, int my_tlo, int my_thi,
                                          int wslot_q0, int W, const bf16x8 (&qf_)[DQK / 16], float& m_, float& l_, f32x16 (&o)[DV / 32]) {
    typedef AttL<DQK, DV, KT> L;
    int tid = threadIdx.x; asm volatile("" : "+v"(tid)); const int lane = tid & 63, r32 = lane & 31, hi = lane >> 5;
    constexpr int SUB = KT / 64;
    constexpr int KCH = DQK / 8, VCH = DV / 8, NKC = KT * KCH, NVC = KT * VCH, NKL = (NKC + 511) / 512, NVL = (NVC + 511) / 512;
    u32x4 kr[NKL], vr[NVL];
    const LAS float* tab = (const LAS float*)(lds + L::OFF_TAB);
    const int slot_q = wslot_q0 + r32;
    const int vlane = (4 * hi + ((lane & 15) >> 2)) * L::VSTR + (16 * ((lane >> 4) & 1) + 4 * (lane & 3)) * 2;
#define ATT_LOAD(t) do { const int seg_ = ((t) * SUB) / G.TPS, tis_ = (t) * SUB - seg_ * G.TPS; const int tok0_ = G.res0 + seg_ + G.dil * (G.ks0 + 64 * tis_); \
        _Pragma("unroll") for (int i_ = 0; i_ < NKL; ++i_) { const int c_ = tid + 512 * i_; if ((NKC % 512 == 0) || c_ < NKC) { const int j_ = c_ / KCH, p_ = c_ - j_ * KCH; \
            kr[i_] = *(const u32x4*)(Kb + (size_t)(tok0_ + G.dil * j_) * kpitch + p_ * 8); } } \
        _Pragma("unroll") for (int i_ = 0; i_ < NVL; ++i_) { const int c_ = tid + 512 * i_; if ((NVC % 512 == 0) || c_ < NVC) { const int j_ = c_ / VCH, p_ = c_ - j_ * VCH; \
            vr[i_] = *(const u32x4*)(Vb + (size_t)(tok0_ + G.dil * j_) * vpitch + p_ * 8); } } } while (0)
#define ATT_STORE(buf) do { \
        _Pragma("unroll") for (int i_ = 0; i_ < NKL; ++i_) { const int c_ = tid + 512 * i_; if ((NKC % 512 == 0) || c_ < NKC) { const int j_ = c_ / KCH, p_ = c_ - j_ * KCH; \
            *(LAS u32x4*)(lds + L::OFF_K + (buf) * L::KBUF + j_ * L::KSTR + p_ * 16) = kr[i_]; } } \
        _Pragma("unroll") for (int i_ = 0; i_ < NVL; ++i_) { const int c_ = tid + 512 * i_; if ((NVC % 512 == 0) || c_ < NVC) { const int j_ = c_ / VCH, p_ = c_ - j_ * VCH; \
            *(LAS u32x4*)(lds + L::OFF_V + (buf) * L::VBUF + j_ * L::VSTR + p_ * 16) = vr[i_]; } } } while (0)
    ATT_LOAD(0);
    ATT_STORE(0);
    float m = m_, l = l_;
    const int NT2 = G.NT / SUB;
    for (int t = 0; t < NT2; ++t) {
        const int buf = t & 1;
        if (t + 1 < NT2) ATT_LOAD(t + 1);
        __syncthreads();
#pragma unroll
        for (int hf = 0; hf < SUB; ++hf) {
        const int st = t * SUB + hf;
        if (st >= my_tlo && st <= my_thi) {
            const int tis = st % G.TPS, slot0 = G.ks0 + 64 * tis;
            const LAS unsigned char* Kt = lds + L::OFF_K + buf * L::KBUF + (hf * 64 + r32) * L::KSTR + hi * 16;
            f32x16 s[2];
            const int dsb = slot_q - slot0 - 4 * hi;
            bf16x8 qf[DQK / 16];
            if (QRELOAD) {
#pragma unroll
                for (int ks = 0; ks < DQK / 16; ++ks) qf[ks] = *(const LAS bf16x8*)(lds + qoff_ + ks * 32); }
            else {
#pragma unroll
                for (int ks = 0; ks < DQK / 16; ++ks) qf[ks] = qf_[ks]; }
#pragma unroll
            for (int kb = 0; kb < 2; ++kb) {
#pragma unroll
                for (int r = 0; r < 16; ++r) s[kb][r] = BIAS ? tab[dsb + 128 - (32 * kb + (r & 3) + 8 * (r >> 2))] : 0.f;
            }
            if (DV == 64) {
                bf16x8 kf[2][DQK / 16];
#pragma unroll
                for (int kb = 0; kb < 2; ++kb)
#pragma unroll
                    for (int ks = 0; ks < DQK / 16; ++ks) kf[kb][ks] = *(const LAS bf16x8*)(Kt + kb * 32 * L::KSTR + ks * 32);
                asm volatile("" ::: "memory");
#pragma unroll
                for (int ks = 0; ks < DQK / 16; ++ks)
#pragma unroll
                    for (int kb = 0; kb < 2; ++kb) s[kb] = __builtin_amdgcn_mfma_f32_32x32x16_bf16(kf[kb][ks], qf[ks], s[kb], 0, 0, 0);
            } else {
#pragma unroll
                for (int kh = 0; kh < 2; ++kh) {
                    bf16x8 kf[2][DQK / 32];
#pragma unroll
                    for (int kb = 0; kb < 2; ++kb)
#pragma unroll
                        for (int k2 = 0; k2 < DQK / 32; ++k2) kf[kb][k2] = *(const LAS bf16x8*)(Kt + kb * 32 * L::KSTR + (kh * (DQK / 32) + k2) * 32);
                    asm volatile("" ::: "memory");
#pragma unroll
                    for (int k2 = 0; k2 < DQK / 32; ++k2)
#pragma unroll
                        for (int kb = 0; kb < 2; ++kb) s[kb] = __builtin_amdgcn_mfma_f32_32x32x16_bf16(kf[kb][k2], qf[kh * (DQK / 32) + k2], s[kb], 0, 0, 0);
                }
            }
            const bool full = (wslot_q0 - slot0 - 63 >= 0) && (wslot_q0 + 31 - slot0 <= W);
            if (!full && !BIAS) {
#pragma unroll
                for (int kb = 0; kb < 2; ++kb)
#pragma unroll
                    for (int r = 0; r < 16; ++r) {
                        const int ds = dsb - (32 * kb + (r & 3) + 8 * (r >> 2));
                        s[kb][r] = ((unsigned)ds <= (unsigned)W) ? s[kb][r] : -INFINITY;
                    }
            }
            float mx = s[0][0];
#pragma unroll
            for (int r = 1; r < 16; ++r) mx = fmaxf(mx, s[0][r]);
#pragma unroll
            for (int r = 0; r < 16; ++r) mx = fmaxf(mx, s[1][r]);
            mx = fmaxf(mx, __shfl_xor(mx, 32));
            const float mn = fmaxf(m, mx);
            const float base = (mn == -INFINITY) ? 0.f : mn;
            const float alpha = __builtin_amdgcn_exp2f(m - base);
            m = mn;
            float ps = 0.f;
#pragma unroll
            for (int kb = 0; kb < 2; ++kb)
#pragma unroll
                for (int r = 0; r < 16; ++r) { const float p = __builtin_amdgcn_exp2f(s[kb][r] - base); s[kb][r] = p; ps += p; }
            l = l * alpha + ps;
            if (__any(alpha != 1.0f)) {
#pragma unroll
                for (int c = 0; c < DV / 32; ++c)
#pragma unroll
                    for (int r = 0; r < 16; ++r) o[c][r] *= alpha;
            }
            const LAS unsigned char* Vt = lds + L::OFF_V + buf * L::VBUF + hf * 64 * L::VSTR + vlane;
#pragma unroll
            for (int kb = 0; kb < 2; ++kb) {
                bf16x8 pb[2];
#pragma unroll
                for (int k2 = 0; k2 < 2; ++k2) {
                    u32x4 pw; pw.x = pk2(s[kb][8 * k2 + 0], s[kb][8 * k2 + 1]); pw.y = pk2(s[kb][8 * k2 + 2], s[kb][8 * k2 + 3]);
                    pw.z = pk2(s[kb][8 * k2 + 4], s[kb][8 * k2 + 5]); pw.w = pk2(s[kb][8 * k2 + 6], s[kb][8 * k2 + 7]);
                    pb[k2] = __builtin_bit_cast(bf16x8, pw);
                }
#pragma unroll
                for (int ch = 0; ch < DV / 64; ++ch) {
                    bf16x8 vf[2][2];
#pragma unroll
                    for (int k2 = 0; k2 < 2; ++k2)
#pragma unroll
                        for (int c2 = 0; c2 < 2; ++c2) {
                            const LAS unsigned char* vp = Vt + (32 * kb + 16 * k2) * L::VSTR + 64 * (2 * ch + c2);
                            const s16x4 lo = __builtin_bit_cast(s16x4, __builtin_amdgcn_ds_read_tr16_b64_v4i16((LAS s16x4*)(vp)));
                            const s16x4 hh = __builtin_bit_cast(s16x4, __builtin_amdgcn_ds_read_tr16_b64_v4i16((LAS s16x4*)(vp + 8 * L::VSTR)));
                            vf[k2][c2] = (bf16x8){lo[0], lo[1], lo[2], lo[3], hh[0], hh[1], hh[2], hh[3]};
                        }
                    asm volatile("" ::: "memory");
#pragma unroll
                    for (int k2 = 0; k2 < 2; ++k2)
#pragma unroll
                        for (int c2 = 0; c2 < 2; ++c2) o[2 * ch + c2] = __builtin_amdgcn_mfma_f32_32x32x16_bf16(vf[k2][c2], pb[k2], o[2 * ch + c2], 0, 0, 0);
                }
            }
        }
        }
        if (t + 1 < NT2) ATT_STORE(buf ^ 1);
    }
    __syncthreads();
    m_ = m; l_ = l;
#undef ATT_LOAD
#undef ATT_STORE
}

template <int MODE>
__device__ __forceinline__ void attn_phase(LAS unsigned char* lds, const Args& a, int Gn, int cid) {
    constexpr int DQK = MODE == 1 ? 96 : 64, DV = MODE == 2 ? 128 : 64;
    constexpr bool BIAS = MODE != 1;
    constexpr int TABN = MODE == 2 ? 2048 + 256 : 512;
    constexpr int NU = MODE == 0 ? 6144 : (MODE == 2 ? 2048 : 4096);
    constexpr int KT = MODE == 2 ? 64 : 128;
    typedef AttL<DQK, DV, KT> L;
    int tid = threadIdx.x; asm volatile("" : "+v"(tid)); const int lane = tid & 63, r32 = lane & 31, hi = lane >> 5, wid = __builtin_amdgcn_readfirstlane(tid >> 6);
    unsigned char* ws = a.ws;
    const float* biasd = (const float*)(ws + WS_BIAS);
    LAS float* tab = (LAS float*)(lds + L::OFF_TAB);
    float lam = 0.f, lam_init = 0.f;
    if (MODE == 2) {
        float d1 = 0.f, d2 = 0.f;
        for (int i = 0; i < 64; ++i) { d1 += a.in[19][i] * a.in[20][i]; d2 += a.in[21][i] * a.in[22][i]; }
        lam_init = 0.8f - 0.6f * expf(-0.3f * 2.0f);
        lam = expf(d1) - expf(d2) + lam_init;
    }
    for (int u = cid; u < NU; u += Gn) {
        int b, h, dil = 1, res0 = 0, s0, nres = 1, W, qb = 0, g = 0;
        if (MODE == 0) { g = u >> 11; const int rem = u & 2047; b = rem >> 6; h = (rem >> 3) & 7; const int blk = (rem + (u >> 8)) & 7; W = 128;
            if (g == 0) { s0 = 256 * blk; } else if (g == 1) { dil = 4; res0 = blk >> 1; s0 = 256 * (blk & 1); } else { dil = 16; res0 = 2 * blk; s0 = 0; nres = 2; } }
        else if (MODE == 3) { b = u >> 7; h = (u >> 3) & 15; s0 = 256 * ((u + (u >> 8)) & 7); W = 127; }
        else if (MODE == 1) { const int bh = u & 511; qb = 7 - (u >> 9); b = bh >> 4; h = bh & 15; s0 = 256 * qb; W = 1 << 20; }
        else { const int bh = u & 255; qb = 7 - (u >> 8); b = bh >> 3; h = bh & 7; s0 = 256 * qb; W = 1 << 20; }
        TileGeo G;
        G.dil = dil; G.res0 = res0;
        const int Lseg = 256 / nres;
        if (MODE == 0 || MODE == 3) { G.ks0 = (nres == 1 && s0 >= 128) ? s0 - 128 : 0; } else { G.ks0 = 0; }
        G.TPS = (s0 + Lseg - G.ks0) >> 6; G.NT = G.TPS * nres;
        const int nws = 8 / nres, seg_w = wid / nws, wslot_q0 = s0 + 32 * (wid - seg_w * nws);
        int tl = 0;
        if (MODE == 0 || MODE == 3) { tl = wslot_q0 - W - G.ks0; tl = tl < 0 ? 0 : (tl >> 6); }
        const int th = (wslot_q0 + 31 - G.ks0) >> 6;
        const int my_tlo = seg_w * G.TPS + tl, my_thi = seg_w * G.TPS + th;
        const int qtok = res0 + seg_w + dil * (wslot_q0 + r32);
        const size_t row_q = (size_t)b * SEQ + qtok, row_b = (size_t)b * SEQ;
        const bf16 *Qp, *Kb, *Vb; int qpitch, kpitch, vpitch;
        if (MODE == 0) { const bf16* base = (const bf16*)(ws + R_A_QKV); qpitch = kpitch = vpitch = 4608;
            Qp = base + row_q * 4608 + g * 1536 + h * 64; Kb = base + row_b * 4608 + g * 1536 + 512 + h * 64; Vb = base + row_b * 4608 + g * 1536 + 1024 + h * 64; }
        else if (MODE == 1) { qpitch = 1536; kpitch = 1536; vpitch = 2048;
            Qp = (const bf16*)(ws + R_B_Q) + row_q * 1536 + h * 96; Kb = (const bf16*)(ws + R_B_KH) + row_b * 1536 + h * 96; Vb = (const bf16*)(ws + R_B_KV) + row_b * 2048 + h * 128 + 64; }
        else if (MODE == 2) { const bf16* base = (const bf16*)(ws + R_C_QKV); qpitch = kpitch = vpitch = 3072;
            Qp = base + row_q * 3072 + (2 * h) * 64; Kb = base + row_b * 3072 + 1024 + (2 * h) * 64; Vb = base + row_b * 3072 + 2048 + h * 128; }
        else { const bf16* base = (const bf16*)(ws + R_D_QKV); qpitch = kpitch = vpitch = 1280;
            Qp = base + row_q * 1280 + h * 64; Kb = base + row_b * 1280 + 1024 + (h >> 3) * 64; Vb = base + row_b * 1280 + 1152 + (h >> 3) * 64; }
        (void)qpitch;
        if (MODE == 0 || MODE == 3) { const int d_ = tid - 128; tab[tid] = (d_ >= 0 && d_ <= W) ? biasd[h * 2048 + d_ * dil] : -INFINITY; }
        if (MODE == 2) {
#pragma unroll
            for (int j = 0; j < 4; ++j) tab[128 + tid + 512 * j] = biasd[h * 2048 + tid + 512 * j];
            if (tid < 128) { tab[tid] = -INFINITY; tab[2176 + tid] = 0.f; } }
        bf16x8 qf[DQK / 16];
        constexpr int OFF_Q = L::OFF_TAB + TABN * 4, QSTR = DQK * 2 + 16;
        const int qoff = OFF_Q + (32 * wid + r32) * QSTR + hi * 16;
        int tq = tid; asm volatile("" : "+v"(tq));
        if (MODE == 2) {
            const bf16* qsrc = (const bf16*)(ws + R_C_QKV) + (row_b + s0) * 3072 + (2 * h) * 64;
#pragma unroll
            for (int j = 0; j < 4; ++j) { const int c_ = tq + 512 * j, rw = c_ >> 3, p_ = c_ & 7;
                *(LAS u32x4*)(lds + OFF_Q + rw * QSTR + p_ * 16) = *(const u32x4*)(qsrc + (size_t)rw * 3072 + p_ * 8); }
        } else {
#pragma unroll
            for (int ks = 0; ks < DQK / 16; ++ks) qf[ks] = *(const bf16x8*)(Qp + 16 * ks + 8 * hi);
            if (MODE == 1) {
                float x[DQK / 16][8]; float ss = 0.f;
#pragma unroll
                for (int ks = 0; ks < DQK / 16; ++ks) { const u32x4 raw = __builtin_bit_cast(u32x4, qf[ks]);
#pragma unroll
                    for (int j = 0; j < 4; ++j) { x[ks][2 * j] = bflo(raw[j]); x[ks][2 * j + 1] = bfhi(raw[j]); ss += x[ks][2 * j] * x[ks][2 * j] + x[ks][2 * j + 1] * x[ks][2 * j + 1]; } }
                ss += __shfl_xor(ss, 32);
                const float rsq = rsqrtf(ss * (1.0f / 96.0f) + EPS) * (0.10206207261596577f * LOG2E);
                const float* gq_ = a.in[13];
#pragma unroll
                for (int ks = 0; ks < DQK / 16; ++ks) { const f32x4 g0 = *(const f32x4*)(gq_ + 16 * ks + 8 * hi), g1 = *(const f32x4*)(gq_ + 16 * ks + 8 * hi + 4);
#pragma unroll
                    for (int j = 0; j < 4; ++j) { x[ks][j] *= rsq * g0[j]; x[ks][4 + j] *= rsq * g1[j]; } }
                const float* cs = (const float*)(ws + WS_ROPE) + ((size_t)qtok * 16 + 8 * hi) * 2;
#pragma unroll
                for (int j = 0; j < 8; ++j) { const float co = cs[2 * j], si = cs[2 * j + 1], x1 = x[4][j], x2 = x[5][j]; x[4][j] = x1 * co - x2 * si; x[5][j] = x2 * co + x1 * si; }
#pragma unroll
                for (int ks = 0; ks < DQK / 16; ++ks) { u32x4 w;
#pragma unroll
                    for (int j = 0; j < 4; ++j) w[j] = pk2(x[ks][2 * j], x[ks][2 * j + 1]);
                    qf[ks] = __builtin_bit_cast(bf16x8, w); }
            }
        }
        f32x16 o[DV / 32];
#pragma unroll
        for (int c = 0; c < DV / 32; ++c)
#pragma unroll
            for (int r = 0; r < 16; ++r) o[c][r] = 0.f;
        float m = -INFINITY, l = 0.f;
        if (MODE == 3) { m = a.in[28][h] * LOG2E; l = hi == 0 ? 1.f : 0.f; }
        attn_pass<DQK, DV, BIAS, TABN, MODE == 2, KT>(qoff, lds, Kb, kpitch, Vb, vpitch, G, my_tlo, my_thi, wslot_q0, W, qf, m, l, o);
        float lt = l + __shfl_xor(l, 32);
        float inv = 1.0f / lt;
        if (MODE != 2) {
            bf16* Op; int opitch;
            if (MODE == 0) { Op = (bf16*)(ws + R_A_O3) + ((size_t)g * M_ + row_q) * 512 + h * 64; opitch = 512;
                if (hi == 0) ((float*)(ws + R_A_LSE))[((size_t)g * M_ + row_q) * 8 + h] = m + __log2f(lt); }
            else if (MODE == 1) { Op = (bf16*)(ws + R_B_O) + row_q * 1024 + h * 64; opitch = 1024; }
            else { Op = (bf16*)(ws + R_D_O) + row_q * 1024 + h * 64; opitch = 1024; }
            (void)opitch;
#pragma unroll
            for (int c = 0; c < DV / 32; ++c)
#pragma unroll
                for (int k = 0; k < 2; ++k) {
                    u32x2 we, wo; we.x = pk2(o[c][8 * k] * inv, o[c][8 * k + 1] * inv); we.y = pk2(o[c][8 * k + 2] * inv, o[c][8 * k + 3] * inv);
                    wo.x = pk2(o[c][8 * k + 4] * inv, o[c][8 * k + 5] * inv); wo.y = pk2(o[c][8 * k + 6] * inv, o[c][8 * k + 7] * inv);
                    const u32x2 snd = hi ? we : wo, mine = hi ? wo : we;
                    u32x2 rcv; rcv.x = __shfl_xor(snd.x, 32); rcv.y = __shfl_xor(snd.y, 32);
                    u32x4 w; if (hi) { w.x = rcv.x; w.y = rcv.y; w.z = mine.x; w.w = mine.y; } else { w.x = mine.x; w.y = mine.y; w.z = rcv.x; w.w = rcv.y; }
                    *(u32x4*)(Op + 32 * c + 8 * (2 * k + hi)) = w;
                }
        } else {
            f32x16 o1[DV / 32];
#pragma unroll
            for (int c = 0; c < DV / 32; ++c)
#pragma unroll
                for (int r = 0; r < 16; ++r) { o1[c][r] = o[c][r] * inv; o[c][r] = 0.f; }
#pragma unroll
            for (int j = 0; j < 4; ++j) tab[128 + tid + 512 * j] = biasd[(8 + h) * 2048 + tid + 512 * j];
            { const bf16* qsrc = (const bf16*)(ws + R_C_QKV) + (row_b + s0) * 3072 + (2 * h + 1) * 64;
#pragma unroll
              for (int j = 0; j < 4; ++j) { const int c_ = tq + 512 * j, rw = c_ >> 3, p_ = c_ & 7;
                  *(LAS u32x4*)(lds + OFF_Q + rw * QSTR + p_ * 16) = *(const u32x4*)(qsrc + (size_t)rw * 3072 + p_ * 8); } }
            m = -INFINITY; l = 0.f;
            attn_pass<DQK, DV, BIAS, TABN, MODE == 2, KT>(qoff, lds, Kb + 64, kpitch, Vb, vpitch, G, my_tlo, my_thi, wslot_q0, W, qf, m, l, o);
            lt = l + __shfl_xor(l, 32);
            inv = lam / lt;
            float ssum = 0.f;
#pragma unroll
            for (int c = 0; c < DV / 32; ++c)
#pragma unroll
                for (int r = 0; r < 16; ++r) { const float d = o1[c][r] - o[c][r] * inv; o1[c][r] = d; ssum += d * d; }
            ssum += __shfl_xor(ssum, 32);
            const float rs = rsqrtf(ssum * (1.0f / 128.0f) + EPS) * (1.0f - lam_init);
            bf16* Op = (bf16*)(ws + R_C_O) + row_q * 1024 + h * 128;
            const float* sub = a.in[23];
#pragma unroll
            for (int c = 0; c < DV / 32; ++c)
#pragma unroll
                for (int k = 0; k < 2; ++k) {
                    const f32x4 se = *(const f32x4*)(sub + 32 * c + 16 * k + 4 * hi), so = *(const f32x4*)(sub + 32 * c + 16 * k + 8 + 4 * hi);
                    u32x2 we, wo; we.x = pk2(o1[c][8 * k] * rs * se[0], o1[c][8 * k + 1] * rs * se[1]); we.y = pk2(o1[c][8 * k + 2] * rs * se[2], o1[c][8 * k + 3] * rs * se[3]);
                    wo.x = pk2(o1[c][8 * k + 4] * rs * so[0], o1[c][8 * k + 5] * rs * so[1]); wo.y = pk2(o1[c][8 * k + 6] * rs * so[2], o1[c][8 * k + 7] * rs * so[3]);
                    const u32x2 snd = hi ? we : wo, mine = hi ? wo : we;
                    u32x2 rcv; rcv.x = __shfl_xor(snd.x, 32); rcv.y = __shfl_xor(snd.y, 32);
                    u32x4 w; if (hi) { w.x = rcv.x; w.y = rcv.y; w.z = mine.x; w.w = mine.y; } else { w.x = mine.x; w.y = mine.y; w.z = rcv.x; w.w = rcv.y; }
                    *(u32x4*)(Op + 32 * c + 8 * (2 * k + hi)) = w;
                }
        }
    }
}

__device__ __forceinline__ void transpose_item(const float* W, int ldw, int ncol0, int K, const float* ksc, bf16* WT, int mode, LAS float* scr, int nblk, int item, int lane) {
    const int kb = item / nblk, nb = item - kb * nblk, k0 = 64 * kb, n0 = 32 * nb;
#pragma unroll
    for (int i = 0; i < 32; ++i) { const int kk = 2 * i + (lane >> 5); float v = W[(size_t)(k0 + kk) * ldw + ncol0 + n0 + (lane & 31)]; if (ksc != nullptr) v *= ksc[k0 + kk]; scr[kk * 33 + (lane & 31)] = v; }
    asm volatile("s_waitcnt lgkmcnt(0)" ::: "memory");
    const int drow0 = mode == 1 ? (256 * (n0 >> 8) + 128 * ((n0 & 63) >> 5) + 32 * ((n0 >> 6) & 3)) : mode == 2 ? (n0 < DFF ? 256 * (n0 >> 7) + (n0 & 127) : 256 * ((n0 - DFF) >> 7) + 128 + ((n0 - DFF) & 127)) : n0;
    const int c = lane & 7;
#pragma unroll
    for (int j = 0; j < 4; ++j) { const int n = (lane >> 3) + 8 * j; const LAS float* s = scr + (8 * c) * 33 + n;
        u32x4 o; o.x = pk2(s[0 * 33], s[1 * 33]); o.y = pk2(s[2 * 33], s[3 * 33]); o.z = pk2(s[4 * 33], s[5 * 33]); o.w = pk2(s[6 * 33], s[7 * 33]);
        *(u32x4*)(WT + (size_t)(drow0 + n) * K + k0 + 8 * c) = o; }
    asm volatile("s_waitcnt lgkmcnt(0)" ::: "memory");
}
__device__ __forceinline__ void prologue(LAS unsigned char* lds, const Args& a, int Gn, int cid) {
    int tid = threadIdx.x; asm volatile("" : "+v"(tid)); const int lane = tid & 63, wid = __builtin_amdgcn_readfirstlane(tid >> 6);
    unsigned char* ws = a.ws;
    LAS float* scr = (LAS float*)(lds + wid * 16384);
    const int gw = cid * 8 + wid, NGW = Gn * 8;
#define MAT_DESC(id) \
        const float* W; int ldw, ncol0 = 0, K, N, mode; const float* ksc = nullptr; size_t dst; \
        if (id == 0) { W = a.in[4]; ldw = 4608; K = 1024; N = 4608; ksc = a.in[2]; dst = W_AIN; mode = 1; } \
        else if (id == 1) { W = a.in[7]; ldw = 1024; K = 512; N = 1024; dst = W_AOUT; mode = 0; } \
        else if (id == 2) { W = a.in[8]; ldw = 672; K = 1024; N = 672; ksc = a.in[2] + 1024; dst = W_BIN; mode = 1; } \
        else if (id == 3) { W = a.in[11]; ldw = 1536; K = 384; N = 1536; ksc = a.in[9]; dst = W_BQUP; mode = 1; } \
        else if (id == 4) { W = a.in[12]; ldw = 2048; K = 256; N = 2048; ksc = a.in[10]; dst = W_BKVUP; mode = 1; } \
        else if (id == 5) { W = a.in[15]; ldw = 1024; K = 1024; N = 1024; dst = W_BOUT; mode = 0; } \
        else if (id == 6) { W = a.in[16]; ldw = 3072; K = 1024; N = 3072; ksc = a.in[2] + 2048; dst = W_CIN; mode = 1; } \
        else if (id == 7) { W = a.in[24]; ldw = 1024; K = 1024; N = 1024; dst = W_COUT; mode = 0; } \
        else if (id == 8) { W = a.in[25]; ldw = 1280; K = 1024; N = 1280; ksc = a.in[2] + 3072; dst = W_DIN; mode = 1; } \
        else if (id == 9) { W = a.in[29]; ldw = 1024; K = 1024; N = 1024; dst = W_DOUT; mode = 0; } \
        else { const int l = (id - 10) / 3, k3 = (id - 10) - 3 * l; \
            if (k3 < 2) { W = a.in[30] + (size_t)l * 1024 * 5632; ldw = 5632; K = 1024; N = 5632; ksc = a.in[3] + 1024 * l; dst = W_FG + l * 2 * W_FSTR; mode = 2; } \
            else { W = a.in[33] + (size_t)l * 2816 * 1024; ldw = 1024; K = 2816; N = 1024; dst = W_FD + l * W_FSTR; mode = 0; } }
    constexpr int TOTAL_ITEMS = 2304 + 256 + 336 + 288 + 256 + 512 + 1536 + 512 + 640 + 512 + 4 * (1408 + 1408 + 1408);
    for (int it = gw; it < TOTAL_ITEMS; it += NGW) {
        int r = it, id = 0;
        for (; id < 21; ++id) {
            int n_;
            if (id < 10) { n_ = id == 0 ? 2304 : id == 1 ? 256 : id == 2 ? 336 : id == 3 ? 288 : id == 4 ? 256 : id == 5 ? 512 : id == 6 ? 1536 : id == 7 ? 512 : id == 8 ? 640 : 512; } else { const int k3_ = (id - 10) % 3; n_ = k3_ == 0 ? 2816 : (k3_ == 1 ? 0 : 1408); }
            if (r < n_) break;
            r -= n_;
        }
        MAT_DESC(id)
        const int nblk = N / 32;
        transpose_item(W, ldw, ncol0, K, ksc, (bf16*)(ws + dst), mode, scr, nblk, r, lane);
    }
#undef MAT_DESC
    const int gt = cid * 512 + tid, NT = Gn * 512;
    { float* biasd = (float*)(ws + WS_BIAS); const float* table = a.in[1];
      for (int i = gt; i < 16 * 2048; i += NT) { const int h = i >> 11, d = i & 2047; int bk = d;
          if (d >= 16) { float t = logf((float)d / 16.0f); t = t / 4.852030263919617f; t = t * 16.0f; int lg = 16 + (int)t; bk = lg < 31 ? lg : 31; }
          biasd[i] = table[bk * 16 + h] * LOG2E; } }
    { float* rope = (float*)(ws + WS_ROPE);
      for (int i = gt; i < 2048 * 16; i += NT) { const int pos = i >> 4, f = i & 15; const float inv = powf(10000.0f, -(float)(2 * f) / 32.0f); const float ang = (float)pos * inv;
          rope[2 * i] = cosf(ang); rope[2 * i + 1] = sinf(ang); } }
    { const float* x = a.in[0]; bf16* xb = (bf16*)(ws + WS_XB); float* rss = (float*)(ws + WS_RSS);
      for (int m0 = gw; m0 < M_; m0 += 4 * NGW) {
          f32x4 v[4][4];
#pragma unroll
          for (int k = 0; k < 4; ++k) { const int m = m0 + k * NGW; if (m < M_) { const f32x4* xr = (const f32x4*)(x + (size_t)m * DMODEL) + lane;
#pragma unroll
              for (int j = 0; j < 4; ++j) v[k][j] = xr[64 * j]; } }
#pragma unroll
          for (int k = 0; k < 4; ++k) { const int m = m0 + k * NGW; if (m < M_) { u32x2* o8 = (u32x2*)(xb + (size_t)m * DMODEL) + lane; float s = 0.f;
#pragma unroll
              for (int j = 0; j < 4; ++j) { s += dot4(v[k][j]); u32x2 w; w.x = pk2(v[k][j][0], v[k][j][1]); w.y = pk2(v[k][j][2], v[k][j][3]); o8[64 * j] = w; }
              s = wave_sum(s); if (lane == 0) rss[m] = rsqrtf(s * (1.0f / 1024.0f) + EPS); } } } }
}
__device__ __forceinline__ void combine_a(const Args& a, int Gn, int cid) {
    unsigned char* ws = a.ws;
    const bf16* o3 = (const bf16*)(ws + R_A_O3); const float* lse = (const float*)(ws + R_A_LSE); bf16* oc = (bf16*)(ws + R_A_OC);
    const size_t NT = (size_t)Gn * 512; int tid = threadIdx.x; asm volatile("" : "+v"(tid));
    for (size_t idx0 = (size_t)cid * 512 + tid; idx0 < (size_t)M_ * 64; idx0 += 4 * NT) {
        u32x4 a0[4], a1[4], a2[4]; float l0[4], l1[4], l2[4];
#pragma unroll
        for (int k = 0; k < 4; ++k) { const size_t idx = idx0 + k * NT; if (idx < (size_t)M_ * 64) {
            const size_t row = idx >> 6; const int ch = (int)(idx & 63), h = ch >> 3;
            l0[k] = lse[row * 8 + h]; l1[k] = lse[((size_t)M_ + row) * 8 + h]; l2[k] = lse[((size_t)2 * M_ + row) * 8 + h];
            a0[k] = *(const u32x4*)(o3 + row * 512 + ch * 8); a1[k] = *(const u32x4*)(o3 + ((size_t)M_ + row) * 512 + ch * 8); a2[k] = *(const u32x4*)(o3 + ((size_t)2 * M_ + row) * 512 + ch * 8); } }
#pragma unroll
        for (int k = 0; k < 4; ++k) { const size_t idx = idx0 + k * NT; if (idx < (size_t)M_ * 64) {
            const size_t row = idx >> 6; const int ch = (int)(idx & 63);
            const float mx = fmaxf(l0[k], fmaxf(l1[k], l2[k]));
            float w0 = __builtin_amdgcn_exp2f(l0[k] - mx), w1 = __builtin_amdgcn_exp2f(l1[k] - mx), w2 = __builtin_amdgcn_exp2f(l2[k] - mx);
            const float inv = 1.0f / (w0 + w1 + w2); w0 *= inv; w1 *= inv; w2 *= inv;
            u32x4 r;
#pragma unroll
            for (int j = 0; j < 4; ++j) r[j] = pk2(w0 * bflo(a0[k][j]) + w1 * bflo(a1[k][j]) + w2 * bflo(a2[k][j]), w0 * bfhi(a0[k][j]) + w1 * bfhi(a1[k][j]) + w2 * bfhi(a2[k][j]));
            *(u32x4*)(oc + row * 512 + ch * 8) = r; } }
    }
}
__device__ __forceinline__ void prep_b(const Args& a, int Gn, int cid) {
    unsigned char* ws = a.ws;
    int tid = threadIdx.x; asm volatile("" : "+v"(tid)); const int lane = tid & 63, wid = __builtin_amdgcn_readfirstlane(tid >> 6);
    bf16* Q = (bf16*)(ws + R_B_Q); const bf16* KV = (const bf16*)(ws + R_B_KV); const bf16* KPE = (const bf16*)(ws + R_B_KPE); bf16* KH = (bf16*)(ws + R_B_KH);
    const float* rope = (const float*)(ws + WS_ROPE);
    const int sub = lane >> 4, c = lane & 15;
    const float qscale = 0.10206207261596577f * LOG2E;
    const int gw = cid * 8 + wid, NGW = Gn * 8;
    const int TOT = 2 * M_ * 4;
    for (int it0 = M_ * 4 + gw; it0 < TOT; it0 += 4 * NGW) {
        u32x4 raw[4];
#pragma unroll
        for (int k = 0; k < 4; ++k) {
            const int it = it0 + k * NGW;
            raw[k] = (u32x4){0u, 0u, 0u, 0u};
            if (it < TOT && c < 12) {
                const bool isk = it >= M_ * 4; const int it2 = isk ? it - M_ * 4 : it;
                const int task = it2 * 4 + sub; const size_t row = (size_t)(task >> 4); const int h = task & 15;
                if (!isk) raw[k] = *(const u32x4*)(Q + row * 1536 + h * 96 + 8 * c);
                else if (c < 8) raw[k] = *(const u32x4*)(KV + row * 2048 + h * 128 + 8 * c);
                else raw[k] = *(const u32x4*)(KPE + row * 64 + 8 * (c - 8));
            }
        }
#pragma unroll
        for (int k = 0; k < 4; ++k) {
            const int it = it0 + k * NGW;
            if (it < TOT) {
                const bool isk = it >= M_ * 4; const int it2 = isk ? it - M_ * 4 : it;
                const int task = it2 * 4 + sub; const size_t row = (size_t)(task >> 4); const int h = task & 15; const int pos = (int)(row & 2047);
                float x[8];
#pragma unroll
                for (int j = 0; j < 4; ++j) { x[2 * j] = bflo(raw[k][j]); x[2 * j + 1] = bfhi(raw[k][j]); }
                float ss = 0.f;
#pragma unroll
                for (int e = 0; e < 8; ++e) ss += x[e] * x[e];
                ss += __shfl_xor(ss, 1); ss += __shfl_xor(ss, 2); ss += __shfl_xor(ss, 4); ss += __shfl_xor(ss, 8);
                const float rs = rsqrtf(ss * (1.0f / 96.0f) + EPS);
                const float* gain = (isk ? a.in[14] : a.in[13]) + 8 * (c < 12 ? c : 0);
                const float* cs = rope + ((size_t)pos * 16 + (c & 1) * 8) * 2;
                float y[8];
#pragma unroll
                for (int e = 0; e < 8; ++e) y[e] = x[e] * rs * gain[e];
#pragma unroll
                for (int e = 0; e < 8; ++e) {
                    const float z = __shfl_xor(y[e], 2);
                    if (c >= 8 && c < 12) { const float co = cs[2 * e], si = cs[2 * e + 1]; y[e] = (c < 10) ? (y[e] * co - z * si) : (y[e] * co + z * si); }
                }
                if (c < 12) {
                    u32x4 w;
                    if (!isk) {
#pragma unroll
                        for (int j = 0; j < 4; ++j) w[j] = pk2(y[2 * j] * qscale, y[2 * j + 1] * qscale);
                        *(u32x4*)(Q + row * 1536 + h * 96 + 8 * c) = w;
                    } else {
#pragma unroll
                        for (int j = 0; j < 4; ++j) w[j] = pk2(y[2 * j], y[2 * j + 1]);
                        *(u32x4*)(KH + row * 1536 + h * 96 + 8 * c) = w;
                    }
                }
            }
        }
    }
}

__device__ __forceinline__ void fixup_ffn(const bf16* gedge, const bf16* uedge, bf16* act, const float* cw, const float* cb, int Gn, int cid) {
    int tid = threadIdx.x; asm volatile("" : "+v"(tid));
    const int TOT = 1024 * 2 * 352;
    for (int idx = cid * 512 + tid; idx < TOT; idx += Gn * 512) {
        const int ch = idx % 352, sj = idx / 352, j = sj & 1, st = sj >> 1, c0 = ch * 8;
        const int row = st * 64 + j, t = row & (SEQ - 1);
        const u32x4 z = (u32x4){0u, 0u, 0u, 0u};
        const u32x4 g0 = *(const u32x4*)(gedge + ((size_t)st * 4 + j) * DFF + c0);
        u32x4 g1, g2;
        if (j == 0) { g1 = t >= 1 ? *(const u32x4*)(gedge + ((size_t)(st - 1) * 4 + 3) * DFF + c0) : z; g2 = t >= 2 ? *(const u32x4*)(gedge + ((size_t)(st - 1) * 4 + 2) * DFF + c0) : z; }
        else { g1 = *(const u32x4*)(gedge + ((size_t)st * 4 + 0) * DFF + c0); g2 = t >= 2 ? *(const u32x4*)(gedge + ((size_t)(st - 1) * 4 + 3) * DFF + c0) : z; }
        const u32x4 uw = *(const u32x4*)(uedge + ((size_t)st * 2 + j) * DFF + c0);
        u32x4 w;
#pragma unroll
        for (int n = 0; n < 2; ++n) {
            const f32x4 w0 = *(const f32x4*)(cw + c0 + 4 * n), w1 = *(const f32x4*)(cw + DFF + c0 + 4 * n), w2 = *(const f32x4*)(cw + 2 * DFF + c0 + 4 * n), b = *(const f32x4*)(cb + c0 + 4 * n);
            float r[4];
#pragma unroll
            for (int e = 0; e < 4; ++e) {
                const unsigned q0 = g0[2 * n + (e >> 1)], q1 = g1[2 * n + (e >> 1)], q2 = g2[2 * n + (e >> 1)], qu = uw[2 * n + (e >> 1)];
                const float x0 = (e & 1) ? bfhi(q0) : bflo(q0), x1 = (e & 1) ? bfhi(q1) : bflo(q1), x2 = (e & 1) ? bfhi(q2) : bflo(q2), up = (e & 1) ? bfhi(qu) : bflo(qu);
                const float cv = b[e] + w2[e] * x0 + w1[e] * x1 + w0[e] * x2;
                r[e] = cv * __builtin_amdgcn_rcpf(1.0f + __builtin_amdgcn_exp2f(-LOG2E * cv)) * up;
            }
            w[2 * n] = pk2(r[0], r[1]); w[2 * n + 1] = pk2(r[2], r[3]);
        }
        *(u32x4*)(act + (size_t)row * DFF + c0) = w;
    }
}
__device__ __forceinline__ void rstd_pass(const float* ssp, int nvec, float invdim, float* rs, int Gn, int cid) {
    int tid = threadIdx.x; asm volatile("" : "+v"(tid));
    for (int row = cid * 512 + tid; row < M_; row += Gn * 512) rs[row] = rsqrtf(rowss_sum(ssp, nvec, row) * invdim + EPS);
}
__device__ __forceinline__ void kpe_pass(const Args& a, int Gn, int cid) {
    unsigned char* ws = a.ws;
    int tid = threadIdx.x; asm volatile("" : "+v"(tid));
    const bf16* KPE = (const bf16*)(ws + R_B_KPE); bf16* RK = (bf16*)(ws + R_B_RK); float* sspe = (float*)(ws + WS_SSPE);
    const float* rope = (const float*)(ws + WS_ROPE); const float* gk = a.in[14] + 64;
    for (int row = cid * 512 + tid; row < M_; row += Gn * 512) {
        float x[32]; float ss = 0.f;
#pragma unroll
        for (int c = 0; c < 4; ++c) { const u32x4 raw = *(const u32x4*)(KPE + (size_t)row * 64 + 8 * c);
#pragma unroll
            for (int j = 0; j < 4; ++j) { x[8 * c + 2 * j] = bflo(raw[j]); x[8 * c + 2 * j + 1] = bfhi(raw[j]); } }
#pragma unroll
        for (int i = 0; i < 32; ++i) { ss += x[i] * x[i]; x[i] *= gk[i]; }
        sspe[row] = ss;
        const float* cs = rope + (size_t)(row & (SEQ - 1)) * 32;
#pragma unroll
        for (int i = 0; i < 16; ++i) { const float co = cs[2 * i], si = cs[2 * i + 1], x1 = x[i], x2 = x[16 + i]; x[i] = x1 * co - x2 * si; x[16 + i] = x2 * co + x1 * si; }
#pragma unroll
        for (int c = 0; c < 4; ++c) { u32x4 w;
#pragma unroll
            for (int j = 0; j < 4; ++j) w[j] = pk2(x[8 * c + 2 * j], x[8 * c + 2 * j + 1]);
            *(u32x4*)(RK + (size_t)row * 32 + 8 * c) = w; }
    }
}
__device__ __forceinline__ void rstd_local(const float* ssp, float* rs, const pg8::StaticOrder& S, int nunits) {
    int tid = threadIdx.x; asm volatile("" : "+v"(tid));
    const int TOT = nunits * 256;
    for (int k0 = tid; k0 < TOT; k0 += 4 * 512) {
        f32x4 p[4][4]; int rows[4];
#pragma unroll
        for (int j = 0; j < 4; ++j) { const int k = k0 + j * 512; rows[j] = -1;
            if (k < TOT) { pg8::Unit uu; S.next(k >> 8, uu); rows[j] = uu.pm * 256 + (k & 255); const f32x4* q = (const f32x4*)(ssp + (size_t)rows[j] * 16);
#pragma unroll
                for (int v = 0; v < 4; ++v) p[j][v] = q[v]; } }
#pragma unroll
        for (int j = 0; j < 4; ++j) if (rows[j] >= 0) { float t = 0.f;
#pragma unroll
            for (int v = 0; v < 4; ++v) t += (p[j][v][0] + p[j][v][1]) + (p[j][v][2] + p[j][v][3]);
            rs[rows[j]] = rsqrtf(t * (1.0f / 1024.0f) + EPS); }
    }
    asm volatile("s_waitcnt vmcnt(0)" ::: "memory");
    __syncthreads();
}
__device__ __forceinline__ void grid_barrier(unsigned* cnt, unsigned& epoch, unsigned G) {
    asm volatile("s_waitcnt vmcnt(0) lgkmcnt(0)" ::: "memory");
    __syncthreads();
    epoch += 1u;
    if (threadIdx.x == 0) {
        __builtin_amdgcn_fence(__ATOMIC_RELEASE, "agent");
        asm volatile("s_waitcnt vmcnt(0)" ::: "memory");
        __hip_atomic_fetch_add(cnt, 1u, __ATOMIC_RELAXED, __HIP_MEMORY_SCOPE_AGENT);
        const unsigned want = epoch * G;
        while (__hip_atomic_load(cnt, __ATOMIC_RELAXED, __HIP_MEMORY_SCOPE_AGENT) < want) __builtin_amdgcn_s_sleep(2);
        __builtin_amdgcn_fence(__ATOMIC_ACQUIRE, "agent");
        asm volatile("s_waitcnt vmcnt(0)" ::: "memory");
    }
    __syncthreads();
}
__global__ void __launch_bounds__(512) fwd_kernel(Args a) {
    extern __shared__ __attribute__((aligned(16))) unsigned char lds_raw[];
    LAS unsigned char* lds = (LAS unsigned char*)lds_raw;
    cg::grid_group grid = cg::this_grid();
    const int Gn = (int)gridDim.x, cid = (int)blockIdx.x;
    unsigned char* ws = a.ws;
    unsigned* barcnt = (unsigned*)(ws + WS_BAR); unsigned epoch = 0u;
    prologue(lds, a, Gn, cid);
    grid.sync();
    grid_barrier(barcnt, epoch, (unsigned)Gn);
    bf16* XB = (bf16*)(ws + WS_XB);
    float* RSS = (float*)(ws + WS_RSSP); float* RSTD = (float*)(ws + WS_RSS);
    for (int ph = 0; ph < 28; ++ph) {
        int type = 0, N = 1024, K = 1024, ldc = 0, hm = 0, layer = 0, sidx = 0, nvec = 4, pbuf = -1;
        const bf16 *A = XB, *Bt = nullptr; bf16* pO = nullptr; const float* pss = RSTD; const float *gq = nullptr, *gk = nullptr; float qs = 0.125f * LOG2E;
        const float* rbase = nullptr; float* rout = nullptr; bf16* rxb = XB; float* rssn = nullptr;
        int f = -1;
        switch (ph) {
        case 0: type = 0; Bt = (const bf16*)(ws + W_AIN); N = 4608; pO = (bf16*)(ws + R_A_QKV); ldc = 4608; hm = 1; gq = a.in[5]; gk = a.in[6]; break;
        case 1: type = 4; break;
        case 2: type = 8; break;
        case 3: type = 1; A = (const bf16*)(ws + R_A_OC); Bt = (const bf16*)(ws + W_AOUT); K = 512; rbase = a.in[0]; rssn = RSS + 1 * (size_t)M_ * 16; break;
        case 4: case 5: case 6: layer = 0; sidx = 1; f = ph - 4; break;
        case 7: type = 2; Bt = (const bf16*)(ws + W_BIN); N = 768; pbuf = 0; break;
        case 8: type = 0; A = (const bf16*)(ws + R_B_CQ); Bt = (const bf16*)(ws + W_BQUP); N = 1536; K = 384; pO = (bf16*)(ws + R_B_Q); ldc = 1536; pss = (const float*)(ws + WS_SSQ); break;
        case 9: type = 10; break;
        case 10: type = 10; break;
        case 11: type = 5; break;
        case 12: type = 1; A = (const bf16*)(ws + R_B_O); Bt = (const bf16*)(ws + W_BOUT); rssn = RSS + 1 * (size_t)M_ * 16; break;
        case 13: case 14: case 15: layer = 1; sidx = 3; f = ph - 13; break;
        case 16: type = 0; Bt = (const bf16*)(ws + W_CIN); N = 3072; pO = (bf16*)(ws + R_C_QKV); ldc = 3072; pbuf = 0; hm = 2; gq = a.in[17]; gk = a.in[18]; break;
        case 17: type = 6; break;
        case 18: type = 1; A = (const bf16*)(ws + R_C_O); Bt = (const bf16*)(ws + W_COUT); rssn = RSS + 1 * (size_t)M_ * 16; break;
        case 19: case 20: case 21: layer = 2; sidx = 5; f = ph - 19; break;
        case 22: type = 0; Bt = (const bf16*)(ws + W_DIN); N = 1280; pO = (bf16*)(ws + R_D_QKV); ldc = 1280; pbuf = 0; hm = 3; gq = a.in[26]; gk = a.in[27]; break;
        case 23: type = 7; break;
        case 24: type = 1; A = (const bf16*)(ws + R_D_O); Bt = (const bf16*)(ws + W_DOUT); rssn = RSS + 1 * (size_t)M_ * 16; break;
        default: layer = 3; sidx = 7; f = ph - 25; break;
        }
        if (f == 0) { type = 3; Bt = (const bf16*)(ws + W_FG + layer * 2 * W_FSTR); N = 2 * DFF; pbuf = 1; }
        else if (f == 1) { type = 11; }
        else if (f == 2) { type = 1; A = (const bf16*)(ws + R_ACT); Bt = (const bf16*)(ws + W_FD + layer * W_FSTR); K = DFF;
            if (layer < 3) { rssn = RSS + ((sidx + 1) & 1) * (size_t)M_ * 16; } else { rssn = nullptr; rxb = nullptr; rout = a.out; } }

        if (type == 10) continue;
        if (type <= 3) {
            pg8::Gemm g{A, Bt, M_, N, K}; pg8::StaticOrder S; S.init(M_, N, Gn, cid);
            if (pbuf >= 0) rstd_local(RSS + (size_t)pbuf * M_ * 16, RSTD, S, (S.nwg - cid + Gn - 1) / Gn);
            if (type == 0) {
                for (int sub = 0; sub < (ph == 8 ? 2 : 1); ++sub) {
                    const bool kv = (sub == 1);
                    const pg8::Gemm g2{kv ? (const bf16*)(ws + R_B_CKV) : A, kv ? (const bf16*)(ws + W_BKVUP) : Bt, M_, kv ? 2048 : N, kv ? 256 : K};
                    pg8::StaticOrder S2; S2.init(M_, kv ? 2048 : N, Gn, cid);
                    const EpiProj E{kv ? (bf16*)(ws + R_B_KV) : pO, kv ? 2048 : ldc, kv ? (const float*)(ws + WS_SSKV) : pss, kv ? 4 : hm, gq, kv ? a.in[14] : gk, qs};
                    pg8::gemm_phase<EpiProj, pg8::StaticOrder, true, true>(lds, g2, S2, E);
                }
            }
            else if (type == 1) { EpiRes E{rbase, rout, XB, rxb, rssn}; pg8::gemm_phase<EpiRes, pg8::StaticOrder, true, true>(lds, g, S, E); }
            else if (type == 2) { EpiLat E{(bf16*)(ws + R_B_CQ), (bf16*)(ws + R_B_CKV), (bf16*)(ws + R_B_KPE), pss, (float*)(ws + WS_SSQP), (float*)(ws + WS_SSKVP)}; pg8::gemm_phase<EpiLat, pg8::StaticOrder, true, true>(lds, g, S, E); }
            else { EpiGateUp E{(bf16*)(ws + R_ACT), (bf16*)(ws + R_GATE), (bf16*)(ws + R_GATE + 32 * MiB), pss, a.in[31] + (size_t)layer * 3 * DFF, a.in[32] + (size_t)layer * DFF}; pg8::gemm_phase<EpiGateUp, pg8::StaticOrder, true, true>(lds, g, S, E); }
        }
        else if (type == 4) attn_phase<0>(lds, a, Gn, cid);
        else if (type == 5) attn_phase<1>(lds, a, Gn, cid);
        else if (type == 6) attn_phase<2>(lds, a, Gn, cid);
        else if (type == 7) attn_phase<3>(lds, a, Gn, cid);
        else if (type == 8) combine_a(a, Gn, cid);
        else if (type == 11) fixup_ffn((const bf16*)(ws + R_GATE), (const bf16*)(ws + R_GATE + 32 * MiB), (bf16*)(ws + R_ACT), a.in[31] + (size_t)layer * 3 * DFF, a.in[32] + (size_t)layer * DFF, Gn, cid);
        else prep_b(a, Gn, cid);
        grid_barrier(barcnt, epoch, (unsigned)Gn);
        if (type == 2) { rstd_pass((const float*)(ws + WS_SSQP), 2, 1.0f / 384.0f, (float*)(ws + WS_SSQ), Gn, cid); rstd_pass((const float*)(ws + WS_SSKVP), 1, 1.0f / 256.0f, (float*)(ws + WS_SSKV), Gn, cid); kpe_pass(a, Gn, cid);
            grid_barrier(barcnt, epoch, (unsigned)Gn); }
    }
}

extern "C" void kernel_launch(void* const* d_in, const int* in_sizes, int n_in, void* d_out, int out_size, void* d_ws, size_t ws_size, hipStream_t stream) {
    static int grid = 0;
    if (grid == 0) {
        if (n_in != 34 || out_size != M_ * DMODEL || ws_size < WS_NEED) { fprintf(stderr, "kernel_launch: unexpected shapes (n_in %d out %d ws %zu)\n", n_in, out_size, ws_size); grid = -1; return; }
        int dev = 0, cus = 0, per_cu = 0;
        if (hipGetDevice(&dev) != hipSuccess || hipDeviceGetAttribute(&cus, hipDeviceAttributeMultiprocessorCount, dev) != hipSuccess) { grid = -1; return; }
        if (hipFuncSetAttribute((const void*)fwd_kernel, hipFuncAttributeMaxDynamicSharedMemorySize, LDS_BYTES) != hipSuccess) { fprintf(stderr, "kernel_launch: hipFuncSetAttribute failed\n"); grid = -1; return; }
        if (hipOccupancyMaxActiveBlocksPerMultiprocessor(&per_cu, (const void*)fwd_kernel, 512, LDS_BYTES) != hipSuccess || per_cu < 1) { fprintf(stderr, "kernel_launch: occupancy query says %d\n", per_cu); per_cu = 1; }
        (void)hipGetLastError();
        grid = cus;
    }
    if (grid < 0) return;
    if (hipMemsetAsync((unsigned char*)d_ws + WS_BAR, 0, 256, stream) != hipSuccess) { fprintf(stderr, "kernel_launch: memset failed\n"); return; }
    Args a{};
    for (int i = 0; i < 34; ++i) a.in[i] = (const float*)d_in[i];
    a.out = (float*)d_out; a.ws = (unsigned char*)d_ws;
    void* args[] = {&a};
    hipError_t e = hipLaunchCooperativeKernel((const void*)fwd_kernel, dim3(grid), dim3(512), args, LDS_BYTES, stream);
    if (e != hipSuccess) fprintf(stderr, "cooperative launch failed: %s (grid %d)\n", hipGetErrorString(e), grid);
}
```

```cpp
#include <hip/hip_runtime.h>
#include <hip/hip_cooperative_groups.h>
#include <cstdio>
#include <cstdint>
namespace cg = cooperative_groups;
namespace pg8 {
#define PG8_LAS __attribute__((address_space(3)))
typedef unsigned short bf16_t;
typedef short bf16x8 __attribute__((ext_vector_type(8)));
typedef float f32x4 __attribute__((ext_vector_type(4)));
typedef unsigned u32x4 __attribute__((ext_vector_type(4)));
constexpr int BM = 256, BK = 64, HALF = 128, HTB = HALF * BK * 2  , STAGE_BYTES = 8 * HTB, NXCD = 8, WGM = 8;

__host__ __device__ __forceinline__ int lds_byte(int r, int c) { const int st = (r >> 4) * 2 + (c >> 5), rr = r & 15, cc = c & 31, ob = rr * 64 + cc * 2; return st * 1024 + (ob ^ (((ob >> 9) & 1) << 5)); }
__host__ __device__ __forceinline__ void stage_rc(int b, int& R, int& C) { const int st = b / 1024, sb = b % 1024, swz = sb ^ (((sb >> 9) & 1) << 5); R = (st >> 1) * 16 + swz / 64; C = (st & 1) * 32 + (swz % 64) / 2; }
__host__ __device__ __forceinline__ int perm32(int rho) { const int n = rho >> 4, i = rho & 15; return 8 * (i >> 2) + 4 * n + (i & 3); }

struct Unit { int pm, pn; };
struct Gemm { const bf16_t* A; const bf16_t* Bt; int M, N, K; };

struct StaticOrder {
    int nM, nN, nwg, G, c;
    __host__ __device__ void init(int M, int N, int G_, int c_) { nM = M / BM; nN = N / BM; nwg = nM * nN; G = G_; c = c_; }
    __host__ __device__ bool next(int i, Unit& u) const {
        const long L = (long)i * G + c; if (L >= nwg) return false;
        int wgid = (int)L; { const int q = nwg / NXCD, r = nwg % NXCD, xcd = wgid % NXCD, off = wgid / NXCD; wgid = (xcd < r ? xcd * (q + 1) : r * (q + 1) + (xcd - r) * q) + off; }
        const int nig = WGM * nN, gid = wgid / nig, fm = gid * WGM, gsz = (nM - fm) < WGM ? (nM - fm) : WGM;
        u.pm = fm + ((wgid % nig) % gsz); u.pn = (wgid % nig) / gsz; return true;
    }
    __device__ __forceinline__ void a_ready(const Unit&) const {}
    __device__ __forceinline__ void done(const Unit&) const {}
};

__device__ __forceinline__ unsigned cvt_pk_bf16(float lo, float hi) { unsigned r; asm volatile("v_cvt_pk_bf16_f32 %0, %1, %2" : "=v"(r) : "v"(lo), "v"(hi)); return r; }
template <class Epi, class Sched, bool ALIGN_EPI = false, bool SP2 = false>
__device__ __forceinline__ void gemm_phase(PG8_LAS unsigned char* lds, const Gemm g, const Sched& S, const Epi& E) {
    int tid = threadIdx.x; asm volatile("" : "+v"(tid)); const int wid = __builtin_amdgcn_readfirstlane(tid >> 6), lane = tid & 63, wr = wid >> 2, wc = wid & 3, fr = lane & 15, fq = lane >> 4;
    const int K = g.K, nt = K / BK;
    unsigned voffA[2], voffB[2];
#pragma unroll
    for (int i = 0; i < 2; ++i) { int R, C; stage_rc(tid * 16 + i * 8192, R, C); const int Rb = Epi::PERM ? ((R & ~31) + perm32(R & 31)) : R;
        voffA[i] = (unsigned)(R * K + C) * 2u; voffB[i] = (unsigned)(Rb * K + C) * 2u; }
    const size_t kstep = (size_t)(BK * 2);
    const size_t hstep = (size_t)HALF * K * 2;
    const size_t tstep = 2 * hstep;
    const unsigned ldsw = (unsigned)wid * 1024u;
    const int aoff = lds_byte(wr * 64 + fr, fq * 8), boff = lds_byte(wc * 32 + fr, fq * 8);
#define PG8_SA(b, h) (((b) * 2 + (h)) * HTB)
#define PG8_SB(b, h) ((4 + (b) * 2 + (h)) * HTB)
#define PG8_STAGE(bufoff, gbase, voff) do { _Pragma("unroll") for (int _i = 0; _i < 2; ++_i) \
        __builtin_amdgcn_global_load_lds((const unsigned*)((const char*)(gbase) + (voff)[_i]), (PG8_LAS unsigned*)(lds + (bufoff) + ldsw + _i * 8192), 16, 0, 0); } while (0)
#define PG8_LDA(dst, b, h) do { _Pragma("unroll") for (int m = 0; m < 4; ++m) _Pragma("unroll") for (int k = 0; k < 2; ++k) dst[m][k] = *(const PG8_LAS bf16x8*)(lds + PG8_SA(b, h) + aoff + m * 2048 + k * 1024); } while (0)
#define PG8_LDB(dst, b, h) do { _Pragma("unroll") for (int n = 0; n < 2; ++n) _Pragma("unroll") for (int k = 0; k < 2; ++k) dst[n][k] = *(const PG8_LAS bf16x8*)(lds + PG8_SB(b, h) + boff + n * 2048 + k * 1024); } while (0)
#define PG8_MMA(ai, bj, At, Bt) do { __builtin_amdgcn_s_setprio(1); _Pragma("unroll") for (int m = 0; m < 4; ++m) _Pragma("unroll") for (int n = 0; n < 2; ++n) _Pragma("unroll") for (int k = 0; k < 2; ++k) \
        acc[ai][bj][m][n] = __builtin_amdgcn_mfma_f32_16x16x32_bf16(Bt[n][k], At[m][k], acc[ai][bj][m][n], 0, 0, 0); __builtin_amdgcn_s_setprio(0); } while (0)
#define PG8_WAIT_V(n) asm volatile("s_waitcnt vmcnt(" #n ")" ::: "memory")
#define PG8_WAIT_L(n) asm volatile("s_waitcnt lgkmcnt(" #n ")" ::: "memory")
#define PG8_BAR __builtin_amdgcn_s_barrier()
#define PG8_SCHED __builtin_amdgcn_sched_barrier(0)
    Unit cur, nxt; int ui = 0;
    if (!S.next(0, cur)) return;
    f32x4 acc[2][2][4][2];
#pragma unroll
    for (int a = 0; a < 2; ++a)
#pragma unroll
        for (int b = 0; b < 2; ++b)
#pragma unroll
            for (int m = 0; m < 4; ++m)
#pragma unroll
                for (int n = 0; n < 2; ++n) acc[a][b][m][n] = (f32x4){0.f, 0.f, 0.f, 0.f};
    bf16x8 At[4][2], B0[2][2], B1[2][2];
    const char* cA = (const char*)g.A + (size_t)cur.pm * tstep; const char* cB = (const char*)g.Bt + (size_t)cur.pn * tstep;
    S.a_ready(cur);
    if constexpr (SP2) {
        PG8_STAGE(PG8_SB(0, 0), cB, voffB); PG8_STAGE(PG8_SB(0, 1), cB + hstep, voffB); PG8_STAGE(PG8_SA(0, 0), cA, voffA); PG8_STAGE(PG8_SA(0, 1), cA + hstep, voffA);
        if (wr == 1) PG8_BAR;
        PG8_WAIT_V(2); PG8_BAR;
        PG8_STAGE(PG8_SB(1, 0), cB + kstep, voffB); PG8_STAGE(PG8_SA(1, 0), cA + kstep, voffA); PG8_STAGE(PG8_SB(1, 1), cB + hstep + kstep, voffB);
        PG8_WAIT_V(6); PG8_BAR;
    } else {
        PG8_STAGE(PG8_SB(0, 0), cB, voffB); PG8_STAGE(PG8_SA(0, 0), cA, voffA); PG8_STAGE(PG8_SB(0, 1), cB + hstep, voffB); PG8_STAGE(PG8_SA(0, 1), cA + hstep, voffA);
        if (wr == 1) PG8_BAR;
        PG8_WAIT_V(4); PG8_BAR;
        PG8_STAGE(PG8_SB(1, 0), cB + kstep, voffB); PG8_STAGE(PG8_SA(1, 0), cA + kstep, voffA); PG8_STAGE(PG8_SB(1, 1), cB + hstep + kstep, voffB);
        PG8_WAIT_V(6); PG8_BAR;
    }
    for (;;) {
        const bool has_next = S.next(ui + 1, nxt);
        const char* nA = has_next ? (const char*)g.A + (size_t)nxt.pm * tstep : cA; const char* nB = has_next ? (const char*)g.Bt + (size_t)nxt.pn * tstep : cB;
        for (int t = 0; t < nt; t += 2) {
            const bool last = (t == nt - 2);
            const char* a1 = cA + (size_t)(t + 1) * kstep;
            const char* a2 = last ? nA : cA + (size_t)(t + 2) * kstep; const char* b2 = last ? nB : cB + (size_t)(t + 2) * kstep;
            const char* a3 = a2 + kstep; const char* b3 = b2 + kstep;
            if (last && has_next) S.a_ready(nxt);
            if constexpr (SP2) {
            PG8_LDB(B0, 0, 0); PG8_LDB(B1, 0, 1); PG8_SCHED; PG8_LDA(At, 0, 0); PG8_STAGE(PG8_SA(1, 1), a1 + hstep, voffA);
            PG8_WAIT_V(8); PG8_WAIT_L(0); PG8_BAR; PG8_MMA(0, 0, At, B0); PG8_MMA(0, 1, At, B1); PG8_BAR; PG8_SCHED;
            PG8_LDA(At, 0, 1); PG8_STAGE(PG8_SB(0, 0), b2, voffB); PG8_STAGE(PG8_SB(0, 1), b2 + hstep, voffB); PG8_STAGE(PG8_SA(0, 0), a2, voffA);
            PG8_WAIT_V(8); PG8_WAIT_L(0); PG8_BAR; PG8_MMA(1, 0, At, B0); PG8_MMA(1, 1, At, B1); PG8_BAR; PG8_SCHED;
            PG8_LDB(B0, 1, 0); PG8_LDB(B1, 1, 1); PG8_SCHED; PG8_LDA(At, 1, 0); PG8_STAGE(PG8_SA(0, 1), a2 + hstep, voffA);
            PG8_WAIT_V(8); PG8_WAIT_L(0); PG8_BAR; PG8_MMA(0, 0, At, B0); PG8_MMA(0, 1, At, B1); PG8_BAR; PG8_SCHED;
            PG8_LDA(At, 1, 1); PG8_STAGE(PG8_SB(1, 0), b3, voffB); PG8_STAGE(PG8_SB(1, 1), b3 + hstep, voffB); PG8_STAGE(PG8_SA(1, 0), a3, voffA);
            PG8_WAIT_V(8); PG8_WAIT_L(0); PG8_BAR; PG8_MMA(1, 0, At, B0); PG8_MMA(1, 1, At, B1); PG8_BAR; PG8_SCHED;
            } else {
            PG8_LDB(B0, 0, 0); PG8_SCHED; PG8_LDA(At, 0, 0); PG8_STAGE(PG8_SA(1, 1), a1 + hstep, voffA);
            PG8_WAIT_L(8); PG8_BAR; PG8_WAIT_L(0); PG8_MMA(0, 0, At, B0); PG8_BAR; PG8_SCHED;
            PG8_LDB(B1, 0, 1); PG8_STAGE(PG8_SB(0, 0), b2, voffB);
            PG8_BAR; PG8_WAIT_L(0); PG8_MMA(0, 1, At, B1); PG8_BAR;
            PG8_LDA(At, 0, 1); PG8_STAGE(PG8_SA(0, 0), a2, voffA);
            PG8_BAR; PG8_WAIT_L(0); PG8_MMA(1, 0, At, B0); PG8_BAR; PG8_SCHED;
            PG8_STAGE(PG8_SB(0, 1), b2 + hstep, voffB);
            PG8_WAIT_V(6); PG8_BAR; PG8_MMA(1, 1, At, B1); PG8_BAR;
            PG8_LDB(B0, 1, 0); PG8_SCHED; PG8_LDA(At, 1, 0); PG8_STAGE(PG8_SA(0, 1), a2 + hstep, voffA);
            PG8_WAIT_L(8); PG8_BAR; PG8_WAIT_L(0); PG8_MMA(0, 0, At, B0); PG8_BAR; PG8_SCHED;
            PG8_LDB(B1, 1, 1); PG8_STAGE(PG8_SB(1, 0), b3, voffB);
            PG8_BAR; PG8_WAIT_L(0); PG8_MMA(0, 1, At, B1); PG8_BAR;
            PG8_LDA(At, 1, 1); PG8_STAGE(PG8_SA(1, 0), a3, voffA);
            PG8_BAR; PG8_WAIT_L(0); PG8_MMA(1, 0, At, B0); PG8_BAR; PG8_SCHED;
            PG8_STAGE(PG8_SB(1, 1), b3 + hstep, voffB);
            PG8_WAIT_V(6); PG8_BAR; PG8_MMA(1, 1, At, B1); PG8_BAR;
            }
        }
        if constexpr (ALIGN_EPI) { if (wr == 0) PG8_BAR; }
        if constexpr (!Epi::AFTER_DRAIN) { E(acc, cur, wr, wc, fr, fq); S.done(cur); }
        if (!has_next) break;
#pragma unroll
        for (int a = 0; a < 2; ++a)
#pragma unroll
            for (int b = 0; b < 2; ++b)
#pragma unroll
                for (int m = 0; m < 4; ++m)
#pragma unroll
                    for (int n = 0; n < 2; ++n) acc[a][b][m][n] = (f32x4){0.f, 0.f, 0.f, 0.f};
        cur = nxt; cA = nA; cB = nB; ++ui;
        if constexpr (ALIGN_EPI) { if (wr == 1) PG8_BAR; }
    }
    PG8_WAIT_V(0);
    if constexpr (!ALIGN_EPI) { if (wr == 0) PG8_BAR; }
    PG8_BAR;
    if constexpr (Epi::AFTER_DRAIN) { E.fused(acc, cur, wr, wc, fr, fq, lds, wid, lane); S.done(cur); }
#undef PG8_SA
#undef PG8_SB
#undef PG8_STAGE
#undef PG8_LDA
#undef PG8_LDB
#undef PG8_MMA
#undef PG8_WAIT_V
#undef PG8_WAIT_L
#undef PG8_BAR
#undef PG8_SCHED
}
}

#define LAS __attribute__((address_space(3)))
typedef unsigned short bf16;
typedef short bf16x8 __attribute__((ext_vector_type(8)));
typedef short s16x4 __attribute__((ext_vector_type(4)));
typedef float f32x2 __attribute__((ext_vector_type(2)));
typedef float f32x4 __attribute__((ext_vector_type(4)));
typedef float f32x16 __attribute__((ext_vector_type(16)));
typedef unsigned u32x2 __attribute__((ext_vector_type(2)));
typedef unsigned u32x4 __attribute__((ext_vector_type(4)));
typedef __bf16 bf16x2_t __attribute__((ext_vector_type(2)));

constexpr int M_ = 65536, SEQ = 2048, DMODEL = 1024, DFF = 2816;
constexpr float EPS = 1e-6f, LOG2E = 1.4426950408889634f;
constexpr size_t MiB = 1u << 20;
constexpr size_t WS_BIAS = 0;
constexpr size_t WS_ROPE = 256 * 1024;
constexpr size_t WS_RSS = 1 * MiB;
constexpr size_t WS_SSQ = 3 * MiB;
constexpr size_t WS_SSKV = 3 * MiB + 256 * 1024;
constexpr size_t W_AIN = 4 * MiB, W_AOUT = 13 * MiB, W_BIN = 14 * MiB, W_BQUP = 16 * MiB, W_BKVUP = 18 * MiB, W_BOUT = 19 * MiB,
                 W_CIN = 21 * MiB, W_COUT = 27 * MiB, W_DIN = 29 * MiB, W_DOUT = 32 * MiB, W_FG = 34 * MiB, W_FU = 58 * MiB, W_FD = 82 * MiB, W_FSTR = 6 * MiB;
constexpr size_t WS_XB = 106 * MiB;
constexpr size_t WS_R = 234 * MiB;
constexpr size_t R_A_QKV = WS_R, R_A_O3 = WS_R + 576 * MiB, R_A_LSE = WS_R + 768 * MiB, R_A_OC = WS_R;
constexpr size_t R_B_CQ = WS_R, R_B_CKV = WS_R + 48 * MiB, R_B_KPE = WS_R + 80 * MiB, R_B_Q = WS_R + 128 * MiB, R_B_KV = WS_R + 320 * MiB, R_B_KH = WS_R + 576 * MiB, R_B_O = WS_R;
constexpr size_t R_C_QKV = WS_R, R_C_O = WS_R + 384 * MiB;
constexpr size_t R_D_QKV = WS_R, R_D_O = WS_R + 160 * MiB;
constexpr size_t R_GATE = WS_R, R_ACT = WS_R + 352 * MiB;
constexpr size_t WS_RSSP = WS_R + 774 * MiB;
constexpr size_t WS_SSQP = WS_R + 782 * MiB;
constexpr size_t WS_SSKVP = WS_R + 784 * MiB;
constexpr size_t WS_SSPE = 3 * MiB + 512 * 1024;
constexpr size_t R_B_RK = WS_R + 96 * MiB;
constexpr size_t WS_BAR = 512 * 1024;
constexpr size_t WS_NEED = WS_R + 786 * MiB;

constexpr int LDS_BYTES = 135168;

struct Args { const float* in[34]; float* out; unsigned char* ws; };

__device__ __forceinline__ unsigned pk2(float lo, float hi) { f32x2 v = {lo, hi}; bf16x2_t b = __builtin_convertvector(v, bf16x2_t); return __builtin_bit_cast(unsigned, b); }
__device__ __forceinline__ float bf2f(unsigned short h) { return __uint_as_float(((unsigned)h) << 16); }
__device__ __forceinline__ float bflo(unsigned w) { return __uint_as_float(w << 16); }
__device__ __forceinline__ float bfhi(unsigned w) { return __uint_as_float(w & 0xffff0000u); }
__device__ __forceinline__ float wave_sum(float v) {
#pragma unroll
    for (int o = 1; o < 64; o <<= 1) v += __shfl_xor(v, o);
    return v;
}
__device__ __forceinline__ float dot4(f32x4 a) { return (a[0] * a[0] + a[1] * a[1]) + (a[2] * a[2] + a[3] * a[3]); }
__device__ __forceinline__ float rowss_sum(const float* ss, int nvec, int row) {
    const f32x4* p = (const f32x4*)(ss + (size_t)row * 4 * nvec); float t = 0.f;
#pragma unroll
    for (int v = 0; v < 4; ++v) if (v < nvec) { const f32x4 q = p[v]; t += (q[0] + q[1]) + (q[2] + q[3]); }
    return t;
}

struct EpiProj {
    static constexpr bool PERM = true, AFTER_DRAIN = false;
    bf16* O; int ldc; const float* rs; int hm; const float* gq; const float* gk; float qscale;
    __device__ __forceinline__ void operator()(const f32x4 (&acc)[2][2][4][2], const pg8::Unit& u, int wr, int wc, int fr, int fq) const {
        const int hg = u.pn * 4 + wc;
        int kind = 2; const float* gain = gq;
        if (hm == 1) { const int t = (hg >> 3) % 3, gi = hg / 24; kind = t; gain = (t == 0 ? gq : gk) + gi * 64; }
        else if (hm == 2) { kind = hg < 16 ? 0 : (hg < 32 ? 1 : 2); gain = kind == 0 ? gq : gk; }
        else if (hm == 3) { kind = hg < 16 ? 0 : (hg < 18 ? 1 : 2); gain = kind == 0 ? gq : gk; }
        else if (hm == 4) { kind = (hg & 1) ? 2 : 3; gain = gk; }
        f32x4 gv[2][2];
#pragma unroll
        for (int bj = 0; bj < 2; ++bj)
#pragma unroll
            for (int n = 0; n < 2; ++n) {
                gv[bj][n] = (f32x4){1.f, 1.f, 1.f, 1.f};
                if (kind != 2) { gv[bj][n] = *(const f32x4*)(gain + 32 * bj + 8 * fq + 4 * n); if (kind == 0) gv[bj][n] = gv[bj][n] * qscale; }
            }
        bf16* colp = O + hg * 64 + 8 * fq;
        float rsv[2][4];
#pragma unroll
        for (int ai = 0; ai < 2; ++ai)
#pragma unroll
            for (int m = 0; m < 4; ++m) rsv[ai][m] = rs[u.pm * 256 + ai * 128 + wr * 64 + m * 16 + fr];
        if (kind == 3) {
#pragma unroll
            for (int ai = 0; ai < 2; ++ai)
#pragma unroll
                for (int m = 0; m < 4; ++m) {
                    const int row = u.pm * 256 + ai * 128 + wr * 64 + m * 16 + fr;
                    const float rstd = rsv[ai][m];
                    f32x4 v[2][2]; float s = 0.f;
#pragma unroll
                    for (int bj = 0; bj < 2; ++bj)
#pragma unroll
                        for (int n = 0; n < 2; ++n) { v[bj][n] = acc[ai][bj][m][n] * rstd; s += dot4(v[bj][n]); }
                    s += __shfl_xor(s, 16); s += __shfl_xor(s, 32);
                    const float rk_ = rsqrtf((s + ((const float*)((const unsigned char*)rs + (WS_SSPE - WS_SSKV)))[row]) * (1.0f / 96.0f) + EPS);
                    bf16* kp = (bf16*)((unsigned char*)O + (R_B_KH - R_B_KV)) + (size_t)row * 1536 + (hg >> 1) * 96 + 8 * fq;
#pragma unroll
                    for (int bj = 0; bj < 2; ++bj) {
                        const f32x4 a_ = v[bj][0] * rk_ * gv[bj][0], b_ = v[bj][1] * rk_ * gv[bj][1];
                        u32x4 w; w.x = pk2(a_[0], a_[1]); w.y = pk2(a_[2], a_[3]); w.z = pk2(b_[0], b_[1]); w.w = pk2(b_[2], b_[3]);
                        *(u32x4*)(kp + 32 * bj) = w;
                    }
                    const u32x4 r_ = *(const u32x4*)((const bf16*)((const unsigned char*)O - (R_B_KV - R_B_RK)) + (size_t)row * 32 + 8 * fq);
                    u32x4 w;
#pragma unroll
                    for (int j = 0; j < 4; ++j) w[j] = pk2(bflo(r_[j]) * rk_, bfhi(r_[j]) * rk_);
                    *(u32x4*)(kp + 64) = w;
                }
            return;
        }
#pragma unroll
        for (int ai = 0; ai < 2; ++ai)
#pragma unroll
            for (int m = 0; m < 4; ++m) {
                const int row = u.pm * 256 + ai * 128 + wr * 64 + m * 16 + fr;
                const float rstd = rsv[ai][m];
                f32x4 v[2][2]; float s = 0.f;
#pragma unroll
                for (int bj = 0; bj < 2; ++bj)
#pragma unroll
                    for (int n = 0; n < 2; ++n) { v[bj][n] = acc[ai][bj][m][n] * rstd; s += dot4(v[bj][n]); }
                if (kind < 2) {
                    s += __shfl_xor(s, 16); s += __shfl_xor(s, 32);
                    const float rs = rsqrtf(s * (1.0f / 64.0f) + EPS);
#pragma unroll
                    for (int bj = 0; bj < 2; ++bj)
#pragma unroll
                        for (int n = 0; n < 2; ++n) v[bj][n] = v[bj][n] * rs * gv[bj][n];
                }
#pragma unroll
                for (int bj = 0; bj < 2; ++bj) {
                    u32x4 w; w.x = pk2(v[bj][0][0], v[bj][0][1]); w.y = pk2(v[bj][0][2], v[bj][0][3]); w.z = pk2(v[bj][1][0], v[bj][1][1]); w.w = pk2(v[bj][1][2], v[bj][1][3]);
                    *(u32x4*)(colp + (size_t)row * ldc + 32 * bj) = w;
                }
            }
    }
};
struct EpiLat {
    static constexpr bool PERM = true, AFTER_DRAIN = false;
    bf16* CQ; bf16* CKV; bf16* KPE; const float* rs; float* ssq; float* sskv;
    __device__ __forceinline__ void operator()(const f32x4 (&acc)[2][2][4][2], const pg8::Unit& u, int wr, int wc, int fr, int fq) const {
        const int hg = u.pn * 4 + wc;
        if (hg > 10) return;
        bf16* dst; int ld; float* sacc = nullptr; int sst = 0;
        if (hg < 6) { dst = CQ + hg * 64; ld = 384; sacc = ssq + hg; sst = 8; } else if (hg < 10) { dst = CKV + (hg - 6) * 64; ld = 256; sacc = sskv + (hg - 6); sst = 4; } else { dst = KPE; ld = 64; }
        dst += 8 * fq;
        float rsv[2][4];
#pragma unroll
        for (int ai = 0; ai < 2; ++ai)
#pragma unroll
            for (int m = 0; m < 4; ++m) rsv[ai][m] = rs[u.pm * 256 + ai * 128 + wr * 64 + m * 16 + fr];
#pragma unroll
        for (int ai = 0; ai < 2; ++ai)
#pragma unroll
            for (int m = 0; m < 4; ++m) {
                const int row = u.pm * 256 + ai * 128 + wr * 64 + m * 16 + fr;
                const float rstd = rsv[ai][m];
                f32x4 v[2][2]; float s = 0.f;
#pragma unroll
                for (int bj = 0; bj < 2; ++bj)
#pragma unroll
                    for (int n = 0; n < 2; ++n) { v[bj][n] = acc[ai][bj][m][n] * rstd; s += dot4(v[bj][n]); }
                s += __shfl_xor(s, 16); s += __shfl_xor(s, 32);
                if (fq == 0) { if (sacc != nullptr) sacc[(size_t)row * sst] = s; else { float z_ = 0.f; asm volatile("" : "+v"(z_)); ssq[(size_t)row * 8 + 6] = z_; ssq[(size_t)row * 8 + 7] = z_; } }
#pragma unroll
                for (int bj = 0; bj < 2; ++bj) {
                    u32x4 w; w.x = pk2(v[bj][0][0], v[bj][0][1]); w.y = pk2(v[bj][0][2], v[bj][0][3]); w.z = pk2(v[bj][1][0], v[bj][1][1]); w.w = pk2(v[bj][1][2], v[bj][1][3]);
                    *(u32x4*)(dst + (size_t)row * ld + 32 * bj) = w;
                }
            }
    }
};
struct EpiRes {
    static constexpr bool PERM = true, AFTER_DRAIN = false;
    const float* base32; float* out32; bf16* xb; bf16* xbw; float* ssn;
    __device__ __forceinline__ void operator()(const f32x4 (&acc)[2][2][4][2], const pg8::Unit& u, int wr, int wc, int fr_, int fq_) const {
        int fr = fr_, fq = fq_; asm volatile("" : "+v"(fr), "+v"(fq));
        float* ssn_ = ssn; bf16* xbw_ = xbw; float* out_ = out32; const float* b32_ = base32; asm volatile("" : "+s"(ssn_), "+s"(xbw_), "+s"(out_), "+s"(b32_));
        const int col0 = u.pn * 256 + wc * 32 + 8 * fq;
#pragma unroll
        for (int ai = 0; ai < 2; ++ai) {
            f32x4 bv[4][2][2];
            if (b32_ != nullptr) {
#pragma unroll
                for (int m = 0; m < 4; ++m)
#pragma unroll
                    for (int bj = 0; bj < 2; ++bj)
#pragma unroll
                        for (int n = 0; n < 2; ++n) bv[m][bj][n] = *(const f32x4*)(b32_ + (size_t)(u.pm * 256 + ai * 128 + wr * 64 + m * 16 + fr) * DMODEL + col0 + bj * 128 + n * 4);
            } else {
                u32x4 rw[4][2];
#pragma unroll
                for (int m = 0; m < 4; ++m)
#pragma unroll
                    for (int bj = 0; bj < 2; ++bj) rw[m][bj] = *(const u32x4*)(xb + (size_t)(u.pm * 256 + ai * 128 + wr * 64 + m * 16 + fr) * DMODEL + col0 + bj * 128);
#pragma unroll
                for (int m = 0; m < 4; ++m)
#pragma unroll
                    for (int bj = 0; bj < 2; ++bj) {
                        bv[m][bj][0] = (f32x4){bflo(rw[m][bj].x), bfhi(rw[m][bj].x), bflo(rw[m][bj].y), bfhi(rw[m][bj].y)};
                        bv[m][bj][1] = (f32x4){bflo(rw[m][bj].z), bfhi(rw[m][bj].z), bflo(rw[m][bj].w), bfhi(rw[m][bj].w)};
                    }
            }
            asm volatile("" ::: "memory");
#pragma unroll
            for (int m = 0; m < 4; ++m) {
                const int row = u.pm * 256 + ai * 128 + wr * 64 + m * 16 + fr;
                float s = 0.f;
#pragma unroll
                for (int bj = 0; bj < 2; ++bj) {
                    const size_t off = (size_t)row * DMODEL + col0 + bj * 128;
                    const f32x4 o0 = bv[m][bj][0] + acc[ai][bj][m][0], o1 = bv[m][bj][1] + acc[ai][bj][m][1];
                    if (out_ != nullptr) { *(f32x4*)(out_ + off) = o0; *(f32x4*)(out_ + off + 4) = o1; }
                    if (xbw_ != nullptr) { u32x4 w; w.x = pk2(o0[0], o0[1]); w.y = pk2(o0[2], o0[3]); w.z = pk2(o1[0], o1[1]); w.w = pk2(o1[2], o1[3]); *(u32x4*)(xbw_ + off) = w; }
                    s += dot4(o0) + dot4(o1);
                }
                if (ssn_ != nullptr) { s += __shfl_xor(s, 16); s += __shfl_xor(s, 32); if (fq == 0) ssn_[(size_t)(u.pn * 4 + wc) * M_ + row] = s; }
            }
            asm volatile("" ::: "memory");
        }
    }
};
__device__ __forceinline__ u32x4 shfl4(u32x4 v, int src) { u32x4 r; r.x = __shfl(v.x, src, 16); r.y = __shfl(v.y, src, 16); r.z = __shfl(v.z, src, 16); r.w = __shfl(v.w, src, 16); return r; }
struct EpiGateUp {
    static constexpr bool PERM = true, AFTER_DRAIN = false;
    bf16* act; bf16* gedge; bf16* uedge; const float* rs; const float* cw; const float* cb;
    __device__ __forceinline__ void operator()(const f32x4 (&acc)[2][2][4][2], const pg8::Unit& u, int wr, int wc, int fr_, int fq_) const {
        int fr = fr_, fq = fq_; asm volatile("" : "+v"(fr), "+v"(fq));
        const int c0 = u.pn * 128 + wc * 32 + 8 * fq;
        f32x4 w0[2], w1[2], w2[2], b[2];
#pragma unroll
        for (int n = 0; n < 2; ++n) { w0[n] = *(const f32x4*)(cw + c0 + 4 * n); w1[n] = *(const f32x4*)(cw + DFF + c0 + 4 * n); w2[n] = *(const f32x4*)(cw + 2 * DFF + c0 + 4 * n); b[n] = *(const f32x4*)(cb + c0 + 4 * n); }
#pragma unroll
        for (int ai = 0; ai < 2; ++ai) {
            u32x4 g[4]; float rstd[4];
            const int strip = u.pm * 4 + ai * 2 + wr;
#pragma unroll
            for (int m = 0; m < 4; ++m) rstd[m] = rs[u.pm * 256 + ai * 128 + wr * 64 + m * 16 + fr];
#pragma unroll
            for (int m = 0; m < 4; ++m) {
                const f32x4 ga = acc[ai][0][m][0] * rstd[m], gb = acc[ai][0][m][1] * rstd[m];
                g[m].x = pk2(ga[0], ga[1]); g[m].y = pk2(ga[2], ga[3]); g[m].z = pk2(gb[0], gb[1]); g[m].w = pk2(gb[2], gb[3]);
            }
#pragma unroll
            for (int m = 0; m < 4; ++m) {
                const int row = u.pm * 256 + ai * 128 + wr * 64 + m * 16 + fr;
                const u32x4 g0 = g[m];
                u32x4 g1, g2;
#pragma unroll
                for (int d = 0; d < 4; ++d) {
                    unsigned o1_ = 0u, o2_ = 0u;
                    if (m > 0) { o1_ = __builtin_amdgcn_update_dpp(0u, g[m - 1][d], 0x121, 0xf, 0xf, false); o2_ = __builtin_amdgcn_update_dpp(0u, g[m - 1][d], 0x122, 0xf, 0xf, false); }
                    g1[d] = __builtin_amdgcn_update_dpp(o1_, g0[d], 0x111, 0xf, 0xf, false);
                    g2[d] = __builtin_amdgcn_update_dpp(o2_, g0[d], 0x112, 0xf, 0xf, false);
                }
                u32x4 w, uw;
#pragma unroll
                for (int n = 0; n < 2; ++n) {
                    float r[4], up[4];
#pragma unroll
                    for (int j = 0; j < 4; ++j) {
                        const unsigned q0 = g0[2 * n + (j >> 1)], q1 = g1[2 * n + (j >> 1)], q2 = g2[2 * n + (j >> 1)];
                        const float x0 = (j & 1) ? bfhi(q0) : bflo(q0), x1 = (j & 1) ? bfhi(q1) : bflo(q1), x2 = (j & 1) ? bfhi(q2) : bflo(q2);
                        const float cv = b[n][j] + w2[n][j] * x0 + w1[n][j] * x1 + w0[n][j] * x2;
                        const float sg = cv * __builtin_amdgcn_rcpf(1.0f + __builtin_amdgcn_exp2f(-LOG2E * cv));
                        up[j] = acc[ai][1][m][n][j] * rstd[m];
                        r[j] = sg * up[j];
                    }
                    w[2 * n] = pk2(r[0], r[1]); w[2 * n + 1] = pk2(r[2], r[3]);
                    uw[2 * n] = pk2(up[0], up[1]); uw[2 * n + 1] = pk2(up[2], up[3]);
                }
                if (m == 0) {
                    if (fr < 2) { *(u32x4*)(gedge + ((size_t)strip * 4 + fr) * DFF + c0) = g0; *(u32x4*)(uedge + ((size_t)strip * 2 + fr) * DFF + c0) = uw; }
                    else *(u32x4*)(act + (size_t)row * DFF + c0) = w;
                } else {
                    *(u32x4*)(act + (size_t)row * DFF + c0) = w;
                    if (m == 3 && fr >= 14) *(u32x4*)(gedge + ((size_t)strip * 4 + 2 + (fr - 14)) * DFF + c0) = g0;
                }
                asm volatile("" ::: "memory");
            }
        }
    }
};

__device__ __forceinline__ int crow(int r, int hi) { return (r & 3) + 8 * (r >> 2) + 4 * hi; }
struct TileGeo { int NT, TPS, ks0, res0, dil; };
template <int DQK, int DV, int KT> struct AttL {
    static constexpr int KSTR = DQK * 2 + 16, VSTR = DV * 2 + 64, KBUF = KT * KSTR, VBUF = KT * VSTR;
    static constexpr int OFF_K = 0, OFF_V = 2 * KBUF, OFF_TAB = OFF_V + 2 * VBUF;
};
template <int DQK, int DV, bool BIAS, int TABN, bool QRELOAD, int KT>
__device__ __forceinline__ void attn_pass(int qoff_, LAS unsigned char* lds, const bf16* Kb, int kpitch, const bf16* Vb, int vpitch, const TileGeo G, int my_tlo, int my_thi,
                                          int wslot_q0, int W, const bf16x8 (&qf_)[DQK / 16], float& m_, float& l_, f32x16 (&o)[DV / 32]) {
    typedef AttL<DQK, DV, KT> L;
    int tid = threadIdx.x; asm volatile("" : "+v"(tid)); const int lane = tid & 63, r32 = lane & 31, hi = lane >> 5;
    constexpr int SUB = KT / 64;
    constexpr int KCH = DQK / 8, VCH = DV / 8, NKC = KT * KCH, NVC = KT * VCH, NKL = (NKC + 511) / 512, NVL = (NVC + 511) / 512;
    u32x4 kr[NKL], vr[NVL];
    const LAS float* tab = (const LAS float*)(lds + L::OFF_TAB);
    const int slot_q = wslot_q0 + r32;
    const int vlane = (4 * hi + ((lane & 15) >> 2)) * L::VSTR + (16 * ((lane >> 4) & 1) + 4 * (lane & 3)) * 2;
#define ATT_LOAD(t) do { const int seg_ = ((t) * SUB) / G.TPS, tis_ = (t) * SUB - seg_ * G.TPS; const int tok0_ = G.res0 + seg_ + G.dil * (G.ks0 + 64 * tis_); \
        _Pragma("unroll") for (int i_ = 0; i_ < NKL; ++i_) { const int c_ = tid + 512 * i_; if ((NKC % 512 == 0) || c_ < NKC) { const int j_ = c_ / KCH, p_ = c_ - j_ * KCH; \
            kr[i_] = *(const u32x4*)(Kb + (size_t)(tok0_ + G.dil * j_) * kpitch + p_ * 8); } } \
        _Pragma("unroll") for (int i_ = 0; i_ < NVL; ++i_) { const int c_ = tid + 512 * i_; if ((NVC % 512 == 0) || c_ < NVC) { const int j_ = c_ / VCH, p_ = c_ - j_ * VCH; \
            vr[i_] = *(const u32x4*)(Vb + (size_t)(tok0_ + G.dil * j_) * vpitch + p_ * 8); } } } while (0)
#define ATT_STORE(buf) do { \
        _Pragma("unroll") for (int i_ = 0; i_ < NKL; ++i_) { const int c_ = tid + 512 * i_; if ((NKC % 512 == 0) || c_ < NKC) { const int j_ = c_ / KCH, p_ = c_ - j_ * KCH; \
            *(LAS u32x4*)(lds + L::OFF_K + (buf) * L::KBUF + j_ * L::KSTR + p_ * 16) = kr[i_]; } } \
        _Pragma("unroll") for (int i_ = 0; i_ < NVL; ++i_) { const int c_ = tid + 512 * i_; if ((NVC % 512 == 0) || c_ < NVC) { const int j_ = c_ / VCH, p_ = c_ - j_ * VCH; \
            *(LAS u32x4*)(lds + L::OFF_V + (buf) * L::VBUF + j_ * L::VSTR + p_ * 16) = vr[i_]; } } } while (0)
    ATT_LOAD(0);
    ATT_STORE(0);
    float m = m_, l = l_;
    const int NT2 = G.NT / SUB;
    for (int t = 0; t < NT2; ++t) {
        const int buf = t & 1;
        if (t + 1 < NT2) ATT_LOAD(t + 1);
        __syncthreads();
#pragma unroll
        for (int hf = 0; hf < SUB; ++hf) {
        const int st = t * SUB + hf;
        if (st >= my_tlo && st <= my_thi) {
            const int tis = st % G.TPS, slot0 = G.ks0 + 64 * tis;
            const LAS unsigned char* Kt = lds + L::OFF_K + buf * L::KBUF + (hf * 64 + r32) * L::KSTR + hi * 16;
            f32x16 s[2];
            const int dsb = slot_q - slot0 - 4 * hi;
            bf16x8 qf[DQK / 16];
            if (QRELOAD) {
#pragma unroll
                for (int ks = 0; ks < DQK / 16; ++ks) qf[ks] = *(const LAS bf16x8*)(lds + qoff_ + ks * 32); }
            else {
#pragma unroll
                for (int ks = 0; ks < DQK / 16; ++ks) qf[ks] = qf_[ks]; }
#pragma unroll
            for (int kb = 0; kb < 2; ++kb) {
#pragma unroll
                for (int r = 0; r < 16; ++r) s[kb][r] = BIAS ? tab[dsb + 128 - (32 * kb + (r & 3) + 8 * (r >> 2))] : 0.f;
            }
            if (DV == 64) {
                bf16x8 kf[2][DQK / 16];
#pragma unroll
                for (int kb = 0; kb < 2; ++kb)
#pragma unroll
                    for (int ks = 0; ks < DQK / 16; ++ks) kf[kb][ks] = *(const LAS bf16x8*)(Kt + kb * 32 * L::KSTR + ks * 32);
                asm volatile("" ::: "memory");
#pragma unroll
                for (int ks = 0; ks < DQK / 16; ++ks)
#pragma unroll
                    for (int kb = 0; kb < 2; ++kb) s[kb] = __builtin_amdgcn_mfma_f32_32x32x16_bf16(kf[kb][ks], qf[ks], s[kb], 0, 0, 0);
            } else {
#pragma unroll
                for (int kh = 0; kh < 2; ++kh) {
                    bf16x8 kf[2][DQK / 32];
#pragma unroll
                    for (int kb = 0; kb < 2; ++kb)
#pragma unroll
                        for (int k2 = 0; k2 < DQK / 32; ++k2) kf[kb][k2] = *(const LAS bf16x8*)(Kt + kb * 32 * L::KSTR + (kh * (DQK / 32) + k2) * 32);
                    asm volatile("" ::: "memory");
#pragma unroll
                    for (int k2 = 0; k2 < DQK / 32; ++k2)
#pragma unroll
                        for (int kb = 0; kb < 2; ++kb) s[kb] = __builtin_amdgcn_mfma_f32_32x32x16_bf16(kf[kb][k2], qf[kh * (DQK / 32) + k2], s[kb], 0, 0, 0);
                }
            }
            const bool full = (wslot_q0 - slot0 - 63 >= 0) && (wslot_q0 + 31 - slot0 <= W);
            if (!full && !BIAS) {
#pragma unroll
                for (int kb = 0; kb < 2; ++kb)
#pragma unroll
                    for (int r = 0; r < 16; ++r) {
                        const int ds = dsb - (32 * kb + (r & 3) + 8 * (r >> 2));
                        s[kb][r] = ((unsigned)ds <= (unsigned)W) ? s[kb][r] : -INFINITY;
                    }
            }
            float mx = s[0][0];
#pragma unroll
            for (int r = 1; r < 16; ++r) mx = fmaxf(mx, s[0][r]);
#pragma unroll
            for (int r = 0; r < 16; ++r) mx = fmaxf(mx, s[1][r]);
            mx = fmaxf(mx, __shfl_xor(mx, 32));
            const float mn = fmaxf(m, mx);
            const float base = (mn == -INFINITY) ? 0.f : mn;
            const float alpha = __builtin_amdgcn_exp2f(m - base);
            m = mn;
            float ps = 0.f;
#pragma unroll
            for (int kb = 0; kb < 2; ++kb)
#pragma unroll
                for (int r = 0; r < 16; ++r) { const float p = __builtin_amdgcn_exp2f(s[kb][r] - base); s[kb][r] = p; ps += p; }
            l = l * alpha + ps;
            if (__any(alpha != 1.0f)) {
#pragma unroll
                for (int c = 0; c < DV / 32; ++c)
#pragma unroll
                    for (int r = 0; r < 16; ++r) o[c][r] *= alpha;
            }
            const LAS unsigned char* Vt = lds + L::OFF_V + buf * L::VBUF + hf * 64 * L::VSTR + vlane;
#pragma unroll
            for (int kb = 0; kb < 2; ++kb) {
                bf16x8 pb[2];
#pragma unroll
                for (int k2 = 0; k2 < 2; ++k2) {
                    u32x4 pw; pw.x = pk2(s[kb][8 * k2 + 0], s[kb][8 * k2 + 1]); pw.y = pk2(s[kb][8 * k2 + 2], s[kb][8 * k2 + 3]);
                    pw.z = pk2(s[kb][8 * k2 + 4], s[kb][8 * k2 + 5]); pw.w = pk2(s[kb][8 * k2 + 6], s[kb][8 * k2 + 7]);
                    pb[k2] = __builtin_bit_cast(bf16x8, pw);
                }
#pragma unroll
                for (int ch = 0; ch < DV / 64; ++ch) {
                    bf16x8 vf[2][2];
#pragma unroll
                    for (int k2 = 0; k2 < 2; ++k2)
#pragma unroll
                        for (int c2 = 0; c2 < 2; ++c2) {
                            const LAS unsigned char* vp = Vt + (32 * kb + 16 * k2) * L::VSTR + 64 * (2 * ch + c2);
                            const s16x4 lo = __builtin_bit_cast(s16x4, __builtin_amdgcn_ds_read_tr16_b64_v4i16((LAS s16x4*)(vp)));
                            const s16x4 hh = __builtin_bit_cast(s16x4, __builtin_amdgcn_ds_read_tr16_b64_v4i16((LAS s16x4*)(vp + 8 * L::VSTR)));
                            vf[k2][c2] = (bf16x8){lo[0], lo[1], lo[2], lo[3], hh[0], hh[1], hh[2], hh[3]};
                        }
                    asm volatile("" ::: "memory");
#pragma unroll
                    for (int k2 = 0; k2 < 2; ++k2)
#pragma unroll
                        for (int c2 = 0; c2 < 2; ++c2) o[2 * ch + c2] = __builtin_amdgcn_mfma_f32_32x32x16_bf16(vf[k2][c2], pb[k2], o[2 * ch + c2], 0, 0, 0);
                }
            }
        }
        }
        if (t + 1 < NT2) ATT_STORE(buf ^ 1);
    }
    __syncthreads();
    m_ = m; l_ = l;
#undef ATT_LOAD
#undef ATT_STORE
}

template <int MODE>
__device__ __forceinline__ void attn_phase(LAS unsigned char* lds, const Args& a, int Gn, int cid) {
    constexpr int DQK = MODE == 1 ? 96 : 64, DV = MODE == 2 ? 128 : 64;
    constexpr bool BIAS = MODE != 1;
    constexpr int TABN = MODE == 2 ? 2048 + 256 : 512;
    constexpr int NU = MODE == 0 ? 6144 : (MODE == 2 ? 2048 : 4096);
    constexpr int KT = MODE == 2 ? 64 : 128;
    typedef AttL<DQK, DV, KT> L;
    int tid = threadIdx.x; asm volatile("" : "+v"(tid)); const int lane = tid & 63, r32 = lane & 31, hi = lane >> 5, wid = __builtin_amdgcn_readfirstlane(tid >> 6);
    unsigned char* ws = a.ws;
    const float* biasd = (const float*)(ws + WS_BIAS);
    LAS float* tab = (LAS float*)(lds + L::OFF_TAB);
    float lam = 0.f, lam_init = 0.f;
    if (MODE == 2) {
        float d1 = 0.f, d2 = 0.f;
        for (int i = 0; i < 64; ++i) { d1 += a.in[19][i] * a.in[20][i]; d2 += a.in[21][i] * a.in[22][i]; }
        lam_init = 0.8f - 0.6f * expf(-0.3f * 2.0f);
        lam = expf(d1) - expf(d2) + lam_init;
    }
    for (int u = cid; u < NU; u += Gn) {
        int b, h, dil = 1, res0 = 0, s0, nres = 1, W, qb = 0, g = 0;
        if (MODE == 0) { g = u >> 11; const int rem = u & 2047; b = rem >> 6; h = (rem >> 3) & 7; const int blk = (rem + (u >> 8)) & 7; W = 128;
            if (g == 0) { s0 = 256 * blk; } else if (g == 1) { dil = 4; res0 = blk >> 1; s0 = 256 * (blk & 1); } else { dil = 16; res0 = 2 * blk; s0 = 0; nres = 2; } }
        else if (MODE == 3) { b = u >> 7; h = (u >> 3) & 15; s0 = 256 * ((u + (u >> 8)) & 7); W = 127; }
        else if (MODE == 1) { const int bh = u & 511; qb = 7 - (u >> 9); b = bh >> 4; h = bh & 15; s0 = 256 * qb; W = 1 << 20; }
        else { const int bh = u & 255; qb = 7 - (u >> 8); b = bh >> 3; h = bh & 7; s0 = 256 * qb; W = 1 << 20; }
        TileGeo G;
        G.dil = dil; G.res0 = res0;
        const int Lseg = 256 / nres;
        if (MODE == 0 || MODE == 3) { G.ks0 = (nres == 1 && s0 >= 128) ? s0 - 128 : 0; } else { G.ks0 = 0; }
        G.TPS = (s0 + Lseg - G.ks0) >> 6; G.NT = G.TPS * nres;
        const int nws = 8 / nres, seg_w = wid / nws, wslot_q0 = s0 + 32 * (wid - seg_w * nws);
        int tl = 0;
        if (MODE == 0 || MODE == 3) { tl = wslot_q0 - W - G.ks0; tl = tl < 0 ? 0 : (tl >> 6); }
        const int th = (wslot_q0 + 31 - G.ks0) >> 6;
        const int my_tlo = seg_w * G.TPS + tl, my_thi = seg_w * G.TPS + th;
        const int qtok = res0 + seg_w + dil * (wslot_q0 + r32);
        const size_t row_q = (size_t)b * SEQ + qtok, row_b = (size_t)b * SEQ;
        const bf16 *Qp, *Kb, *Vb; int qpitch, kpitch, vpitch;
        if (MODE == 0) { const bf16* base = (const bf16*)(ws + R_A_QKV); qpitch = kpitch = vpitch = 4608;
            Qp = base + row_q * 4608 + g * 1536 + h * 64; Kb = base + row_b * 4608 + g * 1536 + 512 + h * 64; Vb = base + row_b * 4608 + g * 1536 + 1024 + h * 64; }
        else if (MODE == 1) { qpitch = 1536; kpitch = 1536; vpitch = 2048;
            Qp = (const bf16*)(ws + R_B_Q) + row_q * 1536 + h * 96; Kb = (const bf16*)(ws + R_B_KH) + row_b * 1536 + h * 96; Vb = (const bf16*)(ws + R_B_KV) + row_b * 2048 + h * 128 + 64; }
        else if (MODE == 2) { const bf16* base = (const bf16*)(ws + R_C_QKV); qpitch = kpitch = vpitch = 3072;
            Qp = base + row_q * 3072 + (2 * h) * 64; Kb = base + row_b * 3072 + 1024 + (2 * h) * 64; Vb = base + row_b * 3072 + 2048 + h * 128; }
        else { const bf16* base = (const bf16*)(ws + R_D_QKV); qpitch = kpitch = vpitch = 1280;
            Qp = base + row_q * 1280 + h * 64; Kb = base + row_b * 1280 + 1024 + (h >> 3) * 64; Vb = base + row_b * 1280 + 1152 + (h >> 3) * 64; }
        (void)qpitch;
        if (MODE == 0 || MODE == 3) { const int d_ = tid - 128; tab[tid] = (d_ >= 0 && d_ <= W) ? biasd[h * 2048 + d_ * dil] : -INFINITY; }
        if (MODE == 2) {
#pragma unroll
            for (int j = 0; j < 4; ++j) tab[128 + tid + 512 * j] = biasd[h * 2048 + tid + 512 * j];
            if (tid < 128) { tab[tid] = -INFINITY; tab[2176 + tid] = 0.f; } }
        bf16x8 qf[DQK / 16];
        constexpr int OFF_Q = L::OFF_TAB + TABN * 4, QSTR = DQK * 2 + 16;
        const int qoff = OFF_Q + (32 * wid + r32) * QSTR + hi * 16;
        int tq = tid; asm volatile("" : "+v"(tq));
        if (MODE == 2) {
            const bf16* qsrc = (const bf16*)(ws + R_C_QKV) + (row_b + s0) * 3072 + (2 * h) * 64;
#pragma unroll
            for (int j = 0; j < 4; ++j) { const int c_ = tq + 512 * j, rw = c_ >> 3, p_ = c_ & 7;
                *(LAS u32x4*)(lds + OFF_Q + rw * QSTR + p_ * 16) = *(const u32x4*)(qsrc + (size_t)rw * 3072 + p_ * 8); }
        } else {
#pragma unroll
            for (int ks = 0; ks < DQK / 16; ++ks) qf[ks] = *(const bf16x8*)(Qp + 16 * ks + 8 * hi);
            if (MODE == 1) {
                float x[DQK / 16][8]; float ss = 0.f;
#pragma unroll
                for (int ks = 0; ks < DQK / 16; ++ks) { const u32x4 raw = __builtin_bit_cast(u32x4, qf[ks]);
#pragma unroll
                    for (int j = 0; j < 4; ++j) { x[ks][2 * j] = bflo(raw[j]); x[ks][2 * j + 1] = bfhi(raw[j]); ss += x[ks][2 * j] * x[ks][2 * j] + x[ks][2 * j + 1] * x[ks][2 * j + 1]; } }
                ss += __shfl_xor(ss, 32);
                const float rsq = rsqrtf(ss * (1.0f / 96.0f) + EPS) * (0.10206207261596577f * LOG2E);
                const float* gq_ = a.in[13];
#pragma unroll
                for (int ks = 0; ks < DQK / 16; ++ks) { const f32x4 g0 = *(const f32x4*)(gq_ + 16 * ks + 8 * hi), g1 = *(const f32x4*)(gq_ + 16 * ks + 8 * hi + 4);
#pragma unroll
                    for (int j = 0; j < 4; ++j) { x[ks][j] *= rsq * g0[j]; x[ks][4 + j] *= rsq * g1[j]; } }
                const float* cs = (const float*)(ws + WS_ROPE) + ((size_t)qtok * 16 + 8 * hi) * 2;
#pragma unroll
                for (int j = 0; j < 8; ++j) { const float co = cs[2 * j], si = cs[2 * j + 1], x1 = x[4][j], x2 = x[5][j]; x[4][j] = x1 * co - x2 * si; x[5][j] = x2 * co + x1 * si; }
#pragma unroll
                for (int ks = 0; ks < DQK / 16; ++ks) { u32x4 w;
#pragma unroll
                    for (int j = 0; j < 4; ++j) w[j] = pk2(x[ks][2 * j], x[ks][2 * j + 1]);
                    qf[ks] = __builtin_bit_cast(bf16x8, w); }
            }
        }
        f32x16 o[DV / 32];
#pragma unroll
        for (int c = 0; c < DV / 32; ++c)
#pragma unroll
            for (int r = 0; r < 16; ++r) o[c][r] = 0.f;
        float m = -INFINITY, l = 0.f;
        if (MODE == 3) { m = a.in[28][h] * LOG2E; l = hi == 0 ? 1.f : 0.f; }
        attn_pass<DQK, DV, BIAS, TABN, MODE == 2, KT>(qoff, lds, Kb, kpitch, Vb, vpitch, G, my_tlo, my_thi, wslot_q0, W, qf, m, l, o);
        float lt = l + __shfl_xor(l, 32);
        float inv = 1.0f / lt;
        if (MODE != 2) {
            bf16* Op; int opitch;
            if (MODE == 0) { Op = (bf16*)(ws + R_A_O3) + ((size_t)g * M_ + row_q) * 512 + h * 64; opitch = 512;
                if (hi == 0) ((float*)(ws + R_A_LSE))[((size_t)g * M_ + row_q) * 8 + h] = m + __log2f(lt); }
            else if (MODE == 1) { Op = (bf16*)(ws + R_B_O) + row_q * 1024 + h * 64; opitch = 1024; }
            else { Op = (bf16*)(ws + R_D_O) + row_q * 1024 + h * 64; opitch = 1024; }
            (void)opitch;
#pragma unroll
            for (int c = 0; c < DV / 32; ++c)
#pragma unroll
                for (int k = 0; k < 2; ++k) {
                    u32x2 we, wo; we.x = pk2(o[c][8 * k] * inv, o[c][8 * k + 1] * inv); we.y = pk2(o[c][8 * k + 2] * inv, o[c][8 * k + 3] * inv);
                    wo.x = pk2(o[c][8 * k + 4] * inv, o[c][8 * k + 5] * inv); wo.y = pk2(o[c][8 * k + 6] * inv, o[c][8 * k + 7] * inv);
                    const u32x2 snd = hi ? we : wo, mine = hi ? wo : we;
                    u32x2 rcv; rcv.x = __shfl_xor(snd.x, 32); rcv.y = __shfl_xor(snd.y, 32);
                    u32x4 w; if (hi) { w.x = rcv.x; w.y = rcv.y; w.z = mine.x; w.w = mine.y; } else { w.x = mine.x; w.y = mine.y; w.z = rcv.x; w.w = rcv.y; }
                    *(u32x4*)(Op + 32 * c + 8 * (2 * k + hi)) = w;
                }
        } else {
            f32x16 o1[DV / 32];
#pragma unroll
            for (int c = 0; c < DV / 32; ++c)
#pragma unroll
                for (int r = 0; r < 16; ++r) { o1[c][r] = o[c][r] * inv; o[c][r] = 0.f; }
#pragma unroll
            for (int j = 0; j < 4; ++j) tab[128 + tid + 512 * j] = biasd[(8 + h) * 2048 + tid + 512 * j];
            { const bf16* qsrc = (const bf16*)(ws + R_C_QKV) + (row_b + s0) * 3072 + (2 * h + 1) * 64;
#pragma unroll
              for (int j = 0; j < 4; ++j) { const int c_ = tq + 512 * j, rw = c_ >> 3, p_ = c_ & 7;
                  *(LAS u32x4*)(lds + OFF_Q + rw * QSTR + p_ * 16) = *(const u32x4*)(qsrc + (size_t)rw * 3072 + p_ * 8); } }
            m = -INFINITY; l = 0.f;
            attn_pass<DQK, DV, BIAS, TABN, MODE == 2, KT>(qoff, lds, Kb + 64, kpitch, Vb, vpitch, G, my_tlo, my_thi, wslot_q0, W, qf, m, l, o);
            lt = l + __shfl_xor(l, 32);
            inv = lam / lt;
            float ssum = 0.f;
#pragma unroll
            for (int c = 0; c < DV / 32; ++c)
#pragma unroll
                for (int r = 0; r < 16; ++r) { const float d = o1[c][r] - o[c][r] * inv; o1[c][r] = d; ssum += d * d; }
            ssum += __shfl_xor(ssum, 32);
            const float rs = rsqrtf(ssum * (1.0f / 128.0f) + EPS) * (1.0f - lam_init);
            bf16* Op = (bf16*)(ws + R_C_O) + row_q * 1024 + h * 128;
            const float* sub = a.in[23];
#pragma unroll
            for (int c = 0; c < DV / 32; ++c)
#pragma unroll
                for (int k = 0; k < 2; ++k) {
                    const f32x4 se = *(const f32x4*)(sub + 32 * c + 16 * k + 4 * hi), so = *(const f32x4*)(sub + 32 * c + 16 * k + 8 + 4 * hi);
                    u32x2 we, wo; we.x = pk2(o1[c][8 * k] * rs * se[0], o1[c][8 * k + 1] * rs * se[1]); we.y = pk2(o1[c][8 * k + 2] * rs * se[2], o1[c][8 * k + 3] * rs * se[3]);
                    wo.x = pk2(o1[c][8 * k + 4] * rs * so[0], o1[c][8 * k + 5] * rs * so[1]); wo.y = pk2(o1[c][8 * k + 6] * rs * so[2], o1[c][8 * k + 7] * rs * so[3]);
                    const u32x2 snd = hi ? we : wo, mine = hi ? wo : we;
                    u32x2 rcv; rcv.x = __shfl_xor(snd.x, 32); rcv.y = __shfl_xor(snd.y, 32);
                    u32x4 w; if (hi) { w.x = rcv.x; w.y = rcv.y; w.z = mine.x; w.w = mine.y; } else { w.x = mine.x; w.y = mine.y; w.z = rcv.x; w.w = rcv.y; }
                    *(u32x4*)(Op + 32 * c + 8 * (2 * k + hi)) = w;
                }
        }
    }
}

__device__ __forceinline__ void transpose_item(const float* W, int ldw, int ncol0, int K, const float* ksc, bf16* WT, int mode, LAS float* scr, int nblk, int item, int lane) {
    const int kb = item / nblk, nb = item - kb * nblk, k0 = 64 * kb, n0 = 32 * nb;
#pragma unroll
    for (int i = 0; i < 32; ++i) { const int kk = 2 * i + (lane >> 5); float v = W[(size_t)(k0 + kk) * ldw + ncol0 + n0 + (lane & 31)]; if (ksc != nullptr) v *= ksc[k0 + kk]; scr[kk * 33 + (lane & 31)] = v; }
    asm volatile("s_waitcnt lgkmcnt(0)" ::: "memory");
    const int drow0 = mode == 1 ? (256 * (n0 >> 8) + 128 * ((n0 & 63) >> 5) + 32 * ((n0 >> 6) & 3)) : mode == 2 ? (n0 < DFF ? 256 * (n0 >> 7) + (n0 & 127) : 256 * ((n0 - DFF) >> 7) + 128 + ((n0 - DFF) & 127)) : n0;
    const int c = lane & 7;
#pragma unroll
    for (int j = 0; j < 4; ++j) { const int n = (lane >> 3) + 8 * j; const LAS float* s = scr + (8 * c) * 33 + n;
        u32x4 o; o.x = pk2(s[0 * 33], s[1 * 33]); o.y = pk2(s[2 * 33], s[3 * 33]); o.z = pk2(s[4 * 33], s[5 * 33]); o.w = pk2(s[6 * 33], s[7 * 33]);
        *(u32x4*)(WT + (size_t)(drow0 + n) * K + k0 + 8 * c) = o; }
    asm volatile("s_waitcnt lgkmcnt(0)" ::: "memory");
}
__device__ __forceinline__ void prologue(LAS unsigned char* lds, const Args& a, int Gn, int cid) {
    int tid = threadIdx.x; asm volatile("" : "+v"(tid)); const int lane = tid & 63, wid = __builtin_amdgcn_readfirstlane(tid >> 6);
    unsigned char* ws = a.ws;
    LAS float* scr = (LAS float*)(lds + wid * 16384);
    const int gw = cid * 8 + wid, NGW = Gn * 8;
#define MAT_DESC(id) \
        const float* W; int ldw, ncol0 = 0, K, N, mode; const float* ksc = nullptr; size_t dst; \
        if (id == 0) { W = a.in[4]; ldw = 4608; K = 1024; N = 4608; ksc = a.in[2]; dst = W_AIN; mode = 1; } \
        else if (id == 1) { W = a.in[7]; ldw = 1024; K = 512; N = 1024; dst = W_AOUT; mode = 0; } \
        else if (id == 2) { W = a.in[8]; ldw = 672; K = 1024; N = 672; ksc = a.in[2] + 1024; dst = W_BIN; mode = 1; } \
        else if (id == 3) { W = a.in[11]; ldw = 1536; K = 384; N = 1536; ksc = a.in[9]; dst = W_BQUP; mode = 1; } \
        else if (id == 4) { W = a.in[12]; ldw = 2048; K = 256; N = 2048; ksc = a.in[10]; dst = W_BKVUP; mode = 1; } \
        else if (id == 5) { W = a.in[15]; ldw = 1024; K = 1024; N = 1024; dst = W_BOUT; mode = 0; } \
        else if (id == 6) { W = a.in[16]; ldw = 3072; K = 1024; N = 3072; ksc = a.in[2] + 2048; dst = W_CIN; mode = 1; } \
        else if (id == 7) { W = a.in[24]; ldw = 1024; K = 1024; N = 1024; dst = W_COUT; mode = 0; } \
        else if (id == 8) { W = a.in[25]; ldw = 1280; K = 1024; N = 1280; ksc = a.in[2] + 3072; dst = W_DIN; mode = 1; } \
        else if (id == 9) { W = a.in[29]; ldw = 1024; K = 1024; N = 1024; dst = W_DOUT; mode = 0; } \
        else { const int l = (id - 10) / 3, k3 = (id - 10) - 3 * l; \
            if (k3 < 2) { W = a.in[30] + (size_t)l * 1024 * 5632; ldw = 5632; K = 1024; N = 5632; ksc = a.in[3] + 1024 * l; dst = W_FG + l * 2 * W_FSTR; mode = 2; } \
            else { W = a.in[33] + (size_t)l * 2816 * 1024; ldw = 1024; K = 2816; N = 1024; dst = W_FD + l * W_FSTR; mode = 0; } }
    constexpr int TOTAL_ITEMS = 2304 + 256 + 336 + 288 + 256 + 512 + 1536 + 512 + 640 + 512 + 4 * (1408 + 1408 + 1408);
    for (int it = gw; it < TOTAL_ITEMS; it += NGW) {
        int r = it, id = 0;
        for (; id < 21; ++id) {
            int n_;
            if (id < 10) { n_ = id == 0 ? 2304 : id == 1 ? 256 : id == 2 ? 336 : id == 3 ? 288 : id == 4 ? 256 : id == 5 ? 512 : id == 6 ? 1536 : id == 7 ? 512 : id == 8 ? 640 : 512; } else { const int k3_ = (id - 10) % 3; n_ = k3_ == 0 ? 2816 : (k3_ == 1 ? 0 : 1408); }
            if (r < n_) break;
            r -= n_;
        }
        MAT_DESC(id)
        const int nblk = N / 32;
        transpose_item(W, ldw, ncol0, K, ksc, (bf16*)(ws + dst), mode, scr, nblk, r, lane);
    }
#undef MAT_DESC
    const int gt = cid * 512 + tid, NT = Gn * 512;
    { float* biasd = (float*)(ws + WS_BIAS); const float* table = a.in[1];
      for (int i = gt; i < 16 * 2048; i += NT) { const int h = i >> 11, d = i & 2047; int bk = d;
          if (d >= 16) { float t = logf((float)d / 16.0f); t = t / 4.852030263919617f; t = t * 16.0f; int lg = 16 + (int)t; bk = lg < 31 ? lg : 31; }
          biasd[i] = table[bk * 16 + h] * LOG2E; } }
    { float* rope = (float*)(ws + WS_ROPE);
      for (int i = gt; i < 2048 * 16; i += NT) { const int pos = i >> 4, f = i & 15; const float inv = powf(10000.0f, -(float)(2 * f) / 32.0f); const float ang = (float)pos * inv;
          rope[2 * i] = cosf(ang); rope[2 * i + 1] = sinf(ang); } }
    { const float* x = a.in[0]; bf16* xb = (bf16*)(ws + WS_XB); float* rss = (float*)(ws + WS_RSS);
      for (int m0 = gw; m0 < M_; m0 += 4 * NGW) {
          f32x4 v[4][4];
#pragma unroll
          for (int k = 0; k < 4; ++k) { const int m = m0 + k * NGW; if (m < M_) { const f32x4* xr = (const f32x4*)(x + (size_t)m * DMODEL) + lane;
#pragma unroll
              for (int j = 0; j < 4; ++j) v[k][j] = xr[64 * j]; } }
#pragma unroll
          for (int k = 0; k < 4; ++k) { const int m = m0 + k * NGW; if (m < M_) { u32x2* o8 = (u32x2*)(xb + (size_t)m * DMODEL) + lane; float s = 0.f;
#pragma unroll
              for (int j = 0; j < 4; ++j) { s += dot4(v[k][j]); u32x2 w; w.x = pk2(v[k][j][0], v[k][j][1]); w.y = pk2(v[k][j][2], v[k][j][3]); o8[64 * j] = w; }
              s = wave_sum(s); if (lane == 0) rss[m] = rsqrtf(s * (1.0f / 1024.0f) + EPS); } } } }
}
__device__ __forceinline__ void combine_a(const Args& a, int Gn, int cid) {
    unsigned char* ws = a.ws;
    const bf16* o3 = (const bf16*)(ws + R_A_O3); const float* lse = (const float*)(ws + R_A_LSE); bf16* oc = (bf16*)(ws + R_A_OC);
    const size_t NT = (size_t)Gn * 512; int tid = threadIdx.x; asm volatile("" : "+v"(tid));
    for (size_t idx0 = (size_t)cid * 512 + tid; idx0 < (size_t)M_ * 64; idx0 += 4 * NT) {
        u32x4 a0[4], a1[4], a2[4]; float l0[4], l1[4], l2[4];
#pragma unroll
        for (int k = 0; k < 4; ++k) { const size_t idx = idx0 + k * NT; if (idx < (size_t)M_ * 64) {
            const size_t row = idx >> 6; const int ch = (int)(idx & 63), h = ch >> 3;
            l0[k] = lse[row * 8 + h]; l1[k] = lse[((size_t)M_ + row) * 8 + h]; l2[k] = lse[((size_t)2 * M_ + row) * 8 + h];
            a0[k] = *(const u32x4*)(o3 + row * 512 + ch * 8); a1[k] = *(const u32x4*)(o3 + ((size_t)M_ + row) * 512 + ch * 8); a2[k] = *(const u32x4*)(o3 + ((size_t)2 * M_ + row) * 512 + ch * 8); } }
#pragma unroll
        for (int k = 0; k < 4; ++k) { const size_t idx = idx0 + k * NT; if (idx < (size_t)M_ * 64) {
            const size_t row = idx >> 6; const int ch = (int)(idx & 63);
            const float mx = fmaxf(l0[k], fmaxf(l1[k], l2[k]));
            float w0 = __builtin_amdgcn_exp2f(l0[k] - mx), w1 = __builtin_amdgcn_exp2f(l1[k] - mx), w2 = __builtin_amdgcn_exp2f(l2[k] - mx);
            const float inv = 1.0f / (w0 + w1 + w2); w0 *= inv; w1 *= inv; w2 *= inv;
            u32x4 r;
#pragma unroll
            for (int j = 0; j < 4; ++j) r[j] = pk2(w0 * bflo(a0[k][j]) + w1 * bflo(a1[k][j]) + w2 * bflo(a2[k][j]), w0 * bfhi(a0[k][j]) + w1 * bfhi(a1[k][j]) + w2 * bfhi(a2[k][j]));
            *(u32x4*)(oc + row * 512 + ch * 8) = r; } }
    }
}
__device__ __forceinline__ void prep_b(const Args& a, int Gn, int cid) {
    unsigned char* ws = a.ws;
    int tid = threadIdx.x; asm volatile("" : "+v"(tid)); const int lane = tid & 63, wid = __builtin_amdgcn_readfirstlane(tid >> 6);
    bf16* Q = (bf16*)(ws + R_B_Q); const bf16* KV = (const bf16*)(ws + R_B_KV); const bf16* KPE = (const bf16*)(ws + R_B_KPE); bf16* KH = (bf16*)(ws + R_B_KH);
    const float* rope = (const float*)(ws + WS_ROPE);
    const int sub = lane >> 4, c = lane & 15;
    const float qscale = 0.10206207261596577f * LOG2E;
    const int gw = cid * 8 + wid, NGW = Gn * 8;
    const int TOT = 2 * M_ * 4;
    for (int it0 = M_ * 4 + gw; it0 < TOT; it0 += 4 * NGW) {
        u32x4 raw[4];
#pragma unroll
        for (int k = 0; k < 4; ++k) {
            const int it = it0 + k * NGW;
            raw[k] = (u32x4){0u, 0u, 0u, 0u};
            if (it < TOT && c < 12) {
                const bool isk = it >= M_ * 4; const int it2 = isk ? it - M_ * 4 : it;
                const int task = it2 * 4 + sub; const size_t row = (size_t)(task >> 4); const int h = task & 15;
                if (!isk) raw[k] = *(const u32x4*)(Q + row * 1536 + h * 96 + 8 * c);
                else if (c < 8) raw[k] = *(const u32x4*)(KV + row * 2048 + h * 128 + 8 * c);
                else raw[k] = *(const u32x4*)(KPE + row * 64 + 8 * (c - 8));
            }
        }
#pragma unroll
        for (int k = 0; k < 4; ++k) {
            const int it = it0 + k * NGW;
            if (it < TOT) {
                const bool isk = it >= M_ * 4; const int it2 = isk ? it - M_ * 4 : it;
                const int task = it2 * 4 + sub; const size_t row = (size_t)(task >> 4); const int h = task & 15; const int pos = (int)(row & 2047);
                float x[8];
#pragma unroll
                for (int j = 0; j < 4; ++j) { x[2 * j] = bflo(raw[k][j]); x[2 * j + 1] = bfhi(raw[k][j]); }
                float ss = 0.f;
#pragma unroll
                for (int e = 0; e < 8; ++e) ss += x[e] * x[e];
                ss += __shfl_xor(ss, 1); ss += __shfl_xor(ss, 2); ss += __shfl_xor(ss, 4); ss += __shfl_xor(ss, 8);
                const float rs = rsqrtf(ss * (1.0f / 96.0f) + EPS);
                const float* gain = (isk ? a.in[14] : a.in[13]) + 8 * (c < 12 ? c : 0);
                const float* cs = rope + ((size_t)pos * 16 + (c & 1) * 8) * 2;
                float y[8];
#pragma unroll
                for (int e = 0; e < 8; ++e) y[e] = x[e] * rs * gain[e];
#pragma unroll
                for (int e = 0; e < 8; ++e) {
                    const float z = __shfl_xor(y[e], 2);
                    if (c >= 8 && c < 12) { const float co = cs[2 * e], si = cs[2 * e + 1]; y[e] = (c < 10) ? (y[e] * co - z * si) : (y[e] * co + z * si); }
                }
                if (c < 12) {
                    u32x4 w;
                    if (!isk) {
#pragma unroll
                        for (int j = 0; j < 4; ++j) w[j] = pk2(y[2 * j] * qscale, y[2 * j + 1] * qscale);
                        *(u32x4*)(Q + row * 1536 + h * 96 + 8 * c) = w;
                    } else {
#pragma unroll
                        for (int j = 0; j < 4; ++j) w[j] = pk2(y[2 * j], y[2 * j + 1]);
                        *(u32x4*)(KH + row * 1536 + h * 96 + 8 * c) = w;
                    }
                }
            }
        }
    }
}

__device__ __forceinline__ void fixup_ffn(const bf16* gedge, const bf16* uedge, bf16* act, const float* cw, const float* cb, int Gn, int cid) {
    int tid = threadIdx.x; asm volatile("" : "+v"(tid));
    const int TOT = 1024 * 2 * 352;
    for (int idx = cid * 512 + tid; idx < TOT; idx += Gn * 512) {
        const int ch = idx % 352, sj = idx / 352, j = sj & 1, st = sj >> 1, c0 = ch * 8;
        const int row = st * 64 + j, t = row & (SEQ - 1);
        const u32x4 z = (u32x4){0u, 0u, 0u, 0u};
        const u32x4 g0 = *(const u32x4*)(gedge + ((size_t)st * 4 + j) * DFF + c0);
        u32x4 g1, g2;
        if (j == 0) { g1 = t >= 1 ? *(const u32x4*)(gedge + ((size_t)(st - 1) * 4 + 3) * DFF + c0) : z; g2 = t >= 2 ? *(const u32x4*)(gedge + ((size_t)(st - 1) * 4 + 2) * DFF + c0) : z; }
        else { g1 = *(const u32x4*)(gedge + ((size_t)st * 4 + 0) * DFF + c0); g2 = t >= 2 ? *(const u32x4*)(gedge + ((size_t)(st - 1) * 4 + 3) * DFF + c0) : z; }
        const u32x4 uw = *(const u32x4*)(uedge + ((size_t)st * 2 + j) * DFF + c0);
        u32x4 w;
#pragma unroll
        for (int n = 0; n < 2; ++n) {
            const f32x4 w0 = *(const f32x4*)(cw + c0 + 4 * n), w1 = *(const f32x4*)(cw + DFF + c0 + 4 * n), w2 = *(const f32x4*)(cw + 2 * DFF + c0 + 4 * n), b = *(const f32x4*)(cb + c0 + 4 * n);
            float r[4];
#pragma unroll
            for (int e = 0; e < 4; ++e) {
                const unsigned q0 = g0[2 * n + (e >> 1)], q1 = g1[2 * n + (e >> 1)], q2 = g2[2 * n + (e >> 1)], qu = uw[2 * n + (e >> 1)];
                const float x0 = (e & 1) ? bfhi(q0) : bflo(q0), x1 = (e & 1) ? bfhi(q1) : bflo(q1), x2 = (e & 1) ? bfhi(q2) : bflo(q2), up = (e & 1) ? bfhi(qu) : bflo(qu);
                const float cv = b[e] + w2[e] * x0 + w1[e] * x1 + w0[e] * x2;
                r[e] = cv * __builtin_amdgcn_rcpf(1.0f + __builtin_amdgcn_exp2f(-LOG2E * cv)) * up;
            }
            w[2 * n] = pk2(r[0], r[1]); w[2 * n + 1] = pk2(r[2], r[3]);
        }
        *(u32x4*)(act + (size_t)row * DFF + c0) = w;
    }
}
__device__ __forceinline__ void rstd_pass(const float* ssp, int nvec, float invdim, float* rs, int Gn, int cid) {
    int tid = threadIdx.x; asm volatile("" : "+v"(tid));
    for (int row = cid * 512 + tid; row < M_; row += Gn * 512) rs[row] = rsqrtf(rowss_sum(ssp, nvec, row) * invdim + EPS);
}
__device__ __forceinline__ void kpe_pass(const Args& a, int Gn, int cid) {
    unsigned char* ws = a.ws;
    int tid = threadIdx.x; asm volatile("" : "+v"(tid));
    const bf16* KPE = (const bf16*)(ws + R_B_KPE); bf16* RK = (bf16*)(ws + R_B_RK); float* sspe = (float*)(ws + WS_SSPE);
    const float* rope = (const float*)(ws + WS_ROPE); const float* gk = a.in[14] + 64;
    for (int row = cid * 512 + tid; row < M_; row += Gn * 512) {
        float x[32]; float ss = 0.f;
#pragma unroll
        for (int c = 0; c < 4; ++c) { const u32x4 raw = *(const u32x4*)(KPE + (size_t)row * 64 + 8 * c);
#pragma unroll
            for (int j = 0; j < 4; ++j) { x[8 * c + 2 * j] = bflo(raw[j]); x[8 * c + 2 * j + 1] = bfhi(raw[j]); } }
#pragma unroll
        for (int i = 0; i < 32; ++i) { ss += x[i] * x[i]; x[i] *= gk[i]; }
        sspe[row] = ss;
        const float* cs = rope + (size_t)(row & (SEQ - 1)) * 32;
#pragma unroll
        for (int i = 0; i < 16; ++i) { const float co = cs[2 * i], si = cs[2 * i + 1], x1 = x[i], x2 = x[16 + i]; x[i] = x1 * co - x2 * si; x[16 + i] = x2 * co + x1 * si; }
#pragma unroll
        for (int c = 0; c < 4; ++c) { u32x4 w;
#pragma unroll
            for (int j = 0; j < 4; ++j) w[j] = pk2(x[8 * c + 2 * j], x[8 * c + 2 * j + 1]);
            *(u32x4*)(RK + (size_t)row * 32 + 8 * c) = w; }
    }
}
__device__ __forceinline__ void rstd_local(const float* ssp, float* rs, const pg8::StaticOrder& S, int nunits) {
    int tid = threadIdx.x; asm volatile("" : "+v"(tid));
    const int TOT = nunits * 256;
    for (int k0 = tid; k0 < TOT; k0 += 2 * 512) {
        float p[2][16]; int rows[2];
#pragma unroll
        for (int j = 0; j < 2; ++j) { const int k = k0 + j * 512; rows[j] = -1;
            if (k < TOT) { pg8::Unit uu; S.next(k >> 8, uu); rows[j] = uu.pm * 256 + (k & 255);
#pragma unroll
                for (int v = 0; v < 16; ++v) p[j][v] = ssp[(size_t)v * M_ + rows[j]]; } }
#pragma unroll
        for (int j = 0; j < 2; ++j) if (rows[j] >= 0) { float t = 0.f;
#pragma unroll
            for (int v = 0; v < 16; v += 4) t += (p[j][v] + p[j][v + 1]) + (p[j][v + 2] + p[j][v + 3]);
            rs[rows[j]] = rsqrtf(t * (1.0f / 1024.0f) + EPS); }
    }
    asm volatile("s_waitcnt vmcnt(0)" ::: "memory");
    __syncthreads();
}
__device__ __forceinline__ void grid_barrier(unsigned* cnt, unsigned& epoch, unsigned G) {
    asm volatile("s_waitcnt vmcnt(0) lgkmcnt(0)" ::: "memory");
    __syncthreads();
    epoch += 1u;
    if (threadIdx.x == 0) {
        __builtin_amdgcn_fence(__ATOMIC_RELEASE, "agent");
        asm volatile("s_waitcnt vmcnt(0)" ::: "memory");
        __hip_atomic_fetch_add(cnt, 1u, __ATOMIC_RELAXED, __HIP_MEMORY_SCOPE_AGENT);
        const unsigned want = epoch * G;
        while (__hip_atomic_load(cnt, __ATOMIC_RELAXED, __HIP_MEMORY_SCOPE_AGENT) < want) __builtin_amdgcn_s_sleep(2);
        __builtin_amdgcn_fence(__ATOMIC_ACQUIRE, "agent");
        asm volatile("s_waitcnt vmcnt(0)" ::: "memory");
    }
    __syncthreads();
}
__global__ void __launch_bounds__(512) fwd_kernel(Args a) {
    extern __shared__ __attribute__((aligned(16))) unsigned char lds_raw[];
    LAS unsigned char* lds = (LAS unsigned char*)lds_raw;
    cg::grid_group grid = cg::this_grid();
    const int Gn = (int)gridDim.x, cid = (int)blockIdx.x;
    unsigned char* ws = a.ws;
    unsigned* barcnt = (unsigned*)(ws + WS_BAR); unsigned epoch = 0u;
    prologue(lds, a, Gn, cid);
    grid.sync();
    grid_barrier(barcnt, epoch, (unsigned)Gn);
    bf16* XB = (bf16*)(ws + WS_XB);
    float* RSS = (float*)(ws + WS_RSSP); float* RSTD = (float*)(ws + WS_RSS);
    for (int ph = 0; ph < 28; ++ph) {
        int type = 0, N = 1024, K = 1024, ldc = 0, hm = 0, layer = 0, sidx = 0, nvec = 4, pbuf = -1;
        const bf16 *A = XB, *Bt = nullptr; bf16* pO = nullptr; const float* pss = RSTD; const float *gq = nullptr, *gk = nullptr; float qs = 0.125f * LOG2E;
        const float* rbase = nullptr; float* rout = nullptr; bf16* rxb = XB; float* rssn = nullptr;
        int f = -1;
        switch (ph) {
        case 0: type = 0; Bt = (const bf16*)(ws + W_AIN); N = 4608; pO = (bf16*)(ws + R_A_QKV); ldc = 4608; hm = 1; gq = a.in[5]; gk = a.in[6]; break;
        case 1: type = 4; break;
        case 2: type = 8; break;
        case 3: type = 1; A = (const bf16*)(ws + R_A_OC); Bt = (const bf16*)(ws + W_AOUT); K = 512; rbase = a.in[0]; rssn = RSS + 1 * (size_t)M_ * 16; break;
        case 4: case 5: case 6: layer = 0; sidx = 1; f = ph - 4; break;
        case 7: type = 2; Bt = (const bf16*)(ws + W_BIN); N = 768; pbuf = 0; break;
        case 8: type = 0; A = (const bf16*)(ws + R_B_CQ); Bt = (const bf16*)(ws + W_BQUP); N = 1536; K = 384; pO = (bf16*)(ws + R_B_Q); ldc = 1536; pss = (const float*)(ws + WS_SSQ); break;
        case 9: type = 10; break;
        case 10: type = 10; break;
        case 11: type = 5; break;
        case 12: type = 1; A = (const bf16*)(ws + R_B_O); Bt = (const bf16*)(ws + W_BOUT); rssn = RSS + 1 * (size_t)M_ * 16; break;
        case 13: case 14: case 15: layer = 1; sidx = 3; f = ph - 13; break;
        case 16: type = 0; Bt = (const bf16*)(ws + W_CIN); N = 3072; pO = (bf16*)(ws + R_C_QKV); ldc = 3072; pbuf = 0; hm = 2; gq = a.in[17]; gk = a.in[18]; break;
        case 17: type = 6; break;
        case 18: type = 1; A = (const bf16*)(ws + R_C_O); Bt = (const bf16*)(ws + W_COUT); rssn = RSS + 1 * (size_t)M_ * 16; break;
        case 19: case 20: case 21: layer = 2; sidx = 5; f = ph - 19; break;
        case 22: type = 0; Bt = (const bf16*)(ws + W_DIN); N = 1280; pO = (bf16*)(ws + R_D_QKV); ldc = 1280; pbuf = 0; hm = 3; gq = a.in[26]; gk = a.in[27]; break;
        case 23: type = 7; break;
        case 24: type = 1; A = (const bf16*)(ws + R_D_O); Bt = (const bf16*)(ws + W_DOUT); rssn = RSS + 1 * (size_t)M_ * 16; break;
        default: layer = 3; sidx = 7; f = ph - 25; break;
        }
        if (f == 0) { type = 3; Bt = (const bf16*)(ws + W_FG + layer * 2 * W_FSTR); N = 2 * DFF; pbuf = 1; }
        else if (f == 1) { type = 11; }
        else if (f == 2) { type = 1; A = (const bf16*)(ws + R_ACT); Bt = (const bf16*)(ws + W_FD + layer * W_FSTR); K = DFF;
            if (layer < 3) { rssn = RSS + ((sidx + 1) & 1) * (size_t)M_ * 16; } else { rssn = nullptr; rxb = nullptr; rout = a.out; } }

        if (type == 10) continue;
        if (type <= 3) {
            pg8::Gemm g{A, Bt, M_, N, K}; pg8::StaticOrder S; S.init(M_, N, Gn, cid);
            if (pbuf >= 0) rstd_local(RSS + (size_t)pbuf * M_ * 16, RSTD, S, (S.nwg - cid + Gn - 1) / Gn);
            if (type == 0) {
                for (int sub = 0; sub < (ph == 8 ? 2 : 1); ++sub) {
                    const bool kv = (sub == 1);
                    const pg8::Gemm g2{kv ? (const bf16*)(ws + R_B_CKV) : A, kv ? (const bf16*)(ws + W_BKVUP) : Bt, M_, kv ? 2048 : N, kv ? 256 : K};
                    pg8::StaticOrder S2; S2.init(M_, kv ? 2048 : N, Gn, cid);
                    const EpiProj E{kv ? (bf16*)(ws + R_B_KV) : pO, kv ? 2048 : ldc, kv ? (const float*)(ws + WS_SSKV) : pss, kv ? 4 : hm, gq, kv ? a.in[14] : gk, qs};
                    pg8::gemm_phase<EpiProj, pg8::StaticOrder, true, true>(lds, g2, S2, E);
                }
            }
            else if (type == 1) { EpiRes E{rbase, rout, XB, rxb, rssn}; pg8::gemm_phase<EpiRes, pg8::StaticOrder, true, true>(lds, g, S, E); }
            else if (type == 2) { EpiLat E{(bf16*)(ws + R_B_CQ), (bf16*)(ws + R_B_CKV), (bf16*)(ws + R_B_KPE), pss, (float*)(ws + WS_SSQP), (float*)(ws + WS_SSKVP)}; pg8::gemm_phase<EpiLat, pg8::StaticOrder, true, true>(lds, g, S, E); }
            else { EpiGateUp E{(bf16*)(ws + R_ACT), (bf16*)(ws + R_GATE), (bf16*)(ws + R_GATE + 32 * MiB), pss, a.in[31] + (size_t)layer * 3 * DFF, a.in[32] + (size_t)layer * DFF}; pg8::gemm_phase<EpiGateUp, pg8::StaticOrder, true, true>(lds, g, S, E); }
        }
        else if (type == 4) attn_phase<0>(lds, a, Gn, cid);
        else if (type == 5) attn_phase<1>(lds, a, Gn, cid);
        else if (type == 6) attn_phase<2>(lds, a, Gn, cid);
        else if (type == 7) attn_phase<3>(lds, a, Gn, cid);
        else if (type == 8) combine_a(a, Gn, cid);
        else if (type == 11) fixup_ffn((const bf16*)(ws + R_GATE), (const bf16*)(ws + R_GATE + 32 * MiB), (bf16*)(ws + R_ACT), a.in[31] + (size_t)layer * 3 * DFF, a.in[32] + (size_t)layer * DFF, Gn, cid);
        else prep_b(a, Gn, cid);
        grid_barrier(barcnt, epoch, (unsigned)Gn);
        if (type == 2) { rstd_pass((const float*)(ws + WS_SSQP), 2, 1.0f / 384.0f, (float*)(ws + WS_SSQ), Gn, cid); rstd_pass((const float*)(ws + WS_SSKVP), 1, 1.0f / 256.0f, (float*)(ws + WS_SSKV), Gn, cid); kpe_pass(a, Gn, cid);
            grid_barrier(barcnt, epoch, (unsigned)Gn); }
    }
}

extern "C" void kernel_launch(void* const* d_in, const int* in_sizes, int n_in, void* d_out, int out_size, void* d_ws, size_t ws_size, hipStream_t stream) {
    static int grid = 0;
    if (grid == 0) {
        if (n_in != 34 || out_size != M_ * DMODEL || ws_size < WS_NEED) { fprintf(stderr, "kernel_launch: unexpected shapes (n_in %d out %d ws %zu)\n", n_in, out_size, ws_size); grid = -1; return; }
        int dev = 0, cus = 0, per_cu = 0;
        if (hipGetDevice(&dev) != hipSuccess || hipDeviceGetAttribute(&cus, hipDeviceAttributeMultiprocessorCount, dev) != hipSuccess) { grid = -1; return; }
        if (hipFuncSetAttribute((const void*)fwd_kernel, hipFuncAttributeMaxDynamicSharedMemorySize, LDS_BYTES) != hipSuccess) { fprintf(stderr, "kernel_launch: hipFuncSetAttribute failed\n"); grid = -1; return; }
        if (hipOccupancyMaxActiveBlocksPerMultiprocessor(&per_cu, (const void*)fwd_kernel, 512, LDS_BYTES) != hipSuccess || per_cu < 1) { fprintf(stderr, "kernel_launch: occupancy query says %d\n", per_cu); per_cu = 1; }
        (void)hipGetLastError();
        grid = cus;
    }
    if (grid < 0) return;
    if (hipMemsetAsync((unsigned char*)d_ws + WS_BAR, 0, 256, stream) != hipSuccess) { fprintf(stderr, "kernel_launch: memset failed\n"); return; }
    Args a{};
    for (int i = 0; i < 34; ++i) a.in[i] = (const float*)d_in[i];
    a.out = (float*)d_out; a.ws = (unsigned char*)d_ws;
    void* args[] = {&a};
    hipError_t e = hipLaunchCooperativeKernel((const void*)fwd_kernel, dim3(grid), dim3(512), args, LDS_BYTES, stream);
    if (e != hipSuccess) fprintf(stderr, "cooperative launch failed: %s (grid %d)\n", hipGetErrorString(e), grid);
}
```

```cpp
#include <hip/hip_runtime.h>
#include <hip/hip_cooperative_groups.h>
#include <cstdio>
#include <cstdint>
namespace cg = cooperative_groups;
namespace pg8 {
#define PG8_LAS __attribute__((address_space(3)))
typedef unsigned short bf16_t;
typedef short bf16x8 __attribute__((ext_vector_type(8)));
typedef float f32x4 __attribute__((ext_vector_type(4)));
typedef unsigned u32x4 __attribute__((ext_vector_type(4)));
constexpr int BM = 256, BK = 64, HALF = 128, HTB = HALF * BK * 2  , STAGE_BYTES = 8 * HTB, NXCD = 8, WGM = 8;

__host__ __device__ __forceinline__ int lds_byte(int r, int c) { const int st = (r >> 4) * 2 + (c >> 5), rr = r & 15, cc = c & 31, ob = rr * 64 + cc * 2; return st * 1024 + (ob ^ (((ob >> 9) & 1) << 5)); }
__host__ __device__ __forceinline__ void stage_rc(int b, int& R, int& C) { const int st = b / 1024, sb = b % 1024, swz = sb ^ (((sb >> 9) & 1) << 5); R = (st >> 1) * 16 + swz / 64; C = (st & 1) * 32 + (swz % 64) / 2; }
__host__ __device__ __forceinline__ int perm32(int rho) { const int n = rho >> 4, i = rho & 15; return 8 * (i >> 2) + 4 * n + (i & 3); }

struct Unit { int pm, pn; };
struct Gemm { const bf16_t* A; const bf16_t* Bt; int M, N, K; };

struct StaticOrder {
    int nM, nN, nwg, G, c;
    __host__ __device__ void init(int M, int N, int G_, int c_) { nM = M / BM; nN = N / BM; nwg = nM * nN; G = G_; c = c_; }
    __host__ __device__ bool next(int i, Unit& u) const {
        const long L = (long)i * G + c; if (L >= nwg) return false;
        int wgid = (int)L; { const int q = nwg / NXCD, r = nwg % NXCD, xcd = wgid % NXCD, off = wgid / NXCD; wgid = (xcd < r ? xcd * (q + 1) : r * (q + 1) + (xcd - r) * q) + off; }
        const int nig = WGM * nN, gid = wgid / nig, fm = gid * WGM, gsz = (nM - fm) < WGM ? (nM - fm) : WGM;
        u.pm = fm + ((wgid % nig) % gsz); u.pn = (wgid % nig) / gsz; return true;
    }
    __device__ __forceinline__ void a_ready(const Unit&) const {}
    __device__ __forceinline__ void done(const Unit&) const {}
};

__device__ __forceinline__ unsigned cvt_pk_bf16(float lo, float hi) { unsigned r; asm volatile("v_cvt_pk_bf16_f32 %0, %1, %2" : "=v"(r) : "v"(lo), "v"(hi)); return r; }
template <class Epi, class Sched, bool ALIGN_EPI = false, bool SP2 = false>
__device__ __forceinline__ void gemm_phase(PG8_LAS unsigned char* lds, const Gemm g, const Sched& S, const Epi& E) {
    int tid = threadIdx.x; asm volatile("" : "+v"(tid)); const int wid = __builtin_amdgcn_readfirstlane(tid >> 6), lane = tid & 63, wr = wid >> 2, wc = wid & 3, fr = lane & 15, fq = lane >> 4;
    const int K = g.K, nt = K / BK;
    unsigned voffA[2], voffB[2];
#pragma unroll
    for (int i = 0; i < 2; ++i) { int R, C; stage_rc(tid * 16 + i * 8192, R, C); const int Rb = Epi::PERM ? ((R & ~31) + perm32(R & 31)) : R;
        voffA[i] = (unsigned)(R * K + C) * 2u; voffB[i] = (unsigned)(Rb * K + C) * 2u; }
    const size_t kstep = (size_t)(BK * 2);
    const size_t hstep = (size_t)HALF * K * 2;
    const size_t tstep = 2 * hstep;
    const unsigned ldsw = (unsigned)wid * 1024u;
    const int aoff = lds_byte(wr * 64 + fr, fq * 8), boff = lds_byte(wc * 32 + fr, fq * 8);
#define PG8_SA(b, h) (((b) * 2 + (h)) * HTB)
#define PG8_SB(b, h) ((4 + (b) * 2 + (h)) * HTB)
#define PG8_STAGE(bufoff, gbase, voff) do { _Pragma("unroll") for (int _i = 0; _i < 2; ++_i) \
        __builtin_amdgcn_global_load_lds((const unsigned*)((const char*)(gbase) + (voff)[_i]), (PG8_LAS unsigned*)(lds + (bufoff) + ldsw + _i * 8192), 16, 0, 0); } while (0)
#define PG8_LDA(dst, b, h) do { _Pragma("unroll") for (int m = 0; m < 4; ++m) _Pragma("unroll") for (int k = 0; k < 2; ++k) dst[m][k] = *(const PG8_LAS bf16x8*)(lds + PG8_SA(b, h) + aoff + m * 2048 + k * 1024); } while (0)
#define PG8_LDB(dst, b, h) do { _Pragma("unroll") for (int n = 0; n < 2; ++n) _Pragma("unroll") for (int k = 0; k < 2; ++k) dst[n][k] = *(const PG8_LAS bf16x8*)(lds + PG8_SB(b, h) + boff + n * 2048 + k * 1024); } while (0)
#define PG8_MMA(ai, bj, At, Bt) do { __builtin_amdgcn_s_setprio(1); _Pragma("unroll") for (int m = 0; m < 4; ++m) _Pragma("unroll") for (int n = 0; n < 2; ++n) _Pragma("unroll") for (int k = 0; k < 2; ++k) \
        acc[ai][bj][m][n] = __builtin_amdgcn_mfma_f32_16x16x32_bf16(Bt[n][k], At[m][k], acc[ai][bj][m][n], 0, 0, 0); __builtin_amdgcn_s_setprio(0); } while (0)
#define PG8_WAIT_V(n) asm volatile("s_waitcnt vmcnt(" #n ")" ::: "memory")
#define PG8_WAIT_L(n) asm volatile("s_waitcnt lgkmcnt(" #n ")" ::: "memory")
#define PG8_BAR __builtin_amdgcn_s_barrier()
#define PG8_SCHED __builtin_amdgcn_sched_barrier(0)
    Unit cur, nxt; int ui = 0;
    if (!S.next(0, cur)) return;
    f32x4 acc[2][2][4][2];
#pragma unroll
    for (int a = 0; a < 2; ++a)
#pragma unroll
        for (int b = 0; b < 2; ++b)
#pragma unroll
            for (int m = 0; m < 4; ++m)
#pragma unroll
                for (int n = 0; n < 2; ++n) acc[a][b][m][n] = (f32x4){0.f, 0.f, 0.f, 0.f};
    bf16x8 At[4][2], B0[2][2], B1[2][2];
    const char* cA = (const char*)g.A + (size_t)cur.pm * tstep; const char* cB = (const char*)g.Bt + (size_t)cur.pn * tstep;
    S.a_ready(cur);
    if constexpr (SP2) {
        PG8_STAGE(PG8_SB(0, 0), cB, voffB); PG8_STAGE(PG8_SB(0, 1), cB + hstep, voffB); PG8_STAGE(PG8_SA(0, 0), cA, voffA); PG8_STAGE(PG8_SA(0, 1), cA + hstep, voffA);
        if (wr == 1) PG8_BAR;
        PG8_WAIT_V(2); PG8_BAR;
        PG8_STAGE(PG8_SB(1, 0), cB + kstep, voffB); PG8_STAGE(PG8_SA(1, 0), cA + kstep, voffA); PG8_STAGE(PG8_SB(1, 1), cB + hstep + kstep, voffB);
        PG8_WAIT_V(6); PG8_BAR;
    } else {
        PG8_STAGE(PG8_SB(0, 0), cB, voffB); PG8_STAGE(PG8_SA(0, 0), cA, voffA); PG8_STAGE(PG8_SB(0, 1), cB + hstep, voffB); PG8_STAGE(PG8_SA(0, 1), cA + hstep, voffA);
        if (wr == 1) PG8_BAR;
        PG8_WAIT_V(4); PG8_BAR;
        PG8_STAGE(PG8_SB(1, 0), cB + kstep, voffB); PG8_STAGE(PG8_SA(1, 0), cA + kstep, voffA); PG8_STAGE(PG8_SB(1, 1), cB + hstep + kstep, voffB);
        PG8_WAIT_V(6); PG8_BAR;
    }
    for (;;) {
        const bool has_next = S.next(ui + 1, nxt);
        const char* nA = has_next ? (const char*)g.A + (size_t)nxt.pm * tstep : cA; const char* nB = has_next ? (const char*)g.Bt + (size_t)nxt.pn * tstep : cB;
        for (int t = 0; t < nt; t += 2) {
            const bool last = (t == nt - 2);
            const char* a1 = cA + (size_t)(t + 1) * kstep;
            const char* a2 = last ? nA : cA + (size_t)(t + 2) * kstep; const char* b2 = last ? nB : cB + (size_t)(t + 2) * kstep;
            const char* a3 = a2 + kstep; const char* b3 = b2 + kstep;
            if (last && has_next) S.a_ready(nxt);
            if constexpr (SP2) {
            PG8_LDB(B0, 0, 0); PG8_LDB(B1, 0, 1); PG8_SCHED; PG8_LDA(At, 0, 0); PG8_STAGE(PG8_SA(1, 1), a1 + hstep, voffA);
            PG8_WAIT_V(8); PG8_WAIT_L(0); PG8_BAR; PG8_MMA(0, 0, At, B0); PG8_MMA(0, 1, At, B1); PG8_BAR; PG8_SCHED;
            PG8_LDA(At, 0, 1); PG8_STAGE(PG8_SB(0, 0), b2, voffB); PG8_STAGE(PG8_SB(0, 1), b2 + hstep, voffB); PG8_STAGE(PG8_SA(0, 0), a2, voffA);
            PG8_WAIT_V(8); PG8_WAIT_L(0); PG8_BAR; PG8_MMA(1, 0, At, B0); PG8_MMA(1, 1, At, B1); PG8_BAR; PG8_SCHED;
            PG8_LDB(B0, 1, 0); PG8_LDB(B1, 1, 1); PG8_SCHED; PG8_LDA(At, 1, 0); PG8_STAGE(PG8_SA(0, 1), a2 + hstep, voffA);
            PG8_WAIT_V(8); PG8_WAIT_L(0); PG8_BAR; PG8_MMA(0, 0, At, B0); PG8_MMA(0, 1, At, B1); PG8_BAR; PG8_SCHED;
            PG8_LDA(At, 1, 1); PG8_STAGE(PG8_SB(1, 0), b3, voffB); PG8_STAGE(PG8_SB(1, 1), b3 + hstep, voffB); PG8_STAGE(PG8_SA(1, 0), a3, voffA);
            PG8_WAIT_V(8); PG8_WAIT_L(0); PG8_BAR; PG8_MMA(1, 0, At, B0); PG8_MMA(1, 1, At, B1); PG8_BAR; PG8_SCHED;
            } else {
            PG8_LDB(B0, 0, 0); PG8_SCHED; PG8_LDA(At, 0, 0); PG8_STAGE(PG8_SA(1, 1), a1 + hstep, voffA);
            PG8_WAIT_L(8); PG8_BAR; PG8_WAIT_L(0); PG8_MMA(0, 0, At, B0); PG8_BAR; PG8_SCHED;
            PG8_LDB(B1, 0, 1); PG8_STAGE(PG8_SB(0, 0), b2, voffB);
            PG8_BAR; PG8_WAIT_L(0); PG8_MMA(0, 1, At, B1); PG8_BAR;
            PG8_LDA(At, 0, 1); PG8_STAGE(PG8_SA(0, 0), a2, voffA);
            PG8_BAR; PG8_WAIT_L(0); PG8_MMA(1, 0, At, B0); PG8_BAR; PG8_SCHED;
            PG8_STAGE(PG8_SB(0, 1), b2 + hstep, voffB);
            PG8_WAIT_V(6); PG8_BAR; PG8_MMA(1, 1, At, B1); PG8_BAR;
            PG8_LDB(B0, 1, 0); PG8_SCHED; PG8_LDA(At, 1, 0); PG8_STAGE(PG8_SA(0, 1), a2 + hstep, voffA);
            PG8_WAIT_L(8); PG8_BAR; PG8_WAIT_L(0); PG8_MMA(0, 0, At, B0); PG8_BAR; PG8_SCHED;
            PG8_LDB(B1, 1, 1); PG8_STAGE(PG8_SB(1, 0), b3, voffB);
            PG8_BAR; PG8_WAIT_L(0); PG8_MMA(0, 1, At, B1); PG8_BAR;
            PG8_LDA(At, 1, 1); PG8_STAGE(PG8_SA(1, 0), a3, voffA);
            PG8_BAR; PG8_WAIT_L(0); PG8_MMA(1, 0, At, B0); PG8_BAR; PG8_SCHED;
            PG8_STAGE(PG8_SB(1, 1), b3 + hstep, voffB);
            PG8_WAIT_V(6); PG8_BAR; PG8_MMA(1, 1, At, B1); PG8_BAR;
            }
        }
        if constexpr (ALIGN_EPI) { if (wr == 0) PG8_BAR; }
        if constexpr (!Epi::AFTER_DRAIN) { E(acc, cur, wr, wc, fr, fq); S.done(cur); }
        if (!has_next) break;
#pragma unroll
        for (int a = 0; a < 2; ++a)
#pragma unroll
            for (int b = 0; b < 2; ++b)
#pragma unroll
                for (int m = 0; m < 4; ++m)
#pragma unroll
                    for (int n = 0; n < 2; ++n) acc[a][b][m][n] = (f32x4){0.f, 0.f, 0.f, 0.f};
        cur = nxt; cA = nA; cB = nB; ++ui;
        if constexpr (ALIGN_EPI) { if (wr == 1) PG8_BAR; }
    }
    PG8_WAIT_V(0);
    if constexpr (!ALIGN_EPI) { if (wr == 0) PG8_BAR; }
    PG8_BAR;
    if constexpr (Epi::AFTER_DRAIN) { E.fused(acc, cur, wr, wc, fr, fq, lds, wid, lane); S.done(cur); }
#undef PG8_SA
#undef PG8_SB
#undef PG8_STAGE
#undef PG8_LDA
#undef PG8_LDB
#undef PG8_MMA
#undef PG8_WAIT_V
#undef PG8_WAIT_L
#undef PG8_BAR
#undef PG8_SCHED
}
}

#define LAS __attribute__((address_space(3)))
typedef unsigned short bf16;
typedef short bf16x8 __attribute__((ext_vector_type(8)));
typedef short s16x4 __attribute__((ext_vector_type(4)));
typedef float f32x2 __attribute__((ext_vector_type(2)));
typedef float f32x4 __attribute__((ext_vector_type(4)));
typedef float f32x16 __attribute__((ext_vector_type(16)));
typedef unsigned u32x2 __attribute__((ext_vector_type(2)));
typedef unsigned u32x4 __attribute__((ext_vector_type(4)));
typedef __bf16 bf16x2_t __attribute__((ext_vector_type(2)));

constexpr int M_ = 65536, SEQ = 2048, DMODEL = 1024, DFF = 2816;
constexpr float EPS = 1e-6f, LOG2E = 1.4426950408889634f;
constexpr size_t MiB = 1u << 20;
constexpr size_t WS_BIAS = 0;
constexpr size_t WS_ROPE = 256 * 1024;
constexpr size_t WS_RSS = 1 * MiB;
constexpr size_t WS_SSQ = 3 * MiB;
constexpr size_t WS_SSKV = 3 * MiB + 256 * 1024;
constexpr size_t W_AIN = 4 * MiB, W_AOUT = 13 * MiB, W_BIN = 14 * MiB, W_BQUP = 16 * MiB, W_BKVUP = 18 * MiB, W_BOUT = 19 * MiB,
                 W_CIN = 21 * MiB, W_COUT = 27 * MiB, W_DIN = 29 * MiB, W_DOUT = 32 * MiB, W_FG = 34 * MiB, W_FU = 58 * MiB, W_FD = 82 * MiB, W_FSTR = 6 * MiB;
constexpr size_t WS_XB = 106 * MiB;
constexpr size_t WS_R = 234 * MiB;
constexpr size_t R_A_QKV = WS_R, R_A_O3 = WS_R + 576 * MiB, R_A_LSE = WS_R + 768 * MiB, R_A_OC = WS_R;
constexpr size_t R_B_CQ = WS_R, R_B_CKV = WS_R + 48 * MiB, R_B_KPE = WS_R + 80 * MiB, R_B_Q = WS_R + 128 * MiB, R_B_KV = WS_R + 320 * MiB, R_B_KH = WS_R + 576 * MiB, R_B_O = WS_R;
constexpr size_t R_C_QKV = WS_R, R_C_O = WS_R + 384 * MiB;
constexpr size_t R_D_QKV = WS_R, R_D_O = WS_R + 160 * MiB;
constexpr size_t R_GATE = WS_R, R_ACT = WS_R + 352 * MiB;
constexpr size_t WS_RSSP = WS_R + 774 * MiB;
constexpr size_t WS_SSQP = WS_R + 782 * MiB;
constexpr size_t WS_SSKVP = WS_R + 784 * MiB;
constexpr size_t WS_SSPE = 3 * MiB + 512 * 1024;
constexpr size_t R_B_RK = WS_R + 96 * MiB;
constexpr size_t WS_BAR = 512 * 1024;
constexpr size_t WS_NEED = WS_R + 786 * MiB;

constexpr int LDS_BYTES = 135168;

struct Args { const float* in[34]; float* out; unsigned char* ws; };

__device__ __forceinline__ unsigned pk2(float lo, float hi) { f32x2 v = {lo, hi}; bf16x2_t b = __builtin_convertvector(v, bf16x2_t); return __builtin_bit_cast(unsigned, b); }
__device__ __forceinline__ float bf2f(unsigned short h) { return __uint_as_float(((unsigned)h) << 16); }
__device__ __forceinline__ float bflo(unsigned w) { return __uint_as_float(w << 16); }
__device__ __forceinline__ float bfhi(unsigned w) { return __uint_as_float(w & 0xffff0000u); }
__device__ __forceinline__ float wave_sum(float v) {
#pragma unroll
    for (int o = 1; o < 64; o <<= 1) v += __shfl_xor(v, o);
    return v;
}
__device__ __forceinline__ float dot4(f32x4 a) { return (a[0] * a[0] + a[1] * a[1]) + (a[2] * a[2] + a[3] * a[3]); }
__device__ __forceinline__ float rowss_sum(const float* ss, int nvec, int row) {
    const f32x4* p = (const f32x4*)(ss + (size_t)row * 4 * nvec); float t = 0.f;
#pragma unroll
    for (int v = 0; v < 4; ++v) if (v < nvec) { const f32x4 q = p[v]; t += (q[0] + q[1]) + (q[2] + q[3]); }
    return t;
}

struct EpiProj {
    static constexpr bool PERM = true, AFTER_DRAIN = false;
    bf16* O; int ldc; const float* rs; int hm; const float* gq; const float* gk; float qscale;
    __device__ __forceinline__ void operator()(const f32x4 (&acc)[2][2][4][2], const pg8::Unit& u, int wr, int wc, int fr, int fq) const {
        const int hg = u.pn * 4 + wc;
        int kind = 2; const float* gain = gq;
        if (hm == 1) { const int t = (hg >> 3) % 3, gi = hg / 24; kind = t; gain = (t == 0 ? gq : gk) + gi * 64; }
        else if (hm == 2) { kind = hg < 16 ? 0 : (hg < 32 ? 1 : 2); gain = kind == 0 ? gq : gk; }
        else if (hm == 3) { kind = hg < 16 ? 0 : (hg < 18 ? 1 : 2); gain = kind == 0 ? gq : gk; }
        else if (hm == 4) { kind = (hg & 1) ? 2 : 3; gain = gk; }
        f32x4 gv[2][2];
#pragma unroll
        for (int bj = 0; bj < 2; ++bj)
#pragma unroll
            for (int n = 0; n < 2; ++n) {
                gv[bj][n] = (f32x4){1.f, 1.f, 1.f, 1.f};
                if (kind != 2) { gv[bj][n] = *(const f32x4*)(gain + 32 * bj + 8 * fq + 4 * n); if (kind == 0) gv[bj][n] = gv[bj][n] * qscale; }
            }
        bf16* colp = O + hg * 64 + 8 * fq;
        float rsv[2][4];
#pragma unroll
        for (int ai = 0; ai < 2; ++ai)
#pragma unroll
            for (int m = 0; m < 4; ++m) rsv[ai][m] = rs[u.pm * 256 + ai * 128 + wr * 64 + m * 16 + fr];
        if (kind == 3) {
#pragma unroll
            for (int ai = 0; ai < 2; ++ai)
#pragma unroll
                for (int m = 0; m < 4; ++m) {
                    const int row = u.pm * 256 + ai * 128 + wr * 64 + m * 16 + fr;
                    const float rstd = rsv[ai][m];
                    f32x4 v[2][2]; float s = 0.f;
#pragma unroll
                    for (int bj = 0; bj < 2; ++bj)
#pragma unroll
                        for (int n = 0; n < 2; ++n) { v[bj][n] = acc[ai][bj][m][n] * rstd; s += dot4(v[bj][n]); }
                    s += __shfl_xor(s, 16); s += __shfl_xor(s, 32);
                    const float rk_ = rsqrtf((s + ((const float*)((const unsigned char*)rs + (WS_SSPE - WS_SSKV)))[row]) * (1.0f / 96.0f) + EPS);
                    bf16* kp = (bf16*)((unsigned char*)O + (R_B_KH - R_B_KV)) + (size_t)row * 1536 + (hg >> 1) * 96 + 8 * fq;
#pragma unroll
                    for (int bj = 0; bj < 2; ++bj) {
                        const f32x4 a_ = v[bj][0] * rk_ * gv[bj][0], b_ = v[bj][1] * rk_ * gv[bj][1];
                        u32x4 w; w.x = pk2(a_[0], a_[1]); w.y = pk2(a_[2], a_[3]); w.z = pk2(b_[0], b_[1]); w.w = pk2(b_[2], b_[3]);
                        *(u32x4*)(kp + 32 * bj) = w;
                    }
                    const u32x4 r_ = *(const u32x4*)((const bf16*)((const unsigned char*)O - (R_B_KV - R_B_RK)) + (size_t)row * 32 + 8 * fq);
                    u32x4 w;
#pragma unroll
                    for (int j = 0; j < 4; ++j) w[j] = pk2(bflo(r_[j]) * rk_, bfhi(r_[j]) * rk_);
                    *(u32x4*)(kp + 64) = w;
                }
            return;
        }
#pragma unroll
        for (int ai = 0; ai < 2; ++ai)
#pragma unroll
            for (int m = 0; m < 4; ++m) {
                const int row = u.pm * 256 + ai * 128 + wr * 64 + m * 16 + fr;
                const float rstd = rsv[ai][m];
                f32x4 v[2][2]; float s = 0.f;
#pragma unroll
                for (int bj = 0; bj < 2; ++bj)
#pragma unroll
                    for (int n = 0; n < 2; ++n) { v[bj][n] = acc[ai][bj][m][n] * rstd; s += dot4(v[bj][n]); }
                if (kind < 2) {
                    s += __shfl_xor(s, 16); s += __shfl_xor(s, 32);
                    const float rs = rsqrtf(s * (1.0f / 64.0f) + EPS);
#pragma unroll
                    for (int bj = 0; bj < 2; ++bj)
#pragma unroll
                        for (int n = 0; n < 2; ++n) v[bj][n] = v[bj][n] * rs * gv[bj][n];
                }
#pragma unroll
                for (int bj = 0; bj < 2; ++bj) {
                    u32x4 w; w.x = pk2(v[bj][0][0], v[bj][0][1]); w.y = pk2(v[bj][0][2], v[bj][0][3]); w.z = pk2(v[bj][1][0], v[bj][1][1]); w.w = pk2(v[bj][1][2], v[bj][1][3]);
                    *(u32x4*)(colp + (size_t)row * ldc + 32 * bj) = w;
                }
            }
    }
};
struct EpiLat {
    static constexpr bool PERM = true, AFTER_DRAIN = false;
    bf16* CQ; bf16* CKV; bf16* KPE; const float* rs; float* ssq; float* sskv;
    __device__ __forceinline__ void operator()(const f32x4 (&acc)[2][2][4][2], const pg8::Unit& u, int wr, int wc, int fr, int fq) const {
        const int hg = u.pn * 4 + wc;
        if (hg > 10) return;
        bf16* dst; int ld; float* sacc = nullptr; int sst = 0;
        if (hg < 6) { dst = CQ + hg * 64; ld = 384; sacc = ssq + hg; sst = 8; } else if (hg < 10) { dst = CKV + (hg - 6) * 64; ld = 256; sacc = sskv + (hg - 6); sst = 4; } else { dst = KPE; ld = 64; }
        dst += 8 * fq;
        float rsv[2][4];
#pragma unroll
        for (int ai = 0; ai < 2; ++ai)
#pragma unroll
            for (int m = 0; m < 4; ++m) rsv[ai][m] = rs[u.pm * 256 + ai * 128 + wr * 64 + m * 16 + fr];
#pragma unroll
        for (int ai = 0; ai < 2; ++ai)
#pragma unroll
            for (int m = 0; m < 4; ++m) {
                const int row = u.pm * 256 + ai * 128 + wr * 64 + m * 16 + fr;
                const float rstd = rsv[ai][m];
                f32x4 v[2][2]; float s = 0.f;
#pragma unroll
                for (int bj = 0; bj < 2; ++bj)
#pragma unroll
                    for (int n = 0; n < 2; ++n) { v[bj][n] = acc[ai][bj][m][n] * rstd; s += dot4(v[bj][n]); }
                s += __shfl_xor(s, 16); s += __shfl_xor(s, 32);
                if (fq == 0) { if (sacc != nullptr) sacc[(size_t)row * sst] = s; else { float z_ = 0.f; asm volatile("" : "+v"(z_)); ssq[(size_t)row * 8 + 6] = z_; ssq[(size_t)row * 8 + 7] = z_; } }
#pragma unroll
                for (int bj = 0; bj < 2; ++bj) {
                    u32x4 w; w.x = pk2(v[bj][0][0], v[bj][0][1]); w.y = pk2(v[bj][0][2], v[bj][0][3]); w.z = pk2(v[bj][1][0], v[bj][1][1]); w.w = pk2(v[bj][1][2], v[bj][1][3]);
                    *(u32x4*)(dst + (size_t)row * ld + 32 * bj) = w;
                }
            }
    }
};
struct EpiRes {
    static constexpr bool PERM = true, AFTER_DRAIN = false;
    const float* base32; float* out32; bf16* xb; bf16* xbw; float* ssn;
    __device__ __forceinline__ void operator()(const f32x4 (&acc)[2][2][4][2], const pg8::Unit& u, int wr, int wc, int fr_, int fq_) const {
        int fr = fr_, fq = fq_; asm volatile("" : "+v"(fr), "+v"(fq));
        float* ssn_ = ssn; bf16* xbw_ = xbw; float* out_ = out32; const float* b32_ = base32; asm volatile("" : "+s"(ssn_), "+s"(xbw_), "+s"(out_), "+s"(b32_));
        const int col0 = u.pn * 256 + wc * 32 + 8 * fq;
#pragma unroll
        for (int ai = 0; ai < 2; ++ai) {
            f32x4 bv[4][2][2];
            if (b32_ != nullptr) {
#pragma unroll
                for (int m = 0; m < 4; ++m)
#pragma unroll
                    for (int bj = 0; bj < 2; ++bj)
#pragma unroll
                        for (int n = 0; n < 2; ++n) bv[m][bj][n] = *(const f32x4*)(b32_ + (size_t)(u.pm * 256 + ai * 128 + wr * 64 + m * 16 + fr) * DMODEL + col0 + bj * 128 + n * 4);
            } else {
                u32x4 rw[4][2];
#pragma unroll
                for (int m = 0; m < 4; ++m)
#pragma unroll
                    for (int bj = 0; bj < 2; ++bj) rw[m][bj] = *(const u32x4*)(xb + (size_t)(u.pm * 256 + ai * 128 + wr * 64 + m * 16 + fr) * DMODEL + col0 + bj * 128);
#pragma unroll
                for (int m = 0; m < 4; ++m)
#pragma unroll
                    for (int bj = 0; bj < 2; ++bj) {
                        bv[m][bj][0] = (f32x4){bflo(rw[m][bj].x), bfhi(rw[m][bj].x), bflo(rw[m][bj].y), bfhi(rw[m][bj].y)};
                        bv[m][bj][1] = (f32x4){bflo(rw[m][bj].z), bfhi(rw[m][bj].z), bflo(rw[m][bj].w), bfhi(rw[m][bj].w)};
                    }
            }
            asm volatile("" ::: "memory");
#pragma unroll
            for (int m = 0; m < 4; ++m) {
                const int row = u.pm * 256 + ai * 128 + wr * 64 + m * 16 + fr;
                float s = 0.f;
#pragma unroll
                for (int bj = 0; bj < 2; ++bj) {
                    const size_t off = (size_t)row * DMODEL + col0 + bj * 128;
                    const f32x4 o0 = bv[m][bj][0] + acc[ai][bj][m][0], o1 = bv[m][bj][1] + acc[ai][bj][m][1];
                    if (out_ != nullptr) { *(f32x4*)(out_ + off) = o0; *(f32x4*)(out_ + off + 4) = o1; }
                    if (xbw_ != nullptr) { u32x4 w; w.x = pk2(o0[0], o0[1]); w.y = pk2(o0[2], o0[3]); w.z = pk2(o1[0], o1[1]); w.w = pk2(o1[2], o1[3]); *(u32x4*)(xbw_ + off) = w; }
                    s += dot4(o0) + dot4(o1);
                }
                if (ssn_ != nullptr) { s += __shfl_xor(s, 16); s += __shfl_xor(s, 32); if (fq == 0) ssn_[(size_t)(u.pn * 4 + wc) * M_ + row] = s; }
            }
            asm volatile("" ::: "memory");
        }
    }
};
__device__ __forceinline__ u32x4 shfl4(u32x4 v, int src) { u32x4 r; r.x = __shfl(v.x, src, 16); r.y = __shfl(v.y, src, 16); r.z = __shfl(v.z, src, 16); r.w = __shfl(v.w, src, 16); return r; }
struct EpiGateUp {
    static constexpr bool PERM = true, AFTER_DRAIN = false;
    bf16* act; bf16* gedge; bf16* uedge; const float* rs; const float* cw; const float* cb;
    __device__ __forceinline__ void operator()(const f32x4 (&acc)[2][2][4][2], const pg8::Unit& u, int wr, int wc, int fr_, int fq_) const {
        int fr = fr_, fq = fq_; asm volatile("" : "+v"(fr), "+v"(fq));
        const int c0 = u.pn * 128 + wc * 32 + 8 * fq;
        f32x4 w0[2], w1[2], w2[2], b[2];
#pragma unroll
        for (int n = 0; n < 2; ++n) { w0[n] = *(const f32x4*)(cw + c0 + 4 * n); w1[n] = *(const f32x4*)(cw + DFF + c0 + 4 * n); w2[n] = *(const f32x4*)(cw + 2 * DFF + c0 + 4 * n); b[n] = *(const f32x4*)(cb + c0 + 4 * n); }
#pragma unroll
        for (int ai = 0; ai < 2; ++ai) {
            u32x4 g[4]; float rstd[4];
            const int strip = u.pm * 4 + ai * 2 + wr;
#pragma unroll
            for (int m = 0; m < 4; ++m) rstd[m] = rs[u.pm * 256 + ai * 128 + wr * 64 + m * 16 + fr];
#pragma unroll
            for (int m = 0; m < 4; ++m) {
                const f32x4 ga = acc[ai][0][m][0] * rstd[m], gb = acc[ai][0][m][1] * rstd[m];
                g[m].x = pk2(ga[0], ga[1]); g[m].y = pk2(ga[2], ga[3]); g[m].z = pk2(gb[0], gb[1]); g[m].w = pk2(gb[2], gb[3]);
            }
#pragma unroll
            for (int m = 0; m < 4; ++m) {
                const int row = u.pm * 256 + ai * 128 + wr * 64 + m * 16 + fr;
                const u32x4 g0 = g[m];
                u32x4 g1, g2;
#pragma unroll
                for (int d = 0; d < 4; ++d) {
                    unsigned o1_ = 0u, o2_ = 0u;
                    if (m > 0) { o1_ = __builtin_amdgcn_update_dpp(0u, g[m - 1][d], 0x121, 0xf, 0xf, false); o2_ = __builtin_amdgcn_update_dpp(0u, g[m - 1][d], 0x122, 0xf, 0xf, false); }
                    g1[d] = __builtin_amdgcn_update_dpp(o1_, g0[d], 0x111, 0xf, 0xf, false);
                    g2[d] = __builtin_amdgcn_update_dpp(o2_, g0[d], 0x112, 0xf, 0xf, false);
                }
                u32x4 w, uw;
#pragma unroll
                for (int n = 0; n < 2; ++n) {
                    float r[4], up[4];
#pragma unroll
                    for (int j = 0; j < 4; ++j) {
                        const unsigned q0 = g0[2 * n + (j >> 1)], q1 = g1[2 * n + (j >> 1)], q2 = g2[2 * n + (j >> 1)];
                        const float x0 = (j & 1) ? bfhi(q0) : bflo(q0), x1 = (j & 1) ? bfhi(q1) : bflo(q1), x2 = (j & 1) ? bfhi(q2) : bflo(q2);
                        const float cv = b[n][j] + w2[n][j] * x0 + w1[n][j] * x1 + w0[n][j] * x2;
                        const float sg = cv * __builtin_amdgcn_rcpf(1.0f + __builtin_amdgcn_exp2f(-LOG2E * cv));
                        up[j] = acc[ai][1][m][n][j] * rstd[m];
                        r[j] = sg * up[j];
                    }
                    w[2 * n] = pk2(r[0], r[1]); w[2 * n + 1] = pk2(r[2], r[3]);
                    uw[2 * n] = pk2(up[0], up[1]); uw[2 * n + 1] = pk2(up[2], up[3]);
                }
                if (m == 0) {
                    if (fr < 2) { *(u32x4*)(gedge + ((size_t)strip * 4 + fr) * DFF + c0) = g0; *(u32x4*)(uedge + ((size_t)strip * 2 + fr) * DFF + c0) = uw; }
                    else *(u32x4*)(act + (size_t)row * DFF + c0) = w;
                } else {
                    *(u32x4*)(act + (size_t)row * DFF + c0) = w;
                    if (m == 3 && fr >= 14) *(u32x4*)(gedge + ((size_t)strip * 4 + 2 + (fr - 14)) * DFF + c0) = g0;
                }
                asm volatile("" ::: "memory");
            }
        }
    }
};

__device__ __forceinline__ int crow(int r, int hi) { return (r & 3) + 8 * (r >> 2) + 4 * hi; }
struct TileGeo { int NT, TPS, ks0, res0, dil; };
template <int DQK, int DV, int KT> struct AttL {
    static constexpr int KSTR = DQK * 2 + 16, VSTR = DV * 2 + 64, KBUF = KT * KSTR, VBUF = KT * VSTR;
    static constexpr int OFF_K = 0, OFF_V = 2 * KBUF, OFF_TAB = OFF_V + 2 * VBUF;
};
template <int DQK, int DV, bool BIAS, int TABN, bool QRELOAD, int KT>
__device__ __forceinline__ void attn_pass(int qoff_, LAS unsigned char* lds, const bf16* Kb, int kpitch, const bf16* Vb, int vpitch, const TileGeo G, int my_tlo, int my_thi,
                                          int wslot_q0, int W, const bf16x8 (&qf_)[DQK / 16], float& m_, float& l_, f32x16 (&o)[DV / 32]) {
    typedef AttL<DQK, DV, KT> L;
    int tid = threadIdx.x; asm volatile("" : "+v"(tid)); const int lane = tid & 63, r32 = lane & 31, hi = lane >> 5;
    constexpr int SUB = KT / 64;
    constexpr int KCH = DQK / 8, VCH = DV / 8, NKC = KT * KCH, NVC = KT * VCH, NKL = (NKC + 511) / 512, NVL = (NVC + 511) / 512;
    u32x4 kr[NKL], vr[NVL];
    const LAS float* tab = (const LAS float*)(lds + L::OFF_TAB);
    const int slot_q = wslot_q0 + r32;
    const int vlane = (4 * hi + ((lane & 15) >> 2)) * L::VSTR + (16 * ((lane >> 4) & 1) + 4 * (lane & 3)) * 2;
#define ATT_LOAD(t) do { const int seg_ = ((t) * SUB) / G.TPS, tis_ = (t) * SUB - seg_ * G.TPS; const int tok0_ = G.res0 + seg_ + G.dil * (G.ks0 + 64 * tis_); \
        _Pragma("unroll") for (int i_ = 0; i_ < NKL; ++i_) { const int c_ = tid + 512 * i_; if ((NKC % 512 == 0) || c_ < NKC) { const int j_ = c_ / KCH, p_ = c_ - j_ * KCH; \
            kr[i_] = *(const u32x4*)(Kb + (size_t)(tok0_ + G.dil * j_) * kpitch + p_ * 8); } } \
        _Pragma("unroll") for (int i_ = 0; i_ < NVL; ++i_) { const int c_ = tid + 512 * i_; if ((NVC % 512 == 0) || c_ < NVC) { const int j_ = c_ / VCH, p_ = c_ - j_ * VCH; \
            vr[i_] = *(const u32x4*)(Vb + (size_t)(tok0_ + G.dil * j_) * vpitch + p_ * 8); } } } while (0)
#define ATT_STORE(buf) do { \
        _Pragma("unroll") for (int i_ = 0; i_ < NKL; ++i_) { const int c_ = tid + 512 * i_; if ((NKC % 512 == 0) || c_ < NKC) { const int j_ = c_ / KCH, p_ = c_ - j_ * KCH; \
            *(LAS u32x4*)(lds + L::OFF_K + (buf) * L::KBUF + j_ * L::KSTR + p_ * 16) = kr[i_]; } } \
        _Pragma("unroll") for (int i_ = 0; i_ < NVL; ++i_) { const int c_ = tid + 512 * i_; if ((NVC % 512 == 0) || c_ < NVC) { const int j_ = c_ / VCH, p_ = c_ - j_ * VCH; \
            *(LAS u32x4*)(lds + L::OFF_V + (buf) * L::VBUF + j_ * L::VSTR + p_ * 16) = vr[i_]; } } } while (0)
    ATT_LOAD(0);
    ATT_STORE(0);
    float m = m_, l = l_;
    const int NT2 = G.NT / SUB;
    for (int t = 0; t < NT2; ++t) {
        const int buf = t & 1;
        if (t + 1 < NT2) ATT_LOAD(t + 1);
        __syncthreads();
#pragma unroll
        for (int hf = 0; hf < SUB; ++hf) {
        const int st = t * SUB + hf;
        if (st >= my_tlo && st <= my_thi) {
            const int tis = st % G.TPS, slot0 = G.ks0 + 64 * tis;
            const LAS unsigned char* Kt = lds + L::OFF_K + buf * L::KBUF + (hf * 64 + r32) * L::KSTR + hi * 16;
            f32x16 s[2];
            const int dsb = slot_q - slot0 - 4 * hi;
            bf16x8 qf[DQK / 16];
            if (QRELOAD) {
#pragma unroll
                for (int ks = 0; ks < DQK / 16; ++ks) qf[ks] = *(const LAS bf16x8*)(lds + qoff_ + ks * 32); }
            else {
#pragma unroll
                for (int ks = 0; ks < DQK / 16; ++ks) qf[ks] = qf_[ks]; }
#pragma unroll
            for (int kb = 0; kb < 2; ++kb) {
#pragma unroll
                for (int r = 0; r < 16; ++r) s[kb][r] = BIAS ? tab[dsb + 128 - (32 * kb + (r & 3) + 8 * (r >> 2))] : 0.f;
            }
            if (DV == 64) {
                bf16x8 kf[2][DQK / 16];
#pragma unroll
                for (int kb = 0; kb < 2; ++kb)
#pragma unroll
                    for (int ks = 0; ks < DQK / 16; ++ks) kf[kb][ks] = *(const LAS bf16x8*)(Kt + kb * 32 * L::KSTR + ks * 32);
                asm volatile("" ::: "memory");
#pragma unroll
                for (int ks = 0; ks < DQK / 16; ++ks)
#pragma unroll
                    for (int kb = 0; kb < 2; ++kb) s[kb] = __builtin_amdgcn_mfma_f32_32x32x16_bf16(kf[kb][ks], qf[ks], s[kb], 0, 0, 0);
            } else {
#pragma unroll
                for (int kh = 0; kh < 2; ++kh) {
                    bf16x8 kf[2][DQK / 32];
#pragma unroll
                    for (int kb = 0; kb < 2; ++kb)
#pragma unroll
                        for (int k2 = 0; k2 < DQK / 32; ++k2) kf[kb][k2] = *(const LAS bf16x8*)(Kt + kb * 32 * L::KSTR + (kh * (DQK / 32) + k2) * 32);
                    asm volatile("" ::: "memory");
#pragma unroll
                    for (int k2 = 0; k2 < DQK / 32; ++k2)
#pragma unroll
                        for (int kb = 0; kb < 2; ++kb) s[kb] = __builtin_amdgcn_mfma_f32_32x32x16_bf16(kf[kb][k2], qf[kh * (DQK / 32) + k2], s[kb], 0, 0, 0);
                }
            }
            const bool full = (wslot_q0 - slot0 - 63 >= 0) && (wslot_q0 + 31 - slot0 <= W);
            if (!full && !BIAS) {
#pragma unroll
                for (int kb = 0; kb < 2; ++kb)
#pragma unroll
                    for (int r = 0; r < 16; ++r) {
                        const int ds = dsb - (32 * kb + (r & 3) + 8 * (r >> 2));
                        s[kb][r] = ((unsigned)ds <= (unsigned)W) ? s[kb][r] : -INFINITY;
                    }
            }
            float mx = s[0][0];
#pragma unroll
            for (int r = 1; r < 16; ++r) mx = fmaxf(mx, s[0][r]);
#pragma unroll
            for (int r = 0; r < 16; ++r) mx = fmaxf(mx, s[1][r]);
            mx = fmaxf(mx, __shfl_xor(mx, 32));
            const float mn = fmaxf(m, mx);
            const float base = (mn == -INFINITY) ? 0.f : mn;
            const float alpha = __builtin_amdgcn_exp2f(m - base);
            m = mn;
            float ps = 0.f;
#pragma unroll
            for (int kb = 0; kb < 2; ++kb)
#pragma unroll
                for (int r = 0; r < 16; ++r) { const float p = __builtin_amdgcn_exp2f(s[kb][r] - base); s[kb][r] = p; ps += p; }
            l = l * alpha + ps;
            if (__any(alpha != 1.0f)) {
#pragma unroll
                for (int c = 0; c < DV / 32; ++c)
#pragma unroll
                    for (int r = 0; r < 16; ++r) o[c][r] *= alpha;
            }
            const LAS unsigned char* Vt = lds + L::OFF_V + buf * L::VBUF + hf * 64 * L::VSTR + vlane;
#pragma unroll
            for (int kb = 0; kb < 2; ++kb) {
                bf16x8 pb[2];
#pragma unroll
                for (int k2 = 0; k2 < 2; ++k2) {
                    u32x4 pw; pw.x = pk2(s[kb][8 * k2 + 0], s[kb][8 * k2 + 1]); pw.y = pk2(s[kb][8 * k2 + 2], s[kb][8 * k2 + 3]);
                    pw.z = pk2(s[kb][8 * k2 + 4], s[kb][8 * k2 + 5]); pw.w = pk2(s[kb][8 * k2 + 6], s[kb][8 * k2 + 7]);
                    pb[k2] = __builtin_bit_cast(bf16x8, pw);
                }
#pragma unroll
                for (int ch = 0; ch < DV / 64; ++ch) {
                    bf16x8 vf[2][2];
#pragma unroll
                    for (int k2 = 0; k2 < 2; ++k2)
#pragma unroll
                        for (int c2 = 0; c2 < 2; ++c2) {
                            const LAS unsigned char* vp = Vt + (32 * kb + 16 * k2) * L::VSTR + 64 * (2 * ch + c2);
                            const s16x4 lo = __builtin_bit_cast(s16x4, __builtin_amdgcn_ds_read_tr16_b64_v4i16((LAS s16x4*)(vp)));
                            const s16x4 hh = __builtin_bit_cast(s16x4, __builtin_amdgcn_ds_read_tr16_b64_v4i16((LAS s16x4*)(vp + 8 * L::VSTR)));
                            vf[k2][c2] = (bf16x8){lo[0], lo[1], lo[2], lo[3], hh[0], hh[1], hh[2], hh[3]};
                        }
                    asm volatile("" ::: "memory");
#pragma unroll
                    for (int k2 = 0; k2 < 2; ++k2)
#pragma unroll
                        for (int c2 = 0; c2 < 2; ++c2) o[2 * ch + c2] = __builtin_amdgcn_mfma_f32_32x32x16_bf16(vf[k2][c2], pb[k2], o[2 * ch + c2], 0, 0, 0);
                }
            }
        }
        }
        if (t + 1 < NT2) ATT_STORE(buf ^ 1);
    }
    __syncthreads();
    m_ = m; l_ = l;
#undef ATT_LOAD
#undef ATT_STORE
}

template <int MODE>
__device__ __forceinline__ void attn_phase(LAS unsigned char* lds, const Args& a, int Gn, int cid) {
    constexpr int DQK = MODE == 1 ? 96 : 64, DV = MODE == 2 ? 128 : 64;
    constexpr bool BIAS = MODE != 1;
    constexpr int TABN = MODE == 2 ? 2048 + 256 : 512;
    constexpr int NU = MODE == 0 ? 6144 : (MODE == 2 ? 2048 : 4096);
    constexpr int KT = MODE == 2 ? 64 : 128;
    typedef AttL<DQK, DV, KT> L;
    int tid = threadIdx.x; asm volatile("" : "+v"(tid)); const int lane = tid & 63, r32 = lane & 31, hi = lane >> 5, wid = __builtin_amdgcn_readfirstlane(tid >> 6);
    unsigned char* ws = a.ws;
    const float* biasd = (const float*)(ws + WS_BIAS);
    LAS float* tab = (LAS float*)(lds + L::OFF_TAB);
    float lam = 0.f, lam_init = 0.f;
    if (MODE == 2) {
        float d1 = 0.f, d2 = 0.f;
        for (int i = 0; i < 64; ++i) { d1 += a.in[19][i] * a.in[20][i]; d2 += a.in[21][i] * a.in[22][i]; }
        lam_init = 0.8f - 0.6f * expf(-0.3f * 2.0f);
        lam = expf(d1) - expf(d2) + lam_init;
    }
    for (int u = cid; u < NU; u += Gn) {
        int b, h, dil = 1, res0 = 0, s0, nres = 1, W, qb = 0, g = 0;
        if (MODE == 0) { g = u >> 11; const int rem = u & 2047; b = rem >> 6; h = (rem >> 3) & 7; const int blk = (rem + (u >> 8)) & 7; W = 128;
            if (g == 0) { s0 = 256 * blk; } else if (g == 1) { dil = 4; res0 = blk >> 1; s0 = 256 * (blk & 1); } else { dil = 16; res0 = 2 * blk; s0 = 0; nres = 2; } }
        else if (MODE == 3) { b = u >> 7; h = (u >> 3) & 15; s0 = 256 * ((u + (u >> 8)) & 7); W = 127; }
        else if (MODE == 1) { const int bh = u & 511; qb = 7 - (u >> 9); b = bh >> 4; h = bh & 15; s0 = 256 * qb; W = 1 << 20; }
        else { const int bh = u & 255; qb = 7 - (u >> 8); b = bh >> 3; h = bh & 7; s0 = 256 * qb; W = 1 << 20; }
        TileGeo G;
        G.dil = dil; G.res0 = res0;
        const int Lseg = 256 / nres;
        if (MODE == 0 || MODE == 3) { G.ks0 = (nres == 1 && s0 >= 128) ? s0 - 128 : 0; } else { G.ks0 = 0; }
        G.TPS = (s0 + Lseg - G.ks0) >> 6; G.NT = G.TPS * nres;
        const int nws = 8 / nres, seg_w = wid / nws, wslot_q0 = s0 + 32 * (wid - seg_w * nws);
        int tl = 0;
        if (MODE == 0 || MODE == 3) { tl = wslot_q0 - W - G.ks0; tl = tl < 0 ? 0 : (tl >> 6); }
        const int th = (wslot_q0 + 31 - G.ks0) >> 6;
        const int my_tlo = seg_w * G.TPS + tl, my_thi = seg_w * G.TPS + th;
        const int qtok = res0 + seg_w + dil * (wslot_q0 + r32);
        const size_t row_q = (size_t)b * SEQ + qtok, row_b = (size_t)b * SEQ;
        const bf16 *Qp, *Kb, *Vb; int qpitch, kpitch, vpitch;
        if (MODE == 0) { const bf16* base = (const bf16*)(ws + R_A_QKV); qpitch = kpitch = vpitch = 4608;
            Qp = base + row_q * 4608 + g * 1536 + h * 64; Kb = base + row_b * 4608 + g * 1536 + 512 + h * 64; Vb = base + row_b * 4608 + g * 1536 + 1024 + h * 64; }
        else if (MODE == 1) { qpitch = 1536; kpitch = 1536; vpitch = 2048;
            Qp = (const bf16*)(ws + R_B_Q) + row_q * 1536 + h * 96; Kb = (const bf16*)(ws + R_B_KH) + row_b * 1536 + h * 96; Vb = (const bf16*)(ws + R_B_KV) + row_b * 2048 + h * 128 + 64; }
        else if (MODE == 2) { const bf16* base = (const bf16*)(ws + R_C_QKV); qpitch = kpitch = vpitch = 3072;
            Qp = base + row_q * 3072 + (2 * h) * 64; Kb = base + row_b * 3072 + 1024 + (2 * h) * 64; Vb = base + row_b * 3072 + 2048 + h * 128; }
        else { const bf16* base = (const bf16*)(ws + R_D_QKV); qpitch = kpitch = vpitch = 1280;
            Qp = base + row_q * 1280 + h * 64; Kb = base + row_b * 1280 + 1024 + (h >> 3) * 64; Vb = base + row_b * 1280 + 1152 + (h >> 3) * 64; }
        (void)qpitch;
        if (MODE == 0 || MODE == 3) { const int d_ = tid - 128; tab[tid] = (d_ >= 0 && d_ <= W) ? biasd[h * 2048 + d_ * dil] : -INFINITY; }
        if (MODE == 2) {
#pragma unroll
            for (int j = 0; j < 4; ++j) tab[128 + tid + 512 * j] = biasd[h * 2048 + tid + 512 * j];
            if (tid < 128) { tab[tid] = -INFINITY; tab[2176 + tid] = 0.f; } }
        bf16x8 qf[DQK / 16];
        constexpr int OFF_Q = L::OFF_TAB + TABN * 4, QSTR = DQK * 2 + 16;
        const int qoff = OFF_Q + (32 * wid + r32) * QSTR + hi * 16;
        int tq = tid; asm volatile("" : "+v"(tq));
        if (MODE == 2) {
            const bf16* qsrc = (const bf16*)(ws + R_C_QKV) + (row_b + s0) * 3072 + (2 * h) * 64;
#pragma unroll
            for (int j = 0; j < 4; ++j) { const int c_ = tq + 512 * j, rw = c_ >> 3, p_ = c_ & 7;
                *(LAS u32x4*)(lds + OFF_Q + rw * QSTR + p_ * 16) = *(const u32x4*)(qsrc + (size_t)rw * 3072 + p_ * 8); }
        } else {
#pragma unroll
            for (int ks = 0; ks < DQK / 16; ++ks) qf[ks] = *(const bf16x8*)(Qp + 16 * ks + 8 * hi);
            if (MODE == 1) {
                float x[DQK / 16][8]; float ss = 0.f;
#pragma unroll
                for (int ks = 0; ks < DQK / 16; ++ks) { const u32x4 raw = __builtin_bit_cast(u32x4, qf[ks]);
#pragma unroll
                    for (int j = 0; j < 4; ++j) { x[ks][2 * j] = bflo(raw[j]); x[ks][2 * j + 1] = bfhi(raw[j]); ss += x[ks][2 * j] * x[ks][2 * j] + x[ks][2 * j + 1] * x[ks][2 * j + 1]; } }
                ss += __shfl_xor(ss, 32);
                const float rsq = rsqrtf(ss * (1.0f / 96.0f) + EPS) * (0.10206207261596577f * LOG2E);
                const float* gq_ = a.in[13];
#pragma unroll
                for (int ks = 0; ks < DQK / 16; ++ks) { const f32x4 g0 = *(const f32x4*)(gq_ + 16 * ks + 8 * hi), g1 = *(const f32x4*)(gq_ + 16 * ks + 8 * hi + 4);
#pragma unroll
                    for (int j = 0; j < 4; ++j) { x[ks][j] *= rsq * g0[j]; x[ks][4 + j] *= rsq * g1[j]; } }
                const float* cs = (const float*)(ws + WS_ROPE) + ((size_t)qtok * 16 + 8 * hi) * 2;
#pragma unroll
                for (int j = 0; j < 8; ++j) { const float co = cs[2 * j], si = cs[2 * j + 1], x1 = x[4][j], x2 = x[5][j]; x[4][j] = x1 * co - x2 * si; x[5][j] = x2 * co + x1 * si; }
#pragma unroll
                for (int ks = 0; ks < DQK / 16; ++ks) { u32x4 w;
#pragma unroll
                    for (int j = 0; j < 4; ++j) w[j] = pk2(x[ks][2 * j], x[ks][2 * j + 1]);
                    qf[ks] = __builtin_bit_cast(bf16x8, w); }
            }
        }
        f32x16 o[DV / 32];
#pragma unroll
        for (int c = 0; c < DV / 32; ++c)
#pragma unroll
            for (int r = 0; r < 16; ++r) o[c][r] = 0.f;
        float m = -INFINITY, l = 0.f;
        if (MODE == 3) { m = a.in[28][h] * LOG2E; l = hi == 0 ? 1.f : 0.f; }
        attn_pass<DQK, DV, BIAS, TABN, MODE == 2, KT>(qoff, lds, Kb, kpitch, Vb, vpitch, G, my_tlo, my_thi, wslot_q0, W, qf, m, l, o);
        float lt = l + __shfl_xor(l, 32);
        float inv = 1.0f / lt;
        if (MODE != 2) {
            bf16* Op; int opitch;
            if (MODE == 0) { Op = (bf16*)(ws + R_A_O3) + ((size_t)g * M_ + row_q) * 512 + h * 64; opitch = 512;
                if (hi == 0) ((float*)(ws + R_A_LSE))[((size_t)g * M_ + row_q) * 8 + h] = m + __log2f(lt); }
            else if (MODE == 1) { Op = (bf16*)(ws + R_B_O) + row_q * 1024 + h * 64; opitch = 1024; }
            else { Op = (bf16*)(ws + R_D_O) + row_q * 1024 + h * 64; opitch = 1024; }
            (void)opitch;
#pragma unroll
            for (int c = 0; c < DV / 32; ++c)
#pragma unroll
                for (int k = 0; k < 2; ++k) {
                    u32x2 we, wo; we.x = pk2(o[c][8 * k] * inv, o[c][8 * k + 1] * inv); we.y = pk2(o[c][8 * k + 2] * inv, o[c][8 * k + 3] * inv);
                    wo.x = pk2(o[c][8 * k + 4] * inv, o[c][8 * k + 5] * inv); wo.y = pk2(o[c][8 * k + 6] * inv, o[c][8 * k + 7] * inv);
                    const u32x2 snd = hi ? we : wo, mine = hi ? wo : we;
                    u32x2 rcv; rcv.x = __shfl_xor(snd.x, 32); rcv.y = __shfl_xor(snd.y, 32);
                    u32x4 w; if (hi) { w.x = rcv.x; w.y = rcv.y; w.z = mine.x; w.w = mine.y; } else { w.x = mine.x; w.y = mine.y; w.z = rcv.x; w.w = rcv.y; }
                    *(u32x4*)(Op + 32 * c + 8 * (2 * k + hi)) = w;
                }
        } else {
            f32x16 o1[DV / 32];
#pragma unroll
            for (int c = 0; c < DV / 32; ++c)
#pragma unroll
                for (int r = 0; r < 16; ++r) { o1[c][r] = o[c][r] * inv; o[c][r] = 0.f; }
#pragma unroll
            for (int j = 0; j < 4; ++j) tab[128 + tid + 512 * j] = biasd[(8 + h) * 2048 + tid + 512 * j];
            { const bf16* qsrc = (const bf16*)(ws + R_C_QKV) + (row_b + s0) * 3072 + (2 * h + 1) * 64;
#pragma unroll
              for (int j = 0; j < 4; ++j) { const int c_ = tq + 512 * j, rw = c_ >> 3, p_ = c_ & 7;
                  *(LAS u32x4*)(lds + OFF_Q + rw * QSTR + p_ * 16) = *(const u32x4*)(qsrc + (size_t)rw * 3072 + p_ * 8); } }
            m = -INFINITY; l = 0.f;
            attn_pass<DQK, DV, BIAS, TABN, MODE == 2, KT>(qoff, lds, Kb + 64, kpitch, Vb, vpitch, G, my_tlo, my_thi, wslot_q0, W, qf, m, l, o);
            lt = l + __shfl_xor(l, 32);
            inv = lam / lt;
            float ssum = 0.f;
#pragma unroll
            for (int c = 0; c < DV / 32; ++c)
#pragma unroll
                for (int r = 0; r < 16; ++r) { const float d = o1[c][r] - o[c][r] * inv; o1[c][r] = d; ssum += d * d; }
            ssum += __shfl_xor(ssum, 32);
            const float rs = rsqrtf(ssum * (1.0f / 128.0f) + EPS) * (1.0f - lam_init);
            bf16* Op = (bf16*)(ws + R_C_O) + row_q * 1024 + h * 128;
            const float* sub = a.in[23];
#pragma unroll
            for (int c = 0; c < DV / 32; ++c)
#pragma unroll
                for (int k = 0; k < 2; ++k) {
                    const f32x4 se = *(const f32x4*)(sub + 32 * c + 16 * k + 4 * hi), so = *(const f32x4*)(sub + 32 * c + 16 * k + 8 + 4 * hi);
                    u32x2 we, wo; we.x = pk2(o1[c][8 * k] * rs * se[0], o1[c][8 * k + 1] * rs * se[1]); we.y = pk2(o1[c][8 * k + 2] * rs * se[2], o1[c][8 * k + 3] * rs * se[3]);
                    wo.x = pk2(o1[c][8 * k + 4] * rs * so[0], o1[c][8 * k + 5] * rs * so[1]); wo.y = pk2(o1[c][8 * k + 6] * rs * so[2], o1[c][8 * k + 7] * rs * so[3]);
                    const u32x2 snd = hi ? we : wo, mine = hi ? wo : we;
                    u32x2 rcv; rcv.x = __shfl_xor(snd.x, 32); rcv.y = __shfl_xor(snd.y, 32);
                    u32x4 w; if (hi) { w.x = rcv.x; w.y = rcv.y; w.z = mine.x; w.w = mine.y; } else { w.x = mine.x; w.y = mine.y; w.z = rcv.x; w.w = rcv.y; }
                    *(u32x4*)(Op + 32 * c + 8 * (2 * k + hi)) = w;
                }
        }
    }
}

__device__ __forceinline__ void transpose_item(const float* W, int ldw, int ncol0, int K, const float* ksc, bf16* WT, int mode, LAS float* scr, int nblk, int item, int lane) {
    const int kb = item / nblk, nb = item - kb * nblk, k0 = 64 * kb, n0 = 32 * nb;
#pragma unroll
    for (int i = 0; i < 32; ++i) { const int kk = 2 * i + (lane >> 5); float v = W[(size_t)(k0 + kk) * ldw + ncol0 + n0 + (lane & 31)]; if (ksc != nullptr) v *= ksc[k0 + kk]; scr[kk * 33 + (lane & 31)] = v; }
    asm volatile("s_waitcnt lgkmcnt(0)" ::: "memory");
    const int drow0 = mode == 1 ? (256 * (n0 >> 8) + 128 * ((n0 & 63) >> 5) + 32 * ((n0 >> 6) & 3)) : mode == 2 ? (n0 < DFF ? 256 * (n0 >> 7) + (n0 & 127) : 256 * ((n0 - DFF) >> 7) + 128 + ((n0 - DFF) & 127)) : n0;
    const int c = lane & 7;
#pragma unroll
    for (int j = 0; j < 4; ++j) { const int n = (lane >> 3) + 8 * j; const LAS float* s = scr + (8 * c) * 33 + n;
        u32x4 o; o.x = pk2(s[0 * 33], s[1 * 33]); o.y = pk2(s[2 * 33], s[3 * 33]); o.z = pk2(s[4 * 33], s[5 * 33]); o.w = pk2(s[6 * 33], s[7 * 33]);
        *(u32x4*)(WT + (size_t)(drow0 + n) * K + k0 + 8 * c) = o; }
    asm volatile("s_waitcnt lgkmcnt(0)" ::: "memory");
}
__device__ __forceinline__ void prologue(LAS unsigned char* lds, const Args& a, int Gn, int cid) {
    int tid = threadIdx.x; asm volatile("" : "+v"(tid)); const int lane = tid & 63, wid = __builtin_amdgcn_readfirstlane(tid >> 6);
    unsigned char* ws = a.ws;
    LAS float* scr = (LAS float*)(lds + wid * 16384);
    const int gw = cid * 8 + wid, NGW = Gn * 8;
#define MAT_DESC(id) \
        const float* W; int ldw, ncol0 = 0, K, N, mode; const float* ksc = nullptr; size_t dst; \
        if (id == 0) { W = a.in[4]; ldw = 4608; K = 1024; N = 4608; ksc = a.in[2]; dst = W_AIN; mode = 1; } \
        else if (id == 1) { W = a.in[7]; ldw = 1024; K = 512; N = 1024; dst = W_AOUT; mode = 0; } \
        else if (id == 2) { W = a.in[8]; ldw = 672; K = 1024; N = 672; ksc = a.in[2] + 1024; dst = W_BIN; mode = 1; } \
        else if (id == 3) { W = a.in[11]; ldw = 1536; K = 384; N = 1536; ksc = a.in[9]; dst = W_BQUP; mode = 1; } \
        else if (id == 4) { W = a.in[12]; ldw = 2048; K = 256; N = 2048; ksc = a.in[10]; dst = W_BKVUP; mode = 1; } \
        else if (id == 5) { W = a.in[15]; ldw = 1024; K = 1024; N = 1024; dst = W_BOUT; mode = 0; } \
        else if (id == 6) { W = a.in[16]; ldw = 3072; K = 1024; N = 3072; ksc = a.in[2] + 2048; dst = W_CIN; mode = 1; } \
        else if (id == 7) { W = a.in[24]; ldw = 1024; K = 1024; N = 1024; dst = W_COUT; mode = 0; } \
        else if (id == 8) { W = a.in[25]; ldw = 1280; K = 1024; N = 1280; ksc = a.in[2] + 3072; dst = W_DIN; mode = 1; } \
        else if (id == 9) { W = a.in[29]; ldw = 1024; K = 1024; N = 1024; dst = W_DOUT; mode = 0; } \
        else { const int l = (id - 10) / 3, k3 = (id - 10) - 3 * l; \
            if (k3 < 2) { W = a.in[30] + (size_t)l * 1024 * 5632; ldw = 5632; K = 1024; N = 5632; ksc = a.in[3] + 1024 * l; dst = W_FG + l * 2 * W_FSTR; mode = 2; } \
            else { W = a.in[33] + (size_t)l * 2816 * 1024; ldw = 1024; K = 2816; N = 1024; dst = W_FD + l * W_FSTR; mode = 0; } }
    constexpr int TOTAL_ITEMS = 2304 + 256 + 336 + 288 + 256 + 512 + 1536 + 512 + 640 + 512 + 4 * (1408 + 1408 + 1408);
    for (int it = gw; it < TOTAL_ITEMS; it += NGW) {
        int r = it, id = 0;
        for (; id < 21; ++id) {
            int n_;
            if (id < 10) { n_ = id == 0 ? 2304 : id == 1 ? 256 : id == 2 ? 336 : id == 3 ? 288 : id == 4 ? 256 : id == 5 ? 512 : id == 6 ? 1536 : id == 7 ? 512 : id == 8 ? 640 : 512; } else { const int k3_ = (id - 10) % 3; n_ = k3_ == 0 ? 2816 : (k3_ == 1 ? 0 : 1408); }
            if (r < n_) break;
            r -= n_;
        }
        MAT_DESC(id)
        const int nblk = N / 32;
        transpose_item(W, ldw, ncol0, K, ksc, (bf16*)(ws + dst), mode, scr, nblk, r, lane);
    }
#undef MAT_DESC
    const int gt = cid * 512 + tid, NT = Gn * 512;
    { float* biasd = (float*)(ws + WS_BIAS); const float* table = a.in[1];
      for (int i = gt; i < 16 * 2048; i += NT) { const int h = i >> 11, d = i & 2047; int bk = d;
          if (d >= 16) { float t = logf((float)d / 16.0f); t = t / 4.852030263919617f; t = t * 16.0f; int lg = 16 + (int)t; bk = lg < 31 ? lg : 31; }
          biasd[i] = table[bk * 16 + h] * LOG2E; } }
    { float* rope = (float*)(ws + WS_ROPE);
      for (int i = gt; i < 2048 * 16; i += NT) { const int pos = i >> 4, f = i & 15; const float inv = powf(10000.0f, -(float)(2 * f) / 32.0f); const float ang = (float)pos * inv;
          rope[2 * i] = cosf(ang); rope[2 * i + 1] = sinf(ang); } }
    { const float* x = a.in[0]; bf16* xb = (bf16*)(ws + WS_XB); float* rss = (float*)(ws + WS_RSS);
      for (int m0 = gw; m0 < M_; m0 += 4 * NGW) {
          f32x4 v[4][4];
#pragma unroll
          for (int k = 0; k < 4; ++k) { const int m = m0 + k * NGW; if (m < M_) { const f32x4* xr = (const f32x4*)(x + (size_t)m * DMODEL) + lane;
#pragma unroll
              for (int j = 0; j < 4; ++j) v[k][j] = xr[64 * j]; } }
#pragma unroll
          for (int k = 0; k < 4; ++k) { const int m = m0 + k * NGW; if (m < M_) { u32x2* o8 = (u32x2*)(xb + (size_t)m * DMODEL) + lane; float s = 0.f;
#pragma unroll
              for (int j = 0; j < 4; ++j) { s += dot4(v[k][j]); u32x2 w; w.x = pk2(v[k][j][0], v[k][j][1]); w.y = pk2(v[k][j][2], v[k][j][3]); o8[64 * j] = w; }
              s = wave_sum(s); if (lane == 0) rss[m] = rsqrtf(s * (1.0f / 1024.0f) + EPS); } } } }
}
__device__ __forceinline__ void combine_a(const Args& a, int Gn, int cid) {
    unsigned char* ws = a.ws;
    const bf16* o3 = (const bf16*)(ws + R_A_O3); const float* lse = (const float*)(ws + R_A_LSE); bf16* oc = (bf16*)(ws + R_A_OC);
    const size_t NT = (size_t)Gn * 512; int tid = threadIdx.x; asm volatile("" : "+v"(tid));
    for (size_t idx0 = (size_t)cid * 512 + tid; idx0 < (size_t)M_ * 64; idx0 += 4 * NT) {
        u32x4 a0[4], a1[4], a2[4]; float l0[4], l1[4], l2[4];
#pragma unroll
        for (int k = 0; k < 4; ++k) { const size_t idx = idx0 + k * NT; if (idx < (size_t)M_ * 64) {
            const size_t row = idx >> 6; const int ch = (int)(idx & 63), h = ch >> 3;
            l0[k] = lse[row * 8 + h]; l1[k] = lse[((size_t)M_ + row) * 8 + h]; l2[k] = lse[((size_t)2 * M_ + row) * 8 + h];
            a0[k] = *(const u32x4*)(o3 + row * 512 + ch * 8); a1[k] = *(const u32x4*)(o3 + ((size_t)M_ + row) * 512 + ch * 8); a2[k] = *(const u32x4*)(o3 + ((size_t)2 * M_ + row) * 512 + ch * 8); } }
#pragma unroll
        for (int k = 0; k < 4; ++k) { const size_t idx = idx0 + k * NT; if (idx < (size_t)M_ * 64) {
            const size_t row = idx >> 6; const int ch = (int)(idx & 63);
            const float mx = fmaxf(l0[k], fmaxf(l1[k], l2[k]));
            float w0 = __builtin_amdgcn_exp2f(l0[k] - mx), w1 = __builtin_amdgcn_exp2f(l1[k] - mx), w2 = __builtin_amdgcn_exp2f(l2[k] - mx);
            const float inv = 1.0f / (w0 + w1 + w2); w0 *= inv; w1 *= inv; w2 *= inv;
            u32x4 r;
#pragma unroll
            for (int j = 0; j < 4; ++j) r[j] = pk2(w0 * bflo(a0[k][j]) + w1 * bflo(a1[k][j]) + w2 * bflo(a2[k][j]), w0 * bfhi(a0[k][j]) + w1 * bfhi(a1[k][j]) + w2 * bfhi(a2[k][j]));
            *(u32x4*)(oc + row * 512 + ch * 8) = r; } }
    }
}
__device__ __forceinline__ void prep_b(const Args& a, int Gn, int cid) {
    unsigned char* ws = a.ws;
    int tid = threadIdx.x; asm volatile("" : "+v"(tid)); const int lane = tid & 63, wid = __builtin_amdgcn_readfirstlane(tid >> 6);
    bf16* Q = (bf16*)(ws + R_B_Q); const bf16* KV = (const bf16*)(ws + R_B_KV); const bf16* KPE = (const bf16*)(ws + R_B_KPE); bf16* KH = (bf16*)(ws + R_B_KH);
    const float* rope = (const float*)(ws + WS_ROPE);
    const int sub = lane >> 4, c = lane & 15;
    const float qscale = 0.10206207261596577f * LOG2E;
    const int gw = cid * 8 + wid, NGW = Gn * 8;
    const int TOT = 2 * M_ * 4;
    for (int it0 = M_ * 4 + gw; it0 < TOT; it0 += 4 * NGW) {
        u32x4 raw[4];
#pragma unroll
        for (int k = 0; k < 4; ++k) {
            const int it = it0 + k * NGW;
            raw[k] = (u32x4){0u, 0u, 0u, 0u};
            if (it < TOT && c < 12) {
                const bool isk = it >= M_ * 4; const int it2 = isk ? it - M_ * 4 : it;
                const int task = it2 * 4 + sub; const size_t row = (size_t)(task >> 4); const int h = task & 15;
                if (!isk) raw[k] = *(const u32x4*)(Q + row * 1536 + h * 96 + 8 * c);
                else if (c < 8) raw[k] = *(const u32x4*)(KV + row * 2048 + h * 128 + 8 * c);
                else raw[k] = *(const u32x4*)(KPE + row * 64 + 8 * (c - 8));
            }
        }
#pragma unroll
        for (int k = 0; k < 4; ++k) {
            const int it = it0 + k * NGW;
            if (it < TOT) {
                const bool isk = it >= M_ * 4; const int it2 = isk ? it - M_ * 4 : it;
                const int task = it2 * 4 + sub; const size_t row = (size_t)(task >> 4); const int h = task & 15; const int pos = (int)(row & 2047);
                float x[8];
#pragma unroll
                for (int j = 0; j < 4; ++j) { x[2 * j] = bflo(raw[k][j]); x[2 * j + 1] = bfhi(raw[k][j]); }
                float ss = 0.f;
#pragma unroll
                for (int e = 0; e < 8; ++e) ss += x[e] * x[e];
                ss += __shfl_xor(ss, 1); ss += __shfl_xor(ss, 2); ss += __shfl_xor(ss, 4); ss += __shfl_xor(ss, 8);
                const float rs = rsqrtf(ss * (1.0f / 96.0f) + EPS);
                const float* gain = (isk ? a.in[14] : a.in[13]) + 8 * (c < 12 ? c : 0);
                const float* cs = rope + ((size_t)pos * 16 + (c & 1) * 8) * 2;
                float y[8];
#pragma unroll
                for (int e = 0; e < 8; ++e) y[e] = x[e] * rs * gain[e];
#pragma unroll
                for (int e = 0; e < 8; ++e) {
                    const float z = __shfl_xor(y[e], 2);
                    if (c >= 8 && c < 12) { const float co = cs[2 * e], si = cs[2 * e + 1]; y[e] = (c < 10) ? (y[e] * co - z * si) : (y[e] * co + z * si); }
                }
                if (c < 12) {
                    u32x4 w;
                    if (!isk) {
#pragma unroll
                        for (int j = 0; j < 4; ++j) w[j] = pk2(y[2 * j] * qscale, y[2 * j + 1] * qscale);
                        *(u32x4*)(Q + row * 1536 + h * 96 + 8 * c) = w;
                    } else {
#pragma unroll
                        for (int j = 0; j < 4; ++j) w[j] = pk2(y[2 * j], y[2 * j + 1]);
                        *(u32x4*)(KH + row * 1536 + h * 96 + 8 * c) = w;
                    }
                }
            }
        }
    }
}

__device__ __forceinline__ void fixup_ffn(const bf16* gedge, const bf16* uedge, bf16* act, const float* cw, const float* cb, int Gn, int cid) {
    int tid = threadIdx.x; asm volatile("" : "+v"(tid));
    const int TOT = 1024 * 2 * 352;
    for (int idx = cid * 512 + tid; idx < TOT; idx += Gn * 512) {
        const int ch = idx % 352, sj = idx / 352, j = sj & 1, st = sj >> 1, c0 = ch * 8;
        const int row = st * 64 + j, t = row & (SEQ - 1);
        const u32x4 z = (u32x4){0u, 0u, 0u, 0u};
        const u32x4 g0 = *(const u32x4*)(gedge + ((size_t)st * 4 + j) * DFF + c0);
        u32x4 g1, g2;
        if (j == 0) { g1 = t >= 1 ? *(const u32x4*)(gedge + ((size_t)(st - 1) * 4 + 3) * DFF + c0) : z; g2 = t >= 2 ? *(const u32x4*)(gedge + ((size_t)(st - 1) * 4 + 2) * DFF + c0) : z; }
        else { g1 = *(const u32x4*)(gedge + ((size_t)st * 4 + 0) * DFF + c0); g2 = t >= 2 ? *(const u32x4*)(gedge + ((size_t)(st - 1) * 4 + 3) * DFF + c0) : z; }
        const u32x4 uw = *(const u32x4*)(uedge + ((size_t)st * 2 + j) * DFF + c0);
        u32x4 w;
#pragma unroll
        for (int n = 0; n < 2; ++n) {
            const f32x4 w0 = *(const f32x4*)(cw + c0 + 4 * n), w1 = *(const f32x4*)(cw + DFF + c0 + 4 * n), w2 = *(const f32x4*)(cw + 2 * DFF + c0 + 4 * n), b = *(const f32x4*)(cb + c0 + 4 * n);
            float r[4];
#pragma unroll
            for (int e = 0; e < 4; ++e) {
                const unsigned q0 = g0[2 * n + (e >> 1)], q1 = g1[2 * n + (e >> 1)], q2 = g2[2 * n + (e >> 1)], qu = uw[2 * n + (e >> 1)];
                const float x0 = (e & 1) ? bfhi(q0) : bflo(q0), x1 = (e & 1) ? bfhi(q1) : bflo(q1), x2 = (e & 1) ? bfhi(q2) : bflo(q2), up = (e & 1) ? bfhi(qu) : bflo(qu);
                const float cv = b[e] + w2[e] * x0 + w1[e] * x1 + w0[e] * x2;
                r[e] = cv * __builtin_amdgcn_rcpf(1.0f + __builtin_amdgcn_exp2f(-LOG2E * cv)) * up;
            }
            w[2 * n] = pk2(r[0], r[1]); w[2 * n + 1] = pk2(r[2], r[3]);
        }
        *(u32x4*)(act + (size_t)row * DFF + c0) = w;
    }
}
__device__ __forceinline__ void rstd_pass(const float* ssp, int nvec, float invdim, float* rs, int Gn, int cid) {
    int tid = threadIdx.x; asm volatile("" : "+v"(tid));
    for (int row = cid * 512 + tid; row < M_; row += Gn * 512) rs[row] = rsqrtf(rowss_sum(ssp, nvec, row) * invdim + EPS);
}
__device__ __forceinline__ void kpe_pass(const Args& a, int Gn, int cid) {
    unsigned char* ws = a.ws;
    int tid = threadIdx.x; asm volatile("" : "+v"(tid));
    const bf16* KPE = (const bf16*)(ws + R_B_KPE); bf16* RK = (bf16*)(ws + R_B_RK); float* sspe = (float*)(ws + WS_SSPE);
    const float* rope = (const float*)(ws + WS_ROPE); const float* gk = a.in[14] + 64;
    for (int row = cid * 512 + tid; row < M_; row += Gn * 512) {
        float x[32]; float ss = 0.f;
#pragma unroll
        for (int c = 0; c < 4; ++c) { const u32x4 raw = *(const u32x4*)(KPE + (size_t)row * 64 + 8 * c);
#pragma unroll
            for (int j = 0; j < 4; ++j) { x[8 * c + 2 * j] = bflo(raw[j]); x[8 * c + 2 * j + 1] = bfhi(raw[j]); } }
#pragma unroll
        for (int i = 0; i < 32; ++i) { ss += x[i] * x[i]; x[i] *= gk[i]; }
        sspe[row] = ss;
        const float* cs = rope + (size_t)(row & (SEQ - 1)) * 32;
#pragma unroll
        for (int i = 0; i < 16; ++i) { const float co = cs[2 * i], si = cs[2 * i + 1], x1 = x[i], x2 = x[16 + i]; x[i] = x1 * co - x2 * si; x[16 + i] = x2 * co + x1 * si; }
#pragma unroll
        for (int c = 0; c < 4; ++c) { u32x4 w;
#pragma unroll
            for (int j = 0; j < 4; ++j) w[j] = pk2(x[8 * c + 2 * j], x[8 * c + 2 * j + 1]);
            *(u32x4*)(RK + (size_t)row * 32 + 8 * c) = w; }
    }
}
__device__ __forceinline__ void rstd_local(const float* ssp, float* rs, const pg8::StaticOrder& S, int nunits) {
    int tid = threadIdx.x; asm volatile("" : "+v"(tid));
    const int TOT = nunits * 256;
    for (int k0 = tid; k0 < TOT; k0 += 2 * 512) {
        float p[2][16]; int rows[2];
#pragma unroll
        for (int j = 0; j < 2; ++j) { const int k = k0 + j * 512; rows[j] = -1;
            if (k < TOT) { pg8::Unit uu; S.next(k >> 8, uu); rows[j] = uu.pm * 256 + (k & 255);
#pragma unroll
                for (int v = 0; v < 16; ++v) p[j][v] = ssp[(size_t)v * M_ + rows[j]]; } }
#pragma unroll
        for (int j = 0; j < 2; ++j) if (rows[j] >= 0) { float t = 0.f;
#pragma unroll
            for (int v = 0; v < 16; v += 4) t += (p[j][v] + p[j][v + 1]) + (p[j][v + 2] + p[j][v + 3]);
            rs[rows[j]] = rsqrtf(t * (1.0f / 1024.0f) + EPS); }
    }
    asm volatile("s_waitcnt vmcnt(0)" ::: "memory");
    __syncthreads();
}
__device__ __forceinline__ void grid_barrier(unsigned* cnt, unsigned& epoch, unsigned G) {
    asm volatile("s_waitcnt vmcnt(0) lgkmcnt(0)" ::: "memory");
    __syncthreads();
    epoch += 1u;
    if (threadIdx.x == 0) {
        __builtin_amdgcn_fence(__ATOMIC_RELEASE, "agent");
        asm volatile("s_waitcnt vmcnt(0)" ::: "memory");
        __hip_atomic_fetch_add(cnt + 64u * (blockIdx.x & 7u), 1u, __ATOMIC_RELAXED, __HIP_MEMORY_SCOPE_AGENT);
        const unsigned want = epoch * G;
        for (;;) {
            unsigned sum = 0u;
#pragma unroll
            for (unsigned j = 0; j < 8u; ++j) sum += __hip_atomic_load(cnt + 64u * j, __ATOMIC_RELAXED, __HIP_MEMORY_SCOPE_AGENT);
            if (sum >= want) break;
            __builtin_amdgcn_s_sleep(2);
        }
        __builtin_amdgcn_fence(__ATOMIC_ACQUIRE, "agent");
        asm volatile("s_waitcnt vmcnt(0)" ::: "memory");
    }
    __syncthreads();
}
__global__ void __launch_bounds__(512) fwd_kernel(Args a) {
    extern __shared__ __attribute__((aligned(16))) unsigned char lds_raw[];
    LAS unsigned char* lds = (LAS unsigned char*)lds_raw;
    cg::grid_group grid = cg::this_grid();
    const int Gn = (int)gridDim.x, cid = (int)blockIdx.x;
    unsigned char* ws = a.ws;
    unsigned* barcnt = (unsigned*)(ws + WS_BAR); unsigned epoch = 0u;
    prologue(lds, a, Gn, cid);
    grid.sync();
    grid_barrier(barcnt, epoch, (unsigned)Gn);
    bf16* XB = (bf16*)(ws + WS_XB);
    float* RSS = (float*)(ws + WS_RSSP); float* RSTD = (float*)(ws + WS_RSS);
    for (int ph = 0; ph < 28; ++ph) {
        int type = 0, N = 1024, K = 1024, ldc = 0, hm = 0, layer = 0, sidx = 0, nvec = 4, pbuf = -1;
        const bf16 *A = XB, *Bt = nullptr; bf16* pO = nullptr; const float* pss = RSTD; const float *gq = nullptr, *gk = nullptr; float qs = 0.125f * LOG2E;
        const float* rbase = nullptr; float* rout = nullptr; bf16* rxb = XB; float* rssn = nullptr;
        int f = -1;
        switch (ph) {
        case 0: type = 0; Bt = (const bf16*)(ws + W_AIN); N = 4608; pO = (bf16*)(ws + R_A_QKV); ldc = 4608; hm = 1; gq = a.in[5]; gk = a.in[6]; break;
        case 1: type = 4; break;
        case 2: type = 8; break;
        case 3: type = 1; A = (const bf16*)(ws + R_A_OC); Bt = (const bf16*)(ws + W_AOUT); K = 512; rbase = a.in[0]; rssn = RSS + 1 * (size_t)M_ * 16; break;
        case 4: case 5: case 6: layer = 0; sidx = 1; f = ph - 4; break;
        case 7: type = 2; Bt = (const bf16*)(ws + W_BIN); N = 768; pbuf = 0; break;
        case 8: type = 0; A = (const bf16*)(ws + R_B_CQ); Bt = (const bf16*)(ws + W_BQUP); N = 1536; K = 384; pO = (bf16*)(ws + R_B_Q); ldc = 1536; pss = (const float*)(ws + WS_SSQ); break;
        case 9: type = 10; break;
        case 10: type = 10; break;
        case 11: type = 5; break;
        case 12: type = 1; A = (const bf16*)(ws + R_B_O); Bt = (const bf16*)(ws + W_BOUT); rssn = RSS + 1 * (size_t)M_ * 16; break;
        case 13: case 14: case 15: layer = 1; sidx = 3; f = ph - 13; break;
        case 16: type = 0; Bt = (const bf16*)(ws + W_CIN); N = 3072; pO = (bf16*)(ws + R_C_QKV); ldc = 3072; pbuf = 0; hm = 2; gq = a.in[17]; gk = a.in[18]; break;
        case 17: type = 6; break;
        case 18: type = 1; A = (const bf16*)(ws + R_C_O); Bt = (const bf16*)(ws + W_COUT); rssn = RSS + 1 * (size_t)M_ * 16; break;
        case 19: case 20: case 21: layer = 2; sidx = 5; f = ph - 19; break;
        case 22: type = 0; Bt = (const bf16*)(ws + W_DIN); N = 1280; pO = (bf16*)(ws + R_D_QKV); ldc = 1280; pbuf = 0; hm = 3; gq = a.in[26]; gk = a.in[27]; break;
        case 23: type = 7; break;
        case 24: type = 1; A = (const bf16*)(ws + R_D_O); Bt = (const bf16*)(ws + W_DOUT); rssn = RSS + 1 * (size_t)M_ * 16; break;
        default: layer = 3; sidx = 7; f = ph - 25; break;
        }
        if (f == 0) { type = 3; Bt = (const bf16*)(ws + W_FG + layer * 2 * W_FSTR); N = 2 * DFF; pbuf = 1; }
        else if (f == 1) { type = 11; }
        else if (f == 2) { type = 1; A = (const bf16*)(ws + R_ACT); Bt = (const bf16*)(ws + W_FD + layer * W_FSTR); K = DFF;
            if (layer < 3) { rssn = RSS + ((sidx + 1) & 1) * (size_t)M_ * 16; } else { rssn = nullptr; rxb = nullptr; rout = a.out; } }

        if (type == 10) continue;
        if (type <= 3) {
            pg8::Gemm g{A, Bt, M_, N, K}; pg8::StaticOrder S; S.init(M_, N, Gn, cid);
            if (pbuf >= 0) rstd_local(RSS + (size_t)pbuf * M_ * 16, RSTD, S, (S.nwg - cid + Gn - 1) / Gn);
            if (type == 0) {
                for (int sub = 0; sub < (ph == 8 ? 2 : 1); ++sub) {
                    const bool kv = (sub == 1);
                    const pg8::Gemm g2{kv ? (const bf16*)(ws + R_B_CKV) : A, kv ? (const bf16*)(ws + W_BKVUP) : Bt, M_, kv ? 2048 : N, kv ? 256 : K};
                    pg8::StaticOrder S2; S2.init(M_, kv ? 2048 : N, Gn, cid);
                    const EpiProj E{kv ? (bf16*)(ws + R_B_KV) : pO, kv ? 2048 : ldc, kv ? (const float*)(ws + WS_SSKV) : pss, kv ? 4 : hm, gq, kv ? a.in[14] : gk, qs};
                    pg8::gemm_phase<EpiProj, pg8::StaticOrder, true, true>(lds, g2, S2, E);
                }
            }
            else if (type == 1) { EpiRes E{rbase, rout, XB, rxb, rssn}; pg8::gemm_phase<EpiRes, pg8::StaticOrder, true, true>(lds, g, S, E); }
            else if (type == 2) { EpiLat E{(bf16*)(ws + R_B_CQ), (bf16*)(ws + R_B_CKV), (bf16*)(ws + R_B_KPE), pss, (float*)(ws + WS_SSQP), (float*)(ws + WS_SSKVP)}; pg8::gemm_phase<EpiLat, pg8::StaticOrder, true, true>(lds, g, S, E); }
            else { EpiGateUp E{(bf16*)(ws + R_ACT), (bf16*)(ws + R_GATE), (bf16*)(ws + R_GATE + 32 * MiB), pss, a.in[31] + (size_t)layer * 3 * DFF, a.in[32] + (size_t)layer * DFF}; pg8::gemm_phase<EpiGateUp, pg8::StaticOrder, true, true>(lds, g, S, E); }
        }
        else if (type == 4) attn_phase<0>(lds, a, Gn, cid);
        else if (type == 5) attn_phase<1>(lds, a, Gn, cid);
        else if (type == 6) attn_phase<2>(lds, a, Gn, cid);
        else if (type == 7) attn_phase<3>(lds, a, Gn, cid);
        else if (type == 8) combine_a(a, Gn, cid);
        else if (type == 11) fixup_ffn((const bf16*)(ws + R_GATE), (const bf16*)(ws + R_GATE + 32 * MiB), (bf16*)(ws + R_ACT), a.in[31] + (size_t)layer * 3 * DFF, a.in[32] + (size_t)layer * DFF, Gn, cid);
        else prep_b(a, Gn, cid);
        grid_barrier(barcnt, epoch, (unsigned)Gn);
        if (type == 2) { rstd_pass((const float*)(ws + WS_SSQP), 2, 1.0f / 384.0f, (float*)(ws + WS_SSQ), Gn, cid); rstd_pass((const float*)(ws + WS_SSKVP), 1, 1.0f / 256.0f, (float*)(ws + WS_SSKV), Gn, cid); kpe_pass(a, Gn, cid);
            grid_barrier(barcnt, epoch, (unsigned)Gn); }
    }
}

extern "C" void kernel_launch(void* const* d_in, const int* in_sizes, int n_in, void* d_out, int out_size, void* d_ws, size_t ws_size, hipStream_t stream) {
    static int grid = 0;
    if (grid == 0) {
        if (n_in != 34 || out_size != M_ * DMODEL || ws_size < WS_NEED) { fprintf(stderr, "kernel_launch: unexpected shapes (n_in %d out %d ws %zu)\n", n_in, out_size, ws_size); grid = -1; return; }
        int dev = 0, cus = 0, per_cu = 0;
        if (hipGetDevice(&dev) != hipSuccess || hipDeviceGetAttribute(&cus, hipDeviceAttributeMultiprocessorCount, dev) != hipSuccess) { grid = -1; return; }
        if (hipFuncSetAttribute((const void*)fwd_kernel, hipFuncAttributeMaxDynamicSharedMemorySize, LDS_BYTES) != hipSuccess) { fprintf(stderr, "kernel_launch: hipFuncSetAttribute failed\n"); grid = -1; return; }
        if (hipOccupancyMaxActiveBlocksPerMultiprocessor(&per_cu, (const void*)fwd_kernel, 512, LDS_BYTES) != hipSuccess || per_cu < 1) { fprintf(stderr, "kernel_launch: occupancy query says %d\n", per_cu); per_cu = 1; }
        (void)hipGetLastError();
        grid = cus;
    }
    if (grid < 0) return;
    if (hipMemsetAsync((unsigned char*)d_ws + WS_BAR, 0, 2048, stream) != hipSuccess) { fprintf(stderr, "kernel_launch: memset failed\n"); return; }
    Args a{};
    for (int i = 0; i < 34; ++i) a.in[i] = (const float*)d_in[i];
    a.out = (float*)d_out; a.ws = (unsigned char*)d_ws;
    void* args[] = {&a};
    hipError_t e = hipLaunchCooperativeKernel((const void*)fwd_kernel, dim3(grid), dim3(512), args, LDS_BYTES, stream);
    if (e != hipSuccess) fprintf(stderr, "cooperative launch failed: %s (grid %d)\n", hipGetErrorString(e), grid);
}
```

```cpp
#include <hip/hip_runtime.h>
#include <hip/hip_cooperative_groups.h>
#include <cstdio>
#include <cstdint>
namespace cg = cooperative_groups;
namespace pg8 {
#define PG8_LAS __attribute__((address_space(3)))
typedef unsigned short bf16_t;
typedef short bf16x8 __attribute__((ext_vector_type(8)));
typedef float f32x4 __attribute__((ext_vector_type(4)));
typedef unsigned u32x4 __attribute__((ext_vector_type(4)));
constexpr int BM = 256, BK = 64, HALF = 128, HTB = HALF * BK * 2  , STAGE_BYTES = 8 * HTB, NXCD = 8, WGM = 8;

__host__ __device__ __forceinline__ int lds_byte(int r, int c) { const int st = (r >> 4) * 2 + (c >> 5), rr = r & 15, cc = c & 31, ob = rr * 64 + cc * 2; return st * 1024 + (ob ^ (((ob >> 9) & 1) << 5)); }
__host__ __device__ __forceinline__ void stage_rc(int b, int& R, int& C) { const int st = b / 1024, sb = b % 1024, swz = sb ^ (((sb >> 9) & 1) << 5); R = (st >> 1) * 16 + swz / 64; C = (st & 1) * 32 + (swz % 64) / 2; }
__host__ __device__ __forceinline__ int perm32(int rho) { const int n = rho >> 4, i = rho & 15; return 8 * (i >> 2) + 4 * n + (i & 3); }

struct Unit { int pm, pn; };
struct Gemm { const bf16_t* A; const bf16_t* Bt; int M, N, K; };

struct StaticOrder {
    int nM, nN, nwg, G, c;
    __host__ __device__ void init(int M, int N, int G_, int c_) { nM = M / BM; nN = N / BM; nwg = nM * nN; G = G_; c = c_; }
    __host__ __device__ bool next(int i, Unit& u) const {
        const long L = (long)i * G + c; if (L >= nwg) return false;
        int wgid = (int)L; { const int q = nwg / NXCD, r = nwg % NXCD, xcd = wgid % NXCD, off = wgid / NXCD; wgid = (xcd < r ? xcd * (q + 1) : r * (q + 1) + (xcd - r) * q) + off; }
        const int nig = WGM * nN, gid = wgid / nig, fm = gid * WGM, gsz = (nM - fm) < WGM ? (nM - fm) : WGM;
        u.pm = fm + ((wgid % nig) % gsz); u.pn = (wgid % nig) / gsz; return true;
    }
    __device__ __forceinline__ void a_ready(const Unit&) const {}
    __device__ __forceinline__ void done(const Unit&) const {}
};

__device__ __forceinline__ unsigned cvt_pk_bf16(float lo, float hi) { unsigned r; asm volatile("v_cvt_pk_bf16_f32 %0, %1, %2" : "=v"(r) : "v"(lo), "v"(hi)); return r; }
template <class Epi, class Sched, bool ALIGN_EPI = false, bool SP2 = false>
__device__ __forceinline__ void gemm_phase(PG8_LAS unsigned char* lds, const Gemm g, const Sched& S, const Epi& E) {
    int tid = threadIdx.x; asm volatile("" : "+v"(tid)); const int wid = __builtin_amdgcn_readfirstlane(tid >> 6), lane = tid & 63, wr = wid >> 2, wc = wid & 3, fr = lane & 15, fq = lane >> 4;
    const int K = g.K, nt = K / BK;
    unsigned voffA[2], voffB[2];
#pragma unroll
    for (int i = 0; i < 2; ++i) { int R, C; stage_rc(tid * 16 + i * 8192, R, C); const int Rb = Epi::PERM ? ((R & ~31) + perm32(R & 31)) : R;
        voffA[i] = (unsigned)(R * K + C) * 2u; voffB[i] = (unsigned)(Rb * K + C) * 2u; }
    const size_t kstep = (size_t)(BK * 2);
    const size_t hstep = (size_t)HALF * K * 2;
    const size_t tstep = 2 * hstep;
    const unsigned ldsw = (unsigned)wid * 1024u;
    const int aoff = lds_byte(wr * 64 + fr, fq * 8), boff = lds_byte(wc * 32 + fr, fq * 8);
#define PG8_SA(b, h) (((b) * 2 + (h)) * HTB)
#define PG8_SB(b, h) ((4 + (b) * 2 + (h)) * HTB)
#define PG8_STAGE(bufoff, gbase, voff) do { _Pragma("unroll") for (int _i = 0; _i < 2; ++_i) \
        __builtin_amdgcn_global_load_lds((const unsigned*)((const char*)(gbase) + (voff)[_i]), (PG8_LAS unsigned*)(lds + (bufoff) + ldsw + _i * 8192), 16, 0, 0); } while (0)
#define PG8_LDA(dst, b, h) do { _Pragma("unroll") for (int m = 0; m < 4; ++m) _Pragma("unroll") for (int k = 0; k < 2; ++k) dst[m][k] = *(const PG8_LAS bf16x8*)(lds + PG8_SA(b, h) + aoff + m * 2048 + k * 1024); } while (0)
#define PG8_LDB(dst, b, h) do { _Pragma("unroll") for (int n = 0; n < 2; ++n) _Pragma("unroll") for (int k = 0; k < 2; ++k) dst[n][k] = *(const PG8_LAS bf16x8*)(lds + PG8_SB(b, h) + boff + n * 2048 + k * 1024); } while (0)
#define PG8_MMA(ai, bj, At, Bt) do { __builtin_amdgcn_s_setprio(1); _Pragma("unroll") for (int m = 0; m < 4; ++m) _Pragma("unroll") for (int n = 0; n < 2; ++n) _Pragma("unroll") for (int k = 0; k < 2; ++k) \
        acc[ai][bj][m][n] = __builtin_amdgcn_mfma_f32_16x16x32_bf16(Bt[n][k], At[m][k], acc[ai][bj][m][n], 0, 0, 0); __builtin_amdgcn_s_setprio(0); } while (0)
#define PG8_WAIT_V(n) asm volatile("s_waitcnt vmcnt(" #n ")" ::: "memory")
#define PG8_WAIT_L(n) asm volatile("s_waitcnt lgkmcnt(" #n ")" ::: "memory")
#define PG8_BAR __builtin_amdgcn_s_barrier()
#define PG8_SCHED __builtin_amdgcn_sched_barrier(0)
    Unit cur, nxt; int ui = 0;
    if (!S.next(0, cur)) return;
    f32x4 acc[2][2][4][2];
#pragma unroll
    for (int a = 0; a < 2; ++a)
#pragma unroll
        for (int b = 0; b < 2; ++b)
#pragma unroll
            for (int m = 0; m < 4; ++m)
#pragma unroll
                for (int n = 0; n < 2; ++n) acc[a][b][m][n] = (f32x4){0.f, 0.f, 0.f, 0.f};
    bf16x8 At[4][2], B0[2][2], B1[2][2];
    const char* cA = (const char*)g.A + (size_t)cur.pm * tstep; const char* cB = (const char*)g.Bt + (size_t)cur.pn * tstep;
    S.a_ready(cur);
    if constexpr (SP2) {
        PG8_STAGE(PG8_SB(0, 0), cB, voffB); PG8_STAGE(PG8_SB(0, 1), cB + hstep, voffB); PG8_STAGE(PG8_SA(0, 0), cA, voffA); PG8_STAGE(PG8_SA(0, 1), cA + hstep, voffA);
        if (wr == 1) PG8_BAR;
        PG8_WAIT_V(2); PG8_BAR;
        PG8_STAGE(PG8_SB(1, 0), cB + kstep, voffB); PG8_STAGE(PG8_SA(1, 0), cA + kstep, voffA); PG8_STAGE(PG8_SB(1, 1), cB + hstep + kstep, voffB);
        PG8_WAIT_V(6); PG8_BAR;
    } else {
        PG8_STAGE(PG8_SB(0, 0), cB, voffB); PG8_STAGE(PG8_SA(0, 0), cA, voffA); PG8_STAGE(PG8_SB(0, 1), cB + hstep, voffB); PG8_STAGE(PG8_SA(0, 1), cA + hstep, voffA);
        if (wr == 1) PG8_BAR;
        PG8_WAIT_V(4); PG8_BAR;
        PG8_STAGE(PG8_SB(1, 0), cB + kstep, voffB); PG8_STAGE(PG8_SA(1, 0), cA + kstep, voffA); PG8_STAGE(PG8_SB(1, 1), cB + hstep + kstep, voffB);
        PG8_WAIT_V(6); PG8_BAR;
    }
    for (;;) {
        const bool has_next = S.next(ui + 1, nxt);
        const char* nA = has_next ? (const char*)g.A + (size_t)nxt.pm * tstep : cA; const char* nB = has_next ? (const char*)g.Bt + (size_t)nxt.pn * tstep : cB;
        for (int t = 0; t < nt; t += 2) {
            const bool last = (t == nt - 2);
            const char* a1 = cA + (size_t)(t + 1) * kstep;
            const char* a2 = last ? nA : cA + (size_t)(t + 2) * kstep; const char* b2 = last ? nB : cB + (size_t)(t + 2) * kstep;
            const char* a3 = a2 + kstep; const char* b3 = b2 + kstep;
            if (last && has_next) S.a_ready(nxt);
            if constexpr (SP2) {
            PG8_LDB(B0, 0, 0); PG8_LDB(B1, 0, 1); PG8_SCHED; PG8_LDA(At, 0, 0); PG8_STAGE(PG8_SA(1, 1), a1 + hstep, voffA);
            PG8_WAIT_V(8); PG8_WAIT_L(0); PG8_BAR; PG8_MMA(0, 0, At, B0); PG8_MMA(0, 1, At, B1); PG8_BAR; PG8_SCHED;
            PG8_LDA(At, 0, 1); PG8_STAGE(PG8_SB(0, 0), b2, voffB); PG8_STAGE(PG8_SB(0, 1), b2 + hstep, voffB); PG8_STAGE(PG8_SA(0, 0), a2, voffA);
            PG8_WAIT_V(8); PG8_WAIT_L(0); PG8_BAR; PG8_MMA(1, 0, At, B0); PG8_MMA(1, 1, At, B1); PG8_BAR; PG8_SCHED;
            PG8_LDB(B0, 1, 0); PG8_LDB(B1, 1, 1); PG8_SCHED; PG8_LDA(At, 1, 0); PG8_STAGE(PG8_SA(0, 1), a2 + hstep, voffA);
            PG8_WAIT_V(8); PG8_WAIT_L(0); PG8_BAR; PG8_MMA(0, 0, At, B0); PG8_MMA(0, 1, At, B1); PG8_BAR; PG8_SCHED;
            PG8_LDA(At, 1, 1); PG8_STAGE(PG8_SB(1, 0), b3, voffB); PG8_STAGE(PG8_SB(1, 1), b3 + hstep, voffB); PG8_STAGE(PG8_SA(1, 0), a3, voffA);
            PG8_WAIT_V(8); PG8_WAIT_L(0); PG8_BAR; PG8_MMA(1, 0, At, B0); PG8_MMA(1, 1, At, B1); PG8_BAR; PG8_SCHED;
            } else {
            PG8_LDB(B0, 0, 0); PG8_SCHED; PG8_LDA(At, 0, 0); PG8_STAGE(PG8_SA(1, 1), a1 + hstep, voffA);
            PG8_WAIT_L(8); PG8_BAR; PG8_WAIT_L(0); PG8_MMA(0, 0, At, B0); PG8_BAR; PG8_SCHED;
            PG8_LDB(B1, 0, 1); PG8_STAGE(PG8_SB(0, 0), b2, voffB);
            PG8_BAR; PG8_WAIT_L(0); PG8_MMA(0, 1, At, B1); PG8_BAR;
            PG8_LDA(At, 0, 1); PG8_STAGE(PG8_SA(0, 0), a2, voffA);
            PG8_BAR; PG8_WAIT_L(0); PG8_MMA(1, 0, At, B0); PG8_BAR; PG8_SCHED;
            PG8_STAGE(PG8_SB(0, 1), b2 + hstep, voffB);
            PG8_WAIT_V(6); PG8_BAR; PG8_MMA(1, 1, At, B1); PG8_BAR;
            PG8_LDB(B0, 1, 0); PG8_SCHED; PG8_LDA(At, 1, 0); PG8_STAGE(PG8_SA(0, 1), a2 + hstep, voffA);
            PG8_WAIT_L(8); PG8_BAR; PG8_WAIT_L(0); PG8_MMA(0, 0, At, B0); PG8_BAR; PG8_SCHED;
            PG8_LDB(B1, 1, 1); PG8_STAGE(PG8_SB(1, 0), b3, voffB);
            PG8_BAR; PG8_WAIT_L(0); PG8_MMA(0, 1, At, B1); PG8_BAR;
            PG8_LDA(At, 1, 1); PG8_STAGE(PG8_SA(1, 0), a3, voffA);
            PG8_BAR; PG8_WAIT_L(0); PG8_MMA(1, 0, At, B0); PG8_BAR; PG8_SCHED;
            PG8_STAGE(PG8_SB(1, 1), b3 + hstep, voffB);
            PG8_WAIT_V(6); PG8_BAR; PG8_MMA(1, 1, At, B1); PG8_BAR;
            }
        }
        if constexpr (ALIGN_EPI) { if (wr == 0) PG8_BAR; }
        if constexpr (!Epi::AFTER_DRAIN) { E(acc, cur, wr, wc, fr, fq); S.done(cur); }
        if (!has_next) break;
#pragma unroll
        for (int a = 0; a < 2; ++a)
#pragma unroll
            for (int b = 0; b < 2; ++b)
#pragma unroll
                for (int m = 0; m < 4; ++m)
#pragma unroll
                    for (int n = 0; n < 2; ++n) acc[a][b][m][n] = (f32x4){0.f, 0.f, 0.f, 0.f};
        cur = nxt; cA = nA; cB = nB; ++ui;
        if constexpr (ALIGN_EPI) { if (wr == 1) PG8_BAR; }
    }
    PG8_WAIT_V(0);
    if constexpr (!ALIGN_EPI) { if (wr == 0) PG8_BAR; }
    PG8_BAR;
    if constexpr (Epi::AFTER_DRAIN) { E.fused(acc, cur, wr, wc, fr, fq, lds, wid, lane); S.done(cur); }
#undef PG8_SA
#undef PG8_SB
#undef PG8_STAGE
#undef PG8_LDA
#undef PG8_LDB
#undef PG8_MMA
#undef PG8_WAIT_V
#undef PG8_WAIT_L
#undef PG8_BAR
#undef PG8_SCHED
}
}

#define LAS __attribute__((address_space(3)))
typedef unsigned short bf16;
typedef short bf16x8 __attribute__((ext_vector_type(8)));
typedef short s16x4 __attribute__((ext_vector_type(4)));
typedef float f32x2 __attribute__((ext_vector_type(2)));
typedef float f32x4 __attribute__((ext_vector_type(4)));
typedef float f32x16 __attribute__((ext_vector_type(16)));
typedef unsigned u32x2 __attribute__((ext_vector_type(2)));
typedef unsigned u32x4 __attribute__((ext_vector_type(4)));
typedef __bf16 bf16x2_t __attribute__((ext_vector_type(2)));

constexpr int M_ = 65536, SEQ = 2048, DMODEL = 1024, DFF = 2816;
constexpr float EPS = 1e-6f, LOG2E = 1.4426950408889634f;
constexpr size_t MiB = 1u << 20;
constexpr size_t WS_BIAS = 0;
constexpr size_t WS_ROPE = 256 * 1024;
constexpr size_t WS_RSS = 1 * MiB;
constexpr size_t WS_SSQ = 3 * MiB;
constexpr size_t WS_SSKV = 3 * MiB + 256 * 1024;
constexpr size_t W_AIN = 4 * MiB, W_AOUT = 13 * MiB, W_BIN = 14 * MiB, W_BQUP = 16 * MiB, W_BKVUP = 18 * MiB, W_BOUT = 19 * MiB,
                 W_CIN = 21 * MiB, W_COUT = 27 * MiB, W_DIN = 29 * MiB, W_DOUT = 32 * MiB, W_FG = 34 * MiB, W_FU = 58 * MiB, W_FD = 82 * MiB, W_FSTR = 6 * MiB;
constexpr size_t WS_XB = 106 * MiB;
constexpr size_t WS_R = 234 * MiB;
constexpr size_t R_A_QKV = WS_R, R_A_O3 = WS_R + 576 * MiB, R_A_LSE = WS_R + 768 * MiB, R_A_OC = WS_R;
constexpr size_t R_B_CQ = WS_R, R_B_CKV = WS_R + 48 * MiB, R_B_KPE = WS_R + 80 * MiB, R_B_Q = WS_R + 128 * MiB, R_B_KV = WS_R + 320 * MiB, R_B_KH = WS_R + 576 * MiB, R_B_O = WS_R;
constexpr size_t R_C_QKV = WS_R, R_C_O = WS_R + 384 * MiB;
constexpr size_t R_D_QKV = WS_R, R_D_O = WS_R + 160 * MiB;
constexpr size_t R_GATE = WS_R, R_ACT = WS_R + 352 * MiB;
constexpr size_t WS_RSSP = WS_R + 774 * MiB;
constexpr size_t WS_SSQP = WS_R + 782 * MiB;
constexpr size_t WS_SSKVP = WS_R + 784 * MiB;
constexpr size_t WS_SSPE = 3 * MiB + 512 * 1024;
constexpr size_t R_B_RK = WS_R + 96 * MiB;
constexpr size_t WS_BAR = 512 * 1024;
constexpr size_t WS_NEED = WS_R + 786 * MiB;

constexpr int LDS_BYTES = 135168;

struct Args { const float* in[34]; float* out; unsigned char* ws; };

__device__ __forceinline__ unsigned pk2(float lo, float hi) { f32x2 v = {lo, hi}; bf16x2_t b = __builtin_convertvector(v, bf16x2_t); return __builtin_bit_cast(unsigned, b); }
__device__ __forceinline__ float bf2f(unsigned short h) { return __uint_as_float(((unsigned)h) << 16); }
__device__ __forceinline__ float bflo(unsigned w) { return __uint_as_float(w << 16); }
__device__ __forceinline__ float bfhi(unsigned w) { return __uint_as_float(w & 0xffff0000u); }
__device__ __forceinline__ float wave_sum(float v) {
#pragma unroll
    for (int o = 1; o < 64; o <<= 1) v += __shfl_xor(v, o);
    return v;
}
__device__ __forceinline__ float dot4(f32x4 a) { return (a[0] * a[0] + a[1] * a[1]) + (a[2] * a[2] + a[3] * a[3]); }
__device__ __forceinline__ float rowss_sum(const float* ss, int nvec, int row) {
    const f32x4* p = (const f32x4*)(ss + (size_t)row * 4 * nvec); float t = 0.f;
#pragma unroll
    for (int v = 0; v < 4; ++v) if (v < nvec) { const f32x4 q = p[v]; t += (q[0] + q[1]) + (q[2] + q[3]); }
    return t;
}

struct EpiProj {
    static constexpr bool PERM = true, AFTER_DRAIN = false;
    bf16* O; int ldc; const float* rs; int hm; const float* gq; const float* gk; float qscale;
    __device__ __forceinline__ void operator()(const f32x4 (&acc)[2][2][4][2], const pg8::Unit& u, int wr, int wc, int fr, int fq) const {
        const int hg = u.pn * 4 + wc;
        int kind = 2; const float* gain = gq;
        if (hm == 1) { const int t = (hg >> 3) % 3, gi = hg / 24; kind = t; gain = (t == 0 ? gq : gk) + gi * 64; }
        else if (hm == 2) { kind = hg < 16 ? 0 : (hg < 32 ? 1 : 2); gain = kind == 0 ? gq : gk; }
        else if (hm == 3) { kind = hg < 16 ? 0 : (hg < 18 ? 1 : 2); gain = kind == 0 ? gq : gk; }
        else if (hm == 4) { kind = (hg & 1) ? 2 : 3; gain = gk; }
        f32x4 gv[2][2];
#pragma unroll
        for (int bj = 0; bj < 2; ++bj)
#pragma unroll
            for (int n = 0; n < 2; ++n) {
                gv[bj][n] = (f32x4){1.f, 1.f, 1.f, 1.f};
                if (kind != 2) { gv[bj][n] = *(const f32x4*)(gain + 32 * bj + 8 * fq + 4 * n); if (kind == 0) gv[bj][n] = gv[bj][n] * qscale; }
            }
        bf16* colp = O + hg * 64 + 8 * fq;
        float rsv[2][4];
#pragma unroll
        for (int ai = 0; ai < 2; ++ai)
#pragma unroll
            for (int m = 0; m < 4; ++m) rsv[ai][m] = rs[u.pm * 256 + ai * 128 + wr * 64 + m * 16 + fr];
        if (kind == 3) {
#pragma unroll
            for (int ai = 0; ai < 2; ++ai)
#pragma unroll
                for (int m = 0; m < 4; ++m) {
                    const int row = u.pm * 256 + ai * 128 + wr * 64 + m * 16 + fr;
                    const float rstd = rsv[ai][m];
                    f32x4 v[2][2]; float s = 0.f;
#pragma unroll
                    for (int bj = 0; bj < 2; ++bj)
#pragma unroll
                        for (int n = 0; n < 2; ++n) { v[bj][n] = acc[ai][bj][m][n] * rstd; s += dot4(v[bj][n]); }
                    s += __shfl_xor(s, 16); s += __shfl_xor(s, 32);
                    const float rk_ = rsqrtf((s + ((const float*)((const unsigned char*)rs + (WS_SSPE - WS_SSKV)))[row]) * (1.0f / 96.0f) + EPS);
                    bf16* kp = (bf16*)((unsigned char*)O + (R_B_KH - R_B_KV)) + (size_t)row * 1536 + (hg >> 1) * 96 + 8 * fq;
#pragma unroll
                    for (int bj = 0; bj < 2; ++bj) {
                        const f32x4 a_ = v[bj][0] * rk_ * gv[bj][0], b_ = v[bj][1] * rk_ * gv[bj][1];
                        u32x4 w; w.x = pk2(a_[0], a_[1]); w.y = pk2(a_[2], a_[3]); w.z = pk2(b_[0], b_[1]); w.w = pk2(b_[2], b_[3]);
                        *(u32x4*)(kp + 32 * bj) = w;
                    }
                    const u32x4 r_ = *(const u32x4*)((const bf16*)((const unsigned char*)O - (R_B_KV - R_B_RK)) + (size_t)row * 32 + 8 * fq);
                    u32x4 w;
#pragma unroll
                    for (int j = 0; j < 4; ++j) w[j] = pk2(bflo(r_[j]) * rk_, bfhi(r_[j]) * rk_);
                    *(u32x4*)(kp + 64) = w;
                }
            return;
        }
#pragma unroll
        for (int ai = 0; ai < 2; ++ai)
#pragma unroll
            for (int m = 0; m < 4; ++m) {
                const int row = u.pm * 256 + ai * 128 + wr * 64 + m * 16 + fr;
                const float rstd = rsv[ai][m];
                f32x4 v[2][2]; float s = 0.f;
#pragma unroll
                for (int bj = 0; bj < 2; ++bj)
#pragma unroll
                    for (int n = 0; n < 2; ++n) { v[bj][n] = acc[ai][bj][m][n] * rstd; s += dot4(v[bj][n]); }
                if (kind < 2) {
                    s += __shfl_xor(s, 16); s += __shfl_xor(s, 32);
                    const float rs = rsqrtf(s * (1.0f / 64.0f) + EPS);
#pragma unroll
                    for (int bj = 0; bj < 2; ++bj)
#pragma unroll
                        for (int n = 0; n < 2; ++n) v[bj][n] = v[bj][n] * rs * gv[bj][n];
                }
#pragma unroll
                for (int bj = 0; bj < 2; ++bj) {
                    u32x4 w; w.x = pk2(v[bj][0][0], v[bj][0][1]); w.y = pk2(v[bj][0][2], v[bj][0][3]); w.z = pk2(v[bj][1][0], v[bj][1][1]); w.w = pk2(v[bj][1][2], v[bj][1][3]);
                    *(u32x4*)(colp + (size_t)row * ldc + 32 * bj) = w;
                }
            }
    }
};
struct EpiLat {
    static constexpr bool PERM = true, AFTER_DRAIN = false;
    bf16* CQ; bf16* CKV; bf16* KPE; const float* rs; float* ssq; float* sskv;
    __device__ __forceinline__ void operator()(const f32x4 (&acc)[2][2][4][2], const pg8::Unit& u, int wr, int wc, int fr, int fq) const {
        const int hg = u.pn * 4 + wc;
        if (hg > 10) return;
        bf16* dst; int ld; float* sacc = nullptr; int sst = 0;
        if (hg < 6) { dst = CQ + hg * 64; ld = 384; sacc = ssq + hg; sst = 8; } else if (hg < 10) { dst = CKV + (hg - 6) * 64; ld = 256; sacc = sskv + (hg - 6); sst = 4; } else { dst = KPE; ld = 64; }
        dst += 8 * fq;
        float rsv[2][4];
#pragma unroll
        for (int ai = 0; ai < 2; ++ai)
#pragma unroll
            for (int m = 0; m < 4; ++m) rsv[ai][m] = rs[u.pm * 256 + ai * 128 + wr * 64 + m * 16 + fr];
#pragma unroll
        for (int ai = 0; ai < 2; ++ai)
#pragma unroll
            for (int m = 0; m < 4; ++m) {
                const int row = u.pm * 256 + ai * 128 + wr * 64 + m * 16 + fr;
                const float rstd = rsv[ai][m];
                f32x4 v[2][2]; float s = 0.f;
#pragma unroll
                for (int bj = 0; bj < 2; ++bj)
#pragma unroll
                    for (int n = 0; n < 2; ++n) { v[bj][n] = acc[ai][bj][m][n] * rstd; s += dot4(v[bj][n]); }
                s += __shfl_xor(s, 16); s += __shfl_xor(s, 32);
                if (fq == 0) { if (sacc != nullptr) sacc[(size_t)row * sst] = s; else { float z_ = 0.f; asm volatile("" : "+v"(z_)); ssq[(size_t)row * 8 + 6] = z_; ssq[(size_t)row * 8 + 7] = z_; } }
#pragma unroll
                for (int bj = 0; bj < 2; ++bj) {
                    u32x4 w; w.x = pk2(v[bj][0][0], v[bj][0][1]); w.y = pk2(v[bj][0][2], v[bj][0][3]); w.z = pk2(v[bj][1][0], v[bj][1][1]); w.w = pk2(v[bj][1][2], v[bj][1][3]);
                    *(u32x4*)(dst + (size_t)row * ld + 32 * bj) = w;
                }
            }
    }
};
struct EpiRes {
    static constexpr bool PERM = true, AFTER_DRAIN = false;
    const float* base32; float* out32; bf16* xb; bf16* xbw; float* ssn;
    __device__ __forceinline__ void operator()(const f32x4 (&acc)[2][2][4][2], const pg8::Unit& u, int wr, int wc, int fr_, int fq_) const {
        int fr = fr_, fq = fq_; asm volatile("" : "+v"(fr), "+v"(fq));
        float* ssn_ = ssn; bf16* xbw_ = xbw; float* out_ = out32; const float* b32_ = base32; asm volatile("" : "+s"(ssn_), "+s"(xbw_), "+s"(out_), "+s"(b32_));
        const int col0 = u.pn * 256 + wc * 32 + 8 * fq;
#pragma unroll
        for (int ai = 0; ai < 2; ++ai) {
            f32x4 bv[4][2][2];
            if (b32_ != nullptr) {
#pragma unroll
                for (int m = 0; m < 4; ++m)
#pragma unroll
                    for (int bj = 0; bj < 2; ++bj)
#pragma unroll
                        for (int n = 0; n < 2; ++n) bv[m][bj][n] = *(const f32x4*)(b32_ + (size_t)(u.pm * 256 + ai * 128 + wr * 64 + m * 16 + fr) * DMODEL + col0 + bj * 128 + n * 4);
            } else {
                u32x4 rw[4][2];
#pragma unroll
                for (int m = 0; m < 4; ++m)
#pragma unroll
                    for (int bj = 0; bj < 2; ++bj) rw[m][bj] = *(const u32x4*)(xb + (size_t)(u.pm * 256 + ai * 128 + wr * 64 + m * 16 + fr) * DMODEL + col0 + bj * 128);
#pragma unroll
                for (int m = 0; m < 4; ++m)
#pragma unroll
                    for (int bj = 0; bj < 2; ++bj) {
                        bv[m][bj][0] = (f32x4){bflo(rw[m][bj].x), bfhi(rw[m][bj].x), bflo(rw[m][bj].y), bfhi(rw[m][bj].y)};
                        bv[m][bj][1] = (f32x4){bflo(rw[m][bj].z), bfhi(rw[m][bj].z), bflo(rw[m][bj].w), bfhi(rw[m][bj].w)};
                    }
            }
            asm volatile("" ::: "memory");
#pragma unroll
            for (int m = 0; m < 4; ++m) {
                const int row = u.pm * 256 + ai * 128 + wr * 64 + m * 16 + fr;
                float s = 0.f;
#pragma unroll
                for (int bj = 0; bj < 2; ++bj) {
                    const size_t off = (size_t)row * DMODEL + col0 + bj * 128;
                    const f32x4 o0 = bv[m][bj][0] + acc[ai][bj][m][0], o1 = bv[m][bj][1] + acc[ai][bj][m][1];
                    if (out_ != nullptr) { *(f32x4*)(out_ + off) = o0; *(f32x4*)(out_ + off + 4) = o1; }
                    if (xbw_ != nullptr) { u32x4 w; w.x = pk2(o0[0], o0[1]); w.y = pk2(o0[2], o0[3]); w.z = pk2(o1[0], o1[1]); w.w = pk2(o1[2], o1[3]); *(u32x4*)(xbw_ + off) = w; }
                    s += dot4(o0) + dot4(o1);
                }
                if (ssn_ != nullptr) { s += __shfl_xor(s, 16); s += __shfl_xor(s, 32); if (fq == 0) ssn_[(size_t)(u.pn * 4 + wc) * M_ + row] = s; }
            }
            asm volatile("" ::: "memory");
        }
    }
};
__device__ __forceinline__ u32x4 shfl4(u32x4 v, int src) { u32x4 r; r.x = __shfl(v.x, src, 16); r.y = __shfl(v.y, src, 16); r.z = __shfl(v.z, src, 16); r.w = __shfl(v.w, src, 16); return r; }
struct EpiGateUp {
    static constexpr bool PERM = true, AFTER_DRAIN = false;
    bf16* act; bf16* gedge; bf16* uedge; const float* rs; const float* cw; const float* cb;
    __device__ __forceinline__ void operator()(const f32x4 (&acc)[2][2][4][2], const pg8::Unit& u, int wr, int wc, int fr_, int fq_) const {
        int fr = fr_, fq = fq_; asm volatile("" : "+v"(fr), "+v"(fq));
        const int c0 = u.pn * 128 + wc * 32 + 8 * fq;
        f32x4 w0[2], w1[2], w2[2], b[2];
#pragma unroll
        for (int n = 0; n < 2; ++n) { w0[n] = *(const f32x4*)(cw + c0 + 4 * n); w1[n] = *(const f32x4*)(cw + DFF + c0 + 4 * n); w2[n] = *(const f32x4*)(cw + 2 * DFF + c0 + 4 * n); b[n] = *(const f32x4*)(cb + c0 + 4 * n); }
#pragma unroll
        for (int ai = 0; ai < 2; ++ai) {
            u32x4 g[4]; float rstd[4];
            const int strip = u.pm * 4 + ai * 2 + wr;
#pragma unroll
            for (int m = 0; m < 4; ++m) rstd[m] = rs[u.pm * 256 + ai * 128 + wr * 64 + m * 16 + fr];
#pragma unroll
            for (int m = 0; m < 4; ++m) {
                const f32x4 ga = acc[ai][0][m][0] * rstd[m], gb = acc[ai][0][m][1] * rstd[m];
                g[m].x = pk2(ga[0], ga[1]); g[m].y = pk2(ga[2], ga[3]); g[m].z = pk2(gb[0], gb[1]); g[m].w = pk2(gb[2], gb[3]);
            }
#pragma unroll
            for (int m = 0; m < 4; ++m) {
                const int row = u.pm * 256 + ai * 128 + wr * 64 + m * 16 + fr;
                const u32x4 g0 = g[m];
                u32x4 g1, g2;
#pragma unroll
                for (int d = 0; d < 4; ++d) {
                    unsigned o1_ = 0u, o2_ = 0u;
                    if (m > 0) { o1_ = __builtin_amdgcn_update_dpp(0u, g[m - 1][d], 0x121, 0xf, 0xf, false); o2_ = __builtin_amdgcn_update_dpp(0u, g[m - 1][d], 0x122, 0xf, 0xf, false); }
                    g1[d] = __builtin_amdgcn_update_dpp(o1_, g0[d], 0x111, 0xf, 0xf, false);
                    g2[d] = __builtin_amdgcn_update_dpp(o2_, g0[d], 0x112, 0xf, 0xf, false);
                }
                u32x4 w, uw;
#pragma unroll
                for (int n = 0; n < 2; ++n) {
                    float r[4], up[4];
#pragma unroll
                    for (int j = 0; j < 4; ++j) {
                        const unsigned q0 = g0[2 * n + (j >> 1)], q1 = g1[2 * n + (j >> 1)], q2 = g2[2 * n + (j >> 1)];
                        const float x0 = (j & 1) ? bfhi(q0) : bflo(q0), x1 = (j & 1) ? bfhi(q1) : bflo(q1), x2 = (j & 1) ? bfhi(q2) : bflo(q2);
                        const float cv = b[n][j] + w2[n][j] * x0 + w1[n][j] * x1 + w0[n][j] * x2;
                        const float sg = cv * __builtin_amdgcn_rcpf(1.0f + __builtin_amdgcn_exp2f(-LOG2E * cv));
                        up[j] = acc[ai][1][m][n][j] * rstd[m];
                        r[j] = sg * up[j];
                    }
                    w[2 * n] = pk2(r[0], r[1]); w[2 * n + 1] = pk2(r[2], r[3]);
                    uw[2 * n] = pk2(up[0], up[1]); uw[2 * n + 1] = pk2(up[2], up[3]);
                }
                if (m == 0) {
                    if (fr < 2) { *(u32x4*)(gedge + ((size_t)strip * 4 + fr) * DFF + c0) = g0; *(u32x4*)(uedge + ((size_t)strip * 2 + fr) * DFF + c0) = uw; }
                    else *(u32x4*)(act + (size_t)row * DFF + c0) = w;
                } else {
                    *(u32x4*)(act + (size_t)row * DFF + c0) = w;
                    if (m == 3 && fr >= 14) *(u32x4*)(gedge + ((size_t)strip * 4 + 2 + (fr - 14)) * DFF + c0) = g0;
                }
                asm volatile("" ::: "memory");
            }
        }
    }
};

__device__ __forceinline__ int crow(int r, int hi) { return (r & 3) + 8 * (r >> 2) + 4 * hi; }
struct TileGeo { int NT, TPS, ks0, res0, dil; };
template <int DQK, int DV, int KT> struct AttL {
    static constexpr int KSTR = DQK * 2 + 16, VSTR = DV * 2 + 64, KBUF = KT * KSTR, VBUF = KT * VSTR;
    static constexpr int OFF_K = 0, OFF_V = 2 * KBUF, OFF_TAB = OFF_V + 2 * VBUF;
};
template <int DQK, int DV, bool BIAS, int TABN, bool QRELOAD, int KT>
__device__ __forceinline__ void attn_pass(int qoff_, LAS unsigned char* lds, const bf16* Kb, int kpitch, const bf16* Vb, int vpitch, const TileGeo G, int my_tlo, int my_thi,
                                          int wslot_q0, int W, const bf16x8 (&qf_)[DQK / 16], float& m_, float& l_, f32x16 (&o)[DV / 32]) {
    typedef AttL<DQK, DV, KT> L;
    int tid = threadIdx.x; asm volatile("" : "+v"(tid)); const int lane = tid & 63, r32 = lane & 31, hi = lane >> 5;
    constexpr int SUB = KT / 64;
    constexpr int KCH = DQK / 8, VCH = DV / 8, NKC = KT * KCH, NVC = KT * VCH, NKL = (NKC + 511) / 512, NVL = (NVC + 511) / 512;
    u32x4 kr[NKL], vr[NVL];
    const LAS float* tab = (const LAS float*)(lds + L::OFF_TAB);
    const int slot_q = wslot_q0 + r32;
    const int vlane = (4 * hi + ((lane & 15) >> 2)) * L::VSTR + (16 * ((lane >> 4) & 1) + 4 * (lane & 3)) * 2;
#define ATT_LOAD(t) do { const int seg_ = ((t) * SUB) / G.TPS, tis_ = (t) * SUB - seg_ * G.TPS; const int tok0_ = G.res0 + seg_ + G.dil * (G.ks0 + 64 * tis_); \
        _Pragma("unroll") for (int i_ = 0; i_ < NKL; ++i_) { const int c_ = tid + 512 * i_; if ((NKC % 512 == 0) || c_ < NKC) { const int j_ = c_ / KCH, p_ = c_ - j_ * KCH; \
            kr[i_] = *(const u32x4*)(Kb + (size_t)(tok0_ + G.dil * j_) * kpitch + p_ * 8); } } \
        _Pragma("unroll") for (int i_ = 0; i_ < NVL; ++i_) { const int c_ = tid + 512 * i_; if ((NVC % 512 == 0) || c_ < NVC) { const int j_ = c_ / VCH, p_ = c_ - j_ * VCH; \
            vr[i_] = *(const u32x4*)(Vb + (size_t)(tok0_ + G.dil * j_) * vpitch + p_ * 8); } } } while (0)
#define ATT_STORE(buf) do { \
        _Pragma("unroll") for (int i_ = 0; i_ < NKL; ++i_) { const int c_ = tid + 512 * i_; if ((NKC % 512 == 0) || c_ < NKC) { const int j_ = c_ / KCH, p_ = c_ - j_ * KCH; \
            *(LAS u32x4*)(lds + L::OFF_K + (buf) * L::KBUF + j_ * L::KSTR + p_ * 16) = kr[i_]; } } \
        _Pragma("unroll") for (int i_ = 0; i_ < NVL; ++i_) { const int c_ = tid + 512 * i_; if ((NVC % 512 == 0) || c_ < NVC) { const int j_ = c_ / VCH, p_ = c_ - j_ * VCH; \
            *(LAS u32x4*)(lds + L::OFF_V + (buf) * L::VBUF + j_ * L::VSTR + p_ * 16) = vr[i_]; } } } while (0)
    ATT_LOAD(0);
    ATT_STORE(0);
    float m = m_, l = l_;
    const int NT2 = G.NT / SUB;
    for (int t = 0; t < NT2; ++t) {
        const int buf = t & 1;
        if (t + 1 < NT2) ATT_LOAD(t + 1);
        __syncthreads();
#pragma unroll
        for (int hf = 0; hf < SUB; ++hf) {
        const int st = t * SUB + hf;
        if (st >= my_tlo && st <= my_thi) {
            const int tis = st % G.TPS, slot0 = G.ks0 + 64 * tis;
            const LAS unsigned char* Kt = lds + L::OFF_K + buf * L::KBUF + (hf * 64 + r32) * L::KSTR + hi * 16;
            f32x16 s[2];
            const int dsb = slot_q - slot0 - 4 * hi;
            bf16x8 qf[DQK / 16];
            if (QRELOAD) {
#pragma unroll
                for (int ks = 0; ks < DQK / 16; ++ks) qf[ks] = *(const LAS bf16x8*)(lds + qoff_ + ks * 32); }
            else {
#pragma unroll
                for (int ks = 0; ks < DQK / 16; ++ks) qf[ks] = qf_[ks]; }
#pragma unroll
            for (int kb = 0; kb < 2; ++kb) {
#pragma unroll
                for (int r = 0; r < 16; ++r) s[kb][r] = BIAS ? tab[dsb + 128 - (32 * kb + (r & 3) + 8 * (r >> 2))] : 0.f;
            }
            if (DV == 64) {
                bf16x8 kf[2][DQK / 16];
#pragma unroll
                for (int kb = 0; kb < 2; ++kb)
#pragma unroll
                    for (int ks = 0; ks < DQK / 16; ++ks) kf[kb][ks] = *(const LAS bf16x8*)(Kt + kb * 32 * L::KSTR + ks * 32);
                asm volatile("" ::: "memory");
#pragma unroll
                for (int ks = 0; ks < DQK / 16; ++ks)
#pragma unroll
                    for (int kb = 0; kb < 2; ++kb) s[kb] = __builtin_amdgcn_mfma_f32_32x32x16_bf16(kf[kb][ks], qf[ks], s[kb], 0, 0, 0);
            } else {
#pragma unroll
                for (int kh = 0; kh < 2; ++kh) {
                    bf16x8 kf[2][DQK / 32];
#pragma unroll
                    for (int kb = 0; kb < 2; ++kb)
#pragma unroll
                        for (int k2 = 0; k2 < DQK / 32; ++k2) kf[kb][k2] = *(const LAS bf16x8*)(Kt + kb * 32 * L::KSTR + (kh * (DQK / 32) + k2) * 32);
                    asm volatile("" ::: "memory");
#pragma unroll
                    for (int k2 = 0; k2 < DQK / 32; ++k2)
#pragma unroll
                        for (int kb = 0; kb < 2; ++kb) s[kb] = __builtin_amdgcn_mfma_f32_32x32x16_bf16(kf[kb][k2], qf[kh * (DQK / 32) + k2], s[kb], 0, 0, 0);
                }
            }
            const bool full = (wslot_q0 - slot0 - 63 >= 0) && (wslot_q0 + 31 - slot0 <= W);
            if (!full && !BIAS) {
#pragma unroll
                for (int kb = 0; kb < 2; ++kb)
#pragma unroll
                    for (int r = 0; r < 16; ++r) {
                        const int ds = dsb - (32 * kb + (r & 3) + 8 * (r >> 2));
                        s[kb][r] = ((unsigned)ds <= (unsigned)W) ? s[kb][r] : -INFINITY;
                    }
            }
            float mx = s[0][0];
#pragma unroll
            for (int r = 1; r < 16; ++r) mx = fmaxf(mx, s[0][r]);
#pragma unroll
            for (int r = 0; r < 16; ++r) mx = fmaxf(mx, s[1][r]);
            mx = fmaxf(mx, __shfl_xor(mx, 32));
            const float mn = fmaxf(m, mx);
            const float base = (mn == -INFINITY) ? 0.f : mn;
            const float alpha = __builtin_amdgcn_exp2f(m - base);
            m = mn;
            float ps = 0.f;
#pragma unroll
            for (int kb = 0; kb < 2; ++kb)
#pragma unroll
                for (int r = 0; r < 16; ++r) { const float p = __builtin_amdgcn_exp2f(s[kb][r] - base); s[kb][r] = p; ps += p; }
            l = l * alpha + ps;
            if (__any(alpha != 1.0f)) {
#pragma unroll
                for (int c = 0; c < DV / 32; ++c)
#pragma unroll
                    for (int r = 0; r < 16; ++r) o[c][r] *= alpha;
            }
            const LAS unsigned char* Vt = lds + L::OFF_V + buf * L::VBUF + hf * 64 * L::VSTR + vlane;
#pragma unroll
            for (int kb = 0; kb < 2; ++kb) {
                bf16x8 pb[2];
#pragma unroll
                for (int k2 = 0; k2 < 2; ++k2) {
                    u32x4 pw; pw.x = pk2(s[kb][8 * k2 + 0], s[kb][8 * k2 + 1]); pw.y = pk2(s[kb][8 * k2 + 2], s[kb][8 * k2 + 3]);
                    pw.z = pk2(s[kb][8 * k2 + 4], s[kb][8 * k2 + 5]); pw.w = pk2(s[kb][8 * k2 + 6], s[kb][8 * k2 + 7]);
                    pb[k2] = __builtin_bit_cast(bf16x8, pw);
                }
#pragma unroll
                for (int ch = 0; ch < DV / 64; ++ch) {
                    bf16x8 vf[2][2];
#pragma unroll
                    for (int k2 = 0; k2 < 2; ++k2)
#pragma unroll
                        for (int c2 = 0; c2 < 2; ++c2) {
                            const LAS unsigned char* vp = Vt + (32 * kb + 16 * k2) * L::VSTR + 64 * (2 * ch + c2);
                            const s16x4 lo = __builtin_bit_cast(s16x4, __builtin_amdgcn_ds_read_tr16_b64_v4i16((LAS s16x4*)(vp)));
                            const s16x4 hh = __builtin_bit_cast(s16x4, __builtin_amdgcn_ds_read_tr16_b64_v4i16((LAS s16x4*)(vp + 8 * L::VSTR)));
                            vf[k2][c2] = (bf16x8){lo[0], lo[1], lo[2], lo[3], hh[0], hh[1], hh[2], hh[3]};
                        }
                    asm volatile("" ::: "memory");
#pragma unroll
                    for (int k2 = 0; k2 < 2; ++k2)
#pragma unroll
                        for (int c2 = 0; c2 < 2; ++c2) o[2 * ch + c2] = __builtin_amdgcn_mfma_f32_32x32x16_bf16(vf[k2][c2], pb[k2], o[2 * ch + c2], 0, 0, 0);
                }
            }
        }
        }
        if (t + 1 < NT2) ATT_STORE(buf ^ 1);
    }
    __syncthreads();
    m_ = m; l_ = l;
#undef ATT_LOAD
#undef ATT_STORE
}

template <int MODE>
__device__ __forceinline__ void attn_phase(LAS unsigned char* lds, const Args& a, int Gn, int cid) {
    constexpr int DQK = MODE == 1 ? 96 : 64, DV = MODE == 2 ? 128 : 64;
    constexpr bool BIAS = MODE != 1;
    constexpr int TABN = MODE == 2 ? 2048 + 256 : 512;
    constexpr int NU = MODE == 0 ? 6144 : (MODE == 2 ? 2048 : 4096);
    constexpr int KT = MODE == 2 ? 64 : 128;
    typedef AttL<DQK, DV, KT> L;
    int tid = threadIdx.x; asm volatile("" : "+v"(tid)); const int lane = tid & 63, r32 = lane & 31, hi = lane >> 5, wid = __builtin_amdgcn_readfirstlane(tid >> 6);
    unsigned char* ws = a.ws;
    const float* biasd = (const float*)(ws + WS_BIAS);
    LAS float* tab = (LAS float*)(lds + L::OFF_TAB);
    float lam = 0.f, lam_init = 0.f;
    if (MODE == 2) {
        float d1 = 0.f, d2 = 0.f;
        for (int i = 0; i < 64; ++i) { d1 += a.in[19][i] * a.in[20][i]; d2 += a.in[21][i] * a.in[22][i]; }
        lam_init = 0.8f - 0.6f * expf(-0.3f * 2.0f);
        lam = expf(d1) - expf(d2) + lam_init;
    }
    for (int u = cid; u < NU; u += Gn) {
        int b, h, dil = 1, res0 = 0, s0, nres = 1, W, qb = 0, g = 0;
        if (MODE == 0) { g = u >> 11; const int rem = u & 2047; b = rem >> 6; h = (rem >> 3) & 7; const int blk = (rem + (u >> 8)) & 7; W = 128;
            if (g == 0) { s0 = 256 * blk; } else if (g == 1) { dil = 4; res0 = blk >> 1; s0 = 256 * (blk & 1); } else { dil = 16; res0 = 2 * blk; s0 = 0; nres = 2; } }
        else if (MODE == 3) { b = u >> 7; h = (u >> 3) & 15; s0 = 256 * ((u + (u >> 8)) & 7); W = 127; }
        else if (MODE == 1) { const int bh = u & 511; qb = 7 - (u >> 9); b = bh >> 4; h = bh & 15; s0 = 256 * qb; W = 1 << 20; }
        else { const int bh = u & 255; qb = 7 - (u >> 8); b = bh >> 3; h = bh & 7; s0 = 256 * qb; W = 1 << 20; }
        TileGeo G;
        G.dil = dil; G.res0 = res0;
        const int Lseg = 256 / nres;
        if (MODE == 0 || MODE == 3) { G.ks0 = (nres == 1 && s0 >= 128) ? s0 - 128 : 0; } else { G.ks0 = 0; }
        G.TPS = (s0 + Lseg - G.ks0) >> 6; G.NT = G.TPS * nres;
        const int nws = 8 / nres, seg_w = wid / nws, wslot_q0 = s0 + 32 * (wid - seg_w * nws);
        int tl = 0;
        if (MODE == 0 || MODE == 3) { tl = wslot_q0 - W - G.ks0; tl = tl < 0 ? 0 : (tl >> 6); }
        const int th = (wslot_q0 + 31 - G.ks0) >> 6;
        const int my_tlo = seg_w * G.TPS + tl, my_thi = seg_w * G.TPS + th;
        const int qtok = res0 + seg_w + dil * (wslot_q0 + r32);
        const size_t row_q = (size_t)b * SEQ + qtok, row_b = (size_t)b * SEQ;
        const bf16 *Qp, *Kb, *Vb; int qpitch, kpitch, vpitch;
        if (MODE == 0) { const bf16* base = (const bf16*)(ws + R_A_QKV); qpitch = kpitch = vpitch = 4608;
            Qp = base + row_q * 4608 + g * 1536 + h * 64; Kb = base + row_b * 4608 + g * 1536 + 512 + h * 64; Vb = base + row_b * 4608 + g * 1536 + 1024 + h * 64; }
        else if (MODE == 1) { qpitch = 1536; kpitch = 1536; vpitch = 2048;
            Qp = (const bf16*)(ws + R_B_Q) + row_q * 1536 + h * 96; Kb = (const bf16*)(ws + R_B_KH) + row_b * 1536 + h * 96; Vb = (const bf16*)(ws + R_B_KV) + row_b * 2048 + h * 128 + 64; }
        else if (MODE == 2) { const bf16* base = (const bf16*)(ws + R_C_QKV); qpitch = kpitch = vpitch = 3072;
            Qp = base + row_q * 3072 + (2 * h) * 64; Kb = base + row_b * 3072 + 1024 + (2 * h) * 64; Vb = base + row_b * 3072 + 2048 + h * 128; }
        else { const bf16* base = (const bf16*)(ws + R_D_QKV); qpitch = kpitch = vpitch = 1280;
            Qp = base + row_q * 1280 + h * 64; Kb = base + row_b * 1280 + 1024 + (h >> 3) * 64; Vb = base + row_b * 1280 + 1152 + (h >> 3) * 64; }
        (void)qpitch;
        if (MODE == 0 || MODE == 3) { const int d_ = tid - 128; tab[tid] = (d_ >= 0 && d_ <= W) ? biasd[h * 2048 + d_ * dil] : -INFINITY; }
        if (MODE == 2) {
#pragma unroll
            for (int j = 0; j < 4; ++j) tab[128 + tid + 512 * j] = biasd[h * 2048 + tid + 512 * j];
            if (tid < 128) { tab[tid] = -INFINITY; tab[2176 + tid] = 0.f; } }
        bf16x8 qf[DQK / 16];
        constexpr int OFF_Q = L::OFF_TAB + TABN * 4, QSTR = DQK * 2 + 16;
        const int qoff = OFF_Q + (32 * wid + r32) * QSTR + hi * 16;
        int tq = tid; asm volatile("" : "+v"(tq));
        if (MODE == 2) {
            const bf16* qsrc = (const bf16*)(ws + R_C_QKV) + (row_b + s0) * 3072 + (2 * h) * 64;
#pragma unroll
            for (int j = 0; j < 4; ++j) { const int c_ = tq + 512 * j, rw = c_ >> 3, p_ = c_ & 7;
                *(LAS u32x4*)(lds + OFF_Q + rw * QSTR + p_ * 16) = *(const u32x4*)(qsrc + (size_t)rw * 3072 + p_ * 8); }
        } else {
#pragma unroll
            for (int ks = 0; ks < DQK / 16; ++ks) qf[ks] = *(const bf16x8*)(Qp + 16 * ks + 8 * hi);
            if (MODE == 1) {
                float x[DQK / 16][8]; float ss = 0.f;
#pragma unroll
                for (int ks = 0; ks < DQK / 16; ++ks) { const u32x4 raw = __builtin_bit_cast(u32x4, qf[ks]);
#pragma unroll
                    for (int j = 0; j < 4; ++j) { x[ks][2 * j] = bflo(raw[j]); x[ks][2 * j + 1] = bfhi(raw[j]); ss += x[ks][2 * j] * x[ks][2 * j] + x[ks][2 * j + 1] * x[ks][2 * j + 1]; } }
                ss += __shfl_xor(ss, 32);
                const float rsq = rsqrtf(ss * (1.0f / 96.0f) + EPS) * (0.10206207261596577f * LOG2E);
                const float* gq_ = a.in[13];
#pragma unroll
                for (int ks = 0; ks < DQK / 16; ++ks) { const f32x4 g0 = *(const f32x4*)(gq_ + 16 * ks + 8 * hi), g1 = *(const f32x4*)(gq_ + 16 * ks + 8 * hi + 4);
#pragma unroll
                    for (int j = 0; j < 4; ++j) { x[ks][j] *= rsq * g0[j]; x[ks][4 + j] *= rsq * g1[j]; } }
                const float* cs = (const float*)(ws + WS_ROPE) + ((size_t)qtok * 16 + 8 * hi) * 2;
#pragma unroll
                for (int j = 0; j < 8; ++j) { const float co = cs[2 * j], si = cs[2 * j + 1], x1 = x[4][j], x2 = x[5][j]; x[4][j] = x1 * co - x2 * si; x[5][j] = x2 * co + x1 * si; }
#pragma unroll
                for (int ks = 0; ks < DQK / 16; ++ks) { u32x4 w;
#pragma unroll
                    for (int j = 0; j < 4; ++j) w[j] = pk2(x[ks][2 * j], x[ks][2 * j + 1]);
                    qf[ks] = __builtin_bit_cast(bf16x8, w); }
            }
        }
        f32x16 o[DV / 32];
#pragma unroll
        for (int c = 0; c < DV / 32; ++c)
#pragma unroll
            for (int r = 0; r < 16; ++r) o[c][r] = 0.f;
        float m = -INFINITY, l = 0.f;
        if (MODE == 3) { m = a.in[28][h] * LOG2E; l = hi == 0 ? 1.f : 0.f; }
        attn_pass<DQK, DV, BIAS, TABN, MODE == 2, KT>(qoff, lds, Kb, kpitch, Vb, vpitch, G, my_tlo, my_thi, wslot_q0, W, qf, m, l, o);
        float lt = l + __shfl_xor(l, 32);
        float inv = 1.0f / lt;
        if (MODE != 2) {
            bf16* Op; int opitch;
            if (MODE == 0) { Op = (bf16*)(ws + R_A_O3) + ((size_t)g * M_ + row_q) * 512 + h * 64; opitch = 512;
                if (hi == 0) ((float*)(ws + R_A_LSE))[((size_t)g * M_ + row_q) * 8 + h] = m + __log2f(lt); }
            else if (MODE == 1) { Op = (bf16*)(ws + R_B_O) + row_q * 1024 + h * 64; opitch = 1024; }
            else { Op = (bf16*)(ws + R_D_O) + row_q * 1024 + h * 64; opitch = 1024; }
            (void)opitch;
#pragma unroll
            for (int c = 0; c < DV / 32; ++c)
#pragma unroll
                for (int k = 0; k < 2; ++k) {
                    u32x2 we, wo; we.x = pk2(o[c][8 * k] * inv, o[c][8 * k + 1] * inv); we.y = pk2(o[c][8 * k + 2] * inv, o[c][8 * k + 3] * inv);
                    wo.x = pk2(o[c][8 * k + 4] * inv, o[c][8 * k + 5] * inv); wo.y = pk2(o[c][8 * k + 6] * inv, o[c][8 * k + 7] * inv);
                    const u32x2 snd = hi ? we : wo, mine = hi ? wo : we;
                    u32x2 rcv; rcv.x = __shfl_xor(snd.x, 32); rcv.y = __shfl_xor(snd.y, 32);
                    u32x4 w; if (hi) { w.x = rcv.x; w.y = rcv.y; w.z = mine.x; w.w = mine.y; } else { w.x = mine.x; w.y = mine.y; w.z = rcv.x; w.w = rcv.y; }
                    *(u32x4*)(Op + 32 * c + 8 * (2 * k + hi)) = w;
                }
        } else {
            f32x16 o1[DV / 32];
#pragma unroll
            for (int c = 0; c < DV / 32; ++c)
#pragma unroll
                for (int r = 0; r < 16; ++r) { o1[c][r] = o[c][r] * inv; o[c][r] = 0.f; }
#pragma unroll
            for (int j = 0; j < 4; ++j) tab[128 + tid + 512 * j] = biasd[(8 + h) * 2048 + tid + 512 * j];
            { const bf16* qsrc = (const bf16*)(ws + R_C_QKV) + (row_b + s0) * 3072 + (2 * h + 1) * 64;
#pragma unroll
              for (int j = 0; j < 4; ++j) { const int c_ = tq + 512 * j, rw = c_ >> 3, p_ = c_ & 7;
                  *(LAS u32x4*)(lds + OFF_Q + rw * QSTR + p_ * 16) = *(const u32x4*)(qsrc + (size_t)rw * 3072 + p_ * 8); } }
            m = -INFINITY; l = 0.f;
            attn_pass<DQK, DV, BIAS, TABN, MODE == 2, KT>(qoff, lds, Kb + 64, kpitch, Vb, vpitch, G, my_tlo, my_thi, wslot_q0, W, qf, m, l, o);
            lt = l + __shfl_xor(l, 32);
            inv = lam / lt;
            float ssum = 0.f;
#pragma unroll
            for (int c = 0; c < DV / 32; ++c)
#pragma unroll
                for (int r = 0; r < 16; ++r) { const float d = o1[c][r] - o[c][r] * inv; o1[c][r] = d; ssum += d * d; }
            ssum += __shfl_xor(ssum, 32);
            const float rs = rsqrtf(ssum * (1.0f / 128.0f) + EPS) * (1.0f - lam_init);
            bf16* Op = (bf16*)(ws + R_C_O) + row_q * 1024 + h * 128;
            const float* sub = a.in[23];
#pragma unroll
            for (int c = 0; c < DV / 32; ++c)
#pragma unroll
                for (int k = 0; k < 2; ++k) {
                    const f32x4 se = *(const f32x4*)(sub + 32 * c + 16 * k + 4 * hi), so = *(const f32x4*)(sub + 32 * c + 16 * k + 8 + 4 * hi);
                    u32x2 we, wo; we.x = pk2(o1[c][8 * k] * rs * se[0], o1[c][8 * k + 1] * rs * se[1]); we.y = pk2(o1[c][8 * k + 2] * rs * se[2], o1[c][8 * k + 3] * rs * se[3]);
                    wo.x = pk2(o1[c][8 * k + 4] * rs * so[0], o1[c][8 * k + 5] * rs * so[1]); wo.y = pk2(o1[c][8 * k + 6] * rs * so[2], o1[c][8 * k + 7] * rs * so[3]);
                    const u32x2 snd = hi ? we : wo, mine = hi ? wo : we;
                    u32x2 rcv; rcv.x = __shfl_xor(snd.x, 32); rcv.y = __shfl_xor(snd.y, 32);
                    u32x4 w; if (hi) { w.x = rcv.x; w.y = rcv.y; w.z = mine.x; w.w = mine.y; } else { w.x = mine.x; w.y = mine.y; w.z = rcv.x; w.w = rcv.y; }
                    *(u32x4*)(Op + 32 * c + 8 * (2 * k + hi)) = w;
                }
        }
    }
}

__device__ __forceinline__ void transpose_item(const float* W, int ldw, int ncol0, int K, const float* ksc, bf16* WT, int mode, LAS float* scr, int nblk, int item, int lane) {
    const int kb = item / nblk, nb = item - kb * nblk, k0 = 64 * kb, n0 = 32 * nb;
#pragma unroll
    for (int i = 0; i < 32; ++i) { const int kk = 2 * i + (lane >> 5); float v = W[(size_t)(k0 + kk) * ldw + ncol0 + n0 + (lane & 31)]; if (ksc != nullptr) v *= ksc[k0 + kk]; scr[kk * 33 + (lane & 31)] = v; }
    asm volatile("s_waitcnt lgkmcnt(0)" ::: "memory");
    const int drow0 = mode == 1 ? (256 * (n0 >> 8) + 128 * ((n0 & 63) >> 5) + 32 * ((n0 >> 6) & 3)) : mode == 2 ? (n0 < DFF ? 256 * (n0 >> 7) + (n0 & 127) : 256 * ((n0 - DFF) >> 7) + 128 + ((n0 - DFF) & 127)) : n0;
    const int c = lane & 7;
#pragma unroll
    for (int j = 0; j < 4; ++j) { const int n = (lane >> 3) + 8 * j; const LAS float* s = scr + (8 * c) * 33 + n;
        u32x4 o; o.x = pk2(s[0 * 33], s[1 * 33]); o.y = pk2(s[2 * 33], s[3 * 33]); o.z = pk2(s[4 * 33], s[5 * 33]); o.w = pk2(s[6 * 33], s[7 * 33]);
        *(u32x4*)(WT + (size_t)(drow0 + n) * K + k0 + 8 * c) = o; }
    asm volatile("s_waitcnt lgkmcnt(0)" ::: "memory");
}
__device__ __forceinline__ void prologue(LAS unsigned char* lds, const Args& a, int Gn, int cid) {
    int tid = threadIdx.x; asm volatile("" : "+v"(tid)); const int lane = tid & 63, wid = __builtin_amdgcn_readfirstlane(tid >> 6);
    unsigned char* ws = a.ws;
    LAS float* scr = (LAS float*)(lds + wid * 16384);
    const int gw = cid * 8 + wid, NGW = Gn * 8;
#define MAT_DESC(id) \
        const float* W; int ldw, ncol0 = 0, K, N, mode; const float* ksc = nullptr; size_t dst; \
        if (id == 0) { W = a.in[4]; ldw = 4608; K = 1024; N = 4608; ksc = a.in[2]; dst = W_AIN; mode = 1; } \
        else if (id == 1) { W = a.in[7]; ldw = 1024; K = 512; N = 1024; dst = W_AOUT; mode = 0; } \
        else if (id == 2) { W = a.in[8]; ldw = 672; K = 1024; N = 672; ksc = a.in[2] + 1024; dst = W_BIN; mode = 1; } \
        else if (id == 3) { W = a.in[11]; ldw = 1536; K = 384; N = 1536; ksc = a.in[9]; dst = W_BQUP; mode = 1; } \
        else if (id == 4) { W = a.in[12]; ldw = 2048; K = 256; N = 2048; ksc = a.in[10]; dst = W_BKVUP; mode = 1; } \
        else if (id == 5) { W = a.in[15]; ldw = 1024; K = 1024; N = 1024; dst = W_BOUT; mode = 0; } \
        else if (id == 6) { W = a.in[16]; ldw = 3072; K = 1024; N = 3072; ksc = a.in[2] + 2048; dst = W_CIN; mode = 1; } \
        else if (id == 7) { W = a.in[24]; ldw = 1024; K = 1024; N = 1024; dst = W_COUT; mode = 0; } \
        else if (id == 8) { W = a.in[25]; ldw = 1280; K = 1024; N = 1280; ksc = a.in[2] + 3072; dst = W_DIN; mode = 1; } \
        else if (id == 9) { W = a.in[29]; ldw = 1024; K = 1024; N = 1024; dst = W_DOUT; mode = 0; } \
        else { const int l = (id - 10) / 3, k3 = (id - 10) - 3 * l; \
            if (k3 < 2) { W = a.in[30] + (size_t)l * 1024 * 5632; ldw = 5632; K = 1024; N = 5632; ksc = a.in[3] + 1024 * l; dst = W_FG + l * 2 * W_FSTR; mode = 2; } \
            else { W = a.in[33] + (size_t)l * 2816 * 1024; ldw = 1024; K = 2816; N = 1024; dst = W_FD + l * W_FSTR; mode = 0; } }
    constexpr int TOTAL_ITEMS = 2304 + 256 + 336 + 288 + 256 + 512 + 1536 + 512 + 640 + 512 + 4 * (1408 + 1408 + 1408);
    for (int it = gw; it < TOTAL_ITEMS; it += NGW) {
        int r = it, id = 0;
        for (; id < 21; ++id) {
            int n_;
            if (id < 10) { n_ = id == 0 ? 2304 : id == 1 ? 256 : id == 2 ? 336 : id == 3 ? 288 : id == 4 ? 256 : id == 5 ? 512 : id == 6 ? 1536 : id == 7 ? 512 : id == 8 ? 640 : 512; } else { const int k3_ = (id - 10) % 3; n_ = k3_ == 0 ? 2816 : (k3_ == 1 ? 0 : 1408); }
            if (r < n_) break;
            r -= n_;
        }
        MAT_DESC(id)
        const int nblk = N / 32;
        transpose_item(W, ldw, ncol0, K, ksc, (bf16*)(ws + dst), mode, scr, nblk, r, lane);
    }
#undef MAT_DESC
    const int gt = cid * 512 + tid, NT = Gn * 512;
    { float* biasd = (float*)(ws + WS_BIAS); const float* table = a.in[1];
      for (int i = gt; i < 16 * 2048; i += NT) { const int h = i >> 11, d = i & 2047; int bk = d;
          if (d >= 16) { float t = logf((float)d / 16.0f); t = t / 4.852030263919617f; t = t * 16.0f; int lg = 16 + (int)t; bk = lg < 31 ? lg : 31; }
          biasd[i] = table[bk * 16 + h] * LOG2E; } }
    { float* rope = (float*)(ws + WS_ROPE);
      for (int i = gt; i < 2048 * 16; i += NT) { const int pos = i >> 4, f = i & 15; const float inv = powf(10000.0f, -(float)(2 * f) / 32.0f); const float ang = (float)pos * inv;
          rope[2 * i] = cosf(ang); rope[2 * i + 1] = sinf(ang); } }
    { const float* x = a.in[0]; bf16* xb = (bf16*)(ws + WS_XB); float* rss = (float*)(ws + WS_RSS);
      for (int m0 = gw; m0 < M_; m0 += 4 * NGW) {
          f32x4 v[4][4];
#pragma unroll
          for (int k = 0; k < 4; ++k) { const int m = m0 + k * NGW; if (m < M_) { const f32x4* xr = (const f32x4*)(x + (size_t)m * DMODEL) + lane;
#pragma unroll
              for (int j = 0; j < 4; ++j) v[k][j] = xr[64 * j]; } }
#pragma unroll
          for (int k = 0; k < 4; ++k) { const int m = m0 + k * NGW; if (m < M_) { u32x2* o8 = (u32x2*)(xb + (size_t)m * DMODEL) + lane; float s = 0.f;
#pragma unroll
              for (int j = 0; j < 4; ++j) { s += dot4(v[k][j]); u32x2 w; w.x = pk2(v[k][j][0], v[k][j][1]); w.y = pk2(v[k][j][2], v[k][j][3]); o8[64 * j] = w; }
              s = wave_sum(s); if (lane == 0) rss[m] = rsqrtf(s * (1.0f / 1024.0f) + EPS); } } } }
}
__device__ __forceinline__ void combine_a(const Args& a, int Gn, int cid) {
    unsigned char* ws = a.ws;
    const bf16* o3 = (const bf16*)(ws + R_A_O3); const float* lse = (const float*)(ws + R_A_LSE); bf16* oc = (bf16*)(ws + R_A_OC);
    const size_t NT = (size_t)Gn * 512; int tid = threadIdx.x; asm volatile("" : "+v"(tid));
    for (size_t idx0 = (size_t)cid * 512 + tid; idx0 < (size_t)M_ * 64; idx0 += 4 * NT) {
        u32x4 a0[4], a1[4], a2[4]; float l0[4], l1[4], l2[4];
#pragma unroll
        for (int k = 0; k < 4; ++k) { const size_t idx = idx0 + k * NT; if (idx < (size_t)M_ * 64) {
            const size_t row = idx >> 6; const int ch = (int)(idx & 63), h = ch >> 3;
            l0[k] = lse[row * 8 + h]; l1[k] = lse[((size_t)M_ + row) * 8 + h]; l2[k] = lse[((size_t)2 * M_ + row) * 8 + h];
            a0[k] = *(const u32x4*)(o3 + row * 512 + ch * 8); a1[k] = *(const u32x4*)(o3 + ((size_t)M_ + row) * 512 + ch * 8); a2[k] = *(const u32x4*)(o3 + ((size_t)2 * M_ + row) * 512 + ch * 8); } }
#pragma unroll
        for (int k = 0; k < 4; ++k) { const size_t idx = idx0 + k * NT; if (idx < (size_t)M_ * 64) {
            const size_t row = idx >> 6; const int ch = (int)(idx & 63);
            const float mx = fmaxf(l0[k], fmaxf(l1[k], l2[k]));
            float w0 = __builtin_amdgcn_exp2f(l0[k] - mx), w1 = __builtin_amdgcn_exp2f(l1[k] - mx), w2 = __builtin_amdgcn_exp2f(l2[k] - mx);
            const float inv = 1.0f / (w0 + w1 + w2); w0 *= inv; w1 *= inv; w2 *= inv;
            u32x4 r;
#pragma unroll
            for (int j = 0; j < 4; ++j) r[j] = pk2(w0 * bflo(a0[k][j]) + w1 * bflo(a1[k][j]) + w2 * bflo(a2[k][j]), w0 * bfhi(a0[k][j]) + w1 * bfhi(a1[k][j]) + w2 * bfhi(a2[k][j]));
            *(u32x4*)(oc + row * 512 + ch * 8) = r; } }
    }
}
__device__ __forceinline__ void prep_b(const Args& a, int Gn, int cid) {
    unsigned char* ws = a.ws;
    int tid = threadIdx.x; asm volatile("" : "+v"(tid)); const int lane = tid & 63, wid = __builtin_amdgcn_readfirstlane(tid >> 6);
    bf16* Q = (bf16*)(ws + R_B_Q); const bf16* KV = (const bf16*)(ws + R_B_KV); const bf16* KPE = (const bf16*)(ws + R_B_KPE); bf16* KH = (bf16*)(ws + R_B_KH);
    const float* rope = (const float*)(ws + WS_ROPE);
    const int sub = lane >> 4, c = lane & 15;
    const float qscale = 0.10206207261596577f * LOG2E;
    const int gw = cid * 8 + wid, NGW = Gn * 8;
    const int TOT = 2 * M_ * 4;
    for (int it0 = M_ * 4 + gw; it0 < TOT; it0 += 4 * NGW) {
        u32x4 raw[4];
#pragma unroll
        for (int k = 0; k < 4; ++k) {
            const int it = it0 + k * NGW;
            raw[k] = (u32x4){0u, 0u, 0u, 0u};
            if (it < TOT && c < 12) {
                const bool isk = it >= M_ * 4; const int it2 = isk ? it - M_ * 4 : it;
                const int task = it2 * 4 + sub; const size_t row = (size_t)(task >> 4); const int h = task & 15;
                if (!isk) raw[k] = *(const u32x4*)(Q + row * 1536 + h * 96 + 8 * c);
                else if (c < 8) raw[k] = *(const u32x4*)(KV + row * 2048 + h * 128 + 8 * c);
                else raw[k] = *(const u32x4*)(KPE + row * 64 + 8 * (c - 8));
            }
        }
#pragma unroll
        for (int k = 0; k < 4; ++k) {
            const int it = it0 + k * NGW;
            if (it < TOT) {
                const bool isk = it >= M_ * 4; const int it2 = isk ? it - M_ * 4 : it;
                const int task = it2 * 4 + sub; const size_t row = (size_t)(task >> 4); const int h = task & 15; const int pos = (int)(row & 2047);
                float x[8];
#pragma unroll
                for (int j = 0; j < 4; ++j) { x[2 * j] = bflo(raw[k][j]); x[2 * j + 1] = bfhi(raw[k][j]); }
                float ss = 0.f;
#pragma unroll
                for (int e = 0; e < 8; ++e) ss += x[e] * x[e];
                ss += __shfl_xor(ss, 1); ss += __shfl_xor(ss, 2); ss += __shfl_xor(ss, 4); ss += __shfl_xor(ss, 8);
                const float rs = rsqrtf(ss * (1.0f / 96.0f) + EPS);
                const float* gain = (isk ? a.in[14] : a.in[13]) + 8 * (c < 12 ? c : 0);
                const float* cs = rope + ((size_t)pos * 16 + (c & 1) * 8) * 2;
                float y[8];
#pragma unroll
                for (int e = 0; e < 8; ++e) y[e] = x[e] * rs * gain[e];
#pragma unroll
                for (int e = 0; e < 8; ++e) {
                    const float z = __shfl_xor(y[e], 2);
                    if (c >= 8 && c < 12) { const float co = cs[2 * e], si = cs[2 * e + 1]; y[e] = (c < 10) ? (y[e] * co - z * si) : (y[e] * co + z * si); }
                }
                if (c < 12) {
                    u32x4 w;
                    if (!isk) {
#pragma unroll
                        for (int j = 0; j < 4; ++j) w[j] = pk2(y[2 * j] * qscale, y[2 * j + 1] * qscale);
                        *(u32x4*)(Q + row * 1536 + h * 96 + 8 * c) = w;
                    } else {
#pragma unroll
                        for (int j = 0; j < 4; ++j) w[j] = pk2(y[2 * j], y[2 * j + 1]);
                        *(u32x4*)(KH + row * 1536 + h * 96 + 8 * c) = w;
                    }
                }
            }
        }
    }
}

__device__ __forceinline__ void fixup_ffn(const bf16* gedge, const bf16* uedge, bf16* act, const float* cw, const float* cb, int Gn, int cid) {
    int tid = threadIdx.x; asm volatile("" : "+v"(tid));
    const int TOT = 1024 * 2 * 352;
    for (int idx = cid * 512 + tid; idx < TOT; idx += Gn * 512) {
        const int ch = idx % 352, sj = idx / 352, j = sj & 1, st = sj >> 1, c0 = ch * 8;
        const int row = st * 64 + j, t = row & (SEQ - 1);
        const u32x4 z = (u32x4){0u, 0u, 0u, 0u};
        const u32x4 g0 = *(const u32x4*)(gedge + ((size_t)st * 4 + j) * DFF + c0);
        u32x4 g1, g2;
        if (j == 0) { g1 = t >= 1 ? *(const u32x4*)(gedge + ((size_t)(st - 1) * 4 + 3) * DFF + c0) : z; g2 = t >= 2 ? *(const u32x4*)(gedge + ((size_t)(st - 1) * 4 + 2) * DFF + c0) : z; }
        else { g1 = *(const u32x4*)(gedge + ((size_t)st * 4 + 0) * DFF + c0); g2 = t >= 2 ? *(const u32x4*)(gedge + ((size_t)(st - 1) * 4 + 3) * DFF + c0) : z; }
        const u32x4 uw = *(const u32x4*)(uedge + ((size_t)st * 2 + j) * DFF + c0);
        u32x4 w;
#pragma unroll
        for (int n = 0; n < 2; ++n) {
            const f32x4 w0 = *(const f32x4*)(cw + c0 + 4 * n), w1 = *(const f32x4*)(cw + DFF + c0 + 4 * n), w2 = *(const f32x4*)(cw + 2 * DFF + c0 + 4 * n), b = *(const f32x4*)(cb + c0 + 4 * n);
            float r[4];
#pragma unroll
            for (int e = 0; e < 4; ++e) {
                const unsigned q0 = g0[2 * n + (e >> 1)], q1 = g1[2 * n + (e >> 1)], q2 = g2[2 * n + (e >> 1)], qu = uw[2 * n + (e >> 1)];
                const float x0 = (e & 1) ? bfhi(q0) : bflo(q0), x1 = (e & 1) ? bfhi(q1) : bflo(q1), x2 = (e & 1) ? bfhi(q2) : bflo(q2), up = (e & 1) ? bfhi(qu) : bflo(qu);
                const float cv = b[e] + w2[e] * x0 + w1[e] * x1 + w0[e] * x2;
                r[e] = cv * __builtin_amdgcn_rcpf(1.0f + __builtin_amdgcn_exp2f(-LOG2E * cv)) * up;
            }
            w[2 * n] = pk2(r[0], r[1]); w[2 * n + 1] = pk2(r[2], r[3]);
        }
        *(u32x4*)(act + (size_t)row * DFF + c0) = w;
    }
}
__device__ __forceinline__ void rstd_pass(const float* ssp, int nvec, float invdim, float* rs, int Gn, int cid) {
    int tid = threadIdx.x; asm volatile("" : "+v"(tid));
    for (int row = cid * 512 + tid; row < M_; row += Gn * 512) rs[row] = rsqrtf(rowss_sum(ssp, nvec, row) * invdim + EPS);
}
__device__ __forceinline__ void kpe_pass(const Args& a, int Gn, int cid) {
    unsigned char* ws = a.ws;
    int tid = threadIdx.x; asm volatile("" : "+v"(tid));
    const bf16* KPE = (const bf16*)(ws + R_B_KPE); bf16* RK = (bf16*)(ws + R_B_RK); float* sspe = (float*)(ws + WS_SSPE);
    const float* rope = (const float*)(ws + WS_ROPE); const float* gk = a.in[14] + 64;
    for (int row = cid * 512 + tid; row < M_; row += Gn * 512) {
        float x[32]; float ss = 0.f;
#pragma unroll
        for (int c = 0; c < 4; ++c) { const u32x4 raw = *(const u32x4*)(KPE + (size_t)row * 64 + 8 * c);
#pragma unroll
            for (int j = 0; j < 4; ++j) { x[8 * c + 2 * j] = bflo(raw[j]); x[8 * c + 2 * j + 1] = bfhi(raw[j]); } }
#pragma unroll
        for (int i = 0; i < 32; ++i) { ss += x[i] * x[i]; x[i] *= gk[i]; }
        sspe[row] = ss;
        const float* cs = rope + (size_t)(row & (SEQ - 1)) * 32;
#pragma unroll
        for (int i = 0; i < 16; ++i) { const float co = cs[2 * i], si = cs[2 * i + 1], x1 = x[i], x2 = x[16 + i]; x[i] = x1 * co - x2 * si; x[16 + i] = x2 * co + x1 * si; }
#pragma unroll
        for (int c = 0; c < 4; ++c) { u32x4 w;
#pragma unroll
            for (int j = 0; j < 4; ++j) w[j] = pk2(x[8 * c + 2 * j], x[8 * c + 2 * j + 1]);
            *(u32x4*)(RK + (size_t)row * 32 + 8 * c) = w; }
    }
}
__device__ __forceinline__ void rstd_local(const float* ssp, float* rs, const pg8::StaticOrder& S, int nunits) {
    int tid = threadIdx.x; asm volatile("" : "+v"(tid));
    const int TOT = nunits * 256;
    for (int k0 = tid; k0 < TOT; k0 += 2 * 512) {
        float p[2][16]; int rows[2];
#pragma unroll
        for (int j = 0; j < 2; ++j) { const int k = k0 + j * 512; rows[j] = -1;
            if (k < TOT) { pg8::Unit uu; S.next(k >> 8, uu); rows[j] = uu.pm * 256 + (k & 255);
#pragma unroll
                for (int v = 0; v < 16; ++v) p[j][v] = ssp[(size_t)v * M_ + rows[j]]; } }
#pragma unroll
        for (int j = 0; j < 2; ++j) if (rows[j] >= 0) { float t = 0.f;
#pragma unroll
            for (int v = 0; v < 16; v += 4) t += (p[j][v] + p[j][v + 1]) + (p[j][v + 2] + p[j][v + 3]);
            rs[rows[j]] = rsqrtf(t * (1.0f / 1024.0f) + EPS); }
    }
    asm volatile("s_waitcnt vmcnt(0)" ::: "memory");
    __syncthreads();
}
__device__ __forceinline__ void grid_barrier(unsigned* cnt, unsigned& epoch, unsigned G) {
    asm volatile("s_waitcnt vmcnt(0) lgkmcnt(0)" ::: "memory");
    __syncthreads();
    epoch += 1u;
    if (threadIdx.x == 0) {
        __builtin_amdgcn_fence(__ATOMIC_RELEASE, "agent");
        asm volatile("s_waitcnt vmcnt(0)" ::: "memory");
        __hip_atomic_fetch_add(cnt + 64u * (blockIdx.x & 15u), 1u, __ATOMIC_RELAXED, __HIP_MEMORY_SCOPE_AGENT);
        const unsigned want = epoch * G;
        for (;;) {
            unsigned sum = 0u;
#pragma unroll
            for (unsigned j = 0; j < 16u; ++j) sum += __hip_atomic_load(cnt + 64u * j, __ATOMIC_RELAXED, __HIP_MEMORY_SCOPE_AGENT);
            if (sum >= want) break;
            __builtin_amdgcn_s_sleep(2);
        }
        __builtin_amdgcn_fence(__ATOMIC_ACQUIRE, "agent");
        asm volatile("s_waitcnt vmcnt(0)" ::: "memory");
    }
    __syncthreads();
}
__global__ void __launch_bounds__(512) fwd_kernel(Args a) {
    extern __shared__ __attribute__((aligned(16))) unsigned char lds_raw[];
    LAS unsigned char* lds = (LAS unsigned char*)lds_raw;
    cg::grid_group grid = cg::this_grid();
    const int Gn = (int)gridDim.x, cid = (int)blockIdx.x;
    unsigned char* ws = a.ws;
    unsigned* barcnt = (unsigned*)(ws + WS_BAR); unsigned epoch = 0u;
    prologue(lds, a, Gn, cid);
    grid.sync();
    grid_barrier(barcnt, epoch, (unsigned)Gn);
    bf16* XB = (bf16*)(ws + WS_XB);
    float* RSS = (float*)(ws + WS_RSSP); float* RSTD = (float*)(ws + WS_RSS);
    for (int ph = 0; ph < 28; ++ph) {
        int type = 0, N = 1024, K = 1024, ldc = 0, hm = 0, layer = 0, sidx = 0, nvec = 4, pbuf = -1;
        const bf16 *A = XB, *Bt = nullptr; bf16* pO = nullptr; const float* pss = RSTD; const float *gq = nullptr, *gk = nullptr; float qs = 0.125f * LOG2E;
        const float* rbase = nullptr; float* rout = nullptr; bf16* rxb = XB; float* rssn = nullptr;
        int f = -1;
        switch (ph) {
        case 0: type = 0; Bt = (const bf16*)(ws + W_AIN); N = 4608; pO = (bf16*)(ws + R_A_QKV); ldc = 4608; hm = 1; gq = a.in[5]; gk = a.in[6]; break;
        case 1: type = 4; break;
        case 2: type = 8; break;
        case 3: type = 1; A = (const bf16*)(ws + R_A_OC); Bt = (const bf16*)(ws + W_AOUT); K = 512; rbase = a.in[0]; rssn = RSS + 1 * (size_t)M_ * 16; break;
        case 4: case 5: case 6: layer = 0; sidx = 1; f = ph - 4; break;
        case 7: type = 2; Bt = (const bf16*)(ws + W_BIN); N = 768; pbuf = 0; break;
        case 8: type = 0; A = (const bf16*)(ws + R_B_CQ); Bt = (const bf16*)(ws + W_BQUP); N = 1536; K = 384; pO = (bf16*)(ws + R_B_Q); ldc = 1536; pss = (const float*)(ws + WS_SSQ); break;
        case 9: type = 10; break;
        case 10: type = 10; break;
        case 11: type = 5; break;
        case 12: type = 1; A = (const bf16*)(ws + R_B_O); Bt = (const bf16*)(ws + W_BOUT); rssn = RSS + 1 * (size_t)M_ * 16; break;
        case 13: case 14: case 15: layer = 1; sidx = 3; f = ph - 13; break;
        case 16: type = 0; Bt = (const bf16*)(ws + W_CIN); N = 3072; pO = (bf16*)(ws + R_C_QKV); ldc = 3072; pbuf = 0; hm = 2; gq = a.in[17]; gk = a.in[18]; break;
        case 17: type = 6; break;
        case 18: type = 1; A = (const bf16*)(ws + R_C_O); Bt = (const bf16*)(ws + W_COUT); rssn = RSS + 1 * (size_t)M_ * 16; break;
        case 19: case 20: case 21: layer = 2; sidx = 5; f = ph - 19; break;
        case 22: type = 0; Bt = (const bf16*)(ws + W_DIN); N = 1280; pO = (bf16*)(ws + R_D_QKV); ldc = 1280; pbuf = 0; hm = 3; gq = a.in[26]; gk = a.in[27]; break;
        case 23: type = 7; break;
        case 24: type = 1; A = (const bf16*)(ws + R_D_O); Bt = (const bf16*)(ws + W_DOUT); rssn = RSS + 1 * (size_t)M_ * 16; break;
        default: layer = 3; sidx = 7; f = ph - 25; break;
        }
        if (f == 0) { type = 3; Bt = (const bf16*)(ws + W_FG + layer * 2 * W_FSTR); N = 2 * DFF; pbuf = 1; }
        else if (f == 1) { type = 11; }
        else if (f == 2) { type = 1; A = (const bf16*)(ws + R_ACT); Bt = (const bf16*)(ws + W_FD + layer * W_FSTR); K = DFF;
            if (layer < 3) { rssn = RSS + ((sidx + 1) & 1) * (size_t)M_ * 16; } else { rssn = nullptr; rxb = nullptr; rout = a.out; } }

        if (type == 10) continue;
        if (type <= 3) {
            pg8::Gemm g{A, Bt, M_, N, K}; pg8::StaticOrder S; S.init(M_, N, Gn, cid);
            if (pbuf >= 0) rstd_local(RSS + (size_t)pbuf * M_ * 16, RSTD, S, (S.nwg - cid + Gn - 1) / Gn);
            if (type == 0) {
                for (int sub = 0; sub < (ph == 8 ? 2 : 1); ++sub) {
                    const bool kv = (sub == 1);
                    const pg8::Gemm g2{kv ? (const bf16*)(ws + R_B_CKV) : A, kv ? (const bf16*)(ws + W_BKVUP) : Bt, M_, kv ? 2048 : N, kv ? 256 : K};
                    pg8::StaticOrder S2; S2.init(M_, kv ? 2048 : N, Gn, cid);
                    const EpiProj E{kv ? (bf16*)(ws + R_B_KV) : pO, kv ? 2048 : ldc, kv ? (const float*)(ws + WS_SSKV) : pss, kv ? 4 : hm, gq, kv ? a.in[14] : gk, qs};
                    pg8::gemm_phase<EpiProj, pg8::StaticOrder, true, true>(lds, g2, S2, E);
                }
            }
            else if (type == 1) { EpiRes E{rbase, rout, XB, rxb, rssn}; pg8::gemm_phase<EpiRes, pg8::StaticOrder, true, true>(lds, g, S, E); }
            else if (type == 2) { EpiLat E{(bf16*)(ws + R_B_CQ), (bf16*)(ws + R_B_CKV), (bf16*)(ws + R_B_KPE), pss, (float*)(ws + WS_SSQP), (float*)(ws + WS_SSKVP)}; pg8::gemm_phase<EpiLat, pg8::StaticOrder, true, true>(lds, g, S, E); }
            else { EpiGateUp E{(bf16*)(ws + R_ACT), (bf16*)(ws + R_GATE), (bf16*)(ws + R_GATE + 32 * MiB), pss, a.in[31] + (size_t)layer * 3 * DFF, a.in[32] + (size_t)layer * DFF}; pg8::gemm_phase<EpiGateUp, pg8::StaticOrder, true, true>(lds, g, S, E); }
        }
        else if (type == 4) attn_phase<0>(lds, a, Gn, cid);
        else if (type == 5) attn_phase<1>(lds, a, Gn, cid);
        else if (type == 6) attn_phase<2>(lds, a, Gn, cid);
        else if (type == 7) attn_phase<3>(lds, a, Gn, cid);
        else if (type == 8) combine_a(a, Gn, cid);
        else if (type == 11) fixup_ffn((const bf16*)(ws + R_GATE), (const bf16*)(ws + R_GATE + 32 * MiB), (bf16*)(ws + R_ACT), a.in[31] + (size_t)layer * 3 * DFF, a.in[32] + (size_t)layer * DFF, Gn, cid);
        else prep_b(a, Gn, cid);
        grid_barrier(barcnt, epoch, (unsigned)Gn);
        if (type == 2) { rstd_pass((const float*)(ws + WS_SSQP), 2, 1.0f / 384.0f, (float*)(ws + WS_SSQ), Gn, cid); rstd_pass((const float*)(ws + WS_SSKVP), 1, 1.0f / 256.0f, (float*)(ws + WS_SSKV), Gn, cid); kpe_pass(a, Gn, cid);
            grid_barrier(barcnt, epoch, (unsigned)Gn); }
    }
}

extern "C" void kernel_launch(void* const* d_in, const int* in_sizes, int n_in, void* d_out, int out_size, void* d_ws, size_t ws_size, hipStream_t stream) {
    static int grid = 0;
    if (grid == 0) {
        if (n_in != 34 || out_size != M_ * DMODEL || ws_size < WS_NEED) { fprintf(stderr, "kernel_launch: unexpected shapes (n_in %d out %d ws %zu)\n", n_in, out_size, ws_size); grid = -1; return; }
        int dev = 0, cus = 0, per_cu = 0;
        if (hipGetDevice(&dev) != hipSuccess || hipDeviceGetAttribute(&cus, hipDeviceAttributeMultiprocessorCount, dev) != hipSuccess) { grid = -1; return; }
        if (hipFuncSetAttribute((const void*)fwd_kernel, hipFuncAttributeMaxDynamicSharedMemorySize, LDS_BYTES) != hipSuccess) { fprintf(stderr, "kernel_launch: hipFuncSetAttribute failed\n"); grid = -1; return; }
        if (hipOccupancyMaxActiveBlocksPerMultiprocessor(&per_cu, (const void*)fwd_kernel, 512, LDS_BYTES) != hipSuccess || per_cu < 1) { fprintf(stderr, "kernel_launch: occupancy query says %d\n", per_cu); per_cu = 1; }
        (void)hipGetLastError();
        grid = cus;
    }
    if (grid < 0) return;
    if (hipMemsetAsync((unsigned char*)d_ws + WS_BAR, 0, 4096, stream) != hipSuccess) { fprintf(stderr, "kernel_launch: memset failed\n"); return; }
    Args a{};
    for (int i = 0; i < 34; ++i) a.in[i] = (const float*)d_in[i];
    a.out = (float*)d_out; a.ws = (unsigned char*)d_ws;
    void* args[] = {&a};
    hipError_t e = hipLaunchCooperativeKernel((const void*)fwd_kernel, dim3(grid), dim3(512), args, LDS_BYTES, stream);
    if (e != hipSuccess) fprintf(stderr, "cooperative launch failed: %s (grid %d)\n", hipGetErrorString(e), grid);
}
```

```cpp
#include <hip/hip_runtime.h>
#include <hip/hip_cooperative_groups.h>
#include <cstdio>
#include <cstdint>
namespace cg = cooperative_groups;
namespace pg8 {
#define PG8_LAS __attribute__((address_space(3)))
typedef unsigned short bf16_t;
typedef short bf16x8 __attribute__((ext_vector_type(8)));
typedef float f32x4 __attribute__((ext_vector_type(4)));
typedef unsigned u32x4 __attribute__((ext_vector_type(4)));
constexpr int BM = 256, BK = 64, HALF = 128, HTB = HALF * BK * 2  , STAGE_BYTES = 8 * HTB, NXCD = 8, WGM = 8;

__host__ __device__ __forceinline__ int lds_byte(int r, int c) { const int st = (r >> 4) * 2 + (c >> 5), rr = r & 15, cc = c & 31, ob = rr * 64 + cc * 2; return st * 1024 + (ob ^ (((ob >> 9) & 1) << 5)); }
__host__ __device__ __forceinline__ void stage_rc(int b, int& R, int& C) { const int st = b / 1024, sb = b % 1024, swz = sb ^ (((sb >> 9) & 1) << 5); R = (st >> 1) * 16 + swz / 64; C = (st & 1) * 32 + (swz % 64) / 2; }
__host__ __device__ __forceinline__ int perm32(int rho) { const int n = rho >> 4, i = rho & 15; return 8 * (i >> 2) + 4 * n + (i & 3); }

struct Unit { int pm, pn; };
struct Gemm { const bf16_t* A; const bf16_t* Bt; int M, N, K; };

struct StaticOrder {
    int nM, nN, nwg, G, c;
    __host__ __device__ void init(int M, int N, int G_, int c_) { nM = M / BM; nN = N / BM; nwg = nM * nN; G = G_; c = c_; }
    __host__ __device__ bool next(int i, Unit& u) const {
        const long L = (long)i * G + c; if (L >= nwg) return false;
        int wgid = (int)L; { const int q = nwg / NXCD, r = nwg % NXCD, xcd = wgid % NXCD, off = wgid / NXCD; wgid = (xcd < r ? xcd * (q + 1) : r * (q + 1) + (xcd - r) * q) + off; }
        const int nig = WGM * nN, gid = wgid / nig, fm = gid * WGM, gsz = (nM - fm) < WGM ? (nM - fm) : WGM;
        u.pm = fm + ((wgid % nig) % gsz); u.pn = (wgid % nig) / gsz; return true;
    }
    __device__ __forceinline__ void a_ready(const Unit&) const {}
    __device__ __forceinline__ void done(const Unit&) const {}
};

__device__ __forceinline__ unsigned cvt_pk_bf16(float lo, float hi) { unsigned r; asm volatile("v_cvt_pk_bf16_f32 %0, %1, %2" : "=v"(r) : "v"(lo), "v"(hi)); return r; }
template <class Epi, class Sched, bool ALIGN_EPI = false, bool SP2 = false>
__device__ __forceinline__ void gemm_phase(PG8_LAS unsigned char* lds, const Gemm g, const Sched& S, const Epi& E) {
    int tid = threadIdx.x; asm volatile("" : "+v"(tid)); const int wid = __builtin_amdgcn_readfirstlane(tid >> 6), lane = tid & 63, wr = wid >> 2, wc = wid & 3, fr = lane & 15, fq = lane >> 4;
    const int K = g.K, nt = K / BK;
    unsigned voffA[2], voffB[2];
#pragma unroll
    for (int i = 0; i < 2; ++i) { int R, C; stage_rc(tid * 16 + i * 8192, R, C); const int Rb = Epi::PERM ? ((R & ~31) + perm32(R & 31)) : R;
        voffA[i] = (unsigned)(R * K + C) * 2u; voffB[i] = (unsigned)(Rb * K + C) * 2u; }
    const size_t kstep = (size_t)(BK * 2);
    const size_t hstep = (size_t)HALF * K * 2;
    const size_t tstep = 2 * hstep;
    const unsigned ldsw = (unsigned)wid * 1024u;
    const int aoff = lds_byte(wr * 64 + fr, fq * 8), boff = lds_byte(wc * 32 + fr, fq * 8);
#define PG8_SA(b, h) (((b) * 2 + (h)) * HTB)
#define PG8_SB(b, h) ((4 + (b) * 2 + (h)) * HTB)
#define PG8_STAGE(bufoff, gbase, voff) do { _Pragma("unroll") for (int _i = 0; _i < 2; ++_i) \
        __builtin_amdgcn_global_load_lds((const unsigned*)((const char*)(gbase) + (voff)[_i]), (PG8_LAS unsigned*)(lds + (bufoff) + ldsw + _i * 8192), 16, 0, 0); } while (0)
#define PG8_LDA(dst, b, h) do { _Pragma("unroll") for (int m = 0; m < 4; ++m) _Pragma("unroll") for (int k = 0; k < 2; ++k) dst[m][k] = *(const PG8_LAS bf16x8*)(lds + PG8_SA(b, h) + aoff + m * 2048 + k * 1024); } while (0)
#define PG8_LDB(dst, b, h) do { _Pragma("unroll") for (int n = 0; n < 2; ++n) _Pragma("unroll") for (int k = 0; k < 2; ++k) dst[n][k] = *(const PG8_LAS bf16x8*)(lds + PG8_SB(b, h) + boff + n * 2048 + k * 1024); } while (0)
#define PG8_MMA(ai, bj, At, Bt) do { __builtin_amdgcn_s_setprio(1); _Pragma("unroll") for (int m = 0; m < 4; ++m) _Pragma("unroll") for (int n = 0; n < 2; ++n) _Pragma("unroll") for (int k = 0; k < 2; ++k) \
        acc[ai][bj][m][n] = __builtin_amdgcn_mfma_f32_16x16x32_bf16(Bt[n][k], At[m][k], acc[ai][bj][m][n], 0, 0, 0); __builtin_amdgcn_s_setprio(0); } while (0)
#define PG8_WAIT_V(n) asm volatile("s_waitcnt vmcnt(" #n ")" ::: "memory")
#define PG8_WAIT_L(n) asm volatile("s_waitcnt lgkmcnt(" #n ")" ::: "memory")
#define PG8_BAR __builtin_amdgcn_s_barrier()
#define PG8_SCHED __builtin_amdgcn_sched_barrier(0)
    Unit cur, nxt; int ui = 0;
    if (!S.next(0, cur)) return;
    f32x4 acc[2][2][4][2];
#pragma unroll
    for (int a = 0; a < 2; ++a)
#pragma unroll
        for (int b = 0; b < 2; ++b)
#pragma unroll
            for (int m = 0; m < 4; ++m)
#pragma unroll
                for (int n = 0; n < 2; ++n) acc[a][b][m][n] = (f32x4){0.f, 0.f, 0.f, 0.f};
    bf16x8 At[4][2], B0[2][2], B1[2][2];
    const char* cA = (const char*)g.A + (size_t)cur.pm * tstep; const char* cB = (const char*)g.Bt + (size_t)cur.pn * tstep;
    S.a_ready(cur);
    if constexpr (SP2) {
        PG8_STAGE(PG8_SB(0, 0), cB, voffB); PG8_STAGE(PG8_SB(0, 1), cB + hstep, voffB); PG8_STAGE(PG8_SA(0, 0), cA, voffA); PG8_STAGE(PG8_SA(0, 1), cA + hstep, voffA);
        if (wr == 1) PG8_BAR;
        PG8_WAIT_V(2); PG8_BAR;
        PG8_STAGE(PG8_SB(1, 0), cB + kstep, voffB); PG8_STAGE(PG8_SA(1, 0), cA + kstep, voffA); PG8_STAGE(PG8_SB(1, 1), cB + hstep + kstep, voffB);
        PG8_WAIT_V(6); PG8_BAR;
    } else {
        PG8_STAGE(PG8_SB(0, 0), cB, voffB); PG8_STAGE(PG8_SA(0, 0), cA, voffA); PG8_STAGE(PG8_SB(0, 1), cB + hstep, voffB); PG8_STAGE(PG8_SA(0, 1), cA + hstep, voffA);
        if (wr == 1) PG8_BAR;
        PG8_WAIT_V(4); PG8_BAR;
        PG8_STAGE(PG8_SB(1, 0), cB + kstep, voffB); PG8_STAGE(PG8_SA(1, 0), cA + kstep, voffA); PG8_STAGE(PG8_SB(1, 1), cB + hstep + kstep, voffB);
        PG8_WAIT_V(6); PG8_BAR;
    }
    for (;;) {
        const bool has_next = S.next(ui + 1, nxt);
        const char* nA = has_next ? (const char*)g.A + (size_t)nxt.pm * tstep : cA; const char* nB = has_next ? (const char*)g.Bt + (size_t)nxt.pn * tstep : cB;
        for (int t = 0; t < nt; t += 2) {
            const bool last = (t == nt - 2);
            const char* a1 = cA + (size_t)(t + 1) * kstep;
            const char* a2 = last ? nA : cA + (size_t)(t + 2) * kstep; const char* b2 = last ? nB : cB + (size_t)(t + 2) * kstep;
            const char* a3 = a2 + kstep; const char* b3 = b2 + kstep;
            if (last && has_next) S.a_ready(nxt);
            if constexpr (SP2) {
            PG8_LDB(B0, 0, 0); PG8_LDB(B1, 0, 1); PG8_SCHED; PG8_LDA(At, 0, 0); PG8_STAGE(PG8_SA(1, 1), a1 + hstep, voffA);
            PG8_WAIT_V(8); PG8_WAIT_L(0); PG8_BAR; PG8_MMA(0, 0, At, B0); PG8_MMA(0, 1, At, B1); PG8_BAR; PG8_SCHED;
            PG8_LDA(At, 0, 1); PG8_STAGE(PG8_SB(0, 0), b2, voffB); PG8_STAGE(PG8_SB(0, 1), b2 + hstep, voffB); PG8_STAGE(PG8_SA(0, 0), a2, voffA);
            PG8_WAIT_V(8); PG8_WAIT_L(0); PG8_BAR; PG8_MMA(1, 0, At, B0); PG8_MMA(1, 1, At, B1); PG8_BAR; PG8_SCHED;
            PG8_LDB(B0, 1, 0); PG8_LDB(B1, 1, 1); PG8_SCHED; PG8_LDA(At, 1, 0); PG8_STAGE(PG8_SA(0, 1), a2 + hstep, voffA);
            PG8_WAIT_V(8); PG8_WAIT_L(0); PG8_BAR; PG8_MMA(0, 0, At, B0); PG8_MMA(0, 1, At, B1); PG8_BAR; PG8_SCHED;
            PG8_LDA(At, 1, 1); PG8_STAGE(PG8_SB(1, 0), b3, voffB); PG8_STAGE(PG8_SB(1, 1), b3 + hstep, voffB); PG8_STAGE(PG8_SA(1, 0), a3, voffA);
            PG8_WAIT_V(8); PG8_WAIT_L(0); PG8_BAR; PG8_MMA(1, 0, At, B0); PG8_MMA(1, 1, At, B1); PG8_BAR; PG8_SCHED;
            } else {
            PG8_LDB(B0, 0, 0); PG8_SCHED; PG8_LDA(At, 0, 0); PG8_STAGE(PG8_SA(1, 1), a1 + hstep, voffA);
            PG8_WAIT_L(8); PG8_BAR; PG8_WAIT_L(0); PG8_MMA(0, 0, At, B0); PG8_BAR; PG8_SCHED;
            PG8_LDB(B1, 0, 1); PG8_STAGE(PG8_SB(0, 0), b2, voffB);
            PG8_BAR; PG8_WAIT_L(0); PG8_MMA(0, 1, At, B1); PG8_BAR;
            PG8_LDA(At, 0, 1); PG8_STAGE(PG8_SA(0, 0), a2, voffA);
            PG8_BAR; PG8_WAIT_L(0); PG8_MMA(1, 0, At, B0); PG8_BAR; PG8_SCHED;
            PG8_STAGE(PG8_SB(0, 1), b2 + hstep, voffB);
            PG8_WAIT_V(6); PG8_BAR; PG8_MMA(1, 1, At, B1); PG8_BAR;
            PG8_LDB(B0, 1, 0); PG8_SCHED; PG8_LDA(At, 1, 0); PG8_STAGE(PG8_SA(0, 1), a2 + hstep, voffA);
            PG8_WAIT_L(8); PG8_BAR; PG8_WAIT_L(0); PG8_MMA(0, 0, At, B0); PG8_BAR; PG8_SCHED;
            PG8_LDB(B1, 1, 1); PG8_STAGE(PG8_SB(1, 0), b3, voffB);
            PG8_BAR; PG8_WAIT_L(0); PG8_MMA(0, 1, At, B1); PG8_BAR;
            PG8_LDA(At, 1, 1); PG8_STAGE(PG8_SA(1, 0), a3, voffA);
            PG8_BAR; PG8_WAIT_L(0); PG8_MMA(1, 0, At, B0); PG8_BAR; PG8_SCHED;
            PG8_STAGE(PG8_SB(1, 1), b3 + hstep, voffB);
            PG8_WAIT_V(6); PG8_BAR; PG8_MMA(1, 1, At, B1); PG8_BAR;
            }
        }
        if constexpr (ALIGN_EPI) { if (wr == 0) PG8_BAR; }
        if constexpr (!Epi::AFTER_DRAIN) { E(acc, cur, wr, wc, fr, fq); S.done(cur); }
        if (!has_next) break;
#pragma unroll
        for (int a = 0; a < 2; ++a)
#pragma unroll
            for (int b = 0; b < 2; ++b)
#pragma unroll
                for (int m = 0; m < 4; ++m)
#pragma unroll
                    for (int n = 0; n < 2; ++n) acc[a][b][m][n] = (f32x4){0.f, 0.f, 0.f, 0.f};
        cur = nxt; cA = nA; cB = nB; ++ui;
        if constexpr (ALIGN_EPI) { if (wr == 1) PG8_BAR; }
    }
    PG8_WAIT_V(0);
    if constexpr (!ALIGN_EPI) { if (wr == 0) PG8_BAR; }
    PG8_BAR;
    if constexpr (Epi::AFTER_DRAIN) { E.fused(acc, cur, wr, wc, fr, fq, lds, wid, lane); S.done(cur); }
#undef PG8_SA
#undef PG8_SB
#undef PG8_STAGE
#undef PG8_LDA
#undef PG8_LDB
#undef PG8_MMA
#undef PG8_WAIT_V
#undef PG8_WAIT_L
#undef PG8_BAR
#undef PG8_SCHED
}
}

#define LAS __attribute__((address_space(3)))
typedef unsigned short bf16;
typedef short bf16x8 __attribute__((ext_vector_type(8)));
typedef short s16x4 __attribute__((ext_vector_type(4)));
typedef float f32x2 __attribute__((ext_vector_type(2)));
typedef float f32x4 __attribute__((ext_vector_type(4)));
typedef float f32x16 __attribute__((ext_vector_type(16)));
typedef unsigned u32x2 __attribute__((ext_vector_type(2)));
typedef unsigned u32x4 __attribute__((ext_vector_type(4)));
typedef __bf16 bf16x2_t __attribute__((ext_vector_type(2)));

constexpr int M_ = 65536, SEQ = 2048, DMODEL = 1024, DFF = 2816;
constexpr float EPS = 1e-6f, LOG2E = 1.4426950408889634f;
constexpr size_t MiB = 1u << 20;
constexpr size_t WS_BIAS = 0;
constexpr size_t WS_ROPE = 256 * 1024;
constexpr size_t WS_RSS = 1 * MiB;
constexpr size_t WS_SSQ = 3 * MiB;
constexpr size_t WS_SSKV = 3 * MiB + 256 * 1024;
constexpr size_t W_AIN = 4 * MiB, W_AOUT = 13 * MiB, W_BIN = 14 * MiB, W_BQUP = 16 * MiB, W_BKVUP = 18 * MiB, W_BOUT = 19 * MiB,
                 W_CIN = 21 * MiB, W_COUT = 27 * MiB, W_DIN = 29 * MiB, W_DOUT = 32 * MiB, W_FG = 34 * MiB, W_FU = 58 * MiB, W_FD = 82 * MiB, W_FSTR = 6 * MiB;
constexpr size_t WS_XB = 106 * MiB;
constexpr size_t WS_R = 234 * MiB;
constexpr size_t R_A_QKV = WS_R, R_A_O3 = WS_R + 576 * MiB, R_A_LSE = WS_R + 768 * MiB, R_A_OC = WS_R;
constexpr size_t R_B_CQ = WS_R, R_B_CKV = WS_R + 48 * MiB, R_B_KPE = WS_R + 80 * MiB, R_B_Q = WS_R + 128 * MiB, R_B_KV = WS_R + 320 * MiB, R_B_KH = WS_R + 576 * MiB, R_B_O = WS_R;
constexpr size_t R_C_QKV = WS_R, R_C_O = WS_R + 384 * MiB;
constexpr size_t R_D_QKV = WS_R, R_D_O = WS_R + 160 * MiB;
constexpr size_t R_GATE = WS_R, R_ACT = WS_R + 352 * MiB;
constexpr size_t WS_RSSP = WS_R + 774 * MiB;
constexpr size_t WS_SSQP = WS_R + 782 * MiB;
constexpr size_t WS_SSKVP = WS_R + 784 * MiB;
constexpr size_t WS_SSPE = 3 * MiB + 512 * 1024;
constexpr size_t R_B_RK = WS_R + 96 * MiB;
constexpr size_t WS_BAR = 512 * 1024;
constexpr size_t WS_NEED = WS_R + 786 * MiB;

constexpr int LDS_BYTES = 135168;

struct Args { const float* in[34]; float* out; unsigned char* ws; };

__device__ __forceinline__ unsigned pk2(float lo, float hi) { f32x2 v = {lo, hi}; bf16x2_t b = __builtin_convertvector(v, bf16x2_t); return __builtin_bit_cast(unsigned, b); }
__device__ __forceinline__ float bf2f(unsigned short h) { return __uint_as_float(((unsigned)h) << 16); }
__device__ __forceinline__ float bflo(unsigned w) { return __uint_as_float(w << 16); }
__device__ __forceinline__ float bfhi(unsigned w) { return __uint_as_float(w & 0xffff0000u); }
__device__ __forceinline__ float wave_sum(float v) {
#pragma unroll
    for (int o = 1; o < 64; o <<= 1) v += __shfl_xor(v, o);
    return v;
}
__device__ __forceinline__ float dot4(f32x4 a) { return (a[0] * a[0] + a[1] * a[1]) + (a[2] * a[2] + a[3] * a[3]); }
__device__ __forceinline__ float rowss_sum(const float* ss, int nvec, int row) {
    const f32x4* p = (const f32x4*)(ss + (size_t)row * 4 * nvec); float t = 0.f;
#pragma unroll
    for (int v = 0; v < 4; ++v) if (v < nvec) { const f32x4 q = p[v]; t += (q[0] + q[1]) + (q[2] + q[3]); }
    return t;
}

struct EpiProj {
    static constexpr bool PERM = true, AFTER_DRAIN = false;
    bf16* O; int ldc; const float* rs; int hm; const float* gq; const float* gk; float qscale;
    __device__ __forceinline__ void operator()(const f32x4 (&acc)[2][2][4][2], const pg8::Unit& u, int wr, int wc, int fr, int fq) const {
        const int hg = u.pn * 4 + wc;
        int kind = 2; const float* gain = gq;
        if (hm == 1) { const int t = (hg >> 3) % 3, gi = hg / 24; kind = t; gain = (t == 0 ? gq : gk) + gi * 64; }
        else if (hm == 2) { kind = hg < 16 ? 0 : (hg < 32 ? 1 : 2); gain = kind == 0 ? gq : gk; }
        else if (hm == 3) { kind = hg < 16 ? 0 : (hg < 18 ? 1 : 2); gain = kind == 0 ? gq : gk; }
        else if (hm == 4) { kind = (hg & 1) ? 2 : 3; gain = gk; }
        f32x4 gv[2][2];
#pragma unroll
        for (int bj = 0; bj < 2; ++bj)
#pragma unroll
            for (int n = 0; n < 2; ++n) {
                gv[bj][n] = (f32x4){1.f, 1.f, 1.f, 1.f};
                if (kind != 2) { gv[bj][n] = *(const f32x4*)(gain + 32 * bj + 8 * fq + 4 * n); if (kind == 0) gv[bj][n] = gv[bj][n] * qscale; }
            }
        bf16* colp = O + hg * 64 + 8 * fq;
        float rsv[2][4];
#pragma unroll
        for (int ai = 0; ai < 2; ++ai)
#pragma unroll
            for (int m = 0; m < 4; ++m) rsv[ai][m] = rs[u.pm * 256 + ai * 128 + wr * 64 + m * 16 + fr];
        if (kind == 3) {
#pragma unroll
            for (int ai = 0; ai < 2; ++ai)
#pragma unroll
                for (int m = 0; m < 4; ++m) {
                    const int row = u.pm * 256 + ai * 128 + wr * 64 + m * 16 + fr;
                    const float rstd = rsv[ai][m];
                    f32x4 v[2][2]; float s = 0.f;
#pragma unroll
                    for (int bj = 0; bj < 2; ++bj)
#pragma unroll
                        for (int n = 0; n < 2; ++n) { v[bj][n] = acc[ai][bj][m][n] * rstd; s += dot4(v[bj][n]); }
                    s += __shfl_xor(s, 16); s += __shfl_xor(s, 32);
                    const float rk_ = rsqrtf((s + ((const float*)((const unsigned char*)rs + (WS_SSPE - WS_SSKV)))[row]) * (1.0f / 96.0f) + EPS);
                    bf16* kp = (bf16*)((unsigned char*)O + (R_B_KH - R_B_KV)) + (size_t)row * 1536 + (hg >> 1) * 96 + 8 * fq;
#pragma unroll
                    for (int bj = 0; bj < 2; ++bj) {
                        const f32x4 a_ = v[bj][0] * rk_ * gv[bj][0], b_ = v[bj][1] * rk_ * gv[bj][1];
                        u32x4 w; w.x = pk2(a_[0], a_[1]); w.y = pk2(a_[2], a_[3]); w.z = pk2(b_[0], b_[1]); w.w = pk2(b_[2], b_[3]);
                        *(u32x4*)(kp + 32 * bj) = w;
                    }
                    const u32x4 r_ = *(const u32x4*)((const bf16*)((const unsigned char*)O - (R_B_KV - R_B_RK)) + (size_t)row * 32 + 8 * fq);
                    u32x4 w;
#pragma unroll
                    for (int j = 0; j < 4; ++j) w[j] = pk2(bflo(r_[j]) * rk_, bfhi(r_[j]) * rk_);
                    *(u32x4*)(kp + 64) = w;
                }
            return;
        }
#pragma unroll
        for (int ai = 0; ai < 2; ++ai)
#pragma unroll
            for (int m = 0; m < 4; ++m) {
                const int row = u.pm * 256 + ai * 128 + wr * 64 + m * 16 + fr;
                const float rstd = rsv[ai][m];
                f32x4 v[2][2]; float s = 0.f;
#pragma unroll
                for (int bj = 0; bj < 2; ++bj)
#pragma unroll
                    for (int n = 0; n < 2; ++n) { v[bj][n] = acc[ai][bj][m][n] * rstd; s += dot4(v[bj][n]); }
                if (kind < 2) {
                    s += __shfl_xor(s, 16); s += __shfl_xor(s, 32);
                    const float rs = rsqrtf(s * (1.0f / 64.0f) + EPS);
#pragma unroll
                    for (int bj = 0; bj < 2; ++bj)
#pragma unroll
                        for (int n = 0; n < 2; ++n) v[bj][n] = v[bj][n] * rs * gv[bj][n];
                }
#pragma unroll
                for (int bj = 0; bj < 2; ++bj) {
                    u32x4 w; w.x = pk2(v[bj][0][0], v[bj][0][1]); w.y = pk2(v[bj][0][2], v[bj][0][3]); w.z = pk2(v[bj][1][0], v[bj][1][1]); w.w = pk2(v[bj][1][2], v[bj][1][3]);
                    *(u32x4*)(colp + (size_t)row * ldc + 32 * bj) = w;
                }
            }
    }
};
struct EpiLat {
    static constexpr bool PERM = true, AFTER_DRAIN = false;
    bf16* CQ; bf16* CKV; bf16* KPE; const float* rs; float* ssq; float* sskv;
    __device__ __forceinline__ void operator()(const f32x4 (&acc)[2][2][4][2], const pg8::Unit& u, int wr, int wc, int fr, int fq) const {
        const int hg = u.pn * 4 + wc;
        if (hg > 10) return;
        bf16* dst; int ld; float* sacc = nullptr; int sst = 0;
        if (hg < 6) { dst = CQ + hg * 64; ld = 384; sacc = ssq + hg; sst = 8; } else if (hg < 10) { dst = CKV + (hg - 6) * 64; ld = 256; sacc = sskv + (hg - 6); sst = 4; } else { dst = KPE; ld = 64; }
        dst += 8 * fq;
        float rsv[2][4];
#pragma unroll
        for (int ai = 0; ai < 2; ++ai)
#pragma unroll
            for (int m = 0; m < 4; ++m) rsv[ai][m] = rs[u.pm * 256 + ai * 128 + wr * 64 + m * 16 + fr];
#pragma unroll
        for (int ai = 0; ai < 2; ++ai)
#pragma unroll
            for (int m = 0; m < 4; ++m) {
                const int row = u.pm * 256 + ai * 128 + wr * 64 + m * 16 + fr;
                const float rstd = rsv[ai][m];
                f32x4 v[2][2]; float s = 0.f;
#pragma unroll
                for (int bj = 0; bj < 2; ++bj)
#pragma unroll
                    for (int n = 0; n < 2; ++n) { v[bj][n] = acc[ai][bj][m][n] * rstd; s += dot4(v[bj][n]); }
                s += __shfl_xor(s, 16); s += __shfl_xor(s, 32);
                if (fq == 0) { if (sacc != nullptr) sacc[(size_t)row * sst] = s; else { float z_ = 0.f; asm volatile("" : "+v"(z_)); ssq[(size_t)row * 8 + 6] = z_; ssq[(size_t)row * 8 + 7] = z_; } }
#pragma unroll
                for (int bj = 0; bj < 2; ++bj) {
                    u32x4 w; w.x = pk2(v[bj][0][0], v[bj][0][1]); w.y = pk2(v[bj][0][2], v[bj][0][3]); w.z = pk2(v[bj][1][0], v[bj][1][1]); w.w = pk2(v[bj][1][2], v[bj][1][3]);
                    *(u32x4*)(dst + (size_t)row * ld + 32 * bj) = w;
                }
            }
    }
};
struct EpiRes {
    static constexpr bool PERM = true, AFTER_DRAIN = false;
    const float* base32; float* out32; bf16* xb; bf16* xbw; float* ssn;
    __device__ __forceinline__ void operator()(const f32x4 (&acc)[2][2][4][2], const pg8::Unit& u, int wr, int wc, int fr_, int fq_) const {
        int fr = fr_, fq = fq_; asm volatile("" : "+v"(fr), "+v"(fq));
        float* ssn_ = ssn; bf16* xbw_ = xbw; float* out_ = out32; const float* b32_ = base32; asm volatile("" : "+s"(ssn_), "+s"(xbw_), "+s"(out_), "+s"(b32_));
        const int col0 = u.pn * 256 + wc * 32 + 8 * fq;
#pragma unroll
        for (int ai = 0; ai < 2; ++ai) {
            f32x4 bv[4][2][2];
            if (b32_ != nullptr) {
#pragma unroll
                for (int m = 0; m < 4; ++m)
#pragma unroll
                    for (int bj = 0; bj < 2; ++bj)
#pragma unroll
                        for (int n = 0; n < 2; ++n) bv[m][bj][n] = *(const f32x4*)(b32_ + (size_t)(u.pm * 256 + ai * 128 + wr * 64 + m * 16 + fr) * DMODEL + col0 + bj * 128 + n * 4);
            } else {
                u32x4 rw[4][2];
#pragma unroll
                for (int m = 0; m < 4; ++m)
#pragma unroll
                    for (int bj = 0; bj < 2; ++bj) rw[m][bj] = *(const u32x4*)(xb + (size_t)(u.pm * 256 + ai * 128 + wr * 64 + m * 16 + fr) * DMODEL + col0 + bj * 128);
#pragma unroll
                for (int m = 0; m < 4; ++m)
#pragma unroll
                    for (int bj = 0; bj < 2; ++bj) {
                        bv[m][bj][0] = (f32x4){bflo(rw[m][bj].x), bfhi(rw[m][bj].x), bflo(rw[m][bj].y), bfhi(rw[m][bj].y)};
                        bv[m][bj][1] = (f32x4){bflo(rw[m][bj].z), bfhi(rw[m][bj].z), bflo(rw[m][bj].w), bfhi(rw[m][bj].w)};
                    }
            }
            asm volatile("" ::: "memory");
#pragma unroll
            for (int m = 0; m < 4; ++m) {
                const int row = u.pm * 256 + ai * 128 + wr * 64 + m * 16 + fr;
                float s = 0.f;
#pragma unroll
                for (int bj = 0; bj < 2; ++bj) {
                    const size_t off = (size_t)row * DMODEL + col0 + bj * 128;
                    const f32x4 o0 = bv[m][bj][0] + acc[ai][bj][m][0], o1 = bv[m][bj][1] + acc[ai][bj][m][1];
                    if (out_ != nullptr) { *(f32x4*)(out_ + off) = o0; *(f32x4*)(out_ + off + 4) = o1; }
                    if (xbw_ != nullptr) { u32x4 w; w.x = pk2(o0[0], o0[1]); w.y = pk2(o0[2], o0[3]); w.z = pk2(o1[0], o1[1]); w.w = pk2(o1[2], o1[3]); *(u32x4*)(xbw_ + off) = w; }
                    s += dot4(o0) + dot4(o1);
                }
                if (ssn_ != nullptr) { s += __shfl_xor(s, 16); s += __shfl_xor(s, 32); if (fq == 0) ssn_[(size_t)(u.pn * 4 + wc) * M_ + row] = s; }
            }
            asm volatile("" ::: "memory");
        }
    }
};
__device__ __forceinline__ u32x4 shfl4(u32x4 v, int src) { u32x4 r; r.x = __shfl(v.x, src, 16); r.y = __shfl(v.y, src, 16); r.z = __shfl(v.z, src, 16); r.w = __shfl(v.w, src, 16); return r; }
struct EpiGateUp {
    static constexpr bool PERM = true, AFTER_DRAIN = false;
    bf16* act; bf16* gedge; bf16* uedge; const float* rs; const float* cw; const float* cb;
    __device__ __forceinline__ void operator()(const f32x4 (&acc)[2][2][4][2], const pg8::Unit& u, int wr, int wc, int fr_, int fq_) const {
        int fr = fr_, fq = fq_; asm volatile("" : "+v"(fr), "+v"(fq));
        const int c0 = u.pn * 128 + wc * 32 + 8 * fq;
        f32x4 w0[2], w1[2], w2[2], b[2];
#pragma unroll
        for (int n = 0; n < 2; ++n) { w0[n] = *(const f32x4*)(cw + c0 + 4 * n); w1[n] = *(const f32x4*)(cw + DFF + c0 + 4 * n); w2[n] = *(const f32x4*)(cw + 2 * DFF + c0 + 4 * n); b[n] = *(const f32x4*)(cb + c0 + 4 * n); }
#pragma unroll
        for (int ai = 0; ai < 2; ++ai) {
            u32x4 g[4]; float rstd[4];
            const int strip = u.pm * 4 + ai * 2 + wr;
#pragma unroll
            for (int m = 0; m < 4; ++m) rstd[m] = rs[u.pm * 256 + ai * 128 + wr * 64 + m * 16 + fr];
#pragma unroll
            for (int m = 0; m < 4; ++m) {
                const f32x4 ga = acc[ai][0][m][0] * rstd[m], gb = acc[ai][0][m][1] * rstd[m];
                g[m].x = pk2(ga[0], ga[1]); g[m].y = pk2(ga[2], ga[3]); g[m].z = pk2(gb[0], gb[1]); g[m].w = pk2(gb[2], gb[3]);
            }
#pragma unroll
            for (int m = 0; m < 4; ++m) {
                const int row = u.pm * 256 + ai * 128 + wr * 64 + m * 16 + fr;
                const u32x4 g0 = g[m];
                u32x4 g1, g2;
#pragma unroll
                for (int d = 0; d < 4; ++d) {
                    unsigned o1_ = 0u, o2_ = 0u;
                    if (m > 0) { o1_ = __builtin_amdgcn_update_dpp(0u, g[m - 1][d], 0x121, 0xf, 0xf, false); o2_ = __builtin_amdgcn_update_dpp(0u, g[m - 1][d], 0x122, 0xf, 0xf, false); }
                    g1[d] = __builtin_amdgcn_update_dpp(o1_, g0[d], 0x111, 0xf, 0xf, false);
                    g2[d] = __builtin_amdgcn_update_dpp(o2_, g0[d], 0x112, 0xf, 0xf, false);
                }
                u32x4 w, uw;
#pragma unroll
                for (int n = 0; n < 2; ++n) {
                    float r[4], up[4];
#pragma unroll
                    for (int j = 0; j < 4; ++j) {
                        const unsigned q0 = g0[2 * n + (j >> 1)], q1 = g1[2 * n + (j >> 1)], q2 = g2[2 * n + (j >> 1)];
                        const float x0 = (j & 1) ? bfhi(q0) : bflo(q0), x1 = (j & 1) ? bfhi(q1) : bflo(q1), x2 = (j & 1) ? bfhi(q2) : bflo(q2);
                        const float cv = b[n][j] + w2[n][j] * x0 + w1[n][j] * x1 + w0[n][j] * x2;
                        const float sg = cv * __builtin_amdgcn_rcpf(1.0f + __builtin_amdgcn_exp2f(-LOG2E * cv));
                        up[j] = acc[ai][1][m][n][j] * rstd[m];
                        r[j] = sg * up[j];
                    }
                    w[2 * n] = pk2(r[0], r[1]); w[2 * n + 1] = pk2(r[2], r[3]);
                    uw[2 * n] = pk2(up[0], up[1]); uw[2 * n + 1] = pk2(up[2], up[3]);
                }
                if (m == 0) {
                    if (fr < 2) { *(u32x4*)(gedge + ((size_t)strip * 4 + fr) * DFF + c0) = g0; *(u32x4*)(uedge + ((size_t)strip * 2 + fr) * DFF + c0) = uw; }
                    else *(u32x4*)(act + (size_t)row * DFF + c0) = w;
                } else {
                    *(u32x4*)(act + (size_t)row * DFF + c0) = w;
                    if (m == 3 && fr >= 14) *(u32x4*)(gedge + ((size_t)strip * 4 + 2 + (fr - 14)) * DFF + c0) = g0;
                }
                asm volatile("" ::: "memory");
            }
        }
    }
};

__device__ __forceinline__ int crow(int r, int hi) { return (r & 3) + 8 * (r >> 2) + 4 * hi; }
struct TileGeo { int NT, TPS, ks0, res0, dil; };
template <int DQK, int DV, int KT> struct AttL {
    static constexpr int KSTR = DQK * 2 + 16, VSTR = DV * 2 + 64, KBUF = KT * KSTR, VBUF = KT * VSTR;
    static constexpr int OFF_K = 0, OFF_V = 2 * KBUF, OFF_TAB = OFF_V + 2 * VBUF;
};
template <int DQK, int DV, bool BIAS, int TABN, bool QRELOAD, int KT>
__device__ __forceinline__ void attn_pass(int qoff_, LAS unsigned char* lds, const bf16* Kb, int kpitch, const bf16* Vb, int vpitch, const TileGeo G, int my_tlo, int my_thi,
                                          int wslot_q0, int W, const bf16x8 (&qf_)[DQK / 16], float& m_, float& l_, f32x16 (&o)[DV / 32]) {
    typedef AttL<DQK, DV, KT> L;
    int tid = threadIdx.x; asm volatile("" : "+v"(tid)); const int lane = tid & 63, r32 = lane & 31, hi = lane >> 5;
    constexpr int SUB = KT / 64;
    constexpr int KCH = DQK / 8, VCH = DV / 8, NKC = KT * KCH, NVC = KT * VCH, NKL = (NKC + 511) / 512, NVL = (NVC + 511) / 512;
    u32x4 kr[NKL], vr[NVL];
    const LAS float* tab = (const LAS float*)(lds + L::OFF_TAB);
    const int slot_q = wslot_q0 + r32;
    const int vlane = (4 * hi + ((lane & 15) >> 2)) * L::VSTR + (16 * ((lane >> 4) & 1) + 4 * (lane & 3)) * 2;
#define ATT_LOAD(t) do { const int seg_ = ((t) * SUB) / G.TPS, tis_ = (t) * SUB - seg_ * G.TPS; const int tok0_ = G.res0 + seg_ + G.dil * (G.ks0 + 64 * tis_); \
        _Pragma("unroll") for (int i_ = 0; i_ < NKL; ++i_) { const int c_ = tid + 512 * i_; if ((NKC % 512 == 0) || c_ < NKC) { const int j_ = c_ / KCH, p_ = c_ - j_ * KCH; \
            kr[i_] = *(const u32x4*)(Kb + (size_t)(tok0_ + G.dil * j_) * kpitch + p_ * 8); } } \
        _Pragma("unroll") for (int i_ = 0; i_ < NVL; ++i_) { const int c_ = tid + 512 * i_; if ((NVC % 512 == 0) || c_ < NVC) { const int j_ = c_ / VCH, p_ = c_ - j_ * VCH; \
            vr[i_] = *(const u32x4*)(Vb + (size_t)(tok0_ + G.dil * j_) * vpitch + p_ * 8); } } } while (0)
#define ATT_STORE(buf) do { \
        _Pragma("unroll") for (int i_ = 0; i_ < NKL; ++i_) { const int c_ = tid + 512 * i_; if ((NKC % 512 == 0) || c_ < NKC) { const int j_ = c_ / KCH, p_ = c_ - j_ * KCH; \
            *(LAS u32x4*)(lds + L::OFF_K + (buf) * L::KBUF + j_ * L::KSTR + p_ * 16) = kr[i_]; } } \
        _Pragma("unroll") for (int i_ = 0; i_ < NVL; ++i_) { const int c_ = tid + 512 * i_; if ((NVC % 512 == 0) || c_ < NVC) { const int j_ = c_ / VCH, p_ = c_ - j_ * VCH; \
            *(LAS u32x4*)(lds + L::OFF_V + (buf) * L::VBUF + j_ * L::VSTR + p_ * 16) = vr[i_]; } } } while (0)
    ATT_LOAD(0);
    ATT_STORE(0);
    float m = m_, l = l_;
    const int NT2 = G.NT / SUB;
    for (int t = 0; t < NT2; ++t) {
        const int buf = t & 1;
        if (t + 1 < NT2) ATT_LOAD(t + 1);
        __syncthreads();
#pragma unroll
        for (int hf = 0; hf < SUB; ++hf) {
        const int st = t * SUB + hf;
        if (st >= my_tlo && st <= my_thi) {
            const int tis = st % G.TPS, slot0 = G.ks0 + 64 * tis;
            const LAS unsigned char* Kt = lds + L::OFF_K + buf * L::KBUF + (hf * 64 + r32) * L::KSTR + hi * 16;
            f32x16 s[2];
            const int dsb = slot_q - slot0 - 4 * hi;
            bf16x8 qf[DQK / 16];
            if (QRELOAD) {
#pragma unroll
                for (int ks = 0; ks < DQK / 16; ++ks) qf[ks] = *(const LAS bf16x8*)(lds + qoff_ + ks * 32); }
            else {
#pragma unroll
                for (int ks = 0; ks < DQK / 16; ++ks) qf[ks] = qf_[ks]; }
#pragma unroll
            for (int kb = 0; kb < 2; ++kb) {
#pragma unroll
                for (int r = 0; r < 16; ++r) s[kb][r] = BIAS ? tab[dsb + 128 - (32 * kb + (r & 3) + 8 * (r >> 2))] : 0.f;
            }
            if (DV == 64) {
                bf16x8 kf[2][DQK / 16];
#pragma unroll
                for (int kb = 0; kb < 2; ++kb)
#pragma unroll
                    for (int ks = 0; ks < DQK / 16; ++ks) kf[kb][ks] = *(const LAS bf16x8*)(Kt + kb * 32 * L::KSTR + ks * 32);
                asm volatile("" ::: "memory");
#pragma unroll
                for (int ks = 0; ks < DQK / 16; ++ks)
#pragma unroll
                    for (int kb = 0; kb < 2; ++kb) s[kb] = __builtin_amdgcn_mfma_f32_32x32x16_bf16(kf[kb][ks], qf[ks], s[kb], 0, 0, 0);
            } else {
#pragma unroll
                for (int kh = 0; kh < 2; ++kh) {
                    bf16x8 kf[2][DQK / 32];
#pragma unroll
                    for (int kb = 0; kb < 2; ++kb)
#pragma unroll
                        for (int k2 = 0; k2 < DQK / 32; ++k2) kf[kb][k2] = *(const LAS bf16x8*)(Kt + kb * 32 * L::KSTR + (kh * (DQK / 32) + k2) * 32);
                    asm volatile("" ::: "memory");
#pragma unroll
                    for (int k2 = 0; k2 < DQK / 32; ++k2)
#pragma unroll
                        for (int kb = 0; kb < 2; ++kb) s[kb] = __builtin_amdgcn_mfma_f32_32x32x16_bf16(kf[kb][k2], qf[kh * (DQK / 32) + k2], s[kb], 0, 0, 0);
                }
            }
            const bool full = (wslot_q0 - slot0 - 63 >= 0) && (wslot_q0 + 31 - slot0 <= W);
            if (!full && !BIAS) {
#pragma unroll
                for (int kb = 0; kb < 2; ++kb)
#pragma unroll
                    for (int r = 0; r < 16; ++r) {
                        const int ds = dsb - (32 * kb + (r & 3) + 8 * (r >> 2));
                        s[kb][r] = ((unsigned)ds <= (unsigned)W) ? s[kb][r] : -INFINITY;
                    }
            }
            float mx = s[0][0];
#pragma unroll
            for (int r = 1; r < 16; ++r) mx = fmaxf(mx, s[0][r]);
#pragma unroll
            for (int r = 0; r < 16; ++r) mx = fmaxf(mx, s[1][r]);
            mx = fmaxf(mx, __shfl_xor(mx, 32));
            const float mn = fmaxf(m, mx);
            const float base = (mn == -INFINITY) ? 0.f : mn;
            const float alpha = __builtin_amdgcn_exp2f(m - base);
            m = mn;
            float ps = 0.f;
#pragma unroll
            for (int kb = 0; kb < 2; ++kb)
#pragma unroll
                for (int r = 0; r < 16; ++r) { const float p = __builtin_amdgcn_exp2f(s[kb][r] - base); s[kb][r] = p; ps += p; }
            l = l * alpha + ps;
            if (__any(alpha != 1.0f)) {
#pragma unroll
                for (int c = 0; c < DV / 32; ++c)
#pragma unroll
                    for (int r = 0; r < 16; ++r) o[c][r] *= alpha;
            }
            const LAS unsigned char* Vt = lds + L::OFF_V + buf * L::VBUF + hf * 64 * L::VSTR + vlane;
#pragma unroll
            for (int kb = 0; kb < 2; ++kb) {
                bf16x8 pb[2];
#pragma unroll
                for (int k2 = 0; k2 < 2; ++k2) {
                    u32x4 pw; pw.x = pk2(s[kb][8 * k2 + 0], s[kb][8 * k2 + 1]); pw.y = pk2(s[kb][8 * k2 + 2], s[kb][8 * k2 + 3]);
                    pw.z = pk2(s[kb][8 * k2 + 4], s[kb][8 * k2 + 5]); pw.w = pk2(s[kb][8 * k2 + 6], s[kb][8 * k2 + 7]);
                    pb[k2] = __builtin_bit_cast(bf16x8, pw);
                }
#pragma unroll
                for (int ch = 0; ch < DV / 64; ++ch) {
                    bf16x8 vf[2][2];
#pragma unroll
                    for (int k2 = 0; k2 < 2; ++k2)
#pragma unroll
                        for (int c2 = 0; c2 < 2; ++c2) {
                            const LAS unsigned char* vp = Vt + (32 * kb + 16 * k2) * L::VSTR + 64 * (2 * ch + c2);
                            const s16x4 lo = __builtin_bit_cast(s16x4, __builtin_amdgcn_ds_read_tr16_b64_v4i16((LAS s16x4*)(vp)));
                            const s16x4 hh = __builtin_bit_cast(s16x4, __builtin_amdgcn_ds_read_tr16_b64_v4i16((LAS s16x4*)(vp + 8 * L::VSTR)));
                            vf[k2][c2] = (bf16x8){lo[0], lo[1], lo[2], lo[3], hh[0], hh[1], hh[2], hh[3]};
                        }
                    asm volatile("" ::: "memory");
#pragma unroll
                    for (int k2 = 0; k2 < 2; ++k2)
#pragma unroll
                        for (int c2 = 0; c2 < 2; ++c2) o[2 * ch + c2] = __builtin_amdgcn_mfma_f32_32x32x16_bf16(vf[k2][c2], pb[k2], o[2 * ch + c2], 0, 0, 0);
                }
            }
        }
        }
        if (t + 1 < NT2) ATT_STORE(buf ^ 1);
    }
    __syncthreads();
    m_ = m; l_ = l;
#undef ATT_LOAD
#undef ATT_STORE
}

template <int MODE>
__device__ __forceinline__ void attn_phase(LAS unsigned char* lds, const Args& a, int Gn, int cid) {
    constexpr int DQK = MODE == 1 ? 96 : 64, DV = MODE == 2 ? 128 : 64;
    constexpr bool BIAS = MODE != 1;
    constexpr int TABN = MODE == 2 ? 2048 + 256 : 512;
    constexpr int NU = MODE == 0 ? 6144 : (MODE == 2 ? 2048 : 4096);
    constexpr int KT = MODE == 2 ? 64 : 128;
    typedef AttL<DQK, DV, KT> L;
    int tid = threadIdx.x; asm volatile("" : "+v"(tid)); const int lane = tid & 63, r32 = lane & 31, hi = lane >> 5, wid = __builtin_amdgcn_readfirstlane(tid >> 6);
    unsigned char* ws = a.ws;
    const float* biasd = (const float*)(ws + WS_BIAS);
    LAS float* tab = (LAS float*)(lds + L::OFF_TAB);
    float lam = 0.f, lam_init = 0.f;
    if (MODE == 2) {
        float d1 = 0.f, d2 = 0.f;
        for (int i = 0; i < 64; ++i) { d1 += a.in[19][i] * a.in[20][i]; d2 += a.in[21][i] * a.in[22][i]; }
        lam_init = 0.8f - 0.6f * expf(-0.3f * 2.0f);
        lam = expf(d1) - expf(d2) + lam_init;
    }
    for (int u = cid; u < NU; u += Gn) {
        int b, h, dil = 1, res0 = 0, s0, nres = 1, W, qb = 0, g = 0;
        if (MODE == 0) { g = u >> 11; const int rem = u & 2047; b = rem >> 6; h = (rem >> 3) & 7; const int blk = (rem + (u >> 8)) & 7; W = 128;
            if (g == 0) { s0 = 256 * blk; } else if (g == 1) { dil = 4; res0 = blk >> 1; s0 = 256 * (blk & 1); } else { dil = 16; res0 = 2 * blk; s0 = 0; nres = 2; } }
        else if (MODE == 3) { b = u >> 7; h = (u >> 3) & 15; s0 = 256 * ((u + (u >> 8)) & 7); W = 127; }
        else if (MODE == 1) { const int bh = u & 511; qb = 7 - (u >> 9); b = bh >> 4; h = bh & 15; s0 = 256 * qb; W = 1 << 20; }
        else { const int bh = u & 255; qb = 7 - (u >> 8); b = bh >> 3; h = bh & 7; s0 = 256 * qb; W = 1 << 20; }
        TileGeo G;
        G.dil = dil; G.res0 = res0;
        const int Lseg = 256 / nres;
        if (MODE == 0 || MODE == 3) { G.ks0 = (nres == 1 && s0 >= 128) ? s0 - 128 : 0; } else { G.ks0 = 0; }
        G.TPS = (s0 + Lseg - G.ks0) >> 6; G.NT = G.TPS * nres;
        const int nws = 8 / nres, seg_w = wid / nws, wslot_q0 = s0 + 32 * (wid - seg_w * nws);
        int tl = 0;
        if (MODE == 0 || MODE == 3) { tl = wslot_q0 - W - G.ks0; tl = tl < 0 ? 0 : (tl >> 6); }
        const int th = (wslot_q0 + 31 - G.ks0) >> 6;
        const int my_tlo = seg_w * G.TPS + tl, my_thi = seg_w * G.TPS + th;
        const int qtok = res0 + seg_w + dil * (wslot_q0 + r32);
        const size_t row_q = (size_t)b * SEQ + qtok, row_b = (size_t)b * SEQ;
        const bf16 *Qp, *Kb, *Vb; int qpitch, kpitch, vpitch;
        if (MODE == 0) { const bf16* base = (const bf16*)(ws + R_A_QKV); qpitch = kpitch = vpitch = 4608;
            Qp = base + row_q * 4608 + g * 1536 + h * 64; Kb = base + row_b * 4608 + g * 1536 + 512 + h * 64; Vb = base + row_b * 4608 + g * 1536 + 1024 + h * 64; }
        else if (MODE == 1) { qpitch = 1536; kpitch = 1536; vpitch = 2048;
            Qp = (const bf16*)(ws + R_B_Q) + row_q * 1536 + h * 96; Kb = (const bf16*)(ws + R_B_KH) + row_b * 1536 + h * 96; Vb = (const bf16*)(ws + R_B_KV) + row_b * 2048 + h * 128 + 64; }
        else if (MODE == 2) { const bf16* base = (const bf16*)(ws + R_C_QKV); qpitch = kpitch = vpitch = 3072;
            Qp = base + row_q * 3072 + (2 * h) * 64; Kb = base + row_b * 3072 + 1024 + (2 * h) * 64; Vb = base + row_b * 3072 + 2048 + h * 128; }
        else { const bf16* base = (const bf16*)(ws + R_D_QKV); qpitch = kpitch = vpitch = 1280;
            Qp = base + row_q * 1280 + h * 64; Kb = base + row_b * 1280 + 1024 + (h >> 3) * 64; Vb = base + row_b * 1280 + 1152 + (h >> 3) * 64; }
        (void)qpitch;
        if (MODE == 0 || MODE == 3) { const int d_ = tid - 128; tab[tid] = (d_ >= 0 && d_ <= W) ? biasd[h * 2048 + d_ * dil] : -INFINITY; }
        if (MODE == 2) {
#pragma unroll
            for (int j = 0; j < 4; ++j) tab[128 + tid + 512 * j] = biasd[h * 2048 + tid + 512 * j];
            if (tid < 128) { tab[tid] = -INFINITY; tab[2176 + tid] = 0.f; } }
        bf16x8 qf[DQK / 16];
        constexpr int OFF_Q = L::OFF_TAB + TABN * 4, QSTR = DQK * 2 + 16;
        const int qoff = OFF_Q + (32 * wid + r32) * QSTR + hi * 16;
        int tq = tid; asm volatile("" : "+v"(tq));
        if (MODE == 2) {
            const bf16* qsrc = (const bf16*)(ws + R_C_QKV) + (row_b + s0) * 3072 + (2 * h) * 64;
#pragma unroll
            for (int j = 0; j < 4; ++j) { const int c_ = tq + 512 * j, rw = c_ >> 3, p_ = c_ & 7;
                *(LAS u32x4*)(lds + OFF_Q + rw * QSTR + p_ * 16) = *(const u32x4*)(qsrc + (size_t)rw * 3072 + p_ * 8); }
        } else {
#pragma unroll
            for (int ks = 0; ks < DQK / 16; ++ks) qf[ks] = *(const bf16x8*)(Qp + 16 * ks + 8 * hi);
            if (MODE == 1) {
                float x[DQK / 16][8]; float ss = 0.f;
#pragma unroll
                for (int ks = 0; ks < DQK / 16; ++ks) { const u32x4 raw = __builtin_bit_cast(u32x4, qf[ks]);
#pragma unroll
                    for (int j = 0; j < 4; ++j) { x[ks][2 * j] = bflo(raw[j]); x[ks][2 * j + 1] = bfhi(raw[j]); ss += x[ks][2 * j] * x[ks][2 * j] + x[ks][2 * j + 1] * x[ks][2 * j + 1]; } }
                ss += __shfl_xor(ss, 32);
                const float rsq = rsqrtf(ss * (1.0f / 96.0f) + EPS) * (0.10206207261596577f * LOG2E);
                const float* gq_ = a.in[13];
#pragma unroll
                for (int ks = 0; ks < DQK / 16; ++ks) { const f32x4 g0 = *(const f32x4*)(gq_ + 16 * ks + 8 * hi), g1 = *(const f32x4*)(gq_ + 16 * ks + 8 * hi + 4);
#pragma unroll
                    for (int j = 0; j < 4; ++j) { x[ks][j] *= rsq * g0[j]; x[ks][4 + j] *= rsq * g1[j]; } }
                const float* cs = (const float*)(ws + WS_ROPE) + ((size_t)qtok * 16 + 8 * hi) * 2;
#pragma unroll
                for (int j = 0; j < 8; ++j) { const float co = cs[2 * j], si = cs[2 * j + 1], x1 = x[4][j], x2 = x[5][j]; x[4][j] = x1 * co - x2 * si; x[5][j] = x2 * co + x1 * si; }
#pragma unroll
                for (int ks = 0; ks < DQK / 16; ++ks) { u32x4 w;
#pragma unroll
                    for (int j = 0; j < 4; ++j) w[j] = pk2(x[ks][2 * j], x[ks][2 * j + 1]);
                    qf[ks] = __builtin_bit_cast(bf16x8, w); }
            }
        }
        f32x16 o[DV / 32];
#pragma unroll
        for (int c = 0; c < DV / 32; ++c)
#pragma unroll
            for (int r = 0; r < 16; ++r) o[c][r] = 0.f;
        float m = -INFINITY, l = 0.f;
        if (MODE == 3) { m = a.in[28][h] * LOG2E; l = hi == 0 ? 1.f : 0.f; }
        attn_pass<DQK, DV, BIAS, TABN, MODE == 2, KT>(qoff, lds, Kb, kpitch, Vb, vpitch, G, my_tlo, my_thi, wslot_q0, W, qf, m, l, o);
        float lt = l + __shfl_xor(l, 32);
        float inv = 1.0f / lt;
        if (MODE != 2) {
            bf16* Op; int opitch;
            if (MODE == 0) { Op = (bf16*)(ws + R_A_O3) + ((size_t)g * M_ + row_q) * 512 + h * 64; opitch = 512;
                if (hi == 0) ((float*)(ws + R_A_LSE))[((size_t)g * M_ + row_q) * 8 + h] = m + __log2f(lt); }
            else if (MODE == 1) { Op = (bf16*)(ws + R_B_O) + row_q * 1024 + h * 64; opitch = 1024; }
            else { Op = (bf16*)(ws + R_D_O) + row_q * 1024 + h * 64; opitch = 1024; }
            (void)opitch;
#pragma unroll
            for (int c = 0; c < DV / 32; ++c)
#pragma unroll
                for (int k = 0; k < 2; ++k) {
                    u32x2 we, wo; we.x = pk2(o[c][8 * k] * inv, o[c][8 * k + 1] * inv); we.y = pk2(o[c][8 * k + 2] * inv, o[c][8 * k + 3] * inv);
                    wo.x = pk2(o[c][8 * k + 4] * inv, o[c][8 * k + 5] * inv); wo.y = pk2(o[c][8 * k + 6] * inv, o[c][8 * k + 7] * inv);
                    const u32x2 snd = hi ? we : wo, mine = hi ? wo : we;
                    u32x2 rcv; rcv.x = __shfl_xor(snd.x, 32); rcv.y = __shfl_xor(snd.y, 32);
                    u32x4 w; if (hi) { w.x = rcv.x; w.y = rcv.y; w.z = mine.x; w.w = mine.y; } else { w.x = mine.x; w.y = mine.y; w.z = rcv.x; w.w = rcv.y; }
                    *(u32x4*)(Op + 32 * c + 8 * (2 * k + hi)) = w;
                }
        } else {
            f32x16 o1[DV / 32];
#pragma unroll
            for (int c = 0; c < DV / 32; ++c)
#pragma unroll
                for (int r = 0; r < 16; ++r) { o1[c][r] = o[c][r] * inv; o[c][r] = 0.f; }
#pragma unroll
            for (int j = 0; j < 4; ++j) tab[128 + tid + 512 * j] = biasd[(8 + h) * 2048 + tid + 512 * j];
            { const bf16* qsrc = (const bf16*)(ws + R_C_QKV) + (row_b + s0) * 3072 + (2 * h + 1) * 64;
#pragma unroll
              for (int j = 0; j < 4; ++j) { const int c_ = tq + 512 * j, rw = c_ >> 3, p_ = c_ & 7;
                  *(LAS u32x4*)(lds + OFF_Q + rw * QSTR + p_ * 16) = *(const u32x4*)(qsrc + (size_t)rw * 3072 + p_ * 8); } }
            m = -INFINITY; l = 0.f;
            attn_pass<DQK, DV, BIAS, TABN, MODE == 2, KT>(qoff, lds, Kb + 64, kpitch, Vb, vpitch, G, my_tlo, my_thi, wslot_q0, W, qf, m, l, o);
            lt = l + __shfl_xor(l, 32);
            inv = lam / lt;
            float ssum = 0.f;
#pragma unroll
            for (int c = 0; c < DV / 32; ++c)
#pragma unroll
                for (int r = 0; r < 16; ++r) { const float d = o1[c][r] - o[c][r] * inv; o1[c][r] = d; ssum += d * d; }
            ssum += __shfl_xor(ssum, 32);
            const float rs = rsqrtf(ssum * (1.0f / 128.0f) + EPS) * (1.0f - lam_init);
            bf16* Op = (bf16*)(ws + R_C_O) + row_q * 1024 + h * 128;
            const float* sub = a.in[23];
#pragma unroll
            for (int c = 0; c < DV / 32; ++c)
#pragma unroll
                for (int k = 0; k < 2; ++k) {
                    const f32x4 se = *(const f32x4*)(sub + 32 * c + 16 * k + 4 * hi), so = *(const f32x4*)(sub + 32 * c + 16 * k + 8 + 4 * hi);
                    u32x2 we, wo; we.x = pk2(o1[c][8 * k] * rs * se[0], o1[c][8 * k + 1] * rs * se[1]); we.y = pk2(o1[c][8 * k + 2] * rs * se[2], o1[c][8 * k + 3] * rs * se[3]);
                    wo.x = pk2(o1[c][8 * k + 4] * rs * so[0], o1[c][8 * k + 5] * rs * so[1]); wo.y = pk2(o1[c][8 * k + 6] * rs * so[2], o1[c][8 * k + 7] * rs * so[3]);
                    const u32x2 snd = hi ? we : wo, mine = hi ? wo : we;
                    u32x2 rcv; rcv.x = __shfl_xor(snd.x, 32); rcv.y = __shfl_xor(snd.y, 32);
                    u32x4 w; if (hi) { w.x = rcv.x; w.y = rcv.y; w.z = mine.x; w.w = mine.y; } else { w.x = mine.x; w.y = mine.y; w.z = rcv.x; w.w = rcv.y; }
                    *(u32x4*)(Op + 32 * c + 8 * (2 * k + hi)) = w;
                }
        }
    }
}

__device__ __forceinline__ void transpose_item(const float* W, int ldw, int ncol0, int K, const float* ksc, bf16* WT, int mode, LAS float* scr, int nblk, int item, int lane) {
    const int kb = item / nblk, nb = item - kb * nblk, k0 = 64 * kb, n0 = 32 * nb;
#pragma unroll
    for (int i = 0; i < 32; ++i) { const int kk = 2 * i + (lane >> 5); float v = W[(size_t)(k0 + kk) * ldw + ncol0 + n0 + (lane & 31)]; if (ksc != nullptr) v *= ksc[k0 + kk]; scr[kk * 33 + (lane & 31)] = v; }
    asm volatile("s_waitcnt lgkmcnt(0)" ::: "memory");
    const int drow0 = mode == 1 ? (256 * (n0 >> 8) + 128 * ((n0 & 63) >> 5) + 32 * ((n0 >> 6) & 3)) : mode == 2 ? (n0 < DFF ? 256 * (n0 >> 7) + (n0 & 127) : 256 * ((n0 - DFF) >> 7) + 128 + ((n0 - DFF) & 127)) : n0;
    const int c = lane & 7;
#pragma unroll
    for (int j = 0; j < 4; ++j) { const int n = (lane >> 3) + 8 * j; const LAS float* s = scr + (8 * c) * 33 + n;
        u32x4 o; o.x = pk2(s[0 * 33], s[1 * 33]); o.y = pk2(s[2 * 33], s[3 * 33]); o.z = pk2(s[4 * 33], s[5 * 33]); o.w = pk2(s[6 * 33], s[7 * 33]);
        *(u32x4*)(WT + (size_t)(drow0 + n) * K + k0 + 8 * c) = o; }
    asm volatile("s_waitcnt lgkmcnt(0)" ::: "memory");
}
__device__ __forceinline__ void prologue(LAS unsigned char* lds, const Args& a, int Gn, int cid) {
    int tid = threadIdx.x; asm volatile("" : "+v"(tid)); const int lane = tid & 63, wid = __builtin_amdgcn_readfirstlane(tid >> 6);
    unsigned char* ws = a.ws;
    LAS float* scr = (LAS float*)(lds + wid * 16384);
    const int gw = cid * 8 + wid, NGW = Gn * 8;
#define MAT_DESC(id) \
        const float* W; int ldw, ncol0 = 0, K, N, mode; const float* ksc = nullptr; size_t dst; \
        if (id == 0) { W = a.in[4]; ldw = 4608; K = 1024; N = 4608; ksc = a.in[2]; dst = W_AIN; mode = 1; } \
        else if (id == 1) { W = a.in[7]; ldw = 1024; K = 512; N = 1024; dst = W_AOUT; mode = 0; } \
        else if (id == 2) { W = a.in[8]; ldw = 672; K = 1024; N = 672; ksc = a.in[2] + 1024; dst = W_BIN; mode = 1; } \
        else if (id == 3) { W = a.in[11]; ldw = 1536; K = 384; N = 1536; ksc = a.in[9]; dst = W_BQUP; mode = 1; } \
        else if (id == 4) { W = a.in[12]; ldw = 2048; K = 256; N = 2048; ksc = a.in[10]; dst = W_BKVUP; mode = 1; } \
        else if (id == 5) { W = a.in[15]; ldw = 1024; K = 1024; N = 1024; dst = W_BOUT; mode = 0; } \
        else if (id == 6) { W = a.in[16]; ldw = 3072; K = 1024; N = 3072; ksc = a.in[2] + 2048; dst = W_CIN; mode = 1; } \
        else if (id == 7) { W = a.in[24]; ldw = 1024; K = 1024; N = 1024; dst = W_COUT; mode = 0; } \
        else if (id == 8) { W = a.in[25]; ldw = 1280; K = 1024; N = 1280; ksc = a.in[2] + 3072; dst = W_DIN; mode = 1; } \
        else if (id == 9) { W = a.in[29]; ldw = 1024; K = 1024; N = 1024; dst = W_DOUT; mode = 0; } \
        else { const int l = (id - 10) / 3, k3 = (id - 10) - 3 * l; \
            if (k3 < 2) { W = a.in[30] + (size_t)l * 1024 * 5632; ldw = 5632; K = 1024; N = 5632; ksc = a.in[3] + 1024 * l; dst = W_FG + l * 2 * W_FSTR; mode = 2; } \
            else { W = a.in[33] + (size_t)l * 2816 * 1024; ldw = 1024; K = 2816; N = 1024; dst = W_FD + l * W_FSTR; mode = 0; } }
    constexpr int TOTAL_ITEMS = 2304 + 256 + 336 + 288 + 256 + 512 + 1536 + 512 + 640 + 512 + 4 * (1408 + 1408 + 1408);
    for (int it = gw; it < TOTAL_ITEMS; it += NGW) {
        int r = it, id = 0;
        for (; id < 21; ++id) {
            int n_;
            if (id < 10) { n_ = id == 0 ? 2304 : id == 1 ? 256 : id == 2 ? 336 : id == 3 ? 288 : id == 4 ? 256 : id == 5 ? 512 : id == 6 ? 1536 : id == 7 ? 512 : id == 8 ? 640 : 512; } else { const int k3_ = (id - 10) % 3; n_ = k3_ == 0 ? 2816 : (k3_ == 1 ? 0 : 1408); }
            if (r < n_) break;
            r -= n_;
        }
        MAT_DESC(id)
        const int nblk = N / 32;
        transpose_item(W, ldw, ncol0, K, ksc, (bf16*)(ws + dst), mode, scr, nblk, r, lane);
    }
#undef MAT_DESC
    const int gt = cid * 512 + tid, NT = Gn * 512;
    { float* biasd = (float*)(ws + WS_BIAS); const float* table = a.in[1];
      for (int i = gt; i < 16 * 2048; i += NT) { const int h = i >> 11, d = i & 2047; int bk = d;
          if (d >= 16) { float t = logf((float)d / 16.0f); t = t / 4.852030263919617f; t = t * 16.0f; int lg = 16 + (int)t; bk = lg < 31 ? lg : 31; }
          biasd[i] = table[bk * 16 + h] * LOG2E; } }
    { float* rope = (float*)(ws + WS_ROPE);
      for (int i = gt; i < 2048 * 16; i += NT) { const int pos = i >> 4, f = i & 15; const float inv = powf(10000.0f, -(float)(2 * f) / 32.0f); const float ang = (float)pos * inv;
          rope[2 * i] = cosf(ang); rope[2 * i + 1] = sinf(ang); } }
    { const float* x = a.in[0]; bf16* xb = (bf16*)(ws + WS_XB); float* rss = (float*)(ws + WS_RSS);
      for (int m0 = gw; m0 < M_; m0 += 4 * NGW) {
          f32x4 v[4][4];
#pragma unroll
          for (int k = 0; k < 4; ++k) { const int m = m0 + k * NGW; if (m < M_) { const f32x4* xr = (const f32x4*)(x + (size_t)m * DMODEL) + lane;
#pragma unroll
              for (int j = 0; j < 4; ++j) v[k][j] = xr[64 * j]; } }
#pragma unroll
          for (int k = 0; k < 4; ++k) { const int m = m0 + k * NGW; if (m < M_) { u32x2* o8 = (u32x2*)(xb + (size_t)m * DMODEL) + lane; float s = 0.f;
#pragma unroll
              for (int j = 0; j < 4; ++j) { s += dot4(v[k][j]); u32x2 w; w.x = pk2(v[k][j][0], v[k][j][1]); w.y = pk2(v[k][j][2], v[k][j][3]); o8[64 * j] = w; }
              s = wave_sum(s); if (lane == 0) rss[m] = rsqrtf(s * (1.0f / 1024.0f) + EPS); } } } }
}
__device__ __forceinline__ void combine_a(const Args& a, int Gn, int cid) {
    unsigned char* ws = a.ws;
    const bf16* o3 = (const bf16*)(ws + R_A_O3); const float* lse = (const float*)(ws + R_A_LSE); bf16* oc = (bf16*)(ws + R_A_OC);
    const size_t NT = (size_t)Gn * 512; int tid = threadIdx.x; asm volatile("" : "+v"(tid));
    for (size_t idx0 = (size_t)cid * 512 + tid; idx0 < (size_t)M_ * 64; idx0 += 4 * NT) {
        u32x4 a0[4], a1[4], a2[4]; float l0[4], l1[4], l2[4];
#pragma unroll
        for (int k = 0; k < 4; ++k) { const size_t idx = idx0 + k * NT; if (idx < (size_t)M_ * 64) {
            const size_t row = idx >> 6; const int ch = (int)(idx & 63), h = ch >> 3;
            l0[k] = lse[row * 8 + h]; l1[k] = lse[((size_t)M_ + row) * 8 + h]; l2[k] = lse[((size_t)2 * M_ + row) * 8 + h];
            a0[k] = *(const u32x4*)(o3 + row * 512 + ch * 8); a1[k] = *(const u32x4*)(o3 + ((size_t)M_ + row) * 512 + ch * 8); a2[k] = *(const u32x4*)(o3 + ((size_t)2 * M_ + row) * 512 + ch * 8); } }
#pragma unroll
        for (int k = 0; k < 4; ++k) { const size_t idx = idx0 + k * NT; if (idx < (size_t)M_ * 64) {
            const size_t row = idx >> 6; const int ch = (int)(idx & 63);
            const float mx = fmaxf(l0[k], fmaxf(l1[k], l2[k]));
            float w0 = __builtin_amdgcn_exp2f(l0[k] - mx), w1 = __builtin_amdgcn_exp2f(l1[k] - mx), w2 = __builtin_amdgcn_exp2f(l2[k] - mx);
            const float inv = 1.0f / (w0 + w1 + w2); w0 *= inv; w1 *= inv; w2 *= inv;
            u32x4 r;
#pragma unroll
            for (int j = 0; j < 4; ++j) r[j] = pk2(w0 * bflo(a0[k][j]) + w1 * bflo(a1[k][j]) + w2 * bflo(a2[k][j]), w0 * bfhi(a0[k][j]) + w1 * bfhi(a1[k][j]) + w2 * bfhi(a2[k][j]));
            *(u32x4*)(oc + row * 512 + ch * 8) = r; } }
    }
}
__device__ __forceinline__ void prep_b(const Args& a, int Gn, int cid) {
    unsigned char* ws = a.ws;
    int tid = threadIdx.x; asm volatile("" : "+v"(tid)); const int lane = tid & 63, wid = __builtin_amdgcn_readfirstlane(tid >> 6);
    bf16* Q = (bf16*)(ws + R_B_Q); const bf16* KV = (const bf16*)(ws + R_B_KV); const bf16* KPE = (const bf16*)(ws + R_B_KPE); bf16* KH = (bf16*)(ws + R_B_KH);
    const float* rope = (const float*)(ws + WS_ROPE);
    const int sub = lane >> 4, c = lane & 15;
    const float qscale = 0.10206207261596577f * LOG2E;
    const int gw = cid * 8 + wid, NGW = Gn * 8;
    const int TOT = 2 * M_ * 4;
    for (int it0 = M_ * 4 + gw; it0 < TOT; it0 += 4 * NGW) {
        u32x4 raw[4];
#pragma unroll
        for (int k = 0; k < 4; ++k) {
            const int it = it0 + k * NGW;
            raw[k] = (u32x4){0u, 0u, 0u, 0u};
            if (it < TOT && c < 12) {
                const bool isk = it >= M_ * 4; const int it2 = isk ? it - M_ * 4 : it;
                const int task = it2 * 4 + sub; const size_t row = (size_t)(task >> 4); const int h = task & 15;
                if (!isk) raw[k] = *(const u32x4*)(Q + row * 1536 + h * 96 + 8 * c);
                else if (c < 8) raw[k] = *(const u32x4*)(KV + row * 2048 + h * 128 + 8 * c);
                else raw[k] = *(const u32x4*)(KPE + row * 64 + 8 * (c - 8));
            }
        }
#pragma unroll
        for (int k = 0; k < 4; ++k) {
            const int it = it0 + k * NGW;
            if (it < TOT) {
                const bool isk = it >= M_ * 4; const int it2 = isk ? it - M_ * 4 : it;
                const int task = it2 * 4 + sub; const size_t row = (size_t)(task >> 4); const int h = task & 15; const int pos = (int)(row & 2047);
                float x[8];
#pragma unroll
                for (int j = 0; j < 4; ++j) { x[2 * j] = bflo(raw[k][j]); x[2 * j + 1] = bfhi(raw[k][j]); }
                float ss = 0.f;
#pragma unroll
                for (int e = 0; e < 8; ++e) ss += x[e] * x[e];
                ss += __shfl_xor(ss, 1); ss += __shfl_xor(ss, 2); ss += __shfl_xor(ss, 4); ss += __shfl_xor(ss, 8);
                const float rs = rsqrtf(ss * (1.0f / 96.0f) + EPS);
                const float* gain = (isk ? a.in[14] : a.in[13]) + 8 * (c < 12 ? c : 0);
                const float* cs = rope + ((size_t)pos * 16 + (c & 1) * 8) * 2;
                float y[8];
#pragma unroll
                for (int e = 0; e < 8; ++e) y[e] = x[e] * rs * gain[e];
#pragma unroll
                for (int e = 0; e < 8; ++e) {
                    const float z = __shfl_xor(y[e], 2);
                    if (c >= 8 && c < 12) { const float co = cs[2 * e], si = cs[2 * e + 1]; y[e] = (c < 10) ? (y[e] * co - z * si) : (y[e] * co + z * si); }
                }
                if (c < 12) {
                    u32x4 w;
                    if (!isk) {
#pragma unroll
                        for (int j = 0; j < 4; ++j) w[j] = pk2(y[2 * j] * qscale, y[2 * j + 1] * qscale);
                        *(u32x4*)(Q + row * 1536 + h * 96 + 8 * c) = w;
                    } else {
#pragma unroll
                        for (int j = 0; j < 4; ++j) w[j] = pk2(y[2 * j], y[2 * j + 1]);
                        *(u32x4*)(KH + row * 1536 + h * 96 + 8 * c) = w;
                    }
                }
            }
        }
    }
}

__device__ __forceinline__ void fixup_ffn(const bf16* gedge, const bf16* uedge, bf16* act, const float* cw, const float* cb, int Gn, int cid) {
    int tid = threadIdx.x; asm volatile("" : "+v"(tid));
    const int TOT = 1024 * 2 * 352;
    for (int idx = cid * 512 + tid; idx < TOT; idx += Gn * 512) {
        const int ch = idx % 352, sj = idx / 352, j = sj & 1, st = sj >> 1, c0 = ch * 8;
        const int row = st * 64 + j, t = row & (SEQ - 1);
        const u32x4 z = (u32x4){0u, 0u, 0u, 0u};
        const u32x4 g0 = *(const u32x4*)(gedge + ((size_t)st * 4 + j) * DFF + c0);
        u32x4 g1, g2;
        if (j == 0) { g1 = t >= 1 ? *(const u32x4*)(gedge + ((size_t)(st - 1) * 4 + 3) * DFF + c0) : z; g2 = t >= 2 ? *(const u32x4*)(gedge + ((size_t)(st - 1) * 4 + 2) * DFF + c0) : z; }
        else { g1 = *(const u32x4*)(gedge + ((size_t)st * 4 + 0) * DFF + c0); g2 = t >= 2 ? *(const u32x4*)(gedge + ((size_t)(st - 1) * 4 + 3) * DFF + c0) : z; }
        const u32x4 uw = *(const u32x4*)(uedge + ((size_t)st * 2 + j) * DFF + c0);
        u32x4 w;
#pragma unroll
        for (int n = 0; n < 2; ++n) {
            const f32x4 w0 = *(const f32x4*)(cw + c0 + 4 * n), w1 = *(const f32x4*)(cw + DFF + c0 + 4 * n), w2 = *(const f32x4*)(cw + 2 * DFF + c0 + 4 * n), b = *(const f32x4*)(cb + c0 + 4 * n);
            float r[4];
#pragma unroll
            for (int e = 0; e < 4; ++e) {
                const unsigned q0 = g0[2 * n + (e >> 1)], q1 = g1[2 * n + (e >> 1)], q2 = g2[2 * n + (e >> 1)], qu = uw[2 * n + (e >> 1)];
                const float x0 = (e & 1) ? bfhi(q0) : bflo(q0), x1 = (e & 1) ? bfhi(q1) : bflo(q1), x2 = (e & 1) ? bfhi(q2) : bflo(q2), up = (e & 1) ? bfhi(qu) : bflo(qu);
                const float cv = b[e] + w2[e] * x0 + w1[e] * x1 + w0[e] * x2;
                r[e] = cv * __builtin_amdgcn_rcpf(1.0f + __builtin_amdgcn_exp2f(-LOG2E * cv)) * up;
            }
            w[2 * n] = pk2(r[0], r[1]); w[2 * n + 1] = pk2(r[2], r[3]);
        }
        *(u32x4*)(act + (size_t)row * DFF + c0) = w;
    }
}
__device__ __forceinline__ void rstd_pass(const float* ssp, int nvec, float invdim, float* rs, int Gn, int cid) {
    int tid = threadIdx.x; asm volatile("" : "+v"(tid));
    for (int row = cid * 512 + tid; row < M_; row += Gn * 512) rs[row] = rsqrtf(rowss_sum(ssp, nvec, row) * invdim + EPS);
}
__device__ __forceinline__ void kpe_pass(const Args& a, int Gn, int cid) {
    unsigned char* ws = a.ws;
    int tid = threadIdx.x; asm volatile("" : "+v"(tid));
    const bf16* KPE = (const bf16*)(ws + R_B_KPE); bf16* RK = (bf16*)(ws + R_B_RK); float* sspe = (float*)(ws + WS_SSPE);
    const float* rope = (const float*)(ws + WS_ROPE); const float* gk = a.in[14] + 64;
    for (int row = cid * 512 + tid; row < M_; row += Gn * 512) {
        float x[32]; float ss = 0.f;
#pragma unroll
        for (int c = 0; c < 4; ++c) { const u32x4 raw = *(const u32x4*)(KPE + (size_t)row * 64 + 8 * c);
#pragma unroll
            for (int j = 0; j < 4; ++j) { x[8 * c + 2 * j] = bflo(raw[j]); x[8 * c + 2 * j + 1] = bfhi(raw[j]); } }
#pragma unroll
        for (int i = 0; i < 32; ++i) { ss += x[i] * x[i]; x[i] *= gk[i]; }
        sspe[row] = ss;
        const float* cs = rope + (size_t)(row & (SEQ - 1)) * 32;
#pragma unroll
        for (int i = 0; i < 16; ++i) { const float co = cs[2 * i], si = cs[2 * i + 1], x1 = x[i], x2 = x[16 + i]; x[i] = x1 * co - x2 * si; x[16 + i] = x2 * co + x1 * si; }
#pragma unroll
        for (int c = 0; c < 4; ++c) { u32x4 w;
#pragma unroll
            for (int j = 0; j < 4; ++j) w[j] = pk2(x[8 * c + 2 * j], x[8 * c + 2 * j + 1]);
            *(u32x4*)(RK + (size_t)row * 32 + 8 * c) = w; }
    }
}
__device__ __forceinline__ void rstd_local(const float* ssp, float* rs, const pg8::StaticOrder& S, int nunits) {
    int tid = threadIdx.x; asm volatile("" : "+v"(tid));
    const int TOT = nunits * 256;
    for (int k0 = tid; k0 < TOT; k0 += 2 * 512) {
        float p[2][16]; int rows[2];
#pragma unroll
        for (int j = 0; j < 2; ++j) { const int k = k0 + j * 512; rows[j] = -1;
            if (k < TOT) { pg8::Unit uu; S.next(k >> 8, uu); rows[j] = uu.pm * 256 + (k & 255);
#pragma unroll
                for (int v = 0; v < 16; ++v) p[j][v] = ssp[(size_t)v * M_ + rows[j]]; } }
#pragma unroll
        for (int j = 0; j < 2; ++j) if (rows[j] >= 0) { float t = 0.f;
#pragma unroll
            for (int v = 0; v < 16; v += 4) t += (p[j][v] + p[j][v + 1]) + (p[j][v + 2] + p[j][v + 3]);
            rs[rows[j]] = rsqrtf(t * (1.0f / 1024.0f) + EPS); }
    }
    asm volatile("s_waitcnt vmcnt(0)" ::: "memory");
    __syncthreads();
}
__device__ __forceinline__ void grid_barrier(unsigned* cnt, unsigned& epoch, unsigned G) {
    asm volatile("s_waitcnt vmcnt(0) lgkmcnt(0)" ::: "memory");
    __syncthreads();
    epoch += 1u;
    if (threadIdx.x == 0) {
        __builtin_amdgcn_fence(__ATOMIC_RELEASE, "agent");
        asm volatile("s_waitcnt vmcnt(0)" ::: "memory");
        __hip_atomic_fetch_add(cnt + 64u * (blockIdx.x & 15u), 1u, __ATOMIC_RELAXED, __HIP_MEMORY_SCOPE_AGENT);
        const unsigned want = epoch * G;
        for (;;) {
            unsigned sum = 0u;
#pragma unroll
            for (unsigned j = 0; j < 16u; ++j) sum += __hip_atomic_load(cnt + 64u * j, __ATOMIC_RELAXED, __HIP_MEMORY_SCOPE_AGENT);
            if (sum >= want) break;
            __builtin_amdgcn_s_sleep(8);
        }
        __builtin_amdgcn_fence(__ATOMIC_ACQUIRE, "agent");
        asm volatile("s_waitcnt vmcnt(0)" ::: "memory");
    }
    __syncthreads();
}
__global__ void __launch_bounds__(512) fwd_kernel(Args a) {
    extern __shared__ __attribute__((aligned(16))) unsigned char lds_raw[];
    LAS unsigned char* lds = (LAS unsigned char*)lds_raw;
    cg::grid_group grid = cg::this_grid();
    const int Gn = (int)gridDim.x, cid = (int)blockIdx.x;
    unsigned char* ws = a.ws;
    unsigned* barcnt = (unsigned*)(ws + WS_BAR); unsigned epoch = 0u;
    prologue(lds, a, Gn, cid);
    grid.sync();
    grid_barrier(barcnt, epoch, (unsigned)Gn);
    bf16* XB = (bf16*)(ws + WS_XB);
    float* RSS = (float*)(ws + WS_RSSP); float* RSTD = (float*)(ws + WS_RSS);
    for (int ph = 0; ph < 28; ++ph) {
        int type = 0, N = 1024, K = 1024, ldc = 0, hm = 0, layer = 0, sidx = 0, nvec = 4, pbuf = -1;
        const bf16 *A = XB, *Bt = nullptr; bf16* pO = nullptr; const float* pss = RSTD; const float *gq = nullptr, *gk = nullptr; float qs = 0.125f * LOG2E;
        const float* rbase = nullptr; float* rout = nullptr; bf16* rxb = XB; float* rssn = nullptr;
        int f = -1;
        switch (ph) {
        case 0: type = 0; Bt = (const bf16*)(ws + W_AIN); N = 4608; pO = (bf16*)(ws + R_A_QKV); ldc = 4608; hm = 1; gq = a.in[5]; gk = a.in[6]; break;
        case 1: type = 4; break;
        case 2: type = 8; break;
        case 3: type = 1; A = (const bf16*)(ws + R_A_OC); Bt = (const bf16*)(ws + W_AOUT); K = 512; rbase = a.in[0]; rssn = RSS + 1 * (size_t)M_ * 16; break;
        case 4: case 5: case 6: layer = 0; sidx = 1; f = ph - 4; break;
        case 7: type = 2; Bt = (const bf16*)(ws + W_BIN); N = 768; pbuf = 0; break;
        case 8: type = 0; A = (const bf16*)(ws + R_B_CQ); Bt = (const bf16*)(ws + W_BQUP); N = 1536; K = 384; pO = (bf16*)(ws + R_B_Q); ldc = 1536; pss = (const float*)(ws + WS_SSQ); break;
        case 9: type = 10; break;
        case 10: type = 10; break;
        case 11: type = 5; break;
        case 12: type = 1; A = (const bf16*)(ws + R_B_O); Bt = (const bf16*)(ws + W_BOUT); rssn = RSS + 1 * (size_t)M_ * 16; break;
        case 13: case 14: case 15: layer = 1; sidx = 3; f = ph - 13; break;
        case 16: type = 0; Bt = (const bf16*)(ws + W_CIN); N = 3072; pO = (bf16*)(ws + R_C_QKV); ldc = 3072; pbuf = 0; hm = 2; gq = a.in[17]; gk = a.in[18]; break;
        case 17: type = 6; break;
        case 18: type = 1; A = (const bf16*)(ws + R_C_O); Bt = (const bf16*)(ws + W_COUT); rssn = RSS + 1 * (size_t)M_ * 16; break;
        case 19: case 20: case 21: layer = 2; sidx = 5; f = ph - 19; break;
        case 22: type = 0; Bt = (const bf16*)(ws + W_DIN); N = 1280; pO = (bf16*)(ws + R_D_QKV); ldc = 1280; pbuf = 0; hm = 3; gq = a.in[26]; gk = a.in[27]; break;
        case 23: type = 7; break;
        case 24: type = 1; A = (const bf16*)(ws + R_D_O); Bt = (const bf16*)(ws + W_DOUT); rssn = RSS + 1 * (size_t)M_ * 16; break;
        default: layer = 3; sidx = 7; f = ph - 25; break;
        }
        if (f == 0) { type = 3; Bt = (const bf16*)(ws + W_FG + layer * 2 * W_FSTR); N = 2 * DFF; pbuf = 1; }
        else if (f == 1) { type = 11; }
        else if (f == 2) { type = 1; A = (const bf16*)(ws + R_ACT); Bt = (const bf16*)(ws + W_FD + layer * W_FSTR); K = DFF;
            if (layer < 3) { rssn = RSS + ((sidx + 1) & 1) * (size_t)M_ * 16; } else { rssn = nullptr; rxb = nullptr; rout = a.out; } }

        if (type == 10) continue;
        if (type <= 3) {
            pg8::Gemm g{A, Bt, M_, N, K}; pg8::StaticOrder S; S.init(M_, N, Gn, cid);
            if (pbuf >= 0) rstd_local(RSS + (size_t)pbuf * M_ * 16, RSTD, S, (S.nwg - cid + Gn - 1) / Gn);
            if (type == 0) {
                for (int sub = 0; sub < (ph == 8 ? 2 : 1); ++sub) {
                    const bool kv = (sub == 1);
                    const pg8::Gemm g2{kv ? (const bf16*)(ws + R_B_CKV) : A, kv ? (const bf16*)(ws + W_BKVUP) : Bt, M_, kv ? 2048 : N, kv ? 256 : K};
                    pg8::StaticOrder S2; S2.init(M_, kv ? 2048 : N, Gn, cid);
                    const EpiProj E{kv ? (bf16*)(ws + R_B_KV) : pO, kv ? 2048 : ldc, kv ? (const float*)(ws + WS_SSKV) : pss, kv ? 4 : hm, gq, kv ? a.in[14] : gk, qs};
                    pg8::gemm_phase<EpiProj, pg8::StaticOrder, true, true>(lds, g2, S2, E);
                }
            }
            else if (type == 1) { EpiRes E{rbase, rout, XB, rxb, rssn}; pg8::gemm_phase<EpiRes, pg8::StaticOrder, true, true>(lds, g, S, E); }
            else if (type == 2) { EpiLat E{(bf16*)(ws + R_B_CQ), (bf16*)(ws + R_B_CKV), (bf16*)(ws + R_B_KPE), pss, (float*)(ws + WS_SSQP), (float*)(ws + WS_SSKVP)}; pg8::gemm_phase<EpiLat, pg8::StaticOrder, true, true>(lds, g, S, E); }
            else { EpiGateUp E{(bf16*)(ws + R_ACT), (bf16*)(ws + R_GATE), (bf16*)(ws + R_GATE + 32 * MiB), pss, a.in[31] + (size_t)layer * 3 * DFF, a.in[32] + (size_t)layer * DFF}; pg8::gemm_phase<EpiGateUp, pg8::StaticOrder, true, true>(lds, g, S, E); }
        }
        else if (type == 4) attn_phase<0>(lds, a, Gn, cid);
        else if (type == 5) attn_phase<1>(lds, a, Gn, cid);
        else if (type == 6) attn_phase<2>(lds, a, Gn, cid);
        else if (type == 7) attn_phase<3>(lds, a, Gn, cid);
        else if (type == 8) combine_a(a, Gn, cid);
        else if (type == 11) fixup_ffn((const bf16*)(ws + R_GATE), (const bf16*)(ws + R_GATE + 32 * MiB), (bf16*)(ws + R_ACT), a.in[31] + (size_t)layer * 3 * DFF, a.in[32] + (size_t)layer * DFF, Gn, cid);
        else prep_b(a, Gn, cid);
        grid_barrier(barcnt, epoch, (unsigned)Gn);
        if (type == 2) { rstd_pass((const float*)(ws + WS_SSQP), 2, 1.0f / 384.0f, (float*)(ws + WS_SSQ), Gn, cid); rstd_pass((const float*)(ws + WS_SSKVP), 1, 1.0f / 256.0f, (float*)(ws + WS_SSKV), Gn, cid); kpe_pass(a, Gn, cid);
            grid_barrier(barcnt, epoch, (unsigned)Gn); }
    }
}

extern "C" void kernel_launch(void* const* d_in, const int* in_sizes, int n_in, void* d_out, int out_size, void* d_ws, size_t ws_size, hipStream_t stream) {
    static int grid = 0;
    if (grid == 0) {
        if (n_in != 34 || out_size != M_ * DMODEL || ws_size < WS_NEED) { fprintf(stderr, "kernel_launch: unexpected shapes (n_in %d out %d ws %zu)\n", n_in, out_size, ws_size); grid = -1; return; }
        int dev = 0, cus = 0, per_cu = 0;
        if (hipGetDevice(&dev) != hipSuccess || hipDeviceGetAttribute(&cus, hipDeviceAttributeMultiprocessorCount, dev) != hipSuccess) { grid = -1; return; }
        if (hipFuncSetAttribute((const void*)fwd_kernel, hipFuncAttributeMaxDynamicSharedMemorySize, LDS_BYTES) != hipSuccess) { fprintf(stderr, "kernel_launch: hipFuncSetAttribute failed\n"); grid = -1; return; }
        if (hipOccupancyMaxActiveBlocksPerMultiprocessor(&per_cu, (const void*)fwd_kernel, 512, LDS_BYTES) != hipSuccess || per_cu < 1) { fprintf(stderr, "kernel_launch: occupancy query says %d\n", per_cu); per_cu = 1; }
        (void)hipGetLastError();
        grid = cus;
    }
    if (grid < 0) return;
    if (hipMemsetAsync((unsigned char*)d_ws + WS_BAR, 0, 4096, stream) != hipSuccess) { fprintf(stderr, "kernel_launch: memset failed\n"); return; }
    Args a{};
    for (int i = 0; i < 34; ++i) a.in[i] = (const float*)d_in[i];
    a.out = (float*)d_out; a.ws = (unsigned char*)d_ws;
    void* args[] = {&a};
    hipError_t e = hipLaunchCooperativeKernel((const void*)fwd_kernel, dim3(grid), dim3(512), args, LDS_BYTES, stream);
    if (e != hipSuccess) fprintf(stderr, "cooperative launch failed: %s (grid %d)\n", hipGetErrorString(e), grid);
}
```
